# Optimizing an MI355X kernel written in HIP

```python
import math
import jax, jax.numpy as jnp
from jax import lax
import numpy as np

D_MODEL = 2048
BATCH = 4
SEQ = 2048
DEPTH = 4

N_EVEN = (DEPTH + 1) // 2
N_ODD = DEPTH // 2
BLOCK = 128
ROPE_THETA = 10000.0
NORM_EPS = 1e-6

A_HEAD_DIM = 128
A_HEADS = D_MODEL // 2 // A_HEAD_DIM
A_WIDTH = A_HEADS * A_HEAD_DIM
A_PATTERNS = ((128, 1), (512, 4), (2048, 16))
B_WIDTH = D_MODEL // 2
B_BLOCKS = 8
B_BLOCK_DIM = B_WIDTH // B_BLOCKS
B_CONV = 4
LRU_C = 8.0
EVEN_IN = 3 * A_WIDTH + 2 * B_WIDTH
EVEN_MIX = A_WIDTH + B_WIDTH

C_HEAD_DIM = 64
C_HEADS = D_MODEL // 2 // C_HEAD_DIM
C_KV_HEADS = C_HEADS // 8
C_GROUP = C_HEADS // C_KV_HEADS
C_WIDTH = C_HEADS * C_HEAD_DIM
C_KV_WIDTH = C_KV_HEADS * C_HEAD_DIM
C_WINDOW = 128
D_WIDTH = D_MODEL // 2
D_GROUP_DIM = 16
D_GROUPS = D_WIDTH // D_GROUP_DIM
D_STATE = 64
ODD_IN = C_WIDTH + 2 * C_KV_WIDTH + D_WIDTH
ODD_MIX = C_WIDTH + D_WIDTH

D_FF = ((8 * D_MODEL // 3 + 127) // 128) * 128
FFN_CONV = 3

kernel_name = 'hybrid_dilated_lru_swa_s5_trunk'

F32 = jnp.float32


def rmsnorm(x, g):
    x32 = x.astype(F32)
    y = x32 * lax.rsqrt(jnp.mean(x32 * x32, axis=-1, keepdims=True) + NORM_EPS)
    return (y * g.astype(F32)).astype(x.dtype)


def modulate(h, shift, scale):
    return (h.astype(F32) * (1.0 + scale[:, None]) + shift[:, None]).astype(h.dtype)


def rope(x, positions):
    half = x.shape[-1] // 2
    inv = ROPE_THETA ** (-jnp.arange(half, dtype=F32) / half)
    ang = positions.astype(F32)[..., None] * inv
    cos, sin = jnp.cos(ang)[:, :, None, :], jnp.sin(ang)[:, :, None, :]
    x1, x2 = x[..., :half].astype(F32), x[..., half:].astype(F32)
    return jnp.concatenate([x1 * cos - x2 * sin, x2 * cos + x1 * sin], axis=-1)


def causal_dwconv(x, w, b):
    k, s = w.shape[0], x.shape[1]
    xp = jnp.pad(x, ((0, 0), (k - 1, 0), (0, 0)))
    out = b
    for i in range(k):
        out = out + w[i] * xp[:, i:i + s]
    return out


def linear_scan(a, b):
    def combine(l, r):
        al, bl = l
        ar, br = r
        return ar * al, ar * bl + br
    _, h = lax.associative_scan(combine, (a, b), axis=1)
    return h


def banded_window_attention(q, k, v, max_dist):
    n, r, l, dh = q.shape
    blk = min(BLOCK, l)
    nb = l // blk
    pad = -(-max_dist // blk) * blk
    span = pad + blk
    kp = jnp.pad(k.astype(F32), ((0, 0), (pad, 0), (0, 0)))
    vp = jnp.pad(v.astype(F32), ((0, 0), (pad, 0), (0, 0)))
    idx = jnp.arange(nb)[:, None] * blk + jnp.arange(span)[None, :]
    kb, vb = kp[:, idx], vp[:, idx]
    qb = q.astype(F32).reshape(n, r, nb, blk, dh)
    s = jnp.einsum('nrbqd,nbkd->nrbqk', qb, kb) * (dh ** -0.5)
    qi = jnp.arange(blk)[:, None]
    kj = jnp.arange(span)[None, :]
    dist = qi + pad - kj
    kpos = jnp.arange(nb)[:, None, None] * blk + kj[None] - pad
    valid = (dist >= 0) & (dist <= max_dist) & (kpos >= 0)
    s = jnp.where(valid, s, -jnp.inf)
    m = jnp.max(s, axis=-1, keepdims=True)
    p = jnp.exp(s - m)
    den = jnp.sum(p, axis=-1)
    o = jnp.einsum('nrbqk,nbkd->nrbqd', p, vb) / den[..., None]
    lse = m[..., 0] + jnp.log(den)
    return o.reshape(n, r, l, dh), lse.reshape(n, r, l)


def dilated_window_attention(q, k, v):
    b, s, h, dh = q.shape
    outs, lses = [], []
    for window, dil in A_PATTERNS:
        l = s // dil
        def to_sub(t):
            return t.reshape(b, l, dil, h, dh).transpose(0, 2, 3, 1, 4).reshape(b * dil * h, l, dh)
        o, lse = banded_window_attention(to_sub(q)[:, None], to_sub(k), to_sub(v), window // dil)
        outs.append(o.reshape(b, dil, h, l, dh).transpose(0, 3, 1, 2, 4).reshape(b, s, h, dh))
        lses.append(lse.reshape(b, dil, h, l).transpose(0, 3, 1, 2).reshape(b, s, h))
    w = jax.nn.softmax(jnp.stack(lses, axis=0), axis=0)
    return jnp.einsum('pbsh,pbshd->bshd', w, jnp.stack(outs, axis=0))


def rg_lru(xb, conv_w, conv_b, ga_w, ga_b, gx_w, gx_b, lam):
    b, s, _ = xb.shape
    xc = causal_dwconv(xb.astype(F32), conv_w.astype(F32), conv_b.astype(F32))
    xh = xc.reshape(b, s, B_BLOCKS, B_BLOCK_DIM)
    r = jax.nn.sigmoid(jnp.einsum('bshi,hij->bshj', xh, ga_w.astype(F32)).reshape(b, s, B_WIDTH) + ga_b.astype(F32))
    i = jax.nn.sigmoid(jnp.einsum('bshi,hij->bshj', xh, gx_w.astype(F32)).reshape(b, s, B_WIDTH) + gx_b.astype(F32))
    log_a = -LRU_C * r * jax.nn.softplus(-lam.astype(F32))
    a = jnp.exp(log_a)
    mult = jnp.sqrt(-jnp.expm1(2.0 * log_a))
    return linear_scan(a, mult * (i * xc))


def sink_window_attention(q, k, v, sinks):
    b, s, _, dh = q.shape
    qg = q.reshape(b, s, C_KV_HEADS, C_GROUP, dh).transpose(0, 2, 3, 1, 4).reshape(b * C_KV_HEADS, C_GROUP, s, dh)
    kg = k.transpose(0, 2, 1, 3).reshape(b * C_KV_HEADS, s, dh)
    vg = v.transpose(0, 2, 1, 3).reshape(b * C_KV_HEADS, s, dh)
    o, lse = banded_window_attention(qg, kg, vg, C_WINDOW - 1)
    sink = sinks.astype(F32).reshape(1, C_KV_HEADS, C_GROUP, 1)
    keep = jax.nn.sigmoid(lse.reshape(b, C_KV_HEADS, C_GROUP, s) - sink)
    o = o.reshape(b, C_KV_HEADS, C_GROUP, s, dh) * keep[..., None]
    return o.transpose(0, 3, 1, 2, 4).reshape(b, s, C_WIDTH)


def s5_ssm(u, a_re, a_im, b_re, b_im, c_re, c_im, d_skip, log_dt, glu_w, glu_b):
    b, s, _ = u.shape
    u32 = u.astype(F32).reshape(b, s, D_GROUPS, D_GROUP_DIM)
    lam = lax.complex(a_re.astype(F32), a_im.astype(F32))
    dt = jnp.exp(log_dt.astype(F32))[:, None]
    a_bar = jnp.exp(lam * dt)
    b_mat = lax.complex(b_re.astype(F32), b_im.astype(F32))
    b_bar = ((a_bar - 1.0) / lam)[..., None] * b_mat
    bu = jnp.einsum('bsgc,gpc->bsgp', u32.astype(jnp.complex64), b_bar)
    state = linear_scan(jnp.broadcast_to(a_bar, bu.shape), bu)
    c_mat = lax.complex(c_re.astype(F32), c_im.astype(F32))
    y = jnp.einsum('bsgp,gcp->bsgc', state, c_mat).real + d_skip.astype(F32).reshape(D_GROUPS, D_GROUP_DIM) * u32
    z = jax.nn.gelu(y.reshape(b, s, D_WIDTH))
    return z * jax.nn.sigmoid(z @ glu_w.astype(F32) + glu_b.astype(F32))


def even_mixer(h, positions, w_in, conv_w, conv_b, ga_w, ga_b, gx_w, gx_b, lam, w_out):
    b, s, _ = h.shape
    proj = h @ w_in
    q, k, v, xb, yb = jnp.split(proj, [A_WIDTH, 2 * A_WIDTH, 3 * A_WIDTH, 3 * A_WIDTH + B_WIDTH], axis=-1)
    q = rope(q.reshape(b, s, A_HEADS, A_HEAD_DIM), positions)
    k = rope(k.reshape(b, s, A_HEADS, A_HEAD_DIM), positions)
    attn = dilated_window_attention(q, k, v.reshape(b, s, A_HEADS, A_HEAD_DIM)).reshape(b, s, A_WIDTH)
    lru = rg_lru(xb, conv_w, conv_b, ga_w, ga_b, gx_w, gx_b, lam) * jax.nn.gelu(yb.astype(F32))
    return jnp.concatenate([attn, lru], axis=-1).astype(h.dtype) @ w_out


def odd_mixer(h, positions, w_in, sinks, a_re, a_im, b_re, b_im, c_re, c_im, d_skip, log_dt, glu_w, glu_b, w_out):
    b, s, _ = h.shape
    proj = h @ w_in
    q, k, v, u = jnp.split(proj, [C_WIDTH, C_WIDTH + C_KV_WIDTH, C_WIDTH + 2 * C_KV_WIDTH], axis=-1)
    q = rope(q.reshape(b, s, C_HEADS, C_HEAD_DIM), positions)
    k = rope(k.reshape(b, s, C_KV_HEADS, C_HEAD_DIM), positions)
    attn = sink_window_attention(q, k, v.reshape(b, s, C_KV_HEADS, C_HEAD_DIM), sinks)
    ssm = s5_ssm(u, a_re, a_im, b_re, b_im, c_re, c_im, d_skip, log_dt, glu_w, glu_b)
    return jnp.concatenate([attn, ssm], axis=-1).astype(h.dtype) @ w_out


def conv_ffn(h, w_in, conv_w, conv_b, w_out):
    u = causal_dwconv((h @ w_in).astype(F32), conv_w.astype(F32), conv_b.astype(F32))
    g, v = jnp.split(u, 2, axis=-1)
    return (jax.nn.gelu(g) * v).astype(h.dtype) @ w_out


def setup_inputs(seed: int = 0) -> dict:
    key = jax.random.key(seed)
    ks = iter(jax.random.split(key, 48))

    def nrm(shape, scale):
        return scale * jax.random.normal(next(ks), shape, F32)

    def unif(shape, lo, hi):
        return jax.random.uniform(next(ks), shape, F32, lo, hi)

    x = nrm((BATCH, SEQ, D_MODEL), 1.0)
    c = nrm((BATCH, D_MODEL), 1.0)
    positions = (jax.random.randint(next(ks), (BATCH, 1), 0, 1024, dtype=jnp.int32)
                 + jnp.arange(SEQ, dtype=jnp.int32)[None, :])
    gate_offset = jnp.repeat(jnp.array([0.0, 0.0, 1.0, 0.0, 0.0, 1.0], F32), D_MODEL)
    ada_w = nrm((DEPTH, D_MODEL, 6 * D_MODEL), 0.1 * D_MODEL ** -0.5)
    ada_b = nrm((DEPTH, 6 * D_MODEL), 0.02) + gate_offset
    norm_mix = 1.0 + nrm((DEPTH, D_MODEL), 0.05)
    norm_ffn = 1.0 + nrm((DEPTH, D_MODEL), 0.05)
    norm_final = 1.0 + nrm((D_MODEL,), 0.05)

    ev_w_in = nrm((N_EVEN, D_MODEL, EVEN_IN), D_MODEL ** -0.5)
    ev_conv_w = nrm((N_EVEN, B_CONV, B_WIDTH), B_CONV ** -0.5)
    ev_conv_b = nrm((N_EVEN, B_WIDTH), 0.02)
    ev_gate_a_w = nrm((N_EVEN, B_BLOCKS, B_BLOCK_DIM, B_BLOCK_DIM), B_BLOCK_DIM ** -0.5)
    ev_gate_a_b = nrm((N_EVEN, B_WIDTH), 0.02)
    ev_gate_x_w = nrm((N_EVEN, B_BLOCKS, B_BLOCK_DIM, B_BLOCK_DIM), B_BLOCK_DIM ** -0.5)
    ev_gate_x_b = nrm((N_EVEN, B_WIDTH), 0.02)
    a_pow_c = unif((N_EVEN, B_WIDTH), 0.9, 0.999)
    a_base = a_pow_c ** (1.0 / LRU_C)
    ev_lambda = jnp.log(a_base) - jnp.log1p(-a_base)
    ev_w_out = nrm((N_EVEN, EVEN_MIX, D_MODEL), EVEN_MIX ** -0.5)

    od_w_in = nrm((N_ODD, D_MODEL, ODD_IN), D_MODEL ** -0.5)
    od_sinks = 3.0 + nrm((N_ODD, C_HEADS), 1.0)
    od_a_re = -0.5 + nrm((N_ODD, D_GROUPS, D_STATE), 0.01)
    od_a_im = math.pi * jnp.arange(D_STATE, dtype=F32) + nrm((N_ODD, D_GROUPS, D_STATE), 0.01)
    od_b_re = nrm((N_ODD, D_GROUPS, D_STATE, D_GROUP_DIM), (2.0 * D_GROUP_DIM) ** -0.5)
    od_b_im = nrm((N_ODD, D_GROUPS, D_STATE, D_GROUP_DIM), (2.0 * D_GROUP_DIM) ** -0.5)
    od_c_re = nrm((N_ODD, D_GROUPS, D_GROUP_DIM, D_STATE), (2.0 * D_STATE) ** -0.5)
    od_c_im = nrm((N_ODD, D_GROUPS, D_GROUP_DIM, D_STATE), (2.0 * D_STATE) ** -0.5)
    od_d = nrm((N_ODD, D_WIDTH), 0.5)
    od_log_dt = unif((N_ODD, D_GROUPS), math.log(1e-3), math.log(1e-1))
    od_glu_w = nrm((N_ODD, D_WIDTH, D_WIDTH), D_WIDTH ** -0.5)
    od_glu_b = nrm((N_ODD, D_WIDTH), 0.02)
    od_w_out = nrm((N_ODD, ODD_MIX, D_MODEL), ODD_MIX ** -0.5)

    ffn_w_in = nrm((DEPTH, D_MODEL, 2 * D_FF), D_MODEL ** -0.5)
    ffn_conv_w = nrm((DEPTH, FFN_CONV, 2 * D_FF), FFN_CONV ** -0.5)
    ffn_conv_b = nrm((DEPTH, 2 * D_FF), 0.02)
    ffn_w_out = nrm((DEPTH, D_FF, D_MODEL), D_FF ** -0.5)

    return {'x': x, 'c': c, 'positions': positions,
            'ada_w': ada_w, 'ada_b': ada_b, 'norm_mix': norm_mix, 'norm_ffn': norm_ffn, 'norm_final': norm_final,
            'ev_w_in': ev_w_in, 'ev_conv_w': ev_conv_w, 'ev_conv_b': ev_conv_b,
            'ev_gate_a_w': ev_gate_a_w, 'ev_gate_a_b': ev_gate_a_b, 'ev_gate_x_w': ev_gate_x_w, 'ev_gate_x_b': ev_gate_x_b,
            'ev_lambda': ev_lambda, 'ev_w_out': ev_w_out,
            'od_w_in': od_w_in, 'od_sinks': od_sinks, 'od_a_re': od_a_re, 'od_a_im': od_a_im,
            'od_b_re': od_b_re, 'od_b_im': od_b_im, 'od_c_re': od_c_re, 'od_c_im': od_c_im,
            'od_d': od_d, 'od_log_dt': od_log_dt, 'od_glu_w': od_glu_w, 'od_glu_b': od_glu_b, 'od_w_out': od_w_out,
            'ffn_w_in': ffn_w_in, 'ffn_conv_w': ffn_conv_w, 'ffn_conv_b': ffn_conv_b, 'ffn_w_out': ffn_w_out}


def reference(x, c, positions, ada_w, ada_b, norm_mix, norm_ffn, norm_final,
              ev_w_in, ev_conv_w, ev_conv_b, ev_gate_a_w, ev_gate_a_b, ev_gate_x_w, ev_gate_x_b, ev_lambda, ev_w_out,
              od_w_in, od_sinks, od_a_re, od_a_im, od_b_re, od_b_im, od_c_re, od_c_im, od_d, od_log_dt,
              od_glu_w, od_glu_b, od_w_out,
              ffn_w_in, ffn_conv_w, ffn_conv_b, ffn_w_out):
    cond = jax.nn.silu(c.astype(F32))
    for layer in range(DEPTH):
        mod = cond @ ada_w[layer].astype(F32) + ada_b[layer].astype(F32)
        sh1, sc1, g1, sh2, sc2, g2 = jnp.split(mod, 6, axis=-1)
        h = modulate(rmsnorm(x, norm_mix[layer]), sh1, sc1)
        if layer % 2 == 0:
            e = layer // 2
            y = even_mixer(h, positions, ev_w_in[e], ev_conv_w[e], ev_conv_b[e], ev_gate_a_w[e], ev_gate_a_b[e],
                           ev_gate_x_w[e], ev_gate_x_b[e], ev_lambda[e], ev_w_out[e])
        else:
            o = layer // 2
            y = odd_mixer(h, positions, od_w_in[o], od_sinks[o], od_a_re[o], od_a_im[o], od_b_re[o], od_b_im[o],
                          od_c_re[o], od_c_im[o], od_d[o], od_log_dt[o], od_glu_w[o], od_glu_b[o], od_w_out[o])
        x = x + (g1[:, None] * y.astype(F32)).astype(x.dtype)
        h = modulate(rmsnorm(x, norm_ffn[layer]), sh2, sc2)
        f = conv_ffn(h, ffn_w_in[layer], ffn_conv_w[layer], ffn_conv_b[layer], ffn_w_out[layer])
        x = x + (g2[:, None] * f.astype(F32)).astype(x.dtype)
    return rmsnorm(x, norm_final)
```

```cpp
#include <hip/hip_runtime.h>
#include <cstdio>
#include <cstdint>
namespace pg8 {
#define PG8_LAS __attribute__((address_space(3)))
typedef unsigned short bf16_t;
typedef short bf16x8 __attribute__((ext_vector_type(8)));
typedef float f32x4 __attribute__((ext_vector_type(4)));
typedef unsigned u32x4 __attribute__((ext_vector_type(4)));
constexpr int BM = 256, BK = 64, HALF = 128, HTB = HALF * BK * 2  , STAGE_BYTES = 8 * HTB, NXCD = 8, WGM = 8;

__host__ __device__ __forceinline__ int lds_byte(int r, int c) { const int st = (r >> 4) * 2 + (c >> 5), rr = r & 15, cc = c & 31, ob = rr * 64 + cc * 2; return st * 1024 + (ob ^ (((ob >> 9) & 1) << 5)); }
__host__ __device__ __forceinline__ void stage_rc(int b, int& R, int& C) { const int st = b / 1024, sb = b % 1024, swz = sb ^ (((sb >> 9) & 1) << 5); R = (st >> 1) * 16 + swz / 64; C = (st & 1) * 32 + (swz % 64) / 2; }
__host__ __device__ __forceinline__ int perm32(int rho) { const int n = rho >> 4, i = rho & 15; return 8 * (i >> 2) + 4 * n + (i & 3); }

struct Unit { int pm, pn; };
struct Gemm { const bf16_t* A; const bf16_t* Bt; int M, N, K; };

struct StaticOrder {
    int nM, nN, nwg, G, c;
    __host__ __device__ void init(int M, int N, int G_, int c_) { nM = M / BM; nN = N / BM; nwg = nM * nN; G = G_; c = c_; }
    __host__ __device__ bool next(int i, Unit& u) const {
        const long L = (long)i * G + c; if (L >= nwg) return false;
        int wgid = (int)L; { const int q = nwg / NXCD, r = nwg % NXCD, xcd = wgid % NXCD, off = wgid / NXCD; wgid = (xcd < r ? xcd * (q + 1) : r * (q + 1) + (xcd - r) * q) + off; }
        const int nig = WGM * nN, gid = wgid / nig, fm = gid * WGM, gsz = (nM - fm) < WGM ? (nM - fm) : WGM;
        u.pm = fm + ((wgid % nig) % gsz); u.pn = (wgid % nig) / gsz; return true;
    }
    __device__ __forceinline__ void a_ready(const Unit&) const {}
    __device__ __forceinline__ void done(const Unit&) const {}
};

__device__ __forceinline__ unsigned cvt_pk_bf16(float lo, float hi) { unsigned r; asm volatile("v_cvt_pk_bf16_f32 %0, %1, %2" : "=v"(r) : "v"(lo), "v"(hi)); return r; }
__device__ __forceinline__ u32x4 pack8(const f32x4 a, const f32x4 b) { u32x4 w; w.x = cvt_pk_bf16(a[0], a[1]); w.y = cvt_pk_bf16(a[2], a[3]); w.z = cvt_pk_bf16(b[0], b[1]); w.w = cvt_pk_bf16(b[2], b[3]); return w; }
__device__ __forceinline__ float bf_lo(unsigned w) { return __uint_as_float(w << 16); }
__device__ __forceinline__ float bf_hi(unsigned w) { return __uint_as_float(w & 0xffff0000u); }
__device__ __forceinline__ float gelu_tanh(float x) {
    const float u = x * (0.7978845608f + 0.0356774081f * x * x);
    const float e = __builtin_amdgcn_exp2f(-2.885390082f * u);
    return x * __builtin_amdgcn_rcpf(1.0f + e);
}
__device__ __forceinline__ f32x4 gelu4(const f32x4 v) { return (f32x4){gelu_tanh(v[0]), gelu_tanh(v[1]), gelu_tanh(v[2]), gelu_tanh(v[3])}; }
__device__ __forceinline__ float sigmoidf_fast(float x) { return __builtin_amdgcn_rcpf(1.0f + __builtin_amdgcn_exp2f(-1.4426950409f * x)); }

struct EpiStore {
    static constexpr bool PERM = true, AFTER_DRAIN = false;
    bf16_t* O; int ldc;
    __device__ __forceinline__ void operator()(const f32x4 (&acc)[2][2][4][2], const Unit& u, int wr, int wc, int fr, int fq) const {
        const int row0 = u.pm * BM + wr * 64 + fr, col0 = u.pn * BM + wc * 32 + 8 * fq;
#pragma unroll
        for (int ai = 0; ai < 2; ++ai)
#pragma unroll
            for (int m = 0; m < 4; ++m) { bf16_t* rowp = O + (size_t)(row0 + ai * HALF + m * 16) * ldc + col0;
#pragma unroll
                for (int bj = 0; bj < 2; ++bj) *(u32x4*)(rowp + bj * HALF) = pack8(acc[ai][bj][m][0], acc[ai][bj][m][1]); }
    }
};

struct EpiEvenIn {
    static constexpr bool PERM = true, AFTER_DRAIN = false;
    bf16_t *Q; const float *cosT, *sinT; float qscale;
    __device__ __forceinline__ void operator()(const f32x4 (&acc)[2][2][4][2], const Unit& u, int wr, int wc, int fr, int fq) const {
        const int row0 = u.pm * BM + wr * 64 + fr;
        if (u.pn < 8) {
            bf16_t* dst = Q + (size_t)(u.pn >> 2) * (8u << 20); const float sc = (u.pn < 4) ? qscale : 1.0f;
            const int head = (u.pn & 3) * 2 + (wc >> 1), i0 = (wc & 1) * 32 + 8 * fq;
#pragma unroll
            for (int ai = 0; ai < 2; ++ai)
#pragma unroll
                for (int m = 0; m < 4; ++m) { const int row = row0 + ai * HALF + m * 16;
                    const f32x4 c0 = *(const f32x4*)(cosT + (size_t)row * 64 + i0), c1 = *(const f32x4*)(cosT + (size_t)row * 64 + i0 + 4);
                    const f32x4 s0 = *(const f32x4*)(sinT + (size_t)row * 64 + i0), s1 = *(const f32x4*)(sinT + (size_t)row * 64 + i0 + 4);
                    const f32x4 a0 = acc[ai][0][m][0], a1 = acc[ai][0][m][1], b0 = acc[ai][1][m][0], b1 = acc[ai][1][m][1];
                    const f32x4 o10 = (a0 * c0 - b0 * s0) * sc, o11 = (a1 * c1 - b1 * s1) * sc, o20 = (b0 * c0 + a0 * s0) * sc, o21 = (b1 * c1 + a1 * s1) * sc;
                    bf16_t* rp = dst + (size_t)row * 1024 + head * 128 + i0;
                    *(u32x4*)(rp) = pack8(o10, o11); *(u32x4*)(rp + 64) = pack8(o20, o21); }
        } else {
            const int sel = (u.pn - 8) >> 2; bf16_t* dst = Q + (size_t)(u.pn >> 2) * (8u << 20); const int col0 = (u.pn & 3) * 256 + wc * 32 + 8 * fq;
#pragma unroll
            for (int ai = 0; ai < 2; ++ai)
#pragma unroll
                for (int m = 0; m < 4; ++m) { bf16_t* rowp = dst + (size_t)(row0 + ai * HALF + m * 16) * 1024 + col0;
#pragma unroll
                    for (int bj = 0; bj < 2; ++bj) { f32x4 v0 = acc[ai][bj][m][0], v1 = acc[ai][bj][m][1];
                        if (sel == 2) { v0 = gelu4(v0); v1 = gelu4(v1); }
                        *(u32x4*)(rowp + bj * HALF) = pack8(v0, v1); } }
        }
    }
};

struct EpiOddIn {
    static constexpr bool PERM = true, AFTER_DRAIN = false;
    bf16_t *Q, *K, *V, *U; const float *cosT, *sinT; float qscale;
    __device__ __forceinline__ void operator()(const f32x4 (&acc)[2][2][4][2], const Unit& u, int wr, int wc, int fr, int fq) const {
        const int row0 = u.pm * BM + wr * 64 + fr;
        if (u.pn < 4 || (u.pn == 4 && wc < 2)) {
            const bool isq = u.pn < 4; const float sc = isq ? qscale : 1.0f;
            bf16_t* dst = isq ? Q + (u.pn * 4 + wc) * 64 : K + wc * 64; const int pitch = isq ? 1024 : 128;
#pragma unroll
            for (int ai = 0; ai < 2; ++ai)
#pragma unroll
                for (int m = 0; m < 4; ++m) { const int row = row0 + ai * HALF + m * 16;
                    const f32x4 c0 = *(const f32x4*)(cosT + (size_t)row * 32 + 8 * fq), c1 = *(const f32x4*)(cosT + (size_t)row * 32 + 8 * fq + 4);
                    const f32x4 s0 = *(const f32x4*)(sinT + (size_t)row * 32 + 8 * fq), s1 = *(const f32x4*)(sinT + (size_t)row * 32 + 8 * fq + 4);
                    const f32x4 a0 = acc[ai][0][m][0], a1 = acc[ai][0][m][1], b0 = acc[ai][1][m][0], b1 = acc[ai][1][m][1];
                    const f32x4 o10 = (a0 * c0 - b0 * s0) * sc, o11 = (a1 * c1 - b1 * s1) * sc, o20 = (b0 * c0 + a0 * s0) * sc, o21 = (b1 * c1 + a1 * s1) * sc;
                    bf16_t* rp = dst + (size_t)row * pitch + 8 * fq;
                    *(u32x4*)(rp) = pack8(o10, o11); *(u32x4*)(rp + 32) = pack8(o20, o21); }
        } else if (u.pn == 4) {
#pragma unroll
            for (int ai = 0; ai < 2; ++ai)
#pragma unroll
                for (int m = 0; m < 4; ++m) { bf16_t* rowp = V + (size_t)(row0 + ai * HALF + m * 16) * 128 + (wc - 2) * 32 + 8 * fq;
#pragma unroll
                    for (int bj = 0; bj < 2; ++bj) *(u32x4*)(rowp + bj * 64) = pack8(acc[ai][bj][m][0], acc[ai][bj][m][1]); }
        } else {
            const int col0 = (u.pn - 5) * 256 + wc * 32 + 8 * fq;
#pragma unroll
            for (int ai = 0; ai < 2; ++ai)
#pragma unroll
                for (int m = 0; m < 4; ++m) { bf16_t* rowp = U + (size_t)(row0 + ai * HALF + m * 16) * 1024 + col0;
#pragma unroll
                    for (int bj = 0; bj < 2; ++bj) *(u32x4*)(rowp + bj * HALF) = pack8(acc[ai][bj][m][0], acc[ai][bj][m][1]); }
        }
    }
};

struct EpiResid {
    static constexpr bool PERM = false, AFTER_DRAIN = false;
    const float* base; float* out; const float* gate;
    __device__ __forceinline__ void operator()(const f32x4 (&acc)[2][2][4][2], const Unit& u, int wr, int wc, int fr, int fq) const {
        const int row0 = u.pm * BM + wr * 64 + fr, col0 = u.pn * BM + wc * 32 + 4 * fq; const float* gp = gate + (size_t)(u.pm >> 3) * 12288 + col0;
        f32x4 gv[2][2];
#pragma unroll
        for (int bj = 0; bj < 2; ++bj)
#pragma unroll
            for (int n = 0; n < 2; ++n) gv[bj][n] = *(const f32x4*)(gp + bj * HALF + n * 16);
#pragma unroll
        for (int ai = 0; ai < 2; ++ai)
#pragma unroll
            for (int m = 0; m < 4; ++m) { const size_t off = (size_t)(row0 + ai * HALF + m * 16) * 2048 + col0;
#pragma unroll
                for (int bj = 0; bj < 2; ++bj)
#pragma unroll
                    for (int n = 0; n < 2; ++n) { const f32x4 bs = *(const f32x4*)(base + off + bj * HALF + n * 16); *(f32x4*)(out + off + bj * HALF + n * 16) = bs + gv[bj][n] * acc[ai][bj][m][n]; } }
    }
};

struct EpiGlu {
    static constexpr bool PERM = true, AFTER_DRAIN = false;
    const bf16_t* Z; bf16_t* MIX; const float* gb;
    __device__ __forceinline__ void operator()(const f32x4 (&acc)[2][2][4][2], const Unit& u, int wr, int wc, int fr, int fq) const {
        const int row0 = u.pm * BM + wr * 64 + fr, col0 = u.pn * BM + wc * 32 + 8 * fq;
        f32x4 bv[2][2];
#pragma unroll
        for (int bj = 0; bj < 2; ++bj)
#pragma unroll
            for (int n = 0; n < 2; ++n) bv[bj][n] = *(const f32x4*)(gb + col0 + bj * HALF + 4 * n);
#pragma unroll
        for (int ai = 0; ai < 2; ++ai)
#pragma unroll
            for (int m = 0; m < 4; ++m) { const size_t row = (size_t)(row0 + ai * HALF + m * 16);
#pragma unroll
                for (int bj = 0; bj < 2; ++bj) { const u32x4 zr = *(const u32x4*)(Z + row * 1024 + col0 + bj * HALF);
                    const f32x4 v0 = acc[ai][bj][m][0] + bv[bj][0], v1 = acc[ai][bj][m][1] + bv[bj][1];
                    const f32x4 z0 = (f32x4){bf_lo(zr.x), bf_hi(zr.x), bf_lo(zr.y), bf_hi(zr.y)}, z1 = (f32x4){bf_lo(zr.z), bf_hi(zr.z), bf_lo(zr.w), bf_hi(zr.w)};
                    const f32x4 o0 = (f32x4){z0[0] * sigmoidf_fast(v0[0]), z0[1] * sigmoidf_fast(v0[1]), z0[2] * sigmoidf_fast(v0[2]), z0[3] * sigmoidf_fast(v0[3])};
                    const f32x4 o1 = (f32x4){z1[0] * sigmoidf_fast(v1[0]), z1[1] * sigmoidf_fast(v1[1]), z1[2] * sigmoidf_fast(v1[2]), z1[3] * sigmoidf_fast(v1[3])};
                    *(u32x4*)(MIX + row * 2048 + 1024 + col0 + bj * HALF) = pack8(o0, o1); } }
    }
};
template <class Epi, class Sched, bool ALIGN_EPI = false, bool SP2 = false>
__device__ __forceinline__ void gemm_phase(PG8_LAS unsigned char* lds, const Gemm g, const Sched& S, const Epi& E) {
    int tid = threadIdx.x; asm volatile("" : "+v"(tid));
    const int wid = __builtin_amdgcn_readfirstlane(tid >> 6), lane = tid & 63, wr = wid >> 2, wc = wid & 3, fr = lane & 15, fq = lane >> 4;
    const int K = g.K, nt = K / BK;
    unsigned voffA[2], voffB[2];
#pragma unroll
    for (int i = 0; i < 2; ++i) { int R, C; stage_rc(tid * 16 + i * 8192, R, C); const int Rb = Epi::PERM ? ((R & ~31) + perm32(R & 31)) : R;
        voffA[i] = (unsigned)(R * K + C) * 2u; voffB[i] = (unsigned)(Rb * K + C) * 2u; }
    const size_t kstep = (size_t)(BK * 2);
    const size_t hstep = (size_t)HALF * K * 2;
    const size_t tstep = 2 * hstep;
    const unsigned ldsw = (unsigned)wid * 1024u;
    const int aoff = lds_byte(wr * 64 + fr, fq * 8), boff = lds_byte(wc * 32 + fr, fq * 8);
#define PG8_SA(b, h) (((b) * 2 + (h)) * HTB)
#define PG8_SB(b, h) ((4 + (b) * 2 + (h)) * HTB)
#define PG8_STAGE(bufoff, gbase, voff) do { _Pragma("unroll") for (int _i = 0; _i < 2; ++_i) \
        __builtin_amdgcn_global_load_lds((const unsigned*)((const char*)(gbase) + (voff)[_i]), (PG8_LAS unsigned*)(lds + (bufoff) + ldsw + _i * 8192), 16, 0, 0); } while (0)
#define PG8_LDA(dst, b, h) do { _Pragma("unroll") for (int m = 0; m < 4; ++m) _Pragma("unroll") for (int k = 0; k < 2; ++k) dst[m][k] = *(const PG8_LAS bf16x8*)(lds + PG8_SA(b, h) + aoff + m * 2048 + k * 1024); } while (0)
#define PG8_LDB(dst, b, h) do { _Pragma("unroll") for (int n = 0; n < 2; ++n) _Pragma("unroll") for (int k = 0; k < 2; ++k) dst[n][k] = *(const PG8_LAS bf16x8*)(lds + PG8_SB(b, h) + boff + n * 2048 + k * 1024); } while (0)
#define PG8_MMA(ai, bj, At, Bt) do { __builtin_amdgcn_s_setprio(1); _Pragma("unroll") for (int m = 0; m < 4; ++m) _Pragma("unroll") for (int n = 0; n < 2; ++n) _Pragma("unroll") for (int k = 0; k < 2; ++k) \
        acc[ai][bj][m][n] = __builtin_amdgcn_mfma_f32_16x16x32_bf16(Bt[n][k], At[m][k], acc[ai][bj][m][n], 0, 0, 0); __builtin_amdgcn_s_setprio(0); } while (0)
#define PG8_WAIT_V(n) asm volatile("s_waitcnt vmcnt(" #n ")" ::: "memory")
#define PG8_WAIT_L(n) asm volatile("s_waitcnt lgkmcnt(" #n ")" ::: "memory")
#define PG8_BAR __builtin_amdgcn_s_barrier()
#define PG8_SCHED __builtin_amdgcn_sched_barrier(0)
    Unit cur, nxt; int ui = 0;
    if (!S.next(0, cur)) return;
    f32x4 acc[2][2][4][2];
#pragma unroll
    for (int a = 0; a < 2; ++a)
#pragma unroll
        for (int b = 0; b < 2; ++b)
#pragma unroll
            for (int m = 0; m < 4; ++m)
#pragma unroll
                for (int n = 0; n < 2; ++n) acc[a][b][m][n] = (f32x4){0.f, 0.f, 0.f, 0.f};
    bf16x8 At[4][2], B0[2][2], B1[2][2];
    const char* cA = (const char*)g.A + (size_t)cur.pm * tstep; const char* cB = (const char*)g.Bt + (size_t)cur.pn * tstep;
    S.a_ready(cur);
    if constexpr (SP2) {
        PG8_STAGE(PG8_SB(0, 0), cB, voffB); PG8_STAGE(PG8_SB(0, 1), cB + hstep, voffB); PG8_STAGE(PG8_SA(0, 0), cA, voffA); PG8_STAGE(PG8_SA(0, 1), cA + hstep, voffA);
        if (wr == 1) PG8_BAR;
        PG8_WAIT_V(2); PG8_BAR;
        PG8_STAGE(PG8_SB(1, 0), cB + kstep, voffB); PG8_STAGE(PG8_SA(1, 0), cA + kstep, voffA); PG8_STAGE(PG8_SB(1, 1), cB + hstep + kstep, voffB);
        PG8_WAIT_V(6); PG8_BAR;
    } else {
        PG8_STAGE(PG8_SB(0, 0), cB, voffB); PG8_STAGE(PG8_SA(0, 0), cA, voffA); PG8_STAGE(PG8_SB(0, 1), cB + hstep, voffB); PG8_STAGE(PG8_SA(0, 1), cA + hstep, voffA);
        if (wr == 1) PG8_BAR;
        PG8_WAIT_V(4); PG8_BAR;
        PG8_STAGE(PG8_SB(1, 0), cB + kstep, voffB); PG8_STAGE(PG8_SA(1, 0), cA + kstep, voffA); PG8_STAGE(PG8_SB(1, 1), cB + hstep + kstep, voffB);
        PG8_WAIT_V(6); PG8_BAR;
    }
    for (;;) {
        const bool has_next = S.next(ui + 1, nxt);
        const char* nA = has_next ? (const char*)g.A + (size_t)nxt.pm * tstep : cA; const char* nB = has_next ? (const char*)g.Bt + (size_t)nxt.pn * tstep : cB;
        for (int t = 0; t < nt; t += 2) {
            const bool last = (t == nt - 2);
            const char* a1 = cA + (size_t)(t + 1) * kstep;
            const char* a2 = last ? nA : cA + (size_t)(t + 2) * kstep; const char* b2 = last ? nB : cB + (size_t)(t + 2) * kstep;
            const char* a3 = a2 + kstep; const char* b3 = b2 + kstep;
            if (last && has_next) S.a_ready(nxt);
            if constexpr (SP2) {
            PG8_LDB(B0, 0, 0); PG8_LDB(B1, 0, 1); PG8_SCHED; PG8_LDA(At, 0, 0); PG8_STAGE(PG8_SA(1, 1), a1 + hstep, voffA);
            PG8_WAIT_V(8); PG8_WAIT_L(0); PG8_BAR; PG8_MMA(0, 0, At, B0); PG8_MMA(0, 1, At, B1); PG8_BAR; PG8_SCHED;
            PG8_LDA(At, 0, 1); PG8_STAGE(PG8_SB(0, 0), b2, voffB); PG8_STAGE(PG8_SB(0, 1), b2 + hstep, voffB); PG8_STAGE(PG8_SA(0, 0), a2, voffA);
            PG8_WAIT_V(8); PG8_WAIT_L(0); PG8_BAR; PG8_MMA(1, 0, At, B0); PG8_MMA(1, 1, At, B1); PG8_BAR; PG8_SCHED;
            PG8_LDB(B0, 1, 0); PG8_LDB(B1, 1, 1); PG8_SCHED; PG8_LDA(At, 1, 0); PG8_STAGE(PG8_SA(0, 1), a2 + hstep, voffA);
            PG8_WAIT_V(8); PG8_WAIT_L(0); PG8_BAR; PG8_MMA(0, 0, At, B0); PG8_MMA(0, 1, At, B1); PG8_BAR; PG8_SCHED;
            PG8_LDA(At, 1, 1); PG8_STAGE(PG8_SB(1, 0), b3, voffB); PG8_STAGE(PG8_SB(1, 1), b3 + hstep, voffB); PG8_STAGE(PG8_SA(1, 0), a3, voffA);
            PG8_WAIT_V(8); PG8_WAIT_L(0); PG8_BAR; PG8_MMA(1, 0, At, B0); PG8_MMA(1, 1, At, B1); PG8_BAR; PG8_SCHED;
            } else {
            PG8_LDB(B0, 0, 0); PG8_SCHED; PG8_LDA(At, 0, 0); PG8_STAGE(PG8_SA(1, 1), a1 + hstep, voffA);
            PG8_WAIT_L(8); PG8_BAR; PG8_WAIT_L(0); PG8_MMA(0, 0, At, B0); PG8_BAR; PG8_SCHED;
            PG8_LDB(B1, 0, 1); PG8_STAGE(PG8_SB(0, 0), b2, voffB);
            PG8_BAR; PG8_WAIT_L(0); PG8_MMA(0, 1, At, B1); PG8_BAR;
            PG8_LDA(At, 0, 1); PG8_STAGE(PG8_SA(0, 0), a2, voffA);
            PG8_BAR; PG8_WAIT_L(0); PG8_MMA(1, 0, At, B0); PG8_BAR; PG8_SCHED;
            PG8_STAGE(PG8_SB(0, 1), b2 + hstep, voffB);
            PG8_WAIT_V(6); PG8_BAR; PG8_MMA(1, 1, At, B1); PG8_BAR;
            PG8_LDB(B0, 1, 0); PG8_SCHED; PG8_LDA(At, 1, 0); PG8_STAGE(PG8_SA(0, 1), a2 + hstep, voffA);
            PG8_WAIT_L(8); PG8_BAR; PG8_WAIT_L(0); PG8_MMA(0, 0, At, B0); PG8_BAR; PG8_SCHED;
            PG8_LDB(B1, 1, 1); PG8_STAGE(PG8_SB(1, 0), b3, voffB);
            PG8_BAR; PG8_WAIT_L(0); PG8_MMA(0, 1, At, B1); PG8_BAR;
            PG8_LDA(At, 1, 1); PG8_STAGE(PG8_SA(1, 0), a3, voffA);
            PG8_BAR; PG8_WAIT_L(0); PG8_MMA(1, 0, At, B0); PG8_BAR; PG8_SCHED;
            PG8_STAGE(PG8_SB(1, 1), b3 + hstep, voffB);
            PG8_WAIT_V(6); PG8_BAR; PG8_MMA(1, 1, At, B1); PG8_BAR;
            }
        }
        if constexpr (ALIGN_EPI) { if (wr == 0) PG8_BAR; }
        if constexpr (!Epi::AFTER_DRAIN) { E(acc, cur, wr, wc, fr, fq); S.done(cur); }
        if (!has_next) break;
#pragma unroll
        for (int a = 0; a < 2; ++a)
#pragma unroll
            for (int b = 0; b < 2; ++b)
#pragma unroll
                for (int m = 0; m < 4; ++m)
#pragma unroll
                    for (int n = 0; n < 2; ++n) acc[a][b][m][n] = (f32x4){0.f, 0.f, 0.f, 0.f};
        cur = nxt; cA = nA; cB = nB; ++ui;
        if constexpr (ALIGN_EPI) { if (wr == 1) PG8_BAR; }
    }
    PG8_WAIT_V(0);
    if constexpr (!ALIGN_EPI) { if (wr == 0) PG8_BAR; }
    PG8_BAR;
    if constexpr (Epi::AFTER_DRAIN) { E.fused(acc, cur, wr, wc, fr, fq, lds, wid, lane); S.done(cur); }
#undef PG8_SA
#undef PG8_SB
#undef PG8_STAGE
#undef PG8_LDA
#undef PG8_LDB
#undef PG8_MMA
#undef PG8_WAIT_V
#undef PG8_WAIT_L
#undef PG8_BAR
#undef PG8_SCHED
}
}

constexpr int DM = 2048, NB = 4, SEQ = 2048, MT = NB * SEQ, NLAYER = 4;
constexpr int EVEN_IN = 5120, ODD_IN = 2304, DFF = 5504, DFF2 = 11008;
constexpr float LOG2E = 1.4426950408889634f;
constexpr float QSCALE_A = 0.08838834764831845f * LOG2E;
constexpr float QSCALE_C = 0.125f * LOG2E;
enum { I_X = 0, I_C, I_POS, I_ADA_W, I_ADA_B, I_NORM_MIX, I_NORM_FFN, I_NORM_FINAL,
       I_EV_W_IN, I_EV_CONV_W, I_EV_CONV_B, I_EV_GA_W, I_EV_GA_B, I_EV_GX_W, I_EV_GX_B, I_EV_LAMBDA, I_EV_W_OUT,
       I_OD_W_IN, I_OD_SINKS, I_OD_A_RE, I_OD_A_IM, I_OD_B_RE, I_OD_B_IM, I_OD_C_RE, I_OD_C_IM, I_OD_D, I_OD_LOG_DT, I_OD_GLU_W, I_OD_GLU_B, I_OD_W_OUT,
       I_FFN_W_IN, I_FFN_CONV_W, I_FFN_CONV_B, I_FFN_W_OUT, N_INPUTS };
constexpr size_t MiB = 1u << 20;
constexpr size_t WS_CTL = 0, CTL_ZERO_BYTES = MiB;
constexpr size_t WS_MOD = 1 * MiB;
constexpr size_t WS_COSA = 2 * MiB, WS_SINA = 4 * MiB, WS_COSC = 6 * MiB, WS_SINC = 7 * MiB;
constexpr size_t WS_S5T = 8 * MiB;
constexpr size_t WS_W_EVIN = 12 * MiB, WS_W_EVOUT = 52 * MiB, WS_W_ODIN = 68 * MiB, WS_W_ODOUT = 86 * MiB, WS_W_GLU = 102 * MiB, WS_W_FFIN = 106 * MiB, WS_W_FFOUT = 278 * MiB;
constexpr size_t WS_H = 364 * MiB, WS_MIX = 396 * MiB, WS_Q = 428 * MiB, WS_K = 444 * MiB, WS_V = 460 * MiB, WS_XB = 476 * MiB, WS_YB = 492 * MiB;
constexpr size_t WS_XC = 508 * MiB, WS_LA = 540 * MiB, WS_LB = 572 * MiB, WS_UFF = 604 * MiB, WS_ACT = 776 * MiB, WS_END = 862 * MiB;
constexpr int CW_BAR = 4096;
constexpr int RING_BYTES = 131072, LDSCTL_OFF = RING_BYTES, LDS_BYTES = 147456;

#define GAS __attribute__((address_space(1)))
#define LAS __attribute__((address_space(3)))
typedef unsigned short bf16;
typedef float f32x4 __attribute__((ext_vector_type(4)));
typedef float f32x2 __attribute__((ext_vector_type(2)));
typedef unsigned u32x4 __attribute__((ext_vector_type(4)));
typedef unsigned u32x2 __attribute__((ext_vector_type(2)));
#define LDS_WAIT() asm volatile("s_waitcnt lgkmcnt(0)" ::: "memory")
using pg8::cvt_pk_bf16; using pg8::bf_lo; using pg8::bf_hi; using pg8::gelu_tanh;
__device__ __forceinline__ float wave_sum(float v) {
#pragma unroll
    for (int o = 1; o < 64; o <<= 1) v += __shfl_xor(v, o);
    return v;
}
__device__ __forceinline__ unsigned short f2bf(float f) { return (unsigned short)(cvt_pk_bf16(f, 0.f) & 0xffffu); }
__device__ __forceinline__ float bf2f(unsigned short b) { return __uint_as_float(((unsigned)b) << 16); }

struct Params { const float* in[N_INPUTS]; float* out; unsigned char* ws; int lo, hi, li, pad; };
typedef const __attribute__((address_space(4))) Params* KP;
#define KPREF(P, kp0) KP kp_ = (kp0); asm volatile("" : "+s"(kp_)); const __attribute__((address_space(4))) Params& P = *kp_
#define PHASE_IDS() int tid = threadIdx.x; asm volatile("" : "+v"(tid)); const int lane = tid & 63, wave = __builtin_amdgcn_readfirstlane(tid >> 6); int bx = blockIdx.x; asm volatile("" : "+s"(bx)); const int G = gridDim.x; (void)lane; (void)wave; (void)G
#define XB_TMO      128
#define XB_XCNT(j)  (256  + 64 * (j))
#define XB_XSUB(j)  (1280 + 64 * (j))
#define XB_XGEN(j)  (2304 + 64 * (j))
#define XB_TOP      3328
#define XB_TOPGEN   3392
#define XCD_BAR_WORDS 3456
#define XB_SPIN_CAP (1u << 18)
#define LAS __attribute__((address_space(3)))

__device__ __forceinline__ unsigned xb_ld(unsigned* p)              { return __hip_atomic_load(p, __ATOMIC_RELAXED, __HIP_MEMORY_SCOPE_AGENT); }
__device__ __forceinline__ unsigned xb_add(unsigned* p, unsigned v) { return __hip_atomic_fetch_add(p, v, __ATOMIC_RELAXED, __HIP_MEMORY_SCOPE_AGENT); }
__device__ __forceinline__ unsigned xb_xcc_id() { return (unsigned)__builtin_amdgcn_s_getreg((3 << 11) | 20) & 0xFu; }
#define XB_SPIN(cond, bar) do { unsigned _sp = 0; while (cond) { __builtin_amdgcn_s_sleep(1); \
    if ((++_sp & 255u) == 0u) { if (xb_ld(&(bar)[XB_TMO])) break; if (_sp > XB_SPIN_CAP) { atomicAdd(&(bar)[XB_TMO], 1u); break; } } } } while (0)

struct XcdBarrier {
    unsigned* bar; unsigned x;
    volatile LAS unsigned* st;
};

__device__ __forceinline__ XcdBarrier xcd_barrier_post(unsigned* bar, volatile LAS unsigned* st) {
    XcdBarrier b; b.bar = bar; b.x = xb_xcc_id(); b.st = st;
    if (threadIdx.x == 0) (void)xb_add(&bar[XB_XCNT(b.x)], 1u);
    return b;
}
__device__ __forceinline__ void xcd_barrier_complete(unsigned* bar, unsigned x, unsigned& nloc, unsigned& nx) {
    const unsigned G = gridDim.x * gridDim.y * gridDim.z;
    unsigned sum, cnt, mine, sp = 0u;
    for (;;) {
        sum = 0u; cnt = 0u; mine = 0u;
#pragma unroll
        for (unsigned j = 0; j < 16; ++j) { const unsigned c = xb_ld(&bar[XB_XCNT(j)]); sum += c; cnt += (c > 0u) ? 1u : 0u; mine = (j == x) ? c : mine; }
        if (sum == G) break;
        __builtin_amdgcn_s_sleep(1);
        if ((++sp & 255u) == 0u) { if (xb_ld(&bar[XB_TMO])) break; if (sp > XB_SPIN_CAP) { atomicAdd(&bar[XB_TMO], 1u); break; } }
    }
    nloc = mine > 0u ? mine : 1u; nx = cnt > 0u ? cnt : 1u;
}

__device__ __forceinline__ void xcd_barrier(const XcdBarrier& b) {
    asm volatile("s_waitcnt vmcnt(0)" ::: "memory");
    __syncthreads();
    if (threadIdx.x == 0) {
        unsigned* bar = b.bar;
        __builtin_amdgcn_s_waitcnt(0);
        unsigned nloc = b.st[0], nx = b.st[1];
        if (nloc == 0u) { xcd_barrier_complete(bar, b.x, nloc, nx); b.st[0] = nloc; b.st[1] = nx; }
        const unsigned old = xb_add(&bar[XB_XSUB(b.x)], 1u);
        const unsigned gen = old / nloc;
        if (old + 1u == (gen + 1u) * nloc) {
            __builtin_amdgcn_fence(__ATOMIC_RELEASE, "agent");
            asm volatile("s_waitcnt vmcnt(0)" ::: "memory");
            const unsigned og = xb_add(&bar[XB_TOP], 1u);
            const unsigned tg = og / nx;
            if (og + 1u == (tg + 1u) * nx) xb_add(&bar[XB_TOPGEN], 1u);
            else XB_SPIN(xb_ld(&bar[XB_TOPGEN]) == tg, bar);
            __builtin_amdgcn_fence(__ATOMIC_ACQUIRE, "agent");
            xb_add(&bar[XB_XGEN(b.x)], 1u);
            asm volatile("s_waitcnt vmcnt(0)" ::: "memory");
        } else {
            XB_SPIN(xb_ld(&bar[XB_XGEN(b.x)]) == gen, bar);
            __builtin_amdgcn_fence(__ATOMIC_ACQUIRE, "agent");
            asm volatile("s_waitcnt vmcnt(0)" ::: "memory");
        }
    }
    __syncthreads();
}

__device__ __forceinline__ void phase_ada(KP kp0, LAS unsigned char* lds) { KPREF(P, kp0); PHASE_IDS();
    LAS float* cond = (LAS float*)lds;
    LAS float* part = (LAS float*)(lds + 32768);
    const float* c = P.in[I_C];
    for (int i = tid; i < NB * DM; i += 512) { const float v = c[i]; cond[i] = v / (1.0f + __expf(-v)); }
    __syncthreads();
    float* mod = (float*)(P.ws + WS_MOD);
    for (int item = bx; item < 192; item += G) {
        const int l = item / 48, ng = item % 48;
        const float* W = P.in[I_ADA_W] + (size_t)l * DM * 12288 + (size_t)(wave * 256) * 12288 + ng * 256 + lane * 4;
        f32x4 a0 = {0.f, 0.f, 0.f, 0.f}, a1 = a0, a2 = a0, a3 = a0;
#pragma unroll 8
        for (int k = 0; k < 256; ++k) {
            const f32x4 w = *(const f32x4*)(W + (size_t)k * 12288); const int kk = wave * 256 + k;
            a0 += cond[kk] * w; a1 += cond[2048 + kk] * w; a2 += cond[4096 + kk] * w; a3 += cond[6144 + kk] * w;
        }
        LAS float* pp = part + wave * 1024 + lane * 4;
        *(LAS f32x4*)(pp) = a0; *(LAS f32x4*)(pp + 256) = a1; *(LAS f32x4*)(pp + 512) = a2; *(LAS f32x4*)(pp + 768) = a3;
        __syncthreads();
        for (int o = tid; o < 1024; o += 512) {
            float s = 0.f;
#pragma unroll
            for (int w = 0; w < 8; ++w) s += part[w * 1024 + o];
            const int b = o >> 8, cc = o & 255;
            mod[(size_t)(l * 4 + b) * 12288 + ng * 256 + cc] = s + P.in[I_ADA_B][l * 12288 + ng * 256 + cc];
        }
        __syncthreads();
    }
}

__constant__ int TRJOBS[7][6] = {
    {I_EV_W_IN, 2048, 5120, 2, 1, 12}, {I_EV_W_OUT, 2048, 2048, 2, 0, 52}, {I_OD_W_IN, 2048, 2304, 2, 2, 68}, {I_OD_W_OUT, 2048, 2048, 2, 0, 86},
    {I_OD_GLU_W, 1024, 1024, 2, 0, 102}, {I_FFN_W_IN, 2048, 11008, 4, 0, 106}, {I_FFN_W_OUT, 5504, 2048, 4, 0, 278} };
__device__ __forceinline__ int cmap(int type, int n) {
    if (type == 1) { if (n >= 2048) return n; const int tile = n >> 8, j = n & 255, bj = j >> 7, jj = j & 127; return tile * 256 + (jj >> 6) * 128 + bj * 64 + (jj & 63); }
    if (type == 2) {
        if (n >= 1280) return n;
        if (n < 1024) { const int tile = n >> 8, j = n & 255, bj = j >> 7, jj = j & 127; return tile * 256 + (jj >> 5) * 64 + bj * 32 + (jj & 31); }
        const int j = n - 1024, bj = j >> 7, jj = j & 127; if (jj < 64) return 1024 + (jj >> 5) * 64 + bj * 32 + (jj & 31); return 1152 + bj * 64 + (jj - 64);
    }
    return n;
}
__device__ __forceinline__ void tr_item(const float* W, int K, int N, bf16* WT, int k0, int srcc0, int dstr0, LAS float* scr, int lane) {
#pragma unroll 8
    for (int i = 0; i < 32; ++i) { const int kk = 2 * i + (lane >> 5); scr[kk * 33 + (lane & 31)] = W[(size_t)(k0 + kk) * N + srcc0 + (lane & 31)]; }
    LDS_WAIT(); asm volatile("" ::: "memory");
    const int c = lane & 7;
#pragma unroll
    for (int j = 0; j < 4; ++j) { const int n = (lane >> 3) + 8 * j; const LAS float* s = scr + (8 * c) * 33 + n;
        u32x4 o; o.x = cvt_pk_bf16(s[0 * 33], s[1 * 33]); o.y = cvt_pk_bf16(s[2 * 33], s[3 * 33]); o.z = cvt_pk_bf16(s[4 * 33], s[5 * 33]); o.w = cvt_pk_bf16(s[6 * 33], s[7 * 33]);
        *(u32x4*)(WT + (size_t)(dstr0 + n) * K + k0 + 8 * c) = o; }
    LDS_WAIT(); asm volatile("" ::: "memory");
}
__device__ __forceinline__ void sincos_rev(double ang, float& s, float& c) {
    double rev = ang * 0.15915494309189535; rev -= floor(rev); const float fr = (float)rev;
    s = __builtin_amdgcn_sinf(fr); c = __builtin_amdgcn_cosf(fr);
}
__device__ __forceinline__ void phase_prep(KP kp0, LAS unsigned char* lds) { KPREF(P, kp0); PHASE_IDS();
    LAS float* scr = (LAS float*)(lds + wave * 16384);
    const int gw = bx * 8 + wave, NGW = G * 8;
    int total = 0;
#pragma unroll
    for (int q = 0; q < 7; ++q) total += TRJOBS[q][3] * (TRJOBS[q][1] / 64) * (TRJOBS[q][2] / 32);
    for (int it = gw; it < total; it += NGW) {
        int r = it, j = 0;
#pragma unroll
        for (int q = 0; q < 6; ++q) { const int cnt = TRJOBS[q][3] * (TRJOBS[q][1] / 64) * (TRJOBS[q][2] / 32); if (j == q && r >= cnt) { r -= cnt; j = q + 1; } }
        const int K = TRJOBS[j][1], N = TRJOBS[j][2], per = (K / 64) * (N / 32), li = r / per, rr = r % per, nblk = N / 32, kb = rr / nblk, nb = rr % nblk;
        const float* src = P.in[TRJOBS[j][0]] + (size_t)li * K * N;
        bf16* dst = (bf16*)(P.ws + (size_t)TRJOBS[j][5] * MiB) + (size_t)li * K * N;
        tr_item(src, K, N, dst, 64 * kb, cmap(TRJOBS[j][4], 32 * nb), 32 * nb, scr, lane);
    }
    const int gt = bx * 512 + tid, NT = G * 512;
    const int* pos = (const int*)P.in[I_POS];
    float* cosA = (float*)(P.ws + WS_COSA); float* sinA = (float*)(P.ws + WS_SINA); float* cosC = (float*)(P.ws + WS_COSC); float* sinC = (float*)(P.ws + WS_SINC);
    for (int idx = gt; idx < MT * 64; idx += NT) { const int row = idx >> 6, i = idx & 63;
        const double inv = exp2(-(double)i * (13.287712379549449 / 64.0)); float s, c; sincos_rev((double)pos[row] * inv, s, c); cosA[idx] = c; sinA[idx] = s; }
    for (int idx = gt; idx < MT * 32; idx += NT) { const int row = idx >> 5, i = idx & 31;
        const double inv = exp2(-(double)i * (13.287712379549449 / 32.0)); float s, c; sincos_rev((double)pos[row] * inv, s, c); cosC[idx] = c; sinC[idx] = s; }
    for (int idx = gt; idx < 2 * 64 * 64; idx += NT) { const int o = idx >> 12, g = (idx >> 6) & 63;
        const float are = P.in[I_OD_A_RE][idx], aim = P.in[I_OD_A_IM][idx], dt = expf(P.in[I_OD_LOG_DT][o * 64 + g]);
        const float er = expf(are * dt); float s, c; sincos_rev((double)aim * (double)dt, s, c);
        const float abr = er * c, abi = er * s, xr = abr - 1.0f, xi = abi, den = 1.0f / (are * are + aim * aim);
        const float cr = (xr * are + xi * aim) * den, ci = (xi * are - xr * aim) * den;
        f32x2* abar = (f32x2*)(P.ws + WS_S5T + (size_t)o * MiB); f32x2* bbar = (f32x2*)(P.ws + WS_S5T + (size_t)o * MiB + 65536);
        abar[idx & 4095] = (f32x2){abr, abi};
#pragma unroll
        for (int cc = 0; cc < 16; ++cc) { const float br = P.in[I_OD_B_RE][(size_t)idx * 16 + cc], bi = P.in[I_OD_B_IM][(size_t)idx * 16 + cc];
            bbar[(size_t)(idx & 4095) * 16 + cc] = (f32x2){cr * br - ci * bi, cr * bi + ci * br}; }
    }
}

__device__ __forceinline__ void phase_norm(KP kp0, int l, int which) { KPREF(P, kp0); PHASE_IDS();
    const float* x = (l == 0 && which == 0) ? P.in[I_X] : P.out;
    const float* gwt = P.in[which ? I_NORM_FFN : I_NORM_MIX] + l * DM;
    const float* modl = (const float*)(P.ws + WS_MOD) + (size_t)l * 4 * 12288 + (which ? 3 * DM : 0);
    bf16* H = (bf16*)(P.ws + WS_H);
    const int gw = bx * 8 + wave, NGW = G * 8;
    for (int row = gw; row < MT; row += NGW) {
        const f32x4* xr = (const f32x4*)(x + (size_t)row * DM) + lane;
        f32x4 v[8]; float ss = 0.f;
#pragma unroll
        for (int j = 0; j < 8; ++j) { v[j] = xr[64 * j]; ss += (v[j][0] * v[j][0] + v[j][1] * v[j][1]) + (v[j][2] * v[j][2] + v[j][3] * v[j][3]); }
        const float rstd = rsqrtf(wave_sum(ss) * (1.0f / DM) + 1e-6f);
        const float* sh = modl + (size_t)(row >> 11) * 12288; const float* sc = sh + DM;
        u32x2* o8 = (u32x2*)(H + (size_t)row * DM) + lane;
#pragma unroll
        for (int j = 0; j < 8; ++j) { const int col = (lane + 64 * j) * 4;
            const f32x4 g4 = *(const f32x4*)(gwt + col), s4 = *(const f32x4*)(sc + col), h4 = *(const f32x4*)(sh + col);
            const f32x4 y = v[j] * rstd * g4 * (1.0f + s4) + h4;
            u32x2 w; w.x = cvt_pk_bf16(y[0], y[1]); w.y = cvt_pk_bf16(y[2], y[3]); o8[64 * j] = w; }
    }
}
__device__ __forceinline__ void phase_final(KP kp0) { KPREF(P, kp0); PHASE_IDS();
    const float* gwt = P.in[I_NORM_FINAL];
    const int gw = bx * 8 + wave, NGW = G * 8;
    for (int row = gw; row < MT; row += NGW) {
        f32x4* xr = (f32x4*)(P.out + (size_t)row * DM) + lane;
        f32x4 v[8]; float ss = 0.f;
#pragma unroll
        for (int j = 0; j < 8; ++j) { v[j] = xr[64 * j]; ss += (v[j][0] * v[j][0] + v[j][1] * v[j][1]) + (v[j][2] * v[j][2] + v[j][3] * v[j][3]); }
        const float rstd = rsqrtf(wave_sum(ss) * (1.0f / DM) + 1e-6f);
#pragma unroll
        for (int j = 0; j < 8; ++j) { const int col = (lane + 64 * j) * 4; xr[64 * j] = v[j] * rstd * *(const f32x4*)(gwt + col); }
    }
}

__device__ __forceinline__ void phase_attn_a_naive(KP kp0) { KPREF(P, kp0); PHASE_IDS();
    const bf16* Q = (const bf16*)(P.ws + WS_Q); const bf16* K = (const bf16*)(P.ws + WS_K); const bf16* V = (const bf16*)(P.ws + WS_V); bf16* MIX = (bf16*)(P.ws + WS_MIX);
    const int gw = bx * 8 + wave, NGW = G * 8;
    for (int task = gw; task < MT * 8; task += NGW) {
        const int h = task & 7, row = task >> 3, b = row >> 11, t = row & 2047;
        const unsigned qw = *(const unsigned*)(Q + (size_t)row * 1024 + h * 128 + 2 * lane); const float q0 = bf_lo(qw), q1 = bf_hi(qw);
        float m = -INFINITY, l = 0.f, o0 = 0.f, o1 = 0.f;
        for (int pat = 0; pat < 3; ++pat) { const int dil = pat == 0 ? 1 : (pat == 1 ? 4 : 16);
            for (int j = 0; j <= 128; ++j) { const int tk = t - dil * j; if (tk < 0) break;
                const size_t kr = (size_t)(b * SEQ + tk) * 1024 + h * 128 + 2 * lane;
                const unsigned kw = *(const unsigned*)(K + kr), vw = *(const unsigned*)(V + kr);
                const float s = wave_sum(q0 * bf_lo(kw) + q1 * bf_hi(kw));
                const float mn = fmaxf(m, s), corr = exp2f(m - mn), p = exp2f(s - mn);
                l = l * corr + p; o0 = o0 * corr + p * bf_lo(vw); o1 = o1 * corr + p * bf_hi(vw); m = mn; } }
        const float inv = 1.0f / l;
        *(unsigned*)(MIX + (size_t)row * 2048 + h * 128 + 2 * lane) = cvt_pk_bf16(o0 * inv, o1 * inv);
    }
}
__device__ __forceinline__ void phase_attn_c_naive(KP kp0, int o_idx) { KPREF(P, kp0); PHASE_IDS();
    const bf16* Q = (const bf16*)(P.ws + WS_Q); const bf16* K = (const bf16*)(P.ws + WS_K); const bf16* V = (const bf16*)(P.ws + WS_V); bf16* MIX = (bf16*)(P.ws + WS_MIX);
    const int gw = bx * 8 + wave, NGW = G * 8;
    for (int task = gw; task < MT * 16; task += NGW) {
        const int h = task & 15, row = task >> 4, b = row >> 11, t = row & 2047, kvh = h >> 3;
        const float q = bf2f(Q[(size_t)row * 1024 + h * 64 + lane]);
        float m = -INFINITY, l = 0.f, o = 0.f;
        for (int tk = (t >= 127 ? t - 127 : 0); tk <= t; ++tk) {
            const size_t kr = (size_t)(b * SEQ + tk) * 128 + kvh * 64 + lane;
            const float s = wave_sum(q * bf2f(K[kr]));
            const float mn = fmaxf(m, s), corr = exp2f(m - mn), p = exp2f(s - mn);
            l = l * corr + p; o = o * corr + p * bf2f(V[kr]); m = mn; }
        const float sk = P.in[I_OD_SINKS][o_idx * 16 + h] * LOG2E;
        MIX[(size_t)row * 2048 + h * 64 + lane] = f2bf(o / (l + exp2f(sk - m)));
    }
}
__device__ __forceinline__ void phase_lru1_naive(KP kp0, int e) { KPREF(P, kp0); PHASE_IDS();
    const bf16* XB = (const bf16*)(P.ws + WS_XB); float* XC = (float*)(P.ws + WS_XC);
    const float* cw = P.in[I_EV_CONV_W] + (size_t)e * 4 * 1024; const float* cb = P.in[I_EV_CONV_B] + e * 1024;
    const int gt = bx * 512 + tid, NT = G * 512;
    for (int idx = gt; idx < MT * 1024; idx += NT) { const int row = idx >> 10, c = idx & 1023, t = row & 2047;
        float acc = cb[c];
#pragma unroll
        for (int i = 0; i < 4; ++i) { const int tt = t - 3 + i; if (tt >= 0) acc += cw[i * 1024 + c] * bf2f(XB[(size_t)(row - 3 + i) * 1024 + c]); }
        XC[idx] = acc; }
}
__device__ __forceinline__ void phase_lru2_naive(KP kp0, int e) { KPREF(P, kp0); PHASE_IDS();
    const float* XC = (const float*)(P.ws + WS_XC); float* LA = (float*)(P.ws + WS_LA); float* LB = (float*)(P.ws + WS_LB);
    const int gt = bx * 512 + tid, NT = G * 512;
    for (int idx = gt; idx < MT * 1024; idx += NT) { const int row = idx >> 10, c = idx & 1023, blk = c >> 7, j = c & 127;
        const float* xr = XC + (size_t)row * 1024 + blk * 128;
        const float* wa = P.in[I_EV_GA_W] + (size_t)((e * 8 + blk) * 128) * 128 + j; const float* wx = P.in[I_EV_GX_W] + (size_t)((e * 8 + blk) * 128) * 128 + j;
        float sa = P.in[I_EV_GA_B][e * 1024 + c], sx = P.in[I_EV_GX_B][e * 1024 + c];
#pragma unroll 8
        for (int i = 0; i < 128; ++i) { const float xv = xr[i]; sa += xv * wa[i * 128]; sx += xv * wx[i * 128]; }
        const float r = 1.0f / (1.0f + expf(-sa)), ig = 1.0f / (1.0f + expf(-sx));
        const float sp = log1pf(expf(-P.in[I_EV_LAMBDA][e * 1024 + c]));
        const float log_a = -8.0f * r * sp, a = expf(log_a), mult = sqrtf(-expm1f(2.0f * log_a));
        LA[idx] = a; LB[idx] = mult * ig * xr[j]; }
}
__device__ __forceinline__ void phase_lru3_naive(KP kp0) { KPREF(P, kp0); PHASE_IDS();
    const float* LA = (const float*)(P.ws + WS_LA); const float* LB = (const float*)(P.ws + WS_LB); const bf16* YB = (const bf16*)(P.ws + WS_YB); bf16* MIX = (bf16*)(P.ws + WS_MIX);
    if (wave != 0) return;
    for (int task = bx; task < 64; task += G) { const int b = task >> 4, c = (task & 15) * 64 + lane;
        float h = 0.f;
#pragma unroll 8
        for (int t = 0; t < SEQ; ++t) { const size_t idx = (size_t)(b * SEQ + t) * 1024 + c;
            h = LA[idx] * h + LB[idx];
            MIX[(size_t)(b * SEQ + t) * 2048 + 1024 + c] = f2bf(h * bf2f(YB[idx])); } }
}
__device__ __forceinline__ void phase_s5_naive(KP kp0, int o_idx) { KPREF(P, kp0); PHASE_IDS();
    const bf16* U = (const bf16*)(P.ws + WS_XB); bf16* Z = (bf16*)(P.ws + WS_YB);
    if (wave != 0) return;
    for (int bg = bx; bg < 256; bg += G) { const int b = bg >> 6, g = bg & 63;
        const f32x2 ab = ((const f32x2*)(P.ws + WS_S5T + (size_t)o_idx * MiB))[g * 64 + lane];
        const f32x2* bbp = (const f32x2*)(P.ws + WS_S5T + (size_t)o_idx * MiB + 65536) + (size_t)(g * 64 + lane) * 16;
        f32x2 bb[16]; float cre[16], cim[16], dsk[16];
#pragma unroll
        for (int c = 0; c < 16; ++c) { bb[c] = bbp[c];
            cre[c] = P.in[I_OD_C_RE][((size_t)(o_idx * 64 + g) * 16 + c) * 64 + lane]; cim[c] = P.in[I_OD_C_IM][((size_t)(o_idx * 64 + g) * 16 + c) * 64 + lane];
            dsk[c] = P.in[I_OD_D][o_idx * 1024 + g * 16 + c]; }
        float hr = 0.f, hi = 0.f;
        for (int t = 0; t < SEQ; ++t) { const size_t row = (size_t)(b * SEQ + t);
            const u32x4 u0 = *(const u32x4*)(U + row * 1024 + g * 16), u1 = *(const u32x4*)(U + row * 1024 + g * 16 + 8);
            float u[16] = {bf_lo(u0.x), bf_hi(u0.x), bf_lo(u0.y), bf_hi(u0.y), bf_lo(u0.z), bf_hi(u0.z), bf_lo(u0.w), bf_hi(u0.w),
                           bf_lo(u1.x), bf_hi(u1.x), bf_lo(u1.y), bf_hi(u1.y), bf_lo(u1.z), bf_hi(u1.z), bf_lo(u1.w), bf_hi(u1.w)};
            float bur = 0.f, bui = 0.f;
#pragma unroll
            for (int c = 0; c < 16; ++c) { bur += u[c] * bb[c][0]; bui += u[c] * bb[c][1]; }
            const float nr = ab[0] * hr - ab[1] * hi + bur, ni = ab[0] * hi + ab[1] * hr + bui; hr = nr; hi = ni;
            float zo = 0.f;
#pragma unroll
            for (int c = 0; c < 16; ++c) { const float y = wave_sum(hr * cre[c] - hi * cim[c]) + dsk[c] * u[c]; const float z = gelu_tanh(y); zo = (lane == c) ? z : zo; }
            if (lane < 16) Z[row * 1024 + g * 16 + lane] = f2bf(zo); }
    }
}
__device__ __forceinline__ void phase_ffn_act(KP kp0, int l) { KPREF(P, kp0); PHASE_IDS();
    const bf16* U = (const bf16*)(P.ws + WS_UFF); bf16* ACT = (bf16*)(P.ws + WS_ACT);
    const float* cw = P.in[I_FFN_CONV_W] + (size_t)l * 3 * DFF2; const float* cb = P.in[I_FFN_CONV_B] + (size_t)l * DFF2;
    const int gt = bx * 512 + tid, NT = G * 512;
    for (int idx = gt; idx < MT * (DFF / 8); idx += NT) { const int row = idx / (DFF / 8), j0 = (idx % (DFF / 8)) * 8, t = row & 2047;
        float ag[8], av[8];
#pragma unroll
        for (int q = 0; q < 8; ++q) { ag[q] = cb[j0 + q]; av[q] = cb[DFF + j0 + q]; }
#pragma unroll
        for (int i = 0; i < 3; ++i) { const int tt = t - 2 + i; if (tt >= 0) {
            const u32x4 ug = *(const u32x4*)(U + (size_t)(row - 2 + i) * DFF2 + j0), uv = *(const u32x4*)(U + (size_t)(row - 2 + i) * DFF2 + DFF + j0);
            const float* wg = cw + (size_t)i * DFF2 + j0; const float* wv = wg + DFF;
            ag[0] += wg[0] * bf_lo(ug.x); ag[1] += wg[1] * bf_hi(ug.x); ag[2] += wg[2] * bf_lo(ug.y); ag[3] += wg[3] * bf_hi(ug.y);
            ag[4] += wg[4] * bf_lo(ug.z); ag[5] += wg[5] * bf_hi(ug.z); ag[6] += wg[6] * bf_lo(ug.w); ag[7] += wg[7] * bf_hi(ug.w);
            av[0] += wv[0] * bf_lo(uv.x); av[1] += wv[1] * bf_hi(uv.x); av[2] += wv[2] * bf_lo(uv.y); av[3] += wv[3] * bf_hi(uv.y);
            av[4] += wv[4] * bf_lo(uv.z); av[5] += wv[5] * bf_hi(uv.z); av[6] += wv[6] * bf_lo(uv.w); av[7] += wv[7] * bf_hi(uv.w); } }
        u32x4 o; o.x = cvt_pk_bf16(gelu_tanh(ag[0]) * av[0], gelu_tanh(ag[1]) * av[1]); o.y = cvt_pk_bf16(gelu_tanh(ag[2]) * av[2], gelu_tanh(ag[3]) * av[3]);
        o.z = cvt_pk_bf16(gelu_tanh(ag[4]) * av[4], gelu_tanh(ag[5]) * av[5]); o.w = cvt_pk_bf16(gelu_tanh(ag[6]) * av[6], gelu_tanh(ag[7]) * av[7]);
        *(u32x4*)(ACT + (size_t)row * DFF + j0) = o; }
}

constexpr int N_PHASES = 2 + 11 * NLAYER + 1;
#ifndef MK_ONE_LAUNCH
#define MK_ONE_LAUNCH 1
#endif
__global__ void __launch_bounds__(512, 2) fwd(Params P) {
    extern __shared__ __attribute__((aligned(16))) unsigned char lds_raw[];
    LAS unsigned char* lds = (LAS unsigned char*)lds_raw;
    for (int u = threadIdx.x; u < (LDS_BYTES - LDSCTL_OFF) / 4; u += 512) ((LAS unsigned*)(lds + LDSCTL_OFF))[u] = 0u;
    __syncthreads();
    const KP kp = (KP)__builtin_amdgcn_kernarg_segment_ptr();
    const int ph_lo = kp->lo, ph_hi = kp->hi;
    unsigned* barw = (unsigned*)(kp->ws + WS_CTL) + CW_BAR + kp->li * XCD_BAR_WORDS;
    XcdBarrier bar; bar.bar = barw; bar.x = 0; bar.st = nullptr;
    if (ph_hi - ph_lo > 1) bar = xcd_barrier_post(barw, (volatile LAS unsigned*)(lds + LDSCTL_OFF + 64));
#define RUN(p) (ph_lo <= (p) && (p) < ph_hi)
#define SEAM(p) do { if (RUN(p) && RUN((p) + 1)) xcd_barrier(bar); } while (0)

    if (RUN(0)) phase_ada(kp, lds);
    SEAM(0);
    if (RUN(1)) phase_prep(kp, lds);
    SEAM(1);
    for (int l = 0; l < NLAYER; ++l) {
        const int pb = 2 + 11 * l, e = l >> 1; const bool odd = (l & 1) != 0;
        if (RUN(pb + 0)) phase_norm(kp, l, 0);
        SEAM(pb + 0);
        if (RUN(pb + 1)) { KPREF(P, kp); int bx = blockIdx.x; asm volatile("" : "+s"(bx)); const int G = gridDim.x; const bf16* H = (const bf16*)(P.ws + WS_H); bf16* Qb = (bf16*)(P.ws + WS_Q);
            if (!odd) { pg8::Gemm g{H, (const bf16*)(P.ws + WS_W_EVIN) + (size_t)e * EVEN_IN * DM, MT, EVEN_IN, DM}; pg8::StaticOrder S; S.init(MT, EVEN_IN, G, bx);
                pg8::EpiEvenIn E{Qb, (const float*)(P.ws + WS_COSA), (const float*)(P.ws + WS_SINA), QSCALE_A};
                pg8::gemm_phase<pg8::EpiEvenIn, pg8::StaticOrder, true, true>(lds, g, S, E); }
            else { pg8::Gemm g{H, (const bf16*)(P.ws + WS_W_ODIN) + (size_t)e * ODD_IN * DM, MT, ODD_IN, DM}; pg8::StaticOrder S; S.init(MT, ODD_IN, G, bx);
                pg8::EpiOddIn E{Qb, (bf16*)(P.ws + WS_K), (bf16*)(P.ws + WS_V), (bf16*)(P.ws + WS_XB), (const float*)(P.ws + WS_COSC), (const float*)(P.ws + WS_SINC), QSCALE_C};
                pg8::gemm_phase<pg8::EpiOddIn, pg8::StaticOrder, true, true>(lds, g, S, E); }
        }
        SEAM(pb + 1);
        if (RUN(pb + 2)) { if (!odd) phase_attn_a_naive(kp); else phase_attn_c_naive(kp, e); }
        SEAM(pb + 2);
        if (RUN(pb + 3)) { if (!odd) phase_lru1_naive(kp, e); else phase_s5_naive(kp, e); }
        SEAM(pb + 3);
        if (RUN(pb + 4)) {
            if (!odd) phase_lru2_naive(kp, e);
            else { KPREF(P, kp); int bx = blockIdx.x; asm volatile("" : "+s"(bx)); const int G = gridDim.x; const bf16* YBb = (const bf16*)(P.ws + WS_YB); bf16* MIX = (bf16*)(P.ws + WS_MIX); pg8::Gemm g{YBb, (const bf16*)(P.ws + WS_W_GLU) + (size_t)e * 1024 * 1024, MT, 1024, 1024}; pg8::StaticOrder S; S.init(MT, 1024, G, bx);
                pg8::EpiGlu E{YBb, MIX, P.in[I_OD_GLU_B] + e * 1024};
                pg8::gemm_phase<pg8::EpiGlu, pg8::StaticOrder, true, true>(lds, g, S, E); }
        }
        SEAM(pb + 4);
        if (RUN(pb + 5)) { if (!odd) phase_lru3_naive(kp); }
        SEAM(pb + 5);
        if (RUN(pb + 6)) { KPREF(P, kp); int bx = blockIdx.x; asm volatile("" : "+s"(bx)); const int G = gridDim.x; const bf16* MIX = (const bf16*)(P.ws + WS_MIX); const float* mod = (const float*)(P.ws + WS_MOD);
            const bf16* W = odd ? (const bf16*)(P.ws + WS_W_ODOUT) + (size_t)e * DM * DM : (const bf16*)(P.ws + WS_W_EVOUT) + (size_t)e * DM * DM;
            pg8::Gemm g{MIX, W, MT, DM, DM}; pg8::StaticOrder S; S.init(MT, DM, G, bx);
            pg8::EpiResid E{l == 0 ? P.in[I_X] : P.out, P.out, mod + (size_t)l * 4 * 12288 + 2 * DM};
            pg8::gemm_phase<pg8::EpiResid, pg8::StaticOrder, true, true>(lds, g, S, E);
        }
        SEAM(pb + 6);
        if (RUN(pb + 7)) phase_norm(kp, l, 1);
        SEAM(pb + 7);
        if (RUN(pb + 8)) { KPREF(P, kp); int bx = blockIdx.x; asm volatile("" : "+s"(bx)); const int G = gridDim.x; const bf16* H = (const bf16*)(P.ws + WS_H); bf16* UFF = (bf16*)(P.ws + WS_UFF);
            pg8::Gemm g{H, (const bf16*)(P.ws + WS_W_FFIN) + (size_t)l * DFF2 * DM, MT, DFF2, DM}; pg8::StaticOrder S; S.init(MT, DFF2, G, bx);
            pg8::EpiStore E{UFF, DFF2};
            pg8::gemm_phase<pg8::EpiStore, pg8::StaticOrder, true, true>(lds, g, S, E);
        }
        SEAM(pb + 8);
        if (RUN(pb + 9)) phase_ffn_act(kp, l);
        SEAM(pb + 9);
        if (RUN(pb + 10)) { KPREF(P, kp); int bx = blockIdx.x; asm volatile("" : "+s"(bx)); const int G = gridDim.x; const bf16* ACT = (const bf16*)(P.ws + WS_ACT); const float* mod = (const float*)(P.ws + WS_MOD);
            pg8::Gemm g{ACT, (const bf16*)(P.ws + WS_W_FFOUT) + (size_t)l * DM * DFF, MT, DM, DFF}; pg8::StaticOrder S; S.init(MT, DM, G, bx);
            pg8::EpiResid E{P.out, P.out, mod + (size_t)l * 4 * 12288 + 5 * DM};
            pg8::gemm_phase<pg8::EpiResid, pg8::StaticOrder, true, true>(lds, g, S, E);
        }
        SEAM(pb + 10);
    }
    if (RUN(N_PHASES - 1)) phase_final(kp);
#undef RUN
#undef SEAM
}

extern "C" void kernel_launch(void* const* d_in, const int* in_sizes, int n_in, void* d_out, int out_size, void* d_ws, size_t ws_size, hipStream_t stream) {
    static int grid = 0;
    if (grid == 0) {
        if (n_in != N_INPUTS || out_size != MT * DM || ws_size < WS_END) { fprintf(stderr, "kernel_launch: unexpected shapes: n_in %d out %d ws %zu (need %zu)\n", n_in, out_size, ws_size, (size_t)WS_END); grid = -1; return; }
        int dev = 0, cus = 0, per_cu = 0;
        if (hipGetDevice(&dev) != hipSuccess || hipDeviceGetAttribute(&cus, hipDeviceAttributeMultiprocessorCount, dev) != hipSuccess) { grid = -1; return; }
        if (hipFuncSetAttribute((const void*)fwd, hipFuncAttributeMaxDynamicSharedMemorySize, LDS_BYTES) != hipSuccess) { fprintf(stderr, "kernel_launch: hipFuncSetAttribute failed\n"); grid = -1; return; }
        if (hipOccupancyMaxActiveBlocksPerMultiprocessor(&per_cu, (const void*)fwd, 512, LDS_BYTES) != hipSuccess || per_cu < 1) fprintf(stderr, "kernel_launch: occupancy query says %d\n", per_cu);
        (void)hipGetLastError();
        grid = cus;
    }
    if (grid < 0) return;
    if (hipMemsetAsync((char*)d_ws + WS_CTL, 0, CTL_ZERO_BYTES, stream) != hipSuccess) return;
    Params p{};
    for (int i = 0; i < N_INPUTS; ++i) p.in[i] = (const float*)d_in[i];
    p.out = (float*)d_out; p.ws = (unsigned char*)d_ws; p.pad = 0;
#if MK_ONE_LAUNCH
    p.lo = 0; p.hi = N_PHASES; p.li = 0;
    hipLaunchKernelGGL(fwd, dim3(grid), dim3(512), LDS_BYTES, stream, p);
#else
    for (int ph = 0; ph < N_PHASES; ++ph) { p.lo = ph; p.hi = ph + 1; p.li = 0; hipLaunchKernelGGL(fwd, dim3(grid), dim3(512), LDS_BYTES, stream, p); }
#endif
    const hipError_t le = hipPeekAtLastError();
    if (le != hipSuccess) fprintf(stderr, "kernel_launch: launch failed: %s\n", hipGetErrorName(le));
}
```

```cpp
#include <hip/hip_runtime.h>
#include <cstdio>
#include <cstdint>
namespace pg8 {
#define PG8_LAS __attribute__((address_space(3)))
typedef unsigned short bf16_t;
typedef short bf16x8 __attribute__((ext_vector_type(8)));
typedef float f32x4 __attribute__((ext_vector_type(4)));
typedef unsigned u32x4 __attribute__((ext_vector_type(4)));
constexpr int BM = 256, BK = 64, HALF = 128, HTB = HALF * BK * 2  , STAGE_BYTES = 8 * HTB, NXCD = 8, WGM = 8;

__host__ __device__ __forceinline__ int lds_byte(int r, int c) { const int st = (r >> 4) * 2 + (c >> 5), rr = r & 15, cc = c & 31, ob = rr * 64 + cc * 2; return st * 1024 + (ob ^ (((ob >> 9) & 1) << 5)); }
__host__ __device__ __forceinline__ void stage_rc(int b, int& R, int& C) { const int st = b / 1024, sb = b % 1024, swz = sb ^ (((sb >> 9) & 1) << 5); R = (st >> 1) * 16 + swz / 64; C = (st & 1) * 32 + (swz % 64) / 2; }
__host__ __device__ __forceinline__ int perm32(int rho) { const int n = rho >> 4, i = rho & 15; return 8 * (i >> 2) + 4 * n + (i & 3); }

struct Unit { int pm, pn; };
struct Gemm { const bf16_t* A; const bf16_t* Bt; int M, N, K; };

struct StaticOrder {
    int nM, nN, nwg, G, c;
    __host__ __device__ void init(int M, int N, int G_, int c_) { nM = M / BM; nN = N / BM; nwg = nM * nN; G = G_; c = c_; }
    __host__ __device__ bool next(int i, Unit& u) const {
        const long L = (long)i * G + c; if (L >= nwg) return false;
        int wgid = (int)L; { const int q = nwg / NXCD, r = nwg % NXCD, xcd = wgid % NXCD, off = wgid / NXCD; wgid = (xcd < r ? xcd * (q + 1) : r * (q + 1) + (xcd - r) * q) + off; }
        const int nig = WGM * nN, gid = wgid / nig, fm = gid * WGM, gsz = (nM - fm) < WGM ? (nM - fm) : WGM;
        u.pm = fm + ((wgid % nig) % gsz); u.pn = (wgid % nig) / gsz; return true;
    }
    __device__ __forceinline__ void a_ready(const Unit&) const {}
    __device__ __forceinline__ void done(const Unit&) const {}
};

__device__ __forceinline__ unsigned cvt_pk_bf16(float lo, float hi) { unsigned r; asm volatile("v_cvt_pk_bf16_f32 %0, %1, %2" : "=v"(r) : "v"(lo), "v"(hi)); return r; }
__device__ __forceinline__ u32x4 pack8(const f32x4 a, const f32x4 b) { u32x4 w; w.x = cvt_pk_bf16(a[0], a[1]); w.y = cvt_pk_bf16(a[2], a[3]); w.z = cvt_pk_bf16(b[0], b[1]); w.w = cvt_pk_bf16(b[2], b[3]); return w; }
__device__ __forceinline__ float bf_lo(unsigned w) { return __uint_as_float(w << 16); }
__device__ __forceinline__ float bf_hi(unsigned w) { return __uint_as_float(w & 0xffff0000u); }
__device__ __forceinline__ float gelu_tanh(float x) {
    const float u = x * (0.7978845608f + 0.0356774081f * x * x);
    const float e = __builtin_amdgcn_exp2f(-2.885390082f * u);
    return x * __builtin_amdgcn_rcpf(1.0f + e);
}
__device__ __forceinline__ f32x4 gelu4(const f32x4 v) { return (f32x4){gelu_tanh(v[0]), gelu_tanh(v[1]), gelu_tanh(v[2]), gelu_tanh(v[3])}; }
__device__ __forceinline__ float sigmoidf_fast(float x) { return __builtin_amdgcn_rcpf(1.0f + __builtin_amdgcn_exp2f(-1.4426950409f * x)); }

struct EpiStore {
    static constexpr bool PERM = true, AFTER_DRAIN = false;
    bf16_t* O; int ldc;
    __device__ __forceinline__ void operator()(const f32x4 (&acc)[2][2][4][2], const Unit& u, int wr, int wc, int fr, int fq) const {
        const int row0 = u.pm * BM + wr * 64 + fr, col0 = u.pn * BM + wc * 32 + 8 * fq;
#pragma unroll
        for (int ai = 0; ai < 2; ++ai)
#pragma unroll
            for (int m = 0; m < 4; ++m) { bf16_t* rowp = O + (size_t)(row0 + ai * HALF + m * 16) * ldc + col0;
#pragma unroll
                for (int bj = 0; bj < 2; ++bj) *(u32x4*)(rowp + bj * HALF) = pack8(acc[ai][bj][m][0], acc[ai][bj][m][1]); }
    }
};

struct EpiEvenIn {
    static constexpr bool PERM = true, AFTER_DRAIN = false;
    bf16_t *Q; const float *cosT, *sinT; float qscale;
    __device__ __forceinline__ void operator()(const f32x4 (&acc)[2][2][4][2], const Unit& u, int wr, int wc, int fr, int fq) const {
        const int row0 = u.pm * BM + wr * 64 + fr;
        if (u.pn < 8) {
            bf16_t* dst = Q + (size_t)(u.pn >> 2) * (8u << 20); const float sc = (u.pn < 4) ? qscale : 1.0f;
            const int head = (u.pn & 3) * 2 + (wc >> 1), i0 = (wc & 1) * 32 + 8 * fq;
#pragma unroll
            for (int ai = 0; ai < 2; ++ai)
#pragma unroll
                for (int m = 0; m < 4; ++m) { const int row = row0 + ai * HALF + m * 16;
                    const f32x4 c0 = *(const f32x4*)(cosT + (size_t)row * 64 + i0), c1 = *(const f32x4*)(cosT + (size_t)row * 64 + i0 + 4);
                    const f32x4 s0 = *(const f32x4*)(sinT + (size_t)row * 64 + i0), s1 = *(const f32x4*)(sinT + (size_t)row * 64 + i0 + 4);
                    const f32x4 a0 = acc[ai][0][m][0], a1 = acc[ai][0][m][1], b0 = acc[ai][1][m][0], b1 = acc[ai][1][m][1];
                    const f32x4 o10 = (a0 * c0 - b0 * s0) * sc, o11 = (a1 * c1 - b1 * s1) * sc, o20 = (b0 * c0 + a0 * s0) * sc, o21 = (b1 * c1 + a1 * s1) * sc;
                    bf16_t* rp = dst + (size_t)row * 1024 + head * 128 + i0;
                    *(u32x4*)(rp) = pack8(o10, o11); *(u32x4*)(rp + 64) = pack8(o20, o21); }
        } else {
            const int sel = (u.pn - 8) >> 2; bf16_t* dst = Q + (size_t)(u.pn >> 2) * (8u << 20); const int col0 = (u.pn & 3) * 256 + wc * 32 + 8 * fq;
#pragma unroll
            for (int ai = 0; ai < 2; ++ai)
#pragma unroll
                for (int m = 0; m < 4; ++m) { bf16_t* rowp = dst + (size_t)(row0 + ai * HALF + m * 16) * 1024 + col0;
#pragma unroll
                    for (int bj = 0; bj < 2; ++bj) { f32x4 v0 = acc[ai][bj][m][0], v1 = acc[ai][bj][m][1];
                        if (sel == 2) { v0 = gelu4(v0); v1 = gelu4(v1); }
                        *(u32x4*)(rowp + bj * HALF) = pack8(v0, v1); } }
        }
    }
};

struct EpiOddIn {
    static constexpr bool PERM = true, AFTER_DRAIN = false;
    bf16_t *Q, *K, *V, *U; const float *cosT, *sinT; float qscale;
    __device__ __forceinline__ void operator()(const f32x4 (&acc)[2][2][4][2], const Unit& u, int wr, int wc, int fr, int fq) const {
        const int row0 = u.pm * BM + wr * 64 + fr;
        if (u.pn < 4 || (u.pn == 4 && wc < 2)) {
            const bool isq = u.pn < 4; const float sc = isq ? qscale : 1.0f;
            bf16_t* dst = isq ? Q + (u.pn * 4 + wc) * 64 : K + wc * 64; const int pitch = isq ? 1024 : 128;
#pragma unroll
            for (int ai = 0; ai < 2; ++ai)
#pragma unroll
                for (int m = 0; m < 4; ++m) { const int row = row0 + ai * HALF + m * 16;
                    const f32x4 c0 = *(const f32x4*)(cosT + (size_t)row * 32 + 8 * fq), c1 = *(const f32x4*)(cosT + (size_t)row * 32 + 8 * fq + 4);
                    const f32x4 s0 = *(const f32x4*)(sinT + (size_t)row * 32 + 8 * fq), s1 = *(const f32x4*)(sinT + (size_t)row * 32 + 8 * fq + 4);
                    const f32x4 a0 = acc[ai][0][m][0], a1 = acc[ai][0][m][1], b0 = acc[ai][1][m][0], b1 = acc[ai][1][m][1];
                    const f32x4 o10 = (a0 * c0 - b0 * s0) * sc, o11 = (a1 * c1 - b1 * s1) * sc, o20 = (b0 * c0 + a0 * s0) * sc, o21 = (b1 * c1 + a1 * s1) * sc;
                    bf16_t* rp = dst + (size_t)row * pitch + 8 * fq;
                    *(u32x4*)(rp) = pack8(o10, o11); *(u32x4*)(rp + 32) = pack8(o20, o21); }
        } else if (u.pn == 4) {
#pragma unroll
            for (int ai = 0; ai < 2; ++ai)
#pragma unroll
                for (int m = 0; m < 4; ++m) { bf16_t* rowp = V + (size_t)(row0 + ai * HALF + m * 16) * 128 + (wc - 2) * 32 + 8 * fq;
#pragma unroll
                    for (int bj = 0; bj < 2; ++bj) *(u32x4*)(rowp + bj * 64) = pack8(acc[ai][bj][m][0], acc[ai][bj][m][1]); }
        } else {
            const int col0 = (u.pn - 5) * 256 + wc * 32 + 8 * fq;
#pragma unroll
            for (int ai = 0; ai < 2; ++ai)
#pragma unroll
                for (int m = 0; m < 4; ++m) { bf16_t* rowp = U + (size_t)(row0 + ai * HALF + m * 16) * 1024 + col0;
#pragma unroll
                    for (int bj = 0; bj < 2; ++bj) *(u32x4*)(rowp + bj * HALF) = pack8(acc[ai][bj][m][0], acc[ai][bj][m][1]); }
        }
    }
};

struct EpiResid {
    static constexpr bool PERM = false, AFTER_DRAIN = false;
    const float* base; float* out; const float* gate;
    __device__ __forceinline__ void operator()(const f32x4 (&acc)[2][2][4][2], const Unit& u, int wr, int wc, int fr, int fq) const {
        const int row0 = u.pm * BM + wr * 64 + fr, col0 = u.pn * BM + wc * 32 + 4 * fq; const float* gp = gate + (size_t)(u.pm >> 3) * 12288 + col0;
        f32x4 gv[2][2];
#pragma unroll
        for (int bj = 0; bj < 2; ++bj)
#pragma unroll
            for (int n = 0; n < 2; ++n) gv[bj][n] = *(const f32x4*)(gp + bj * HALF + n * 16);
#pragma unroll
        for (int ai = 0; ai < 2; ++ai)
#pragma unroll
            for (int m = 0; m < 4; ++m) { const size_t off = (size_t)(row0 + ai * HALF + m * 16) * 2048 + col0;
#pragma unroll
                for (int bj = 0; bj < 2; ++bj)
#pragma unroll
                    for (int n = 0; n < 2; ++n) { const f32x4 bs = *(const f32x4*)(base + off + bj * HALF + n * 16); *(f32x4*)(out + off + bj * HALF + n * 16) = bs + gv[bj][n] * acc[ai][bj][m][n]; } }
    }
};

struct EpiGlu {
    static constexpr bool PERM = true, AFTER_DRAIN = false;
    const bf16_t* Z; bf16_t* MIX; const float* gb;
    __device__ __forceinline__ void operator()(const f32x4 (&acc)[2][2][4][2], const Unit& u, int wr, int wc, int fr, int fq) const {
        const int row0 = u.pm * BM + wr * 64 + fr, col0 = u.pn * BM + wc * 32 + 8 * fq;
        f32x4 bv[2][2];
#pragma unroll
        for (int bj = 0; bj < 2; ++bj)
#pragma unroll
            for (int n = 0; n < 2; ++n) bv[bj][n] = *(const f32x4*)(gb + col0 + bj * HALF + 4 * n);
#pragma unroll
        for (int ai = 0; ai < 2; ++ai)
#pragma unroll
            for (int m = 0; m < 4; ++m) { const size_t row = (size_t)(row0 + ai * HALF + m * 16);
#pragma unroll
                for (int bj = 0; bj < 2; ++bj) { const u32x4 zr = *(const u32x4*)(Z + row * 1024 + col0 + bj * HALF);
                    const f32x4 v0 = acc[ai][bj][m][0] + bv[bj][0], v1 = acc[ai][bj][m][1] + bv[bj][1];
                    const f32x4 z0 = (f32x4){bf_lo(zr.x), bf_hi(zr.x), bf_lo(zr.y), bf_hi(zr.y)}, z1 = (f32x4){bf_lo(zr.z), bf_hi(zr.z), bf_lo(zr.w), bf_hi(zr.w)};
                    const f32x4 o0 = (f32x4){z0[0] * sigmoidf_fast(v0[0]), z0[1] * sigmoidf_fast(v0[1]), z0[2] * sigmoidf_fast(v0[2]), z0[3] * sigmoidf_fast(v0[3])};
                    const f32x4 o1 = (f32x4){z1[0] * sigmoidf_fast(v1[0]), z1[1] * sigmoidf_fast(v1[1]), z1[2] * sigmoidf_fast(v1[2]), z1[3] * sigmoidf_fast(v1[3])};
                    *(u32x4*)(MIX + row * 2048 + 1024 + col0 + bj * HALF) = pack8(o0, o1); } }
    }
};
template <class Epi, class Sched, bool ALIGN_EPI = false, bool SP2 = false>
__device__ __forceinline__ void gemm_phase(PG8_LAS unsigned char* lds, const Gemm g, const Sched& S, const Epi& E) {
    int tid = threadIdx.x; asm volatile("" : "+v"(tid));
    const int wid = __builtin_amdgcn_readfirstlane(tid >> 6), lane = tid & 63, wr = wid >> 2, wc = wid & 3, fr = lane & 15, fq = lane >> 4;
    const int K = g.K, nt = K / BK;
    unsigned voffA[2], voffB[2];
#pragma unroll
    for (int i = 0; i < 2; ++i) { int R, C; stage_rc(tid * 16 + i * 8192, R, C); const int Rb = Epi::PERM ? ((R & ~31) + perm32(R & 31)) : R;
        voffA[i] = (unsigned)(R * K + C) * 2u; voffB[i] = (unsigned)(Rb * K + C) * 2u; }
    const size_t kstep = (size_t)(BK * 2);
    const size_t hstep = (size_t)HALF * K * 2;
    const size_t tstep = 2 * hstep;
    const unsigned ldsw = (unsigned)wid * 1024u;
    const int aoff = lds_byte(wr * 64 + fr, fq * 8), boff = lds_byte(wc * 32 + fr, fq * 8);
#define PG8_SA(b, h) (((b) * 2 + (h)) * HTB)
#define PG8_SB(b, h) ((4 + (b) * 2 + (h)) * HTB)
#define PG8_STAGE(bufoff, gbase, voff) do { _Pragma("unroll") for (int _i = 0; _i < 2; ++_i) \
        __builtin_amdgcn_global_load_lds((const unsigned*)((const char*)(gbase) + (voff)[_i]), (PG8_LAS unsigned*)(lds + (bufoff) + ldsw + _i * 8192), 16, 0, 0); } while (0)
#define PG8_LDA(dst, b, h) do { _Pragma("unroll") for (int m = 0; m < 4; ++m) _Pragma("unroll") for (int k = 0; k < 2; ++k) dst[m][k] = *(const PG8_LAS bf16x8*)(lds + PG8_SA(b, h) + aoff + m * 2048 + k * 1024); } while (0)
#define PG8_LDB(dst, b, h) do { _Pragma("unroll") for (int n = 0; n < 2; ++n) _Pragma("unroll") for (int k = 0; k < 2; ++k) dst[n][k] = *(const PG8_LAS bf16x8*)(lds + PG8_SB(b, h) + boff + n * 2048 + k * 1024); } while (0)
#define PG8_MMA(ai, bj, At, Bt) do { __builtin_amdgcn_s_setprio(1); _Pragma("unroll") for (int m = 0; m < 4; ++m) _Pragma("unroll") for (int n = 0; n < 2; ++n) _Pragma("unroll") for (int k = 0; k < 2; ++k) \
        acc[ai][bj][m][n] = __builtin_amdgcn_mfma_f32_16x16x32_bf16(Bt[n][k], At[m][k], acc[ai][bj][m][n], 0, 0, 0); __builtin_amdgcn_s_setprio(0); } while (0)
#define PG8_WAIT_V(n) asm volatile("s_waitcnt vmcnt(" #n ")" ::: "memory")
#define PG8_WAIT_L(n) asm volatile("s_waitcnt lgkmcnt(" #n ")" ::: "memory")
#define PG8_BAR __builtin_amdgcn_s_barrier()
#define PG8_SCHED __builtin_amdgcn_sched_barrier(0)
    Unit cur, nxt; int ui = 0;
    if (!S.next(0, cur)) return;
    f32x4 acc[2][2][4][2];
#pragma unroll
    for (int a = 0; a < 2; ++a)
#pragma unroll
        for (int b = 0; b < 2; ++b)
#pragma unroll
            for (int m = 0; m < 4; ++m)
#pragma unroll
                for (int n = 0; n < 2; ++n) acc[a][b][m][n] = (f32x4){0.f, 0.f, 0.f, 0.f};
    bf16x8 At[4][2], B0[2][2], B1[2][2];
    const char* cA = (const char*)g.A + (size_t)cur.pm * tstep; const char* cB = (const char*)g.Bt + (size_t)cur.pn * tstep;
    S.a_ready(cur);
    if constexpr (SP2) {
        PG8_STAGE(PG8_SB(0, 0), cB, voffB); PG8_STAGE(PG8_SB(0, 1), cB + hstep, voffB); PG8_STAGE(PG8_SA(0, 0), cA, voffA); PG8_STAGE(PG8_SA(0, 1), cA + hstep, voffA);
        if (wr == 1) PG8_BAR;
        PG8_WAIT_V(2); PG8_BAR;
        PG8_STAGE(PG8_SB(1, 0), cB + kstep, voffB); PG8_STAGE(PG8_SA(1, 0), cA + kstep, voffA); PG8_STAGE(PG8_SB(1, 1), cB + hstep + kstep, voffB);
        PG8_WAIT_V(6); PG8_BAR;
    } else {
        PG8_STAGE(PG8_SB(0, 0), cB, voffB); PG8_STAGE(PG8_SA(0, 0), cA, voffA); PG8_STAGE(PG8_SB(0, 1), cB + hstep, voffB); PG8_STAGE(PG8_SA(0, 1), cA + hstep, voffA);
        if (wr == 1) PG8_BAR;
        PG8_WAIT_V(4); PG8_BAR;
        PG8_STAGE(PG8_SB(1, 0), cB + kstep, voffB); PG8_STAGE(PG8_SA(1, 0), cA + kstep, voffA); PG8_STAGE(PG8_SB(1, 1), cB + hstep + kstep, voffB);
        PG8_WAIT_V(6); PG8_BAR;
    }
    for (;;) {
        const bool has_next = S.next(ui + 1, nxt);
        const char* nA = has_next ? (const char*)g.A + (size_t)nxt.pm * tstep : cA; const char* nB = has_next ? (const char*)g.Bt + (size_t)nxt.pn * tstep : cB;
        for (int t = 0; t < nt; t += 2) {
            const bool last = (t == nt - 2);
            const char* a1 = cA + (size_t)(t + 1) * kstep;
            const char* a2 = last ? nA : cA + (size_t)(t + 2) * kstep; const char* b2 = last ? nB : cB + (size_t)(t + 2) * kstep;
            const char* a3 = a2 + kstep; const char* b3 = b2 + kstep;
            if (last && has_next) S.a_ready(nxt);
            if constexpr (SP2) {
            PG8_LDB(B0, 0, 0); PG8_LDB(B1, 0, 1); PG8_SCHED; PG8_LDA(At, 0, 0); PG8_STAGE(PG8_SA(1, 1), a1 + hstep, voffA);
            PG8_WAIT_V(8); PG8_WAIT_L(0); PG8_BAR; PG8_MMA(0, 0, At, B0); PG8_MMA(0, 1, At, B1); PG8_BAR; PG8_SCHED;
            PG8_LDA(At, 0, 1); PG8_STAGE(PG8_SB(0, 0), b2, voffB); PG8_STAGE(PG8_SB(0, 1), b2 + hstep, voffB); PG8_STAGE(PG8_SA(0, 0), a2, voffA);
            PG8_WAIT_V(8); PG8_WAIT_L(0); PG8_BAR; PG8_MMA(1, 0, At, B0); PG8_MMA(1, 1, At, B1); PG8_BAR; PG8_SCHED;
            PG8_LDB(B0, 1, 0); PG8_LDB(B1, 1, 1); PG8_SCHED; PG8_LDA(At, 1, 0); PG8_STAGE(PG8_SA(0, 1), a2 + hstep, voffA);
            PG8_WAIT_V(8); PG8_WAIT_L(0); PG8_BAR; PG8_MMA(0, 0, At, B0); PG8_MMA(0, 1, At, B1); PG8_BAR; PG8_SCHED;
            PG8_LDA(At, 1, 1); PG8_STAGE(PG8_SB(1, 0), b3, voffB); PG8_STAGE(PG8_SB(1, 1), b3 + hstep, voffB); PG8_STAGE(PG8_SA(1, 0), a3, voffA);
            PG8_WAIT_V(8); PG8_WAIT_L(0); PG8_BAR; PG8_MMA(1, 0, At, B0); PG8_MMA(1, 1, At, B1); PG8_BAR; PG8_SCHED;
            } else {
            PG8_LDB(B0, 0, 0); PG8_SCHED; PG8_LDA(At, 0, 0); PG8_STAGE(PG8_SA(1, 1), a1 + hstep, voffA);
            PG8_WAIT_L(8); PG8_BAR; PG8_WAIT_L(0); PG8_MMA(0, 0, At, B0); PG8_BAR; PG8_SCHED;
            PG8_LDB(B1, 0, 1); PG8_STAGE(PG8_SB(0, 0), b2, voffB);
            PG8_BAR; PG8_WAIT_L(0); PG8_MMA(0, 1, At, B1); PG8_BAR;
            PG8_LDA(At, 0, 1); PG8_STAGE(PG8_SA(0, 0), a2, voffA);
            PG8_BAR; PG8_WAIT_L(0); PG8_MMA(1, 0, At, B0); PG8_BAR; PG8_SCHED;
            PG8_STAGE(PG8_SB(0, 1), b2 + hstep, voffB);
            PG8_WAIT_V(6); PG8_BAR; PG8_MMA(1, 1, At, B1); PG8_BAR;
            PG8_LDB(B0, 1, 0); PG8_SCHED; PG8_LDA(At, 1, 0); PG8_STAGE(PG8_SA(0, 1), a2 + hstep, voffA);
            PG8_WAIT_L(8); PG8_BAR; PG8_WAIT_L(0); PG8_MMA(0, 0, At, B0); PG8_BAR; PG8_SCHED;
            PG8_LDB(B1, 1, 1); PG8_STAGE(PG8_SB(1, 0), b3, voffB);
            PG8_BAR; PG8_WAIT_L(0); PG8_MMA(0, 1, At, B1); PG8_BAR;
            PG8_LDA(At, 1, 1); PG8_STAGE(PG8_SA(1, 0), a3, voffA);
            PG8_BAR; PG8_WAIT_L(0); PG8_MMA(1, 0, At, B0); PG8_BAR; PG8_SCHED;
            PG8_STAGE(PG8_SB(1, 1), b3 + hstep, voffB);
            PG8_WAIT_V(6); PG8_BAR; PG8_MMA(1, 1, At, B1); PG8_BAR;
            }
        }
        if constexpr (ALIGN_EPI) { if (wr == 0) PG8_BAR; }
        if constexpr (!Epi::AFTER_DRAIN) { E(acc, cur, wr, wc, fr, fq); S.done(cur); }
        if (!has_next) break;
#pragma unroll
        for (int a = 0; a < 2; ++a)
#pragma unroll
            for (int b = 0; b < 2; ++b)
#pragma unroll
                for (int m = 0; m < 4; ++m)
#pragma unroll
                    for (int n = 0; n < 2; ++n) acc[a][b][m][n] = (f32x4){0.f, 0.f, 0.f, 0.f};
        cur = nxt; cA = nA; cB = nB; ++ui;
        if constexpr (ALIGN_EPI) { if (wr == 1) PG8_BAR; }
    }
    PG8_WAIT_V(0);
    if constexpr (!ALIGN_EPI) { if (wr == 0) PG8_BAR; }
    PG8_BAR;
    if constexpr (Epi::AFTER_DRAIN) { E.fused(acc, cur, wr, wc, fr, fq, lds, wid, lane); S.done(cur); }
#undef PG8_SA
#undef PG8_SB
#undef PG8_STAGE
#undef PG8_LDA
#undef PG8_LDB
#undef PG8_MMA
#undef PG8_WAIT_V
#undef PG8_WAIT_L
#undef PG8_BAR
#undef PG8_SCHED
}
}

constexpr int DM = 2048, NB = 4, SEQ = 2048, MT = NB * SEQ, NLAYER = 4;
constexpr int EVEN_IN = 5120, ODD_IN = 2304, DFF = 5504, DFF2 = 11008;
constexpr float LOG2E = 1.4426950408889634f;
constexpr float QSCALE_A = 0.08838834764831845f * LOG2E;
constexpr float QSCALE_C = 0.125f * LOG2E;
enum { I_X = 0, I_C, I_POS, I_ADA_W, I_ADA_B, I_NORM_MIX, I_NORM_FFN, I_NORM_FINAL,
       I_EV_W_IN, I_EV_CONV_W, I_EV_CONV_B, I_EV_GA_W, I_EV_GA_B, I_EV_GX_W, I_EV_GX_B, I_EV_LAMBDA, I_EV_W_OUT,
       I_OD_W_IN, I_OD_SINKS, I_OD_A_RE, I_OD_A_IM, I_OD_B_RE, I_OD_B_IM, I_OD_C_RE, I_OD_C_IM, I_OD_D, I_OD_LOG_DT, I_OD_GLU_W, I_OD_GLU_B, I_OD_W_OUT,
       I_FFN_W_IN, I_FFN_CONV_W, I_FFN_CONV_B, I_FFN_W_OUT, N_INPUTS };
constexpr size_t MiB = 1u << 20;
constexpr size_t WS_CTL = 0, CTL_ZERO_BYTES = MiB;
constexpr size_t WS_MOD = 1 * MiB;
constexpr size_t WS_COSA = 2 * MiB, WS_SINA = 4 * MiB, WS_COSC = 6 * MiB, WS_SINC = 7 * MiB;
constexpr size_t WS_S5T = 8 * MiB;
constexpr size_t WS_WGATE = 10 * MiB;
constexpr size_t WS_W_EVIN = 12 * MiB, WS_W_EVOUT = 52 * MiB, WS_W_ODIN = 68 * MiB, WS_W_ODOUT = 86 * MiB, WS_W_GLU = 102 * MiB, WS_W_FFIN = 106 * MiB, WS_W_FFOUT = 278 * MiB;
constexpr size_t WS_H = 364 * MiB, WS_MIX = 396 * MiB, WS_Q = 428 * MiB, WS_K = 444 * MiB, WS_V = 460 * MiB, WS_XB = 476 * MiB, WS_YB = 492 * MiB;
constexpr size_t WS_XC = 508 * MiB, WS_LA = 540 * MiB, WS_LB = 572 * MiB, WS_UFF = 604 * MiB, WS_ACT = 776 * MiB, WS_END = 862 * MiB;
constexpr int CW_BAR = 4096;
constexpr int RING_BYTES = 131072, LDSCTL_OFF = 143360, LDS_BYTES = 147456;

#define GAS __attribute__((address_space(1)))
#define LAS __attribute__((address_space(3)))
typedef unsigned short bf16;
typedef float f32x4 __attribute__((ext_vector_type(4)));
typedef float f32x2 __attribute__((ext_vector_type(2)));
typedef unsigned u32x4 __attribute__((ext_vector_type(4)));
typedef unsigned u32x2 __attribute__((ext_vector_type(2)));
#define LDS_WAIT() asm volatile("s_waitcnt lgkmcnt(0)" ::: "memory")
using pg8::cvt_pk_bf16; using pg8::bf_lo; using pg8::bf_hi; using pg8::gelu_tanh;
__device__ __forceinline__ float wave_sum(float v) {
#pragma unroll
    for (int o = 1; o < 64; o <<= 1) v += __shfl_xor(v, o);
    return v;
}
__device__ __forceinline__ unsigned short f2bf(float f) { return (unsigned short)(cvt_pk_bf16(f, 0.f) & 0xffffu); }
__device__ __forceinline__ float bf2f(unsigned short b) { return __uint_as_float(((unsigned)b) << 16); }

struct Params { const float* in[N_INPUTS]; float* out; unsigned char* ws; int lo, hi, li, pad; };
typedef const __attribute__((address_space(4))) Params* KP;
#define KPREF(P, kp0) KP kp_ = (kp0); asm volatile("" : "+s"(kp_)); const __attribute__((address_space(4))) Params& P = *kp_
#define PHASE_IDS() int tid = threadIdx.x; asm volatile("" : "+v"(tid)); const int lane = tid & 63, wave = __builtin_amdgcn_readfirstlane(tid >> 6); int bx = blockIdx.x; asm volatile("" : "+s"(bx)); const int G = gridDim.x; (void)lane; (void)wave; (void)G
#define XB_TMO      128
#define XB_XCNT(j)  (256  + 64 * (j))
#define XB_XSUB(j)  (1280 + 64 * (j))
#define XB_XGEN(j)  (2304 + 64 * (j))
#define XB_TOP      3328
#define XB_TOPGEN   3392
#define XCD_BAR_WORDS 3456
#define XB_SPIN_CAP (1u << 18)
#define LAS __attribute__((address_space(3)))

__device__ __forceinline__ unsigned xb_ld(unsigned* p)              { return __hip_atomic_load(p, __ATOMIC_RELAXED, __HIP_MEMORY_SCOPE_AGENT); }
__device__ __forceinline__ unsigned xb_add(unsigned* p, unsigned v) { return __hip_atomic_fetch_add(p, v, __ATOMIC_RELAXED, __HIP_MEMORY_SCOPE_AGENT); }
__device__ __forceinline__ unsigned xb_xcc_id() { return (unsigned)__builtin_amdgcn_s_getreg((3 << 11) | 20) & 0xFu; }
#define XB_SPIN(cond, bar) do { unsigned _sp = 0; while (cond) { __builtin_amdgcn_s_sleep(1); \
    if ((++_sp & 255u) == 0u) { if (xb_ld(&(bar)[XB_TMO])) break; if (_sp > XB_SPIN_CAP) { atomicAdd(&(bar)[XB_TMO], 1u); break; } } } } while (0)

struct XcdBarrier {
    unsigned* bar; unsigned x;
    volatile LAS unsigned* st;
};

__device__ __forceinline__ XcdBarrier xcd_barrier_post(unsigned* bar, volatile LAS unsigned* st) {
    XcdBarrier b; b.bar = bar; b.x = xb_xcc_id(); b.st = st;
    if (threadIdx.x == 0) (void)xb_add(&bar[XB_XCNT(b.x)], 1u);
    return b;
}
__device__ __forceinline__ void xcd_barrier_complete(unsigned* bar, unsigned x, unsigned& nloc, unsigned& nx) {
    const unsigned G = gridDim.x * gridDim.y * gridDim.z;
    unsigned sum, cnt, mine, sp = 0u;
    for (;;) {
        sum = 0u; cnt = 0u; mine = 0u;
#pragma unroll
        for (unsigned j = 0; j < 16; ++j) { const unsigned c = xb_ld(&bar[XB_XCNT(j)]); sum += c; cnt += (c > 0u) ? 1u : 0u; mine = (j == x) ? c : mine; }
        if (sum == G) break;
        __builtin_amdgcn_s_sleep(1);
        if ((++sp & 255u) == 0u) { if (xb_ld(&bar[XB_TMO])) break; if (sp > XB_SPIN_CAP) { atomicAdd(&bar[XB_TMO], 1u); break; } }
    }
    nloc = mine > 0u ? mine : 1u; nx = cnt > 0u ? cnt : 1u;
}

__device__ __forceinline__ void xcd_barrier(const XcdBarrier& b) {
    asm volatile("s_waitcnt vmcnt(0)" ::: "memory");
    __syncthreads();
    if (threadIdx.x == 0) {
        unsigned* bar = b.bar;
        __builtin_amdgcn_s_waitcnt(0);
        unsigned nloc = b.st[0], nx = b.st[1];
        if (nloc == 0u) { xcd_barrier_complete(bar, b.x, nloc, nx); b.st[0] = nloc; b.st[1] = nx; }
        const unsigned old = xb_add(&bar[XB_XSUB(b.x)], 1u);
        const unsigned gen = old / nloc;
        if (old + 1u == (gen + 1u) * nloc) {
            __builtin_amdgcn_fence(__ATOMIC_RELEASE, "agent");
            asm volatile("s_waitcnt vmcnt(0)" ::: "memory");
            const unsigned og = xb_add(&bar[XB_TOP], 1u);
            const unsigned tg = og / nx;
            if (og + 1u == (tg + 1u) * nx) xb_add(&bar[XB_TOPGEN], 1u);
            else XB_SPIN(xb_ld(&bar[XB_TOPGEN]) == tg, bar);
            __builtin_amdgcn_fence(__ATOMIC_ACQUIRE, "agent");
            xb_add(&bar[XB_XGEN(b.x)], 1u);
            asm volatile("s_waitcnt vmcnt(0)" ::: "memory");
        } else {
            XB_SPIN(xb_ld(&bar[XB_XGEN(b.x)]) == gen, bar);
            __builtin_amdgcn_fence(__ATOMIC_ACQUIRE, "agent");
            asm volatile("s_waitcnt vmcnt(0)" ::: "memory");
        }
    }
    __syncthreads();
}

__device__ __forceinline__ void phase_ada(KP kp0, LAS unsigned char* lds) { KPREF(P, kp0); PHASE_IDS();
    LAS float* cond = (LAS float*)lds;
    LAS float* part = (LAS float*)(lds + 32768);
    const float* c = P.in[I_C];
    for (int i = tid; i < NB * DM; i += 512) { const float v = c[i]; cond[i] = v / (1.0f + __expf(-v)); }
    __syncthreads();
    float* mod = (float*)(P.ws + WS_MOD);
    for (int item = bx; item < 192; item += G) {
        const int l = item / 48, ng = item % 48;
        const float* W = P.in[I_ADA_W] + (size_t)l * DM * 12288 + (size_t)(wave * 256) * 12288 + ng * 256 + lane * 4;
        f32x4 a0 = {0.f, 0.f, 0.f, 0.f}, a1 = a0, a2 = a0, a3 = a0;
#pragma unroll 8
        for (int k = 0; k < 256; ++k) {
            const f32x4 w = *(const f32x4*)(W + (size_t)k * 12288); const int kk = wave * 256 + k;
            a0 += cond[kk] * w; a1 += cond[2048 + kk] * w; a2 += cond[4096 + kk] * w; a3 += cond[6144 + kk] * w;
        }
        LAS float* pp = part + wave * 1024 + lane * 4;
        *(LAS f32x4*)(pp) = a0; *(LAS f32x4*)(pp + 256) = a1; *(LAS f32x4*)(pp + 512) = a2; *(LAS f32x4*)(pp + 768) = a3;
        __syncthreads();
        for (int o = tid; o < 1024; o += 512) {
            float s = 0.f;
#pragma unroll
            for (int w = 0; w < 8; ++w) s += part[w * 1024 + o];
            const int b = o >> 8, cc = o & 255;
            mod[(size_t)(l * 4 + b) * 12288 + ng * 256 + cc] = s + P.in[I_ADA_B][l * 12288 + ng * 256 + cc];
        }
        __syncthreads();
    }
}

__constant__ int TRJOBS[7][6] = {
    {I_EV_W_IN, 2048, 5120, 2, 1, 12}, {I_EV_W_OUT, 2048, 2048, 2, 0, 52}, {I_OD_W_IN, 2048, 2304, 2, 2, 68}, {I_OD_W_OUT, 2048, 2048, 2, 0, 86},
    {I_OD_GLU_W, 1024, 1024, 2, 0, 102}, {I_FFN_W_IN, 2048, 11008, 4, 0, 106}, {I_FFN_W_OUT, 5504, 2048, 4, 0, 278} };
__device__ __forceinline__ int cmap(int type, int n) {
    if (type == 1) { if (n >= 2048) return n; const int tile = n >> 8, j = n & 255, bj = j >> 7, jj = j & 127; return tile * 256 + (jj >> 6) * 128 + bj * 64 + (jj & 63); }
    if (type == 2) {
        if (n >= 1280) return n;
        if (n < 1024) { const int tile = n >> 8, j = n & 255, bj = j >> 7, jj = j & 127; return tile * 256 + (jj >> 5) * 64 + bj * 32 + (jj & 31); }
        const int j = n - 1024, bj = j >> 7, jj = j & 127; if (jj < 64) return 1024 + (jj >> 5) * 64 + bj * 32 + (jj & 31); return 1152 + bj * 64 + (jj - 64);
    }
    return n;
}
__device__ __forceinline__ void tr_item(const float* W, int K, int N, bf16* WT, int k0, int srcc0, int dstr0, LAS float* scr, int lane) {
#pragma unroll 8
    for (int i = 0; i < 32; ++i) { const int kk = 2 * i + (lane >> 5); scr[kk * 33 + (lane & 31)] = W[(size_t)(k0 + kk) * N + srcc0 + (lane & 31)]; }
    LDS_WAIT(); asm volatile("" ::: "memory");
    const int c = lane & 7;
#pragma unroll
    for (int j = 0; j < 4; ++j) { const int n = (lane >> 3) + 8 * j; const LAS float* s = scr + (8 * c) * 33 + n;
        u32x4 o; o.x = cvt_pk_bf16(s[0 * 33], s[1 * 33]); o.y = cvt_pk_bf16(s[2 * 33], s[3 * 33]); o.z = cvt_pk_bf16(s[4 * 33], s[5 * 33]); o.w = cvt_pk_bf16(s[6 * 33], s[7 * 33]);
        *(u32x4*)(WT + (size_t)(dstr0 + n) * K + k0 + 8 * c) = o; }
    LDS_WAIT(); asm volatile("" ::: "memory");
}
__device__ __forceinline__ void sincos_rev(double ang, float& s, float& c) {
    double rev = ang * 0.15915494309189535; rev -= floor(rev); const float fr = (float)rev;
    s = __builtin_amdgcn_sinf(fr); c = __builtin_amdgcn_cosf(fr);
}
__device__ __forceinline__ void phase_prep(KP kp0, LAS unsigned char* lds) { KPREF(P, kp0); PHASE_IDS();
    LAS float* scr = (LAS float*)(lds + wave * 16384);
    const int gw = bx * 8 + wave, NGW = G * 8;
    int total = 0;
#pragma unroll
    for (int q = 0; q < 7; ++q) total += TRJOBS[q][3] * (TRJOBS[q][1] / 64) * (TRJOBS[q][2] / 32);
    for (int it = gw; it < total; it += NGW) {
        int r = it, j = 0;
#pragma unroll
        for (int q = 0; q < 6; ++q) { const int cnt = TRJOBS[q][3] * (TRJOBS[q][1] / 64) * (TRJOBS[q][2] / 32); if (j == q && r >= cnt) { r -= cnt; j = q + 1; } }
        const int K = TRJOBS[j][1], N = TRJOBS[j][2], per = (K / 64) * (N / 32), li = r / per, rr = r % per, nblk = N / 32, kb = rr / nblk, nb = rr % nblk;
        const float* src = P.in[TRJOBS[j][0]] + (size_t)li * K * N;
        bf16* dst = (bf16*)(P.ws + (size_t)TRJOBS[j][5] * MiB) + (size_t)li * K * N;
        tr_item(src, K, N, dst, 64 * kb, cmap(TRJOBS[j][4], 32 * nb), 32 * nb, scr, lane);
    }
    for (int it = gw; it < 256; it += NGW) { const int mat = it >> 3, rr = it & 7, kb = rr >> 2, nb = rr & 3, gate = mat & 1, eb = mat >> 1;
        tr_item(P.in[gate ? I_EV_GX_W : I_EV_GA_W] + (size_t)eb * 16384, 128, 128, (bf16*)(P.ws + WS_WGATE) + ((size_t)eb * 256 + gate * 128) * 128, 64 * kb, 32 * nb, 32 * nb, scr, lane); }
    const int gt = bx * 512 + tid, NT = G * 512;
    const int* pos = (const int*)P.in[I_POS];
    float* cosA = (float*)(P.ws + WS_COSA); float* sinA = (float*)(P.ws + WS_SINA); float* cosC = (float*)(P.ws + WS_COSC); float* sinC = (float*)(P.ws + WS_SINC);
    for (int idx = gt; idx < MT * 64; idx += NT) { const int row = idx >> 6, i = idx & 63;
        const double inv = exp2(-(double)i * (13.287712379549449 / 64.0)); float s, c; sincos_rev((double)pos[row] * inv, s, c); cosA[idx] = c; sinA[idx] = s; }
    for (int idx = gt; idx < MT * 32; idx += NT) { const int row = idx >> 5, i = idx & 31;
        const double inv = exp2(-(double)i * (13.287712379549449 / 32.0)); float s, c; sincos_rev((double)pos[row] * inv, s, c); cosC[idx] = c; sinC[idx] = s; }
    for (int idx = gt; idx < 2 * 64 * 64; idx += NT) { const int o = idx >> 12, g = (idx >> 6) & 63;
        const float are = P.in[I_OD_A_RE][idx], aim = P.in[I_OD_A_IM][idx], dt = expf(P.in[I_OD_LOG_DT][o * 64 + g]);
        const float er = expf(are * dt); float s, c; sincos_rev((double)aim * (double)dt, s, c);
        const float abr = er * c, abi = er * s, xr = abr - 1.0f, xi = abi, den = 1.0f / (are * are + aim * aim);
        const float cr = (xr * are + xi * aim) * den, ci = (xi * are - xr * aim) * den;
        f32x2* abar = (f32x2*)(P.ws + WS_S5T + (size_t)o * MiB); f32x2* bbar = (f32x2*)(P.ws + WS_S5T + (size_t)o * MiB + 65536);
        abar[idx & 4095] = (f32x2){abr, abi};
#pragma unroll
        for (int cc = 0; cc < 16; ++cc) { const float br = P.in[I_OD_B_RE][(size_t)idx * 16 + cc], bi = P.in[I_OD_B_IM][(size_t)idx * 16 + cc];
            bbar[(size_t)(idx & 4095) * 16 + cc] = (f32x2){cr * br - ci * bi, cr * bi + ci * br}; }
    }
}

__device__ __forceinline__ void phase_norm(KP kp0, int l, int which) { KPREF(P, kp0); PHASE_IDS();
    const float* x = (l == 0 && which == 0) ? P.in[I_X] : P.out;
    const float* gwt = P.in[which ? I_NORM_FFN : I_NORM_MIX] + l * DM;
    const float* modl = (const float*)(P.ws + WS_MOD) + (size_t)l * 4 * 12288 + (which ? 3 * DM : 0);
    bf16* H = (bf16*)(P.ws + WS_H);
    const int gw = bx * 8 + wave, NGW = G * 8;
    for (int row = gw; row < MT; row += NGW) {
        const f32x4* xr = (const f32x4*)(x + (size_t)row * DM) + lane;
        f32x4 v[8]; float ss = 0.f;
#pragma unroll
        for (int j = 0; j < 8; ++j) { v[j] = xr[64 * j]; ss += (v[j][0] * v[j][0] + v[j][1] * v[j][1]) + (v[j][2] * v[j][2] + v[j][3] * v[j][3]); }
        const float rstd = rsqrtf(wave_sum(ss) * (1.0f / DM) + 1e-6f);
        const float* sh = modl + (size_t)(row >> 11) * 12288; const float* sc = sh + DM;
        u32x2* o8 = (u32x2*)(H + (size_t)row * DM) + lane;
#pragma unroll
        for (int j = 0; j < 8; ++j) { const int col = (lane + 64 * j) * 4;
            const f32x4 g4 = *(const f32x4*)(gwt + col), s4 = *(const f32x4*)(sc + col), h4 = *(const f32x4*)(sh + col);
            const f32x4 y = v[j] * rstd * g4 * (1.0f + s4) + h4;
            u32x2 w; w.x = cvt_pk_bf16(y[0], y[1]); w.y = cvt_pk_bf16(y[2], y[3]); o8[64 * j] = w; }
    }
}
__device__ __forceinline__ void phase_final(KP kp0) { KPREF(P, kp0); PHASE_IDS();
    const float* gwt = P.in[I_NORM_FINAL];
    const int gw = bx * 8 + wave, NGW = G * 8;
    for (int row = gw; row < MT; row += NGW) {
        f32x4* xr = (f32x4*)(P.out + (size_t)row * DM) + lane;
        f32x4 v[8]; float ss = 0.f;
#pragma unroll
        for (int j = 0; j < 8; ++j) { v[j] = xr[64 * j]; ss += (v[j][0] * v[j][0] + v[j][1] * v[j][1]) + (v[j][2] * v[j][2] + v[j][3] * v[j][3]); }
        const float rstd = rsqrtf(wave_sum(ss) * (1.0f / DM) + 1e-6f);
#pragma unroll
        for (int j = 0; j < 8; ++j) { const int col = (lane + 64 * j) * 4; xr[64 * j] = v[j] * rstd * *(const f32x4*)(gwt + col); }
    }
}

__device__ __forceinline__ void phase_attn_a_naive(KP kp0) { KPREF(P, kp0); PHASE_IDS();
    const bf16* Q = (const bf16*)(P.ws + WS_Q); const bf16* K = (const bf16*)(P.ws + WS_K); const bf16* V = (const bf16*)(P.ws + WS_V); bf16* MIX = (bf16*)(P.ws + WS_MIX);
    const int gw = bx * 8 + wave, NGW = G * 8;
    for (int task = gw; task < MT * 8; task += NGW) {
        const int h = task & 7, row = task >> 3, b = row >> 11, t = row & 2047;
        const unsigned qw = *(const unsigned*)(Q + (size_t)row * 1024 + h * 128 + 2 * lane); const float q0 = bf_lo(qw), q1 = bf_hi(qw);
        float m = -INFINITY, l = 0.f, o0 = 0.f, o1 = 0.f;
        for (int pat = 0; pat < 3; ++pat) { const int dil = pat == 0 ? 1 : (pat == 1 ? 4 : 16);
            for (int j = 0; j <= 128; ++j) { const int tk = t - dil * j; if (tk < 0) break;
                const size_t kr = (size_t)(b * SEQ + tk) * 1024 + h * 128 + 2 * lane;
                const unsigned kw = *(const unsigned*)(K + kr), vw = *(const unsigned*)(V + kr);
                const float s = wave_sum(q0 * bf_lo(kw) + q1 * bf_hi(kw));
                const float mn = fmaxf(m, s), corr = exp2f(m - mn), p = exp2f(s - mn);
                l = l * corr + p; o0 = o0 * corr + p * bf_lo(vw); o1 = o1 * corr + p * bf_hi(vw); m = mn; } }
        const float inv = 1.0f / l;
        *(unsigned*)(MIX + (size_t)row * 2048 + h * 128 + 2 * lane) = cvt_pk_bf16(o0 * inv, o1 * inv);
    }
}
__device__ __forceinline__ void phase_attn_c_naive(KP kp0, int o_idx) { KPREF(P, kp0); PHASE_IDS();
    const bf16* Q = (const bf16*)(P.ws + WS_Q); const bf16* K = (const bf16*)(P.ws + WS_K); const bf16* V = (const bf16*)(P.ws + WS_V); bf16* MIX = (bf16*)(P.ws + WS_MIX);
    const int gw = bx * 8 + wave, NGW = G * 8;
    for (int task = gw; task < MT * 16; task += NGW) {
        const int h = task & 15, row = task >> 4, b = row >> 11, t = row & 2047, kvh = h >> 3;
        const float q = bf2f(Q[(size_t)row * 1024 + h * 64 + lane]);
        float m = -INFINITY, l = 0.f, o = 0.f;
        for (int tk = (t >= 127 ? t - 127 : 0); tk <= t; ++tk) {
            const size_t kr = (size_t)(b * SEQ + tk) * 128 + kvh * 64 + lane;
            const float s = wave_sum(q * bf2f(K[kr]));
            const float mn = fmaxf(m, s), corr = exp2f(m - mn), p = exp2f(s - mn);
            l = l * corr + p; o = o * corr + p * bf2f(V[kr]); m = mn; }
        const float sk = P.in[I_OD_SINKS][o_idx * 16 + h] * LOG2E;
        MIX[(size_t)row * 2048 + h * 64 + lane] = f2bf(o / (l + exp2f(sk - m)));
    }
}
__device__ __forceinline__ void phase_lru1_naive(KP kp0, int e) { KPREF(P, kp0); PHASE_IDS();
    const bf16* XB = (const bf16*)(P.ws + WS_XB); float* XC = (float*)(P.ws + WS_XC);
    const float* cw = P.in[I_EV_CONV_W] + (size_t)e * 4 * 1024; const float* cb = P.in[I_EV_CONV_B] + e * 1024;
    const int gt = bx * 512 + tid, NT = G * 512;
    for (int idx = gt; idx < MT * 1024; idx += NT) { const int row = idx >> 10, c = idx & 1023, t = row & 2047;
        float acc = cb[c];
#pragma unroll
        for (int i = 0; i < 4; ++i) { const int tt = t - 3 + i; if (tt >= 0) acc += cw[i * 1024 + c] * bf2f(XB[(size_t)(row - 3 + i) * 1024 + c]); }
        XC[idx] = acc; }
}
__device__ __forceinline__ void phase_lru2_naive(KP kp0, int e) { KPREF(P, kp0); PHASE_IDS();
    const float* XC = (const float*)(P.ws + WS_XC); float* LA = (float*)(P.ws + WS_LA); float* LB = (float*)(P.ws + WS_LB);
    const int gt = bx * 512 + tid, NT = G * 512;
    for (int idx = gt; idx < MT * 1024; idx += NT) { const int row = idx >> 10, c = idx & 1023, blk = c >> 7, j = c & 127;
        const float* xr = XC + (size_t)row * 1024 + blk * 128;
        const float* wa = P.in[I_EV_GA_W] + (size_t)((e * 8 + blk) * 128) * 128 + j; const float* wx = P.in[I_EV_GX_W] + (size_t)((e * 8 + blk) * 128) * 128 + j;
        float sa = P.in[I_EV_GA_B][e * 1024 + c], sx = P.in[I_EV_GX_B][e * 1024 + c];
#pragma unroll 8
        for (int i = 0; i < 128; ++i) { const float xv = xr[i]; sa += xv * wa[i * 128]; sx += xv * wx[i * 128]; }
        const float r = 1.0f / (1.0f + expf(-sa)), ig = 1.0f / (1.0f + expf(-sx));
        const float sp = log1pf(expf(-P.in[I_EV_LAMBDA][e * 1024 + c]));
        const float log_a = -8.0f * r * sp, a = expf(log_a), mult = sqrtf(-expm1f(2.0f * log_a));
        LA[idx] = a; LB[idx] = mult * ig * xr[j]; }
}
__device__ __forceinline__ void phase_lru3_naive(KP kp0) { KPREF(P, kp0); PHASE_IDS();
    const float* LA = (const float*)(P.ws + WS_LA); const float* LB = (const float*)(P.ws + WS_LB); const bf16* YB = (const bf16*)(P.ws + WS_YB); bf16* MIX = (bf16*)(P.ws + WS_MIX);
    if (wave != 0) return;
    for (int task = bx; task < 64; task += G) { const int b = task >> 4, c = (task & 15) * 64 + lane;
        float h = 0.f;
#pragma unroll 8
        for (int t = 0; t < SEQ; ++t) { const size_t idx = (size_t)(b * SEQ + t) * 1024 + c;
            h = LA[idx] * h + LB[idx];
            MIX[(size_t)(b * SEQ + t) * 2048 + 1024 + c] = f2bf(h * bf2f(YB[idx])); } }
}
__device__ __forceinline__ void phase_s5_naive(KP kp0, int o_idx) { KPREF(P, kp0); PHASE_IDS();
    const bf16* U = (const bf16*)(P.ws + WS_XB); bf16* Z = (bf16*)(P.ws + WS_YB);
    if (wave != 0) return;
    for (int bg = bx; bg < 256; bg += G) { const int b = bg >> 6, g = bg & 63;
        const f32x2 ab = ((const f32x2*)(P.ws + WS_S5T + (size_t)o_idx * MiB))[g * 64 + lane];
        const f32x2* bbp = (const f32x2*)(P.ws + WS_S5T + (size_t)o_idx * MiB + 65536) + (size_t)(g * 64 + lane) * 16;
        f32x2 bb[16]; float cre[16], cim[16], dsk[16];
#pragma unroll
        for (int c = 0; c < 16; ++c) { bb[c] = bbp[c];
            cre[c] = P.in[I_OD_C_RE][((size_t)(o_idx * 64 + g) * 16 + c) * 64 + lane]; cim[c] = P.in[I_OD_C_IM][((size_t)(o_idx * 64 + g) * 16 + c) * 64 + lane];
            dsk[c] = P.in[I_OD_D][o_idx * 1024 + g * 16 + c]; }
        float hr = 0.f, hi = 0.f;
        for (int t = 0; t < SEQ; ++t) { const size_t row = (size_t)(b * SEQ + t);
            const u32x4 u0 = *(const u32x4*)(U + row * 1024 + g * 16), u1 = *(const u32x4*)(U + row * 1024 + g * 16 + 8);
            float u[16] = {bf_lo(u0.x), bf_hi(u0.x), bf_lo(u0.y), bf_hi(u0.y), bf_lo(u0.z), bf_hi(u0.z), bf_lo(u0.w), bf_hi(u0.w),
                           bf_lo(u1.x), bf_hi(u1.x), bf_lo(u1.y), bf_hi(u1.y), bf_lo(u1.z), bf_hi(u1.z), bf_lo(u1.w), bf_hi(u1.w)};
            float bur = 0.f, bui = 0.f;
#pragma unroll
            for (int c = 0; c < 16; ++c) { bur += u[c] * bb[c][0]; bui += u[c] * bb[c][1]; }
            const float nr = ab[0] * hr - ab[1] * hi + bur, ni = ab[0] * hi + ab[1] * hr + bui; hr = nr; hi = ni;
            float zo = 0.f;
#pragma unroll
            for (int c = 0; c < 16; ++c) { const float y = wave_sum(hr * cre[c] - hi * cim[c]) + dsk[c] * u[c]; const float z = gelu_tanh(y); zo = (lane == c) ? z : zo; }
            if (lane < 16) Z[row * 1024 + g * 16 + lane] = f2bf(zo); }
    }
}
__device__ __forceinline__ void phase_ffn_act(KP kp0, int l) { KPREF(P, kp0); PHASE_IDS();
    const bf16* U = (const bf16*)(P.ws + WS_UFF); bf16* ACT = (bf16*)(P.ws + WS_ACT);
    const float* cw = P.in[I_FFN_CONV_W] + (size_t)l * 3 * DFF2; const float* cb = P.in[I_FFN_CONV_B] + (size_t)l * DFF2;
    const int gt = bx * 512 + tid, NT = G * 512;
    for (int idx = gt; idx < MT * (DFF / 8); idx += NT) { const int row = idx / (DFF / 8), j0 = (idx % (DFF / 8)) * 8, t = row & 2047;
        float ag[8], av[8];
#pragma unroll
        for (int q = 0; q < 8; ++q) { ag[q] = cb[j0 + q]; av[q] = cb[DFF + j0 + q]; }
#pragma unroll
        for (int i = 0; i < 3; ++i) { const int tt = t - 2 + i; if (tt >= 0) {
            const u32x4 ug = *(const u32x4*)(U + (size_t)(row - 2 + i) * DFF2 + j0), uv = *(const u32x4*)(U + (size_t)(row - 2 + i) * DFF2 + DFF + j0);
            const float* wg = cw + (size_t)i * DFF2 + j0; const float* wv = wg + DFF;
            ag[0] += wg[0] * bf_lo(ug.x); ag[1] += wg[1] * bf_hi(ug.x); ag[2] += wg[2] * bf_lo(ug.y); ag[3] += wg[3] * bf_hi(ug.y);
            ag[4] += wg[4] * bf_lo(ug.z); ag[5] += wg[5] * bf_hi(ug.z); ag[6] += wg[6] * bf_lo(ug.w); ag[7] += wg[7] * bf_hi(ug.w);
            av[0] += wv[0] * bf_lo(uv.x); av[1] += wv[1] * bf_hi(uv.x); av[2] += wv[2] * bf_lo(uv.y); av[3] += wv[3] * bf_hi(uv.y);
            av[4] += wv[4] * bf_lo(uv.z); av[5] += wv[5] * bf_hi(uv.z); av[6] += wv[6] * bf_lo(uv.w); av[7] += wv[7] * bf_hi(uv.w); } }
        u32x4 o; o.x = cvt_pk_bf16(gelu_tanh(ag[0]) * av[0], gelu_tanh(ag[1]) * av[1]); o.y = cvt_pk_bf16(gelu_tanh(ag[2]) * av[2], gelu_tanh(ag[3]) * av[3]);
        o.z = cvt_pk_bf16(gelu_tanh(ag[4]) * av[4], gelu_tanh(ag[5]) * av[5]); o.w = cvt_pk_bf16(gelu_tanh(ag[6]) * av[6], gelu_tanh(ag[7]) * av[7]);
        *(u32x4*)(ACT + (size_t)row * DFF + j0) = o; }
}

typedef short s16x4 __attribute__((ext_vector_type(4)));
typedef short bf16x8v __attribute__((ext_vector_type(8)));
typedef float f32x16 __attribute__((ext_vector_type(16)));
__device__ __forceinline__ unsigned offb(unsigned row, unsigned ch) { return 256u * row + 16u * (ch ^ (((row & 3u) << 2) | ((row >> 2) & 3u))); }
constexpr int ATT_TILE_BYTES = 64 * 256, ATT_BUF_BYTES = 2 * ATT_TILE_BYTES;
__device__ __forceinline__ bf16x8v cat8(const s16x4 a, const s16x4 b) { return (bf16x8v){a[0], a[1], a[2], a[3], b[0], b[1], b[2], b[3]}; }

template <int MODE>
__device__ __forceinline__ void phase_attn(KP kp0, LAS unsigned char* lds, int o_idx) { KPREF(P, kp0); PHASE_IDS();
    constexpr int NKS = MODE == 0 ? 8 : 4;
    constexpr int NDT = MODE == 0 ? 4 : 2;
    constexpr int NH = 1;
    const bf16* Q = (const bf16*)(P.ws + WS_Q); const bf16* K = (const bf16*)(P.ws + WS_K); const bf16* V = (const bf16*)(P.ws + WS_V); bf16* MIX = (bf16*)(P.ws + WS_MIX);
    const int r = lane & 31, hh = lane >> 5, q4 = (lane & 15) >> 2, p4 = lane & 3, blk = (lane >> 4) & 1;
    unsigned kaddr[NKS], vaddr[2][NDT];
    { const unsigned x = ((r & 3u) << 2) | ((r >> 2) & 3u);
#pragma unroll
      for (int s = 0; s < NKS; ++s) kaddr[s] = 256u * r + 16u * (((unsigned)(2 * s + hh)) ^ x);
#pragma unroll
      for (int t = 0; t < 2; ++t)
#pragma unroll
        for (int c = 0; c < NDT; ++c) { const unsigned row = 8u * t + 4u * hh + q4, ch = 4u * c + 2u * blk + (p4 >> 1);
            vaddr[t][c] = 256u * row + 16u * (ch ^ (((row & 3u) << 2) | ((row >> 2) & 3u))) + 8u * (p4 & 1); } }
    const int nunits = MODE == 0 ? 256 : 512;
    for (int unit = bx; unit < nunits; unit += G) {
        int b, head0, q0, kt0, kt1; size_t kvbase; int kvpitch; unsigned kx = 0u;
        if (MODE == 0) { const int qb = 7 - (unit >> 5), bh = unit & 31; b = bh >> 3; head0 = bh & 7; q0 = qb * 256; kt0 = 0; kt1 = qb * 4 + 3; kvbase = (size_t)b * SEQ * 1024 + head0 * 128; kvpitch = 1024; }
        else { b = unit >> 7; const int kvh = (unit >> 6) & 1; kx = 128u * kvh; q0 = (unit & 63) * 32; head0 = 8 * kvh + wave; kt0 = (q0 >= 127 ? q0 - 127 : 0) >> 6; kt1 = (q0 + 31) >> 6; kvbase = (size_t)b * SEQ * 128; kvpitch = 128; }
        const int qw0 = MODE == 0 ? q0 + 32 * wave : q0;
        const int tq = qw0 + r;
        const size_t qrow = (size_t)b * SEQ + tq;
        bf16x8v qf[NH][NKS];
#pragma unroll
        for (int hd = 0; hd < NH; ++hd)
#pragma unroll
            for (int s = 0; s < NKS; ++s) qf[hd][s] = *(const bf16x8v*)(Q + qrow * 1024 + (MODE == 0 ? head0 * 128 : (head0 + hd) * 64) + 16 * s + 8 * hh);
        f32x16 O[NH][NDT]; float m[NH], l[NH];
#pragma unroll
        for (int hd = 0; hd < NH; ++hd) { m[hd] = -1e30f; l[hd] = 0.f;
#pragma unroll
            for (int c = 0; c < NDT; ++c)
#pragma unroll
                for (int i = 0; i < 16; ++i) O[hd][c][i] = 0.f; }
        const int srow = tid >> 4, sch = tid & 15;
        const unsigned soff0 = offb(srow, sch), soff1 = offb(srow + 32, sch);
        u32x4 kreg[2], vreg[2];
        { const size_t g0 = kvbase + (size_t)(kt0 * 64 + srow) * kvpitch + sch * 8, g1 = g0 + (size_t)32 * kvpitch;
          kreg[0] = *(const u32x4*)(K + g0); kreg[1] = *(const u32x4*)(K + g1); vreg[0] = *(const u32x4*)(V + g0); vreg[1] = *(const u32x4*)(V + g1); }
        __syncthreads();
        *(LAS u32x4*)(lds + soff0) = kreg[0]; *(LAS u32x4*)(lds + soff1) = kreg[1];
        *(LAS u32x4*)(lds + ATT_TILE_BYTES + soff0) = vreg[0]; *(LAS u32x4*)(lds + ATT_TILE_BYTES + soff1) = vreg[1];
        __syncthreads();
        for (int kt = kt0; kt <= kt1; ++kt) {
            const int cur = (kt - kt0) & 1;
            LAS unsigned char* kb_ = lds + cur * ATT_BUF_BYTES; LAS unsigned char* vb_ = kb_ + ATT_TILE_BYTES;
            if (kt < kt1) { const size_t g0 = kvbase + (size_t)((kt + 1) * 64 + srow) * kvpitch + sch * 8, g1 = g0 + (size_t)32 * kvpitch;
                kreg[0] = *(const u32x4*)(K + g0); kreg[1] = *(const u32x4*)(K + g1); vreg[0] = *(const u32x4*)(V + g0); vreg[1] = *(const u32x4*)(V + g1); }
            if (64 * kt <= qw0 + 31) {
                const int dq = tq - 64 * kt - 4 * hh;
#pragma unroll
                for (int hd = 0; hd < NH; ++hd) {
                    f32x16 S[2];
#pragma unroll
                    for (int kb = 0; kb < 2; ++kb) {
#pragma unroll
                        for (int i = 0; i < 16; ++i) S[kb][i] = 0.f;
#pragma unroll
                        for (int s = 0; s < NKS; ++s) { const bf16x8v kf = *(const LAS bf16x8v*)(kb_ + (kaddr[s] ^ kx) + kb * 8192); S[kb] = __builtin_amdgcn_mfma_f32_32x32x16_bf16(kf, qf[hd][s], S[kb], 0, 0, 0); }
                    }
                    float w[2][16]; float tmax = -INFINITY;
#pragma unroll
                    for (int kb = 0; kb < 2; ++kb)
#pragma unroll
                        for (int i = 0; i < 16; ++i) { const int d = dq - (kb * 32 + (i & 3) + 8 * (i >> 2));
                            if (MODE == 0) { const int cnt = (d <= 128 ? 1 : 0) + (((d & 3) == 0 && d <= 512) ? 1 : 0) + ((d & 15) == 0 ? 1 : 0); w[kb][i] = (d >= 0) ? (float)cnt : 0.f; }
                            else w[kb][i] = (d >= 0 && d <= 127) ? 1.f : 0.f;
                            S[kb][i] = (w[kb][i] > 0.f) ? S[kb][i] : -INFINITY; tmax = fmaxf(tmax, S[kb][i]); }
                    tmax = fmaxf(tmax, __shfl_xor(tmax, 32));
                    const float mn = fmaxf(m[hd], tmax), corr = __builtin_amdgcn_exp2f(m[hd] - mn); m[hd] = mn;
                    float ps = 0.f;
#pragma unroll
                    for (int kb = 0; kb < 2; ++kb)
#pragma unroll
                        for (int i = 0; i < 16; ++i) { const float pv = w[kb][i] * __builtin_amdgcn_exp2f(S[kb][i] - mn); S[kb][i] = pv; ps += pv; }
                    l[hd] = l[hd] * corr + ps;
#pragma unroll
                    for (int c = 0; c < NDT; ++c)
#pragma unroll
                        for (int i = 0; i < 16; ++i) O[hd][c][i] *= corr;
#pragma unroll
                    for (int kb = 0; kb < 2; ++kb)
#pragma unroll
                        for (int s2 = 0; s2 < 2; ++s2) {
                            bf16x8v pf; { const unsigned a0 = cvt_pk_bf16(S[kb][8 * s2 + 0], S[kb][8 * s2 + 1]), a1 = cvt_pk_bf16(S[kb][8 * s2 + 2], S[kb][8 * s2 + 3]),
                                                         a2 = cvt_pk_bf16(S[kb][8 * s2 + 4], S[kb][8 * s2 + 5]), a3 = cvt_pk_bf16(S[kb][8 * s2 + 6], S[kb][8 * s2 + 7]);
                                pf = __builtin_bit_cast(bf16x8v, (u32x4){a0, a1, a2, a3}); }
#pragma unroll
                            for (int c = 0; c < NDT; ++c) {
                                const s16x4 v0 = __builtin_amdgcn_ds_read_tr16_b64_v4i16((LAS s16x4*)(vb_ + (vaddr[0][c] ^ kx) + 256 * (32 * kb + 16 * s2)));
                                const s16x4 v1 = __builtin_amdgcn_ds_read_tr16_b64_v4i16((LAS s16x4*)(vb_ + (vaddr[1][c] ^ kx) + 256 * (32 * kb + 16 * s2)));
                                O[hd][c] = __builtin_amdgcn_mfma_f32_32x32x16_bf16(cat8(v0, v1), pf, O[hd][c], 0, 0, 0); }
                        }
                }
            }
            if (kt < kt1) { LAS unsigned char* nb_ = lds + (cur ^ 1) * ATT_BUF_BYTES;
                *(LAS u32x4*)(nb_ + soff0) = kreg[0]; *(LAS u32x4*)(nb_ + soff1) = kreg[1];
                *(LAS u32x4*)(nb_ + ATT_TILE_BYTES + soff0) = vreg[0]; *(LAS u32x4*)(nb_ + ATT_TILE_BYTES + soff1) = vreg[1]; }
            __syncthreads();
        }
#pragma unroll
        for (int hd = 0; hd < NH; ++hd) {
            float lt = l[hd] + __shfl_xor(l[hd], 32);
            if (MODE == 1) lt += __builtin_amdgcn_exp2f(P.in[I_OD_SINKS][o_idx * 16 + head0 + hd] * LOG2E - m[hd]);
            const float inv = 1.0f / lt;
            bf16* orow = MIX + qrow * 2048 + (MODE == 0 ? head0 * 128 : (head0 + hd) * 64);
#pragma unroll
            for (int c = 0; c < NDT; ++c)
#pragma unroll
                for (int g4 = 0; g4 < 4; ++g4) { u32x2 o; o.x = cvt_pk_bf16(O[hd][c][4 * g4 + 0] * inv, O[hd][c][4 * g4 + 1] * inv); o.y = cvt_pk_bf16(O[hd][c][4 * g4 + 2] * inv, O[hd][c][4 * g4 + 3] * inv);
                    *(u32x2*)(orow + 32 * c + 8 * g4 + 4 * hh) = o; }
        }
    }
}

__device__ __forceinline__ void phase_s5(KP kp0, LAS unsigned char* lds, int o_idx) { KPREF(P, kp0); PHASE_IDS();
    const bf16* U = (const bf16*)(P.ws + WS_XB); bf16* Z = (bf16*)(P.ws + WS_YB);
    LAS unsigned char* uL = lds;
    LAS unsigned char* hL = lds + 65536 + wave * 8704;
    LAS float* eL = (LAS float*)(lds + 65536 + 8 * 8704);
    const int r = lane & 31, hh = lane >> 5;
    for (int bg = bx; bg < 256; bg += G) { const int b = bg >> 6, g = bg & 63;
        __syncthreads();
#pragma unroll
        for (int j = 0; j < 8; ++j) { const int n = tid + 512 * j, row = n >> 1, hf = n & 1;
            *(LAS u32x4*)(uL + row * 32 + hf * 16) = *(const u32x4*)(U + (size_t)(b * SEQ + row) * 1024 + g * 16 + hf * 8); }
        const f32x2 ab = ((const f32x2*)(P.ws + WS_S5T + (size_t)o_idx * MiB))[g * 64 + lane];
        const f32x2* bbp = (const f32x2*)(P.ws + WS_S5T + (size_t)o_idx * MiB + 65536) + (size_t)(g * 64 + lane) * 16;
        f32x2 bb[16];
#pragma unroll
        for (int c = 0; c < 16; ++c) bb[c] = bbp[c];
        __syncthreads();
        const int t0 = wave * 256;
        float hr = 0.f, hi = 0.f;
#define S5_STEP(t) { const u32x4 u0 = *(const LAS u32x4*)(uL + (t) * 32), u1 = *(const LAS u32x4*)(uL + (t) * 32 + 16); \
            const float uf[16] = {bf_lo(u0.x), bf_hi(u0.x), bf_lo(u0.y), bf_hi(u0.y), bf_lo(u0.z), bf_hi(u0.z), bf_lo(u0.w), bf_hi(u0.w), bf_lo(u1.x), bf_hi(u1.x), bf_lo(u1.y), bf_hi(u1.y), bf_lo(u1.z), bf_hi(u1.z), bf_lo(u1.w), bf_hi(u1.w)}; \
            float bur = 0.f, bui = 0.f; _Pragma("unroll") for (int c = 0; c < 16; ++c) { bur += uf[c] * bb[c][0]; bui += uf[c] * bb[c][1]; } \
            const float nr = ab[0] * hr - ab[1] * hi + bur, ni = ab[0] * hi + ab[1] * hr + bui; hr = nr; hi = ni; }
        for (int t = t0; t < t0 + 256; ++t) S5_STEP(t)
        eL[(wave * 64 + lane) * 2] = hr; eL[(wave * 64 + lane) * 2 + 1] = hi;
        float pr = ab[0], pi = ab[1];
#pragma unroll
        for (int q = 0; q < 8; ++q) { const float nr = pr * pr - pi * pi, ni = 2.f * pr * pi; pr = nr; pi = ni; }
        __syncthreads();
        hr = 0.f; hi = 0.f;
        for (int w = 0; w < wave; ++w) { const float er = eL[(w * 64 + lane) * 2], ei = eL[(w * 64 + lane) * 2 + 1]; const float nr = pr * hr - pi * hi + er, ni = pr * hi + pi * hr + ei; hr = nr; hi = ni; }
        bf16x8v cf[8];
#pragma unroll
        for (int s = 0; s < 8; ++s) { u32x4 w4 = {0u, 0u, 0u, 0u};
            if (r < 16) { const float* cp = P.in[s < 4 ? I_OD_C_RE : I_OD_C_IM] + ((size_t)(o_idx * 64 + g) * 16 + r) * 64 + 16 * (s & 3) + 8 * hh; const float sg = s < 4 ? 1.f : -1.f;
                const f32x4 c0 = *(const f32x4*)cp, c1 = *(const f32x4*)(cp + 4);
                w4.x = cvt_pk_bf16(sg * c0[0], sg * c0[1]); w4.y = cvt_pk_bf16(sg * c0[2], sg * c0[3]); w4.z = cvt_pk_bf16(sg * c1[0], sg * c1[1]); w4.w = cvt_pk_bf16(sg * c1[2], sg * c1[3]); }
            cf[s] = __builtin_bit_cast(bf16x8v, w4); }
        const float dsk = r < 16 ? P.in[I_OD_D][o_idx * 1024 + g * 16 + r] : 0.f;
        for (int tb = 0; tb < 8; ++tb) {
            for (int tt = 0; tt < 32; ++tt) { const int t = t0 + tb * 32 + tt; S5_STEP(t)
                *(LAS unsigned short*)(hL + tt * 272 + lane * 2) = f2bf(hr); *(LAS unsigned short*)(hL + tt * 272 + 128 + lane * 2) = f2bf(hi); }
            f32x16 Y;
#pragma unroll
            for (int i = 0; i < 16; ++i) Y[i] = 0.f;
#pragma unroll
            for (int s = 0; s < 8; ++s) { const bf16x8v af = *(const LAS bf16x8v*)(hL + r * 272 + 32 * s + 16 * hh); Y = __builtin_amdgcn_mfma_f32_32x32x16_bf16(af, cf[s], Y, 0, 0, 0); }
            if (r < 16) {
#pragma unroll
                for (int i = 0; i < 16; ++i) { const int t = t0 + tb * 32 + (i & 3) + 8 * (i >> 2) + 4 * hh;
                    const float uv = bf2f(*(const LAS unsigned short*)(uL + t * 32 + r * 2));
                    Z[(size_t)(b * SEQ + t) * 1024 + g * 16 + r] = f2bf(gelu_tanh(Y[i] + dsk * uv)); }
            }
        }
#undef S5_STEP
    }
}

__device__ __forceinline__ void phase_lru(KP kp0, LAS unsigned char* lds, int e) { KPREF(P, kp0); PHASE_IDS();
    const bf16* XB = (const bf16*)(P.ws + WS_XB); const bf16* YB = (const bf16*)(P.ws + WS_YB); bf16* MIX = (bf16*)(P.ws + WS_MIX);
    LAS unsigned char* xcL = lds;
    LAS float* aL = (LAS float*)(lds + 69632); LAS float* bL = (LAS float*)(lds + 86016);
    LAS float* sA = (LAS float*)(lds + 102400); LAS float* sB = (LAS float*)(lds + 104448);
    LAS float* carry = (LAS float*)(lds + 106496);
    const int c16 = lane & 15, kq = lane >> 4, cg = tid & 15, rg = tid >> 4;
    for (int item = bx; item < 256; item += G) { const int b = item >> 6, blk = (item >> 3) & 7, oct = item & 7, ch0 = blk * 128 + oct * 16;
        float cw[4][8], cb[8];
#pragma unroll
        for (int q = 0; q < 8; ++q) { cb[q] = P.in[I_EV_CONV_B][e * 1024 + blk * 128 + cg * 8 + q];
#pragma unroll
            for (int i = 0; i < 4; ++i) cw[i][q] = P.in[I_EV_CONV_W][(size_t)(e * 4 + i) * 1024 + blk * 128 + cg * 8 + q]; }
        bf16x8v bfr[4], bfi[4];
        { const bf16* wg = (const bf16*)(P.ws + WS_WGATE) + ((size_t)(e * 8 + blk) * 256 + oct * 16 + c16) * 128 + 8 * kq;
#pragma unroll
          for (int s = 0; s < 4; ++s) { bfr[s] = *(const bf16x8v*)(wg + 32 * s); bfi[s] = *(const bf16x8v*)(wg + 128 * 128 + 32 * s); } }
        const float gab = P.in[I_EV_GA_B][e * 1024 + ch0 + c16], gxb = P.in[I_EV_GX_B][e * 1024 + ch0 + c16];
        const float sp8 = -8.0f * log1pf(expf(-P.in[I_EV_LAMBDA][e * 1024 + ch0 + c16]));
        if (tid < 16) carry[tid] = 0.f;
        for (int tc = 0; tc < 8; ++tc) { const int t0 = tc * 256;
            __syncthreads();
            {
                u32x4 xin[11];
#pragma unroll
                for (int i = 0; i < 11; ++i) { const int tt = t0 + 8 * rg - 3 + i;
                    xin[i] = (tt >= 0) ? *(const u32x4*)(XB + (size_t)(b * SEQ + tt) * 1024 + blk * 128 + cg * 8) : (u32x4){0u, 0u, 0u, 0u}; }
#pragma unroll
                for (int j = 0; j < 8; ++j) { float o[8];
#pragma unroll
                    for (int q = 0; q < 8; ++q) o[q] = cb[q];
#pragma unroll
                    for (int i = 0; i < 4; ++i) { const u32x4 x = xin[j + i];
                        o[0] += cw[i][0] * bf_lo(x.x); o[1] += cw[i][1] * bf_hi(x.x); o[2] += cw[i][2] * bf_lo(x.y); o[3] += cw[i][3] * bf_hi(x.y);
                        o[4] += cw[i][4] * bf_lo(x.z); o[5] += cw[i][5] * bf_hi(x.z); o[6] += cw[i][6] * bf_lo(x.w); o[7] += cw[i][7] * bf_hi(x.w); }
                    u32x4 w; w.x = cvt_pk_bf16(o[0], o[1]); w.y = cvt_pk_bf16(o[2], o[3]); w.z = cvt_pk_bf16(o[4], o[5]); w.w = cvt_pk_bf16(o[6], o[7]);
                    *(LAS u32x4*)(xcL + (8 * rg + j) * 272 + cg * 16) = w; }
            }
            __syncthreads();
#pragma unroll
            for (int rb = 0; rb < 2; ++rb) { const int row0 = 32 * wave + 16 * rb;
                f32x4 accr = {0.f, 0.f, 0.f, 0.f}, acci = {0.f, 0.f, 0.f, 0.f};
#pragma unroll
                for (int s = 0; s < 4; ++s) { const bf16x8v af = *(const LAS bf16x8v*)(xcL + (row0 + c16) * 272 + 64 * s + 16 * kq);
                    accr = __builtin_amdgcn_mfma_f32_16x16x32_bf16(af, bfr[s], accr, 0, 0, 0); acci = __builtin_amdgcn_mfma_f32_16x16x32_bf16(af, bfi[s], acci, 0, 0, 0); }
#pragma unroll
                for (int i = 0; i < 4; ++i) { const int row = row0 + 4 * kq + i;
                    const float rr = 1.0f / (1.0f + __expf(-(accr[i] + gab))), ig = 1.0f / (1.0f + __expf(-(acci[i] + gxb)));
                    const float a = __expf(sp8 * rr), mult = sqrtf(fmaxf(1.0f - a * a, 0.f));
                    const float xv = bf2f(*(const LAS unsigned short*)(xcL + row * 272 + (oct * 16 + c16) * 2));
                    aL[row * 16 + c16] = a; bL[row * 16 + c16] = mult * ig * xv; }
            }
            __syncthreads();
            float av[8], bv[8], A = 1.f, B = 0.f;
#pragma unroll
            for (int i = 0; i < 8; ++i) { av[i] = aL[(8 * rg + i) * 16 + cg]; bv[i] = bL[(8 * rg + i) * 16 + cg]; B = av[i] * B + bv[i]; A *= av[i]; }
            sA[rg * 16 + cg] = A; sB[rg * 16 + cg] = B;
            __syncthreads();
            float h = carry[cg];
            for (int j = 0; j < rg; ++j) h = sA[j * 16 + cg] * h + sB[j * 16 + cg];
#pragma unroll
            for (int i = 0; i < 8; ++i) { h = av[i] * h + bv[i]; const size_t row = (size_t)(b * SEQ + t0 + 8 * rg + i);
                MIX[row * 2048 + 1024 + ch0 + cg] = f2bf(h * bf2f(YB[row * 1024 + ch0 + cg])); }
            __syncthreads();
            if (rg == 31) carry[cg] = h;
        }
    }
}

constexpr int N_PHASES = 2 + 11 * NLAYER + 1;
#ifndef MK_ONE_LAUNCH
#define MK_ONE_LAUNCH 1
#endif
__global__ void __launch_bounds__(512, 2) fwd(Params P) {
    extern __shared__ __attribute__((aligned(16))) unsigned char lds_raw[];
    LAS unsigned char* lds = (LAS unsigned char*)lds_raw;
    for (int u = threadIdx.x; u < (LDS_BYTES - LDSCTL_OFF) / 4; u += 512) ((LAS unsigned*)(lds + LDSCTL_OFF))[u] = 0u;
    __syncthreads();
    const KP kp = (KP)__builtin_amdgcn_kernarg_segment_ptr();
    const int ph_lo = kp->lo, ph_hi = kp->hi;
    unsigned* barw = (unsigned*)(kp->ws + WS_CTL) + CW_BAR + kp->li * XCD_BAR_WORDS;
    XcdBarrier bar; bar.bar = barw; bar.x = 0; bar.st = nullptr;
    if (ph_hi - ph_lo > 1) bar = xcd_barrier_post(barw, (volatile LAS unsigned*)(lds + LDSCTL_OFF + 64));
#define RUN(p) (ph_lo <= (p) && (p) < ph_hi)
#define SEAM(p) do { if (RUN(p) && RUN((p) + 1)) xcd_barrier(bar); } while (0)

    if (RUN(0)) phase_ada(kp, lds);
    SEAM(0);
    if (RUN(1)) phase_prep(kp, lds);
    SEAM(1);
    for (int l = 0; l < NLAYER; ++l) {
        const int pb = 2 + 11 * l, e = l >> 1; const bool odd = (l & 1) != 0;
        if (RUN(pb + 0)) phase_norm(kp, l, 0);
        SEAM(pb + 0);
        if (RUN(pb + 1)) { KPREF(P, kp); int bx = blockIdx.x; asm volatile("" : "+s"(bx)); const int G = gridDim.x; const bf16* H = (const bf16*)(P.ws + WS_H); bf16* Qb = (bf16*)(P.ws + WS_Q);
            if (!odd) { pg8::Gemm g{H, (const bf16*)(P.ws + WS_W_EVIN) + (size_t)e * EVEN_IN * DM, MT, EVEN_IN, DM}; pg8::StaticOrder S; S.init(MT, EVEN_IN, G, bx);
                pg8::EpiEvenIn E{Qb, (const float*)(P.ws + WS_COSA), (const float*)(P.ws + WS_SINA), QSCALE_A};
                pg8::gemm_phase<pg8::EpiEvenIn, pg8::StaticOrder, true, true>(lds, g, S, E); }
            else { pg8::Gemm g{H, (const bf16*)(P.ws + WS_W_ODIN) + (size_t)e * ODD_IN * DM, MT, ODD_IN, DM}; pg8::StaticOrder S; S.init(MT, ODD_IN, G, bx);
                pg8::EpiOddIn E{Qb, (bf16*)(P.ws + WS_K), (bf16*)(P.ws + WS_V), (bf16*)(P.ws + WS_XB), (const float*)(P.ws + WS_COSC), (const float*)(P.ws + WS_SINC), QSCALE_C};
                pg8::gemm_phase<pg8::EpiOddIn, pg8::StaticOrder, true, true>(lds, g, S, E); }
        }
        SEAM(pb + 1);
        if (RUN(pb + 2)) { if (!odd) phase_attn<0>(kp, lds, 0); else phase_attn<1>(kp, lds, e); }
        if (RUN(pb + 3)) { if (!odd) phase_lru(kp, lds, e); else phase_s5(kp, lds, e); }
        SEAM(pb + 3);
        if (RUN(pb + 4)) {
            if (odd) { KPREF(P, kp); int bx = blockIdx.x; asm volatile("" : "+s"(bx)); const int G = gridDim.x; const bf16* YBb = (const bf16*)(P.ws + WS_YB); bf16* MIX = (bf16*)(P.ws + WS_MIX); pg8::Gemm g{YBb, (const bf16*)(P.ws + WS_W_GLU) + (size_t)e * 1024 * 1024, MT, 1024, 1024}; pg8::StaticOrder S; S.init(MT, 1024, G, bx);
                pg8::EpiGlu E{YBb, MIX, P.in[I_OD_GLU_B] + e * 1024};
                pg8::gemm_phase<pg8::EpiGlu, pg8::StaticOrder, true, true>(lds, g, S, E); }
        }
        if (odd) SEAM(pb + 4);
        if (RUN(pb + 6)) { KPREF(P, kp); int bx = blockIdx.x; asm volatile("" : "+s"(bx)); const int G = gridDim.x; const bf16* MIX = (const bf16*)(P.ws + WS_MIX); const float* mod = (const float*)(P.ws + WS_MOD);
            const bf16* W = odd ? (const bf16*)(P.ws + WS_W_ODOUT) + (size_t)e * DM * DM : (const bf16*)(P.ws + WS_W_EVOUT) + (size_t)e * DM * DM;
            pg8::Gemm g{MIX, W, MT, DM, DM}; pg8::StaticOrder S; S.init(MT, DM, G, bx);
            pg8::EpiResid E{l == 0 ? P.in[I_X] : P.out, P.out, mod + (size_t)l * 4 * 12288 + 2 * DM};
            pg8::gemm_phase<pg8::EpiResid, pg8::StaticOrder, true, true>(lds, g, S, E);
        }
        SEAM(pb + 6);
        if (RUN(pb + 7)) phase_norm(kp, l, 1);
        SEAM(pb + 7);
        if (RUN(pb + 8)) { KPREF(P, kp); int bx = blockIdx.x; asm volatile("" : "+s"(bx)); const int G = gridDim.x; const bf16* H = (const bf16*)(P.ws + WS_H); bf16* UFF = (bf16*)(P.ws + WS_UFF);
            pg8::Gemm g{H, (const bf16*)(P.ws + WS_W_FFIN) + (size_t)l * DFF2 * DM, MT, DFF2, DM}; pg8::StaticOrder S; S.init(MT, DFF2, G, bx);
            pg8::EpiStore E{UFF, DFF2};
            pg8::gemm_phase<pg8::EpiStore, pg8::StaticOrder, true, true>(lds, g, S, E);
        }
        SEAM(pb + 8);
        if (RUN(pb + 9)) phase_ffn_act(kp, l);
        SEAM(pb + 9);
        if (RUN(pb + 10)) { KPREF(P, kp); int bx = blockIdx.x; asm volatile("" : "+s"(bx)); const int G = gridDim.x; const bf16* ACT = (const bf16*)(P.ws + WS_ACT); const float* mod = (const float*)(P.ws + WS_MOD);
            pg8::Gemm g{ACT, (const bf16*)(P.ws + WS_W_FFOUT) + (size_t)l * DM * DFF, MT, DM, DFF}; pg8::StaticOrder S; S.init(MT, DM, G, bx);
            pg8::EpiResid E{P.out, P.out, mod + (size_t)l * 4 * 12288 + 5 * DM};
            pg8::gemm_phase<pg8::EpiResid, pg8::StaticOrder, true, true>(lds, g, S, E);
        }
        SEAM(pb + 10);
    }
    if (RUN(N_PHASES - 1)) phase_final(kp);
#undef RUN
#undef SEAM
}

extern "C" void kernel_launch(void* const* d_in, const int* in_sizes, int n_in, void* d_out, int out_size, void* d_ws, size_t ws_size, hipStream_t stream) {
    static int grid = 0;
    if (grid == 0) {
        if (n_in != N_INPUTS || out_size != MT * DM || ws_size < WS_END) { fprintf(stderr, "kernel_launch: unexpected shapes: n_in %d out %d ws %zu (need %zu)\n", n_in, out_size, ws_size, (size_t)WS_END); grid = -1; return; }
        int dev = 0, cus = 0, per_cu = 0;
        if (hipGetDevice(&dev) != hipSuccess || hipDeviceGetAttribute(&cus, hipDeviceAttributeMultiprocessorCount, dev) != hipSuccess) { grid = -1; return; }
        if (hipFuncSetAttribute((const void*)fwd, hipFuncAttributeMaxDynamicSharedMemorySize, LDS_BYTES) != hipSuccess) { fprintf(stderr, "kernel_launch: hipFuncSetAttribute failed\n"); grid = -1; return; }
        if (hipOccupancyMaxActiveBlocksPerMultiprocessor(&per_cu, (const void*)fwd, 512, LDS_BYTES) != hipSuccess || per_cu < 1) fprintf(stderr, "kernel_launch: occupancy query says %d\n", per_cu);
        (void)hipGetLastError();
        grid = cus;
    }
    if (grid < 0) return;
    if (hipMemsetAsync((char*)d_ws + WS_CTL, 0, CTL_ZERO_BYTES, stream) != hipSuccess) return;
    Params p{};
    for (int i = 0; i < N_INPUTS; ++i) p.in[i] = (const float*)d_in[i];
    p.out = (float*)d_out; p.ws = (unsigned char*)d_ws; p.pad = 0;
#if MK_ONE_LAUNCH
    p.lo = 0; p.hi = N_PHASES; p.li = 0;
    hipLaunchKernelGGL(fwd, dim3(grid), dim3(512), LDS_BYTES, stream, p);
#else
    for (int ph = 0; ph < N_PHASES; ++ph) { p.lo = ph; p.hi = ph + 1; p.li = 0; hipLaunchKernelGGL(fwd, dim3(grid), dim3(512), LDS_BYTES, stream, p); }
#endif
    const hipError_t le = hipPeekAtLastError();
    if (le != hipSuccess) fprintf(stderr, "kernel_launch: launch failed: %s\n", hipGetErrorName(le));
}
```

```cpp
#include <hip/hip_runtime.h>
#include <cstdio>
#include <cstdint>
namespace pg8 {
#define PG8_LAS __attribute__((address_space(3)))
typedef unsigned short bf16_t;
typedef short bf16x8 __attribute__((ext_vector_type(8)));
typedef float f32x4 __attribute__((ext_vector_type(4)));
typedef unsigned u32x4 __attribute__((ext_vector_type(4)));
typedef unsigned u32x2 __attribute__((ext_vector_type(2)));
constexpr int BM = 256, BK = 64, HALF = 128, HTB = HALF * BK * 2  , STAGE_BYTES = 8 * HTB, NXCD = 8, WGM = 8;

__host__ __device__ __forceinline__ int lds_byte(int r, int c) { const int st = (r >> 4) * 2 + (c >> 5), rr = r & 15, cc = c & 31, ob = rr * 64 + cc * 2; return st * 1024 + (ob ^ (((ob >> 9) & 1) << 5)); }
__host__ __device__ __forceinline__ void stage_rc(int b, int& R, int& C) { const int st = b / 1024, sb = b % 1024, swz = sb ^ (((sb >> 9) & 1) << 5); R = (st >> 1) * 16 + swz / 64; C = (st & 1) * 32 + (swz % 64) / 2; }
__host__ __device__ __forceinline__ int perm32(int rho) { const int n = rho >> 4, i = rho & 15; return 8 * (i >> 2) + 4 * n + (i & 3); }

struct Unit { int pm, pn; };
struct Gemm { const bf16_t* A; const bf16_t* Bt; int M, N, K; };

struct StaticOrder {
    int nM, nN, nwg, G, c;
    __host__ __device__ void init(int M, int N, int G_, int c_) { nM = M / BM; nN = N / BM; nwg = nM * nN; G = G_; c = c_; }
    __host__ __device__ bool next(int i, Unit& u) const {
        const long L = (long)i * G + c; if (L >= nwg) return false;
        int wgid = (int)L; { const int q = nwg / NXCD, r = nwg % NXCD, xcd = wgid % NXCD, off = wgid / NXCD; wgid = (xcd < r ? xcd * (q + 1) : r * (q + 1) + (xcd - r) * q) + off; }
        const int nig = WGM * nN, gid = wgid / nig, fm = gid * WGM, gsz = (nM - fm) < WGM ? (nM - fm) : WGM;
        u.pm = fm + ((wgid % nig) % gsz); u.pn = (wgid % nig) / gsz; return true;
    }
    __device__ __forceinline__ void a_ready(const Unit&) const {}
    __device__ __forceinline__ void done(const Unit&) const {}
};

__device__ __forceinline__ unsigned cvt_pk_bf16(float lo, float hi) { unsigned r; asm volatile("v_cvt_pk_bf16_f32 %0, %1, %2" : "=v"(r) : "v"(lo), "v"(hi)); return r; }
__device__ __forceinline__ u32x4 pack8(const f32x4 a, const f32x4 b) { u32x4 w; w.x = cvt_pk_bf16(a[0], a[1]); w.y = cvt_pk_bf16(a[2], a[3]); w.z = cvt_pk_bf16(b[0], b[1]); w.w = cvt_pk_bf16(b[2], b[3]); return w; }
__device__ __forceinline__ float bf_lo(unsigned w) { return __uint_as_float(w << 16); }
__device__ __forceinline__ float bf_hi(unsigned w) { return __uint_as_float(w & 0xffff0000u); }
__device__ __forceinline__ float gelu_tanh(float x) {
    const float u = x * (0.7978845608f + 0.0356774081f * x * x);
    const float e = __builtin_amdgcn_exp2f(-2.885390082f * u);
    return x * __builtin_amdgcn_rcpf(1.0f + e);
}
__device__ __forceinline__ f32x4 gelu4(const f32x4 v) { return (f32x4){gelu_tanh(v[0]), gelu_tanh(v[1]), gelu_tanh(v[2]), gelu_tanh(v[3])}; }
__device__ __forceinline__ float sigmoidf_fast(float x) { return __builtin_amdgcn_rcpf(1.0f + __builtin_amdgcn_exp2f(-1.4426950409f * x)); }

struct EpiStore {
    static constexpr bool PERM = true, AFTER_DRAIN = false;
    bf16_t* O; int ldc;
    __device__ __forceinline__ void operator()(const f32x4 (&acc)[2][2][4][2], const Unit& u, int wr, int wc, int fr, int fq) const {
        const int row0 = u.pm * BM + wr * 64 + fr, col0 = u.pn * BM + wc * 32 + 8 * fq;
#pragma unroll
        for (int ai = 0; ai < 2; ++ai)
#pragma unroll
            for (int m = 0; m < 4; ++m) { bf16_t* rowp = O + (size_t)(row0 + ai * HALF + m * 16) * ldc + col0;
#pragma unroll
                for (int bj = 0; bj < 2; ++bj) *(u32x4*)(rowp + bj * HALF) = pack8(acc[ai][bj][m][0], acc[ai][bj][m][1]); }
    }
};

struct EpiEvenIn {
    static constexpr bool PERM = true, AFTER_DRAIN = false;
    bf16_t *Q; const float *cosT, *sinT; float qscale;
    __device__ __forceinline__ void operator()(const f32x4 (&acc)[2][2][4][2], const Unit& u, int wr, int wc, int fr, int fq) const {
        const int row0 = u.pm * BM + wr * 64 + fr;
        if (u.pn < 8) {
            bf16_t* dst = Q + (size_t)(u.pn >> 2) * (8u << 20); const float sc = (u.pn < 4) ? qscale : 1.0f;
            const int head = (u.pn & 3) * 2 + (wc >> 1), i0 = (wc & 1) * 32 + 8 * fq;
#pragma unroll
            for (int ai = 0; ai < 2; ++ai)
#pragma unroll
                for (int m = 0; m < 4; ++m) { const int row = row0 + ai * HALF + m * 16;
                    const f32x4 c0 = *(const f32x4*)(cosT + (size_t)row * 64 + i0), c1 = *(const f32x4*)(cosT + (size_t)row * 64 + i0 + 4);
                    const f32x4 s0 = *(const f32x4*)(sinT + (size_t)row * 64 + i0), s1 = *(const f32x4*)(sinT + (size_t)row * 64 + i0 + 4);
                    const f32x4 a0 = acc[ai][0][m][0], a1 = acc[ai][0][m][1], b0 = acc[ai][1][m][0], b1 = acc[ai][1][m][1];
                    const f32x4 o10 = (a0 * c0 - b0 * s0) * sc, o11 = (a1 * c1 - b1 * s1) * sc, o20 = (b0 * c0 + a0 * s0) * sc, o21 = (b1 * c1 + a1 * s1) * sc;
                    bf16_t* rp = dst + (size_t)row * 1024 + head * 128 + i0;
                    *(u32x4*)(rp) = pack8(o10, o11); *(u32x4*)(rp + 64) = pack8(o20, o21); }
        } else {
            const int sel = (u.pn - 8) >> 2; bf16_t* dst = Q + (size_t)(u.pn >> 2) * (8u << 20); const int col0 = (u.pn & 3) * 256 + wc * 32 + 8 * fq;
#pragma unroll
            for (int ai = 0; ai < 2; ++ai)
#pragma unroll
                for (int m = 0; m < 4; ++m) { bf16_t* rowp = dst + (size_t)(row0 + ai * HALF + m * 16) * 1024 + col0;
#pragma unroll
                    for (int bj = 0; bj < 2; ++bj) { f32x4 v0 = acc[ai][bj][m][0], v1 = acc[ai][bj][m][1];
                        if (sel == 2) { v0 = gelu4(v0); v1 = gelu4(v1); }
                        *(u32x4*)(rowp + bj * HALF) = pack8(v0, v1); } }
        }
    }
};

struct EpiOddIn {
    static constexpr bool PERM = true, AFTER_DRAIN = false;
    bf16_t *Q, *K, *V, *U; const float *cosT, *sinT; float qscale;
    __device__ __forceinline__ void operator()(const f32x4 (&acc)[2][2][4][2], const Unit& u, int wr, int wc, int fr, int fq) const {
        const int row0 = u.pm * BM + wr * 64 + fr;
        if (u.pn < 4 || (u.pn == 4 && wc < 2)) {
            const bool isq = u.pn < 4; const float sc = isq ? qscale : 1.0f;
            bf16_t* dst = isq ? Q + (u.pn * 4 + wc) * 64 : K + wc * 64; const int pitch = isq ? 1024 : 128;
#pragma unroll
            for (int ai = 0; ai < 2; ++ai)
#pragma unroll
                for (int m = 0; m < 4; ++m) { const int row = row0 + ai * HALF + m * 16;
                    const f32x4 c0 = *(const f32x4*)(cosT + (size_t)row * 32 + 8 * fq), c1 = *(const f32x4*)(cosT + (size_t)row * 32 + 8 * fq + 4);
                    const f32x4 s0 = *(const f32x4*)(sinT + (size_t)row * 32 + 8 * fq), s1 = *(const f32x4*)(sinT + (size_t)row * 32 + 8 * fq + 4);
                    const f32x4 a0 = acc[ai][0][m][0], a1 = acc[ai][0][m][1], b0 = acc[ai][1][m][0], b1 = acc[ai][1][m][1];
                    const f32x4 o10 = (a0 * c0 - b0 * s0) * sc, o11 = (a1 * c1 - b1 * s1) * sc, o20 = (b0 * c0 + a0 * s0) * sc, o21 = (b1 * c1 + a1 * s1) * sc;
                    bf16_t* rp = dst + (size_t)row * pitch + 8 * fq;
                    *(u32x4*)(rp) = pack8(o10, o11); *(u32x4*)(rp + 32) = pack8(o20, o21); }
        } else if (u.pn == 4) {
#pragma unroll
            for (int ai = 0; ai < 2; ++ai)
#pragma unroll
                for (int m = 0; m < 4; ++m) { bf16_t* rowp = V + (size_t)(row0 + ai * HALF + m * 16) * 128 + (wc - 2) * 32 + 8 * fq;
#pragma unroll
                    for (int bj = 0; bj < 2; ++bj) *(u32x4*)(rowp + bj * 64) = pack8(acc[ai][bj][m][0], acc[ai][bj][m][1]); }
        } else {
            const int col0 = (u.pn - 5) * 256 + wc * 32 + 8 * fq;
#pragma unroll
            for (int ai = 0; ai < 2; ++ai)
#pragma unroll
                for (int m = 0; m < 4; ++m) { bf16_t* rowp = U + (size_t)(row0 + ai * HALF + m * 16) * 1024 + col0;
#pragma unroll
                    for (int bj = 0; bj < 2; ++bj) *(u32x4*)(rowp + bj * HALF) = pack8(acc[ai][bj][m][0], acc[ai][bj][m][1]); }
        }
    }
};

struct EpiResid {
    static constexpr bool PERM = false, AFTER_DRAIN = false;
    const float* base; float* out; const float* gate;
    __device__ __forceinline__ void operator()(const f32x4 (&acc)[2][2][4][2], const Unit& u, int wr, int wc, int fr, int fq) const {
        const int row0 = u.pm * BM + wr * 64 + fr, col0 = u.pn * BM + wc * 32 + 4 * fq; const float* gp = gate + (size_t)(u.pm >> 3) * 12288 + col0;
        f32x4 gv[2][2];
#pragma unroll
        for (int bj = 0; bj < 2; ++bj)
#pragma unroll
            for (int n = 0; n < 2; ++n) gv[bj][n] = *(const f32x4*)(gp + bj * HALF + n * 16);
#pragma unroll
        for (int ai = 0; ai < 2; ++ai)
#pragma unroll
            for (int m = 0; m < 4; ++m) { const size_t off = (size_t)(row0 + ai * HALF + m * 16) * 2048 + col0;
#pragma unroll
                for (int bj = 0; bj < 2; ++bj)
#pragma unroll
                    for (int n = 0; n < 2; ++n) { const f32x4 bs = *(const f32x4*)(base + off + bj * HALF + n * 16); *(f32x4*)(out + off + bj * HALF + n * 16) = bs + gv[bj][n] * acc[ai][bj][m][n]; } }
    }
};

struct EpiGlu {
    static constexpr bool PERM = true, AFTER_DRAIN = false;
    const bf16_t* Z; bf16_t* MIX; const float* gb;
    __device__ __forceinline__ void operator()(const f32x4 (&acc)[2][2][4][2], const Unit& u, int wr, int wc, int fr, int fq) const {
        const int row0 = u.pm * BM + wr * 64 + fr, col0 = u.pn * BM + wc * 32 + 8 * fq;
        f32x4 bv[2][2];
#pragma unroll
        for (int bj = 0; bj < 2; ++bj)
#pragma unroll
            for (int n = 0; n < 2; ++n) bv[bj][n] = *(const f32x4*)(gb + col0 + bj * HALF + 4 * n);
#pragma unroll
        for (int ai = 0; ai < 2; ++ai)
#pragma unroll
            for (int m = 0; m < 4; ++m) { const size_t row = (size_t)(row0 + ai * HALF + m * 16);
#pragma unroll
                for (int bj = 0; bj < 2; ++bj) { const u32x4 zr = *(const u32x4*)(Z + row * 1024 + col0 + bj * HALF);
                    const f32x4 v0 = acc[ai][bj][m][0] + bv[bj][0], v1 = acc[ai][bj][m][1] + bv[bj][1];
                    const f32x4 z0 = (f32x4){bf_lo(zr.x), bf_hi(zr.x), bf_lo(zr.y), bf_hi(zr.y)}, z1 = (f32x4){bf_lo(zr.z), bf_hi(zr.z), bf_lo(zr.w), bf_hi(zr.w)};
                    const f32x4 o0 = (f32x4){z0[0] * sigmoidf_fast(v0[0]), z0[1] * sigmoidf_fast(v0[1]), z0[2] * sigmoidf_fast(v0[2]), z0[3] * sigmoidf_fast(v0[3])};
                    const f32x4 o1 = (f32x4){z1[0] * sigmoidf_fast(v1[0]), z1[1] * sigmoidf_fast(v1[1]), z1[2] * sigmoidf_fast(v1[2]), z1[3] * sigmoidf_fast(v1[3])};
                    *(u32x4*)(MIX + row * 2048 + 1024 + col0 + bj * HALF) = pack8(o0, o1); } }
    }
};

__device__ __forceinline__ float dpp_ror1(float v) { return __builtin_bit_cast(float, __builtin_amdgcn_update_dpp(0, __builtin_bit_cast(int, v), 0x121, 0xf, 0xf, false)); }
__device__ __forceinline__ float dpp_ror2(float v) { return __builtin_bit_cast(float, __builtin_amdgcn_update_dpp(0, __builtin_bit_cast(int, v), 0x122, 0xf, 0xf, false)); }
__device__ __forceinline__ float dpp_shr1(float old, float v) { return __builtin_bit_cast(float, __builtin_amdgcn_update_dpp(__builtin_bit_cast(int, old), __builtin_bit_cast(int, v), 0x111, 0xf, 0xf, false)); }
__device__ __forceinline__ float dpp_shr2(float old, float v) { return __builtin_bit_cast(float, __builtin_amdgcn_update_dpp(__builtin_bit_cast(int, old), __builtin_bit_cast(int, v), 0x112, 0xf, 0xf, false)); }
struct EpiFfnIn {
    static constexpr bool PERM = true, AFTER_DRAIN = false;
    bf16_t* ACT; float* halo_first; float* halo_last; const float* cw; const float* cb; PG8_LAS float* exch;
    __device__ __forceinline__ void operator()(const f32x4 (&acc)[2][2][4][2], const Unit& u, int wr, int wc, int fr, int fq) const {
        const int jj0 = wc * 32 + 8 * fq, jcol = u.pn * 128 + jj0;
        if (fr >= 14) { const int r2 = fr - 14;
#pragma unroll
            for (int bj = 0; bj < 2; ++bj)
#pragma unroll
                for (int n = 0; n < 2; ++n) {
                    *(PG8_LAS f32x4*)(exch + ((wr * 2 + r2) * 2 + bj) * 128 + jj0 + 4 * n) = acc[0][bj][3][n];
                    if (wr == 0) *(PG8_LAS f32x4*)(exch + ((2 * 2 + r2) * 2 + bj) * 128 + jj0 + 4 * n) = acc[1][bj][3][n];
                    else *(f32x4*)(halo_last + ((size_t)(u.pm * 2 + r2) * 2 + bj) * 5504 + jcol + 4 * n) = acc[1][bj][3][n];
                } }
        if (wr == 0 && fr < 2) {
#pragma unroll
            for (int bj = 0; bj < 2; ++bj)
#pragma unroll
                for (int n = 0; n < 2; ++n) *(f32x4*)(halo_first + ((size_t)(u.pm * 2 + fr) * 2 + bj) * 5504 + jcol + 4 * n) = acc[0][bj][0][n]; }
        asm volatile("s_waitcnt lgkmcnt(0)" ::: "memory"); __builtin_amdgcn_s_barrier(); asm volatile("" ::: "memory");
        const bool seq_start = (u.pm & 7) == 0;
#pragma unroll
        for (int n = 0; n < 2; ++n) {
            f32x4 w0[2], w1[2], w2[2], bb[2];
#pragma unroll
            for (int bj = 0; bj < 2; ++bj) { const int col = bj * 5504 + jcol + 4 * n;
                w0[bj] = *(const f32x4*)(cw + col); w1[bj] = *(const f32x4*)(cw + 11008 + col); w2[bj] = *(const f32x4*)(cw + 22016 + col); bb[bj] = *(const f32x4*)(cb + col); }
#pragma unroll
            for (int ai = 0; ai < 2; ++ai) {
                f32x4 prev[2];
                const int slot = 2 * ai + wr - 1;
#pragma unroll
                for (int bj = 0; bj < 2; ++bj) prev[bj] = (slot >= 0) ? *(const PG8_LAS f32x4*)(exch + ((slot * 2 + (fr & 1)) * 2 + bj) * 128 + jj0 + 4 * n) : (f32x4){0.f, 0.f, 0.f, 0.f};
#pragma unroll
                for (int m = 0; m < 4; ++m) {
                    f32x4 cv[2];
#pragma unroll
                    for (int bj = 0; bj < 2; ++bj) { const f32x4 cur = acc[ai][bj][m][n]; f32x4 o;
#pragma unroll
                        for (int q = 0; q < 4; ++q) { const float um1 = dpp_shr1(dpp_ror1(prev[bj][q]), cur[q]), um2 = dpp_shr2(dpp_ror2(prev[bj][q]), cur[q]);
                            o[q] = bb[bj][q] + w0[bj][q] * um2 + w1[bj][q] * um1 + w2[bj][q] * cur[q]; }
                        cv[bj] = o; prev[bj] = cur; }
                    const f32x4 o0 = gelu4(cv[0]) * cv[1];
                    const bool skip = (ai == 0 && m == 0) && wr == 0 && fr < 2 && !seq_start;
                    if (!skip) { u32x2 w; w.x = cvt_pk_bf16(o0[0], o0[1]); w.y = cvt_pk_bf16(o0[2], o0[3]); *(u32x2*)(ACT + (size_t)(u.pm * BM + ai * HALF + wr * 64 + m * 16 + fr) * 5504 + jcol + 4 * n) = w; }
                }
            }
        }
    }
};
template <class Epi, class Sched, bool ALIGN_EPI = false, bool SP2 = false>
__device__ __forceinline__ void gemm_phase(PG8_LAS unsigned char* lds, const Gemm g, const Sched& S, const Epi& E) {
    int tid = threadIdx.x; asm volatile("" : "+v"(tid));
    const int wid = __builtin_amdgcn_readfirstlane(tid >> 6), lane = tid & 63, wr = wid >> 2, wc = wid & 3, fr = lane & 15, fq = lane >> 4;
    const int K = g.K, nt = K / BK;
    unsigned voffA[2], voffB[2];
#pragma unroll
    for (int i = 0; i < 2; ++i) { int R, C; stage_rc(tid * 16 + i * 8192, R, C); const int Rb = Epi::PERM ? ((R & ~31) + perm32(R & 31)) : R;
        voffA[i] = (unsigned)(R * K + C) * 2u; voffB[i] = (unsigned)(Rb * K + C) * 2u; }
    const size_t kstep = (size_t)(BK * 2);
    const size_t hstep = (size_t)HALF * K * 2;
    const size_t tstep = 2 * hstep;
    const unsigned ldsw = (unsigned)wid * 1024u;
    const int aoff = lds_byte(wr * 64 + fr, fq * 8), boff = lds_byte(wc * 32 + fr, fq * 8);
#define PG8_SA(b, h) (((b) * 2 + (h)) * HTB)
#define PG8_SB(b, h) ((4 + (b) * 2 + (h)) * HTB)
#define PG8_STAGE(bufoff, gbase, voff) do { _Pragma("unroll") for (int _i = 0; _i < 2; ++_i) \
        __builtin_amdgcn_global_load_lds((const unsigned*)((const char*)(gbase) + (voff)[_i]), (PG8_LAS unsigned*)(lds + (bufoff) + ldsw + _i * 8192), 16, 0, 0); } while (0)
#define PG8_LDA(dst, b, h) do { _Pragma("unroll") for (int m = 0; m < 4; ++m) _Pragma("unroll") for (int k = 0; k < 2; ++k) dst[m][k] = *(const PG8_LAS bf16x8*)(lds + PG8_SA(b, h) + aoff + m * 2048 + k * 1024); } while (0)
#define PG8_LDB(dst, b, h) do { _Pragma("unroll") for (int n = 0; n < 2; ++n) _Pragma("unroll") for (int k = 0; k < 2; ++k) dst[n][k] = *(const PG8_LAS bf16x8*)(lds + PG8_SB(b, h) + boff + n * 2048 + k * 1024); } while (0)
#define PG8_MMA(ai, bj, At, Bt) do { __builtin_amdgcn_s_setprio(1); _Pragma("unroll") for (int m = 0; m < 4; ++m) _Pragma("unroll") for (int n = 0; n < 2; ++n) _Pragma("unroll") for (int k = 0; k < 2; ++k) \
        acc[ai][bj][m][n] = __builtin_amdgcn_mfma_f32_16x16x32_bf16(Bt[n][k], At[m][k], acc[ai][bj][m][n], 0, 0, 0); __builtin_amdgcn_s_setprio(0); } while (0)
#define PG8_WAIT_V(n) asm volatile("s_waitcnt vmcnt(" #n ")" ::: "memory")
#define PG8_WAIT_L(n) asm volatile("s_waitcnt lgkmcnt(" #n ")" ::: "memory")
#define PG8_BAR __builtin_amdgcn_s_barrier()
#define PG8_SCHED __builtin_amdgcn_sched_barrier(0)
    Unit cur, nxt; int ui = 0;
    if (!S.next(0, cur)) return;
    f32x4 acc[2][2][4][2];
#pragma unroll
    for (int a = 0; a < 2; ++a)
#pragma unroll
        for (int b = 0; b < 2; ++b)
#pragma unroll
            for (int m = 0; m < 4; ++m)
#pragma unroll
                for (int n = 0; n < 2; ++n) acc[a][b][m][n] = (f32x4){0.f, 0.f, 0.f, 0.f};
    bf16x8 At[4][2], B0[2][2], B1[2][2];
    const char* cA = (const char*)g.A + (size_t)cur.pm * tstep; const char* cB = (const char*)g.Bt + (size_t)cur.pn * tstep;
    S.a_ready(cur);
    if constexpr (SP2) {
        PG8_STAGE(PG8_SB(0, 0), cB, voffB); PG8_STAGE(PG8_SB(0, 1), cB + hstep, voffB); PG8_STAGE(PG8_SA(0, 0), cA, voffA); PG8_STAGE(PG8_SA(0, 1), cA + hstep, voffA);
        if (wr == 1) PG8_BAR;
        PG8_WAIT_V(2); PG8_BAR;
        PG8_STAGE(PG8_SB(1, 0), cB + kstep, voffB); PG8_STAGE(PG8_SA(1, 0), cA + kstep, voffA); PG8_STAGE(PG8_SB(1, 1), cB + hstep + kstep, voffB);
        PG8_WAIT_V(6); PG8_BAR;
    } else {
        PG8_STAGE(PG8_SB(0, 0), cB, voffB); PG8_STAGE(PG8_SA(0, 0), cA, voffA); PG8_STAGE(PG8_SB(0, 1), cB + hstep, voffB); PG8_STAGE(PG8_SA(0, 1), cA + hstep, voffA);
        if (wr == 1) PG8_BAR;
        PG8_WAIT_V(4); PG8_BAR;
        PG8_STAGE(PG8_SB(1, 0), cB + kstep, voffB); PG8_STAGE(PG8_SA(1, 0), cA + kstep, voffA); PG8_STAGE(PG8_SB(1, 1), cB + hstep + kstep, voffB);
        PG8_WAIT_V(6); PG8_BAR;
    }
    for (;;) {
        const bool has_next = S.next(ui + 1, nxt);
        const char* nA = has_next ? (const char*)g.A + (size_t)nxt.pm * tstep : cA; const char* nB = has_next ? (const char*)g.Bt + (size_t)nxt.pn * tstep : cB;
        for (int t = 0; t < nt; t += 2) {
            const bool last = (t == nt - 2);
            const char* a1 = cA + (size_t)(t + 1) * kstep;
            const char* a2 = last ? nA : cA + (size_t)(t + 2) * kstep; const char* b2 = last ? nB : cB + (size_t)(t + 2) * kstep;
            const char* a3 = a2 + kstep; const char* b3 = b2 + kstep;
            if (last && has_next) S.a_ready(nxt);
            if constexpr (SP2) {
            PG8_LDB(B0, 0, 0); PG8_LDB(B1, 0, 1); PG8_SCHED; PG8_LDA(At, 0, 0); PG8_STAGE(PG8_SA(1, 1), a1 + hstep, voffA);
            PG8_WAIT_V(8); PG8_WAIT_L(0); PG8_BAR; PG8_MMA(0, 0, At, B0); PG8_MMA(0, 1, At, B1); PG8_BAR; PG8_SCHED;
            PG8_LDA(At, 0, 1); PG8_STAGE(PG8_SB(0, 0), b2, voffB); PG8_STAGE(PG8_SB(0, 1), b2 + hstep, voffB); PG8_STAGE(PG8_SA(0, 0), a2, voffA);
            PG8_WAIT_V(8); PG8_WAIT_L(0); PG8_BAR; PG8_MMA(1, 0, At, B0); PG8_MMA(1, 1, At, B1); PG8_BAR; PG8_SCHED;
            PG8_LDB(B0, 1, 0); PG8_LDB(B1, 1, 1); PG8_SCHED; PG8_LDA(At, 1, 0); PG8_STAGE(PG8_SA(0, 1), a2 + hstep, voffA);
            PG8_WAIT_V(8); PG8_WAIT_L(0); PG8_BAR; PG8_MMA(0, 0, At, B0); PG8_MMA(0, 1, At, B1); PG8_BAR; PG8_SCHED;
            PG8_LDA(At, 1, 1); PG8_STAGE(PG8_SB(1, 0), b3, voffB); PG8_STAGE(PG8_SB(1, 1), b3 + hstep, voffB); PG8_STAGE(PG8_SA(1, 0), a3, voffA);
            PG8_WAIT_V(8); PG8_WAIT_L(0); PG8_BAR; PG8_MMA(1, 0, At, B0); PG8_MMA(1, 1, At, B1); PG8_BAR; PG8_SCHED;
            } else {
            PG8_LDB(B0, 0, 0); PG8_SCHED; PG8_LDA(At, 0, 0); PG8_STAGE(PG8_SA(1, 1), a1 + hstep, voffA);
            PG8_WAIT_L(8); PG8_BAR; PG8_WAIT_L(0); PG8_MMA(0, 0, At, B0); PG8_BAR; PG8_SCHED;
            PG8_LDB(B1, 0, 1); PG8_STAGE(PG8_SB(0, 0), b2, voffB);
            PG8_BAR; PG8_WAIT_L(0); PG8_MMA(0, 1, At, B1); PG8_BAR;
            PG8_LDA(At, 0, 1); PG8_STAGE(PG8_SA(0, 0), a2, voffA);
            PG8_BAR; PG8_WAIT_L(0); PG8_MMA(1, 0, At, B0); PG8_BAR; PG8_SCHED;
            PG8_STAGE(PG8_SB(0, 1), b2 + hstep, voffB);
            PG8_WAIT_V(6); PG8_BAR; PG8_MMA(1, 1, At, B1); PG8_BAR;
            PG8_LDB(B0, 1, 0); PG8_SCHED; PG8_LDA(At, 1, 0); PG8_STAGE(PG8_SA(0, 1), a2 + hstep, voffA);
            PG8_WAIT_L(8); PG8_BAR; PG8_WAIT_L(0); PG8_MMA(0, 0, At, B0); PG8_BAR; PG8_SCHED;
            PG8_LDB(B1, 1, 1); PG8_STAGE(PG8_SB(1, 0), b3, voffB);
            PG8_BAR; PG8_WAIT_L(0); PG8_MMA(0, 1, At, B1); PG8_BAR;
            PG8_LDA(At, 1, 1); PG8_STAGE(PG8_SA(1, 0), a3, voffA);
            PG8_BAR; PG8_WAIT_L(0); PG8_MMA(1, 0, At, B0); PG8_BAR; PG8_SCHED;
            PG8_STAGE(PG8_SB(1, 1), b3 + hstep, voffB);
            PG8_WAIT_V(6); PG8_BAR; PG8_MMA(1, 1, At, B1); PG8_BAR;
            }
        }
        if constexpr (ALIGN_EPI) { if (wr == 0) PG8_BAR; }
        if constexpr (!Epi::AFTER_DRAIN) { E(acc, cur, wr, wc, fr, fq); S.done(cur); }
        if (!has_next) break;
#pragma unroll
        for (int a = 0; a < 2; ++a)
#pragma unroll
            for (int b = 0; b < 2; ++b)
#pragma unroll
                for (int m = 0; m < 4; ++m)
#pragma unroll
                    for (int n = 0; n < 2; ++n) acc[a][b][m][n] = (f32x4){0.f, 0.f, 0.f, 0.f};
        cur = nxt; cA = nA; cB = nB; ++ui;
        if constexpr (ALIGN_EPI) { if (wr == 1) PG8_BAR; }
    }
    PG8_WAIT_V(0);
    if constexpr (!ALIGN_EPI) { if (wr == 0) PG8_BAR; }
    PG8_BAR;
    if constexpr (Epi::AFTER_DRAIN) { E.fused(acc, cur, wr, wc, fr, fq, lds, wid, lane); S.done(cur); }
#undef PG8_SA
#undef PG8_SB
#undef PG8_STAGE
#undef PG8_LDA
#undef PG8_LDB
#undef PG8_MMA
#undef PG8_WAIT_V
#undef PG8_WAIT_L
#undef PG8_BAR
#undef PG8_SCHED
}
}

constexpr int DM = 2048, NB = 4, SEQ = 2048, MT = NB * SEQ, NLAYER = 4;
constexpr int EVEN_IN = 5120, ODD_IN = 2304, DFF = 5504, DFF2 = 11008;
constexpr float LOG2E = 1.4426950408889634f;
constexpr float QSCALE_A = 0.08838834764831845f * LOG2E;
constexpr float QSCALE_C = 0.125f * LOG2E;
enum { I_X = 0, I_C, I_POS, I_ADA_W, I_ADA_B, I_NORM_MIX, I_NORM_FFN, I_NORM_FINAL,
       I_EV_W_IN, I_EV_CONV_W, I_EV_CONV_B, I_EV_GA_W, I_EV_GA_B, I_EV_GX_W, I_EV_GX_B, I_EV_LAMBDA, I_EV_W_OUT,
       I_OD_W_IN, I_OD_SINKS, I_OD_A_RE, I_OD_A_IM, I_OD_B_RE, I_OD_B_IM, I_OD_C_RE, I_OD_C_IM, I_OD_D, I_OD_LOG_DT, I_OD_GLU_W, I_OD_GLU_B, I_OD_W_OUT,
       I_FFN_W_IN, I_FFN_CONV_W, I_FFN_CONV_B, I_FFN_W_OUT, N_INPUTS };
constexpr size_t MiB = 1u << 20;
constexpr size_t WS_CTL = 0, CTL_ZERO_BYTES = MiB;
constexpr size_t WS_MOD = 1 * MiB;
constexpr size_t WS_COSA = 2 * MiB, WS_SINA = 4 * MiB, WS_COSC = 6 * MiB, WS_SINC = 7 * MiB;
constexpr size_t WS_S5T = 8 * MiB;
constexpr size_t WS_WGATE = 10 * MiB;
constexpr size_t WS_W_EVIN = 12 * MiB, WS_W_EVOUT = 52 * MiB, WS_W_ODIN = 68 * MiB, WS_W_ODOUT = 86 * MiB, WS_W_GLU = 102 * MiB, WS_W_FFIN = 106 * MiB, WS_W_FFOUT = 278 * MiB;
constexpr size_t WS_H = 364 * MiB, WS_MIX = 396 * MiB, WS_Q = 428 * MiB, WS_K = 444 * MiB, WS_V = 460 * MiB, WS_XB = 476 * MiB, WS_YB = 492 * MiB;
constexpr size_t WS_XC = 508 * MiB, WS_LA = 540 * MiB, WS_LB = 572 * MiB, WS_UFF = 604 * MiB, WS_ACT = 776 * MiB, WS_END = 862 * MiB;
constexpr size_t WS_HALO_F = 508 * MiB, WS_HALO_L = 512 * MiB;
constexpr int CW_BAR = 4096;
constexpr int RING_BYTES = 131072, LDSCTL_OFF = 143360, LDS_BYTES = 147456;

#define GAS __attribute__((address_space(1)))
#define LAS __attribute__((address_space(3)))
typedef unsigned short bf16;
typedef float f32x4 __attribute__((ext_vector_type(4)));
typedef float f32x2 __attribute__((ext_vector_type(2)));
typedef unsigned u32x4 __attribute__((ext_vector_type(4)));
typedef unsigned u32x2 __attribute__((ext_vector_type(2)));
#define LDS_WAIT() asm volatile("s_waitcnt lgkmcnt(0)" ::: "memory")
using pg8::cvt_pk_bf16; using pg8::bf_lo; using pg8::bf_hi; using pg8::gelu_tanh;
__device__ __forceinline__ float wave_sum(float v) {
#pragma unroll
    for (int o = 1; o < 64; o <<= 1) v += __shfl_xor(v, o);
    return v;
}
__device__ __forceinline__ unsigned short f2bf(float f) { return (unsigned short)(cvt_pk_bf16(f, 0.f) & 0xffffu); }
__device__ __forceinline__ float bf2f(unsigned short b) { return __uint_as_float(((unsigned)b) << 16); }

struct Params { const float* in[N_INPUTS]; float* out; unsigned char* ws; int lo, hi, li, pad; };
typedef const __attribute__((address_space(4))) Params* KP;
#define KPREF(P, kp0) KP kp_ = (kp0); asm volatile("" : "+s"(kp_)); const __attribute__((address_space(4))) Params& P = *kp_
#define PHASE_IDS() int tid = threadIdx.x; asm volatile("" : "+v"(tid)); const int lane = tid & 63, wave = __builtin_amdgcn_readfirstlane(tid >> 6); int bx = blockIdx.x; asm volatile("" : "+s"(bx)); const int G = gridDim.x; (void)lane; (void)wave; (void)G
#define XB_TMO      128
#define XB_XCNT(j)  (256  + 64 * (j))
#define XB_XSUB(j)  (1280 + 64 * (j))
#define XB_XGEN(j)  (2304 + 64 * (j))
#define XB_TOP      3328
#define XB_TOPGEN   3392
#define XCD_BAR_WORDS 3456
#define XB_SPIN_CAP (1u << 18)
#define LAS __attribute__((address_space(3)))

__device__ __forceinline__ unsigned xb_ld(unsigned* p)              { return __hip_atomic_load(p, __ATOMIC_RELAXED, __HIP_MEMORY_SCOPE_AGENT); }
__device__ __forceinline__ unsigned xb_add(unsigned* p, unsigned v) { return __hip_atomic_fetch_add(p, v, __ATOMIC_RELAXED, __HIP_MEMORY_SCOPE_AGENT); }
__device__ __forceinline__ unsigned xb_xcc_id() { return (unsigned)__builtin_amdgcn_s_getreg((3 << 11) | 20) & 0xFu; }
#define XB_SPIN(cond, bar) do { unsigned _sp = 0; while (cond) { __builtin_amdgcn_s_sleep(1); \
    if ((++_sp & 255u) == 0u) { if (xb_ld(&(bar)[XB_TMO])) break; if (_sp > XB_SPIN_CAP) { atomicAdd(&(bar)[XB_TMO], 1u); break; } } } } while (0)

struct XcdBarrier {
    unsigned* bar; unsigned x;
    volatile LAS unsigned* st;
};

__device__ __forceinline__ XcdBarrier xcd_barrier_post(unsigned* bar, volatile LAS unsigned* st) {
    XcdBarrier b; b.bar = bar; b.x = xb_xcc_id(); b.st = st;
    if (threadIdx.x == 0) (void)xb_add(&bar[XB_XCNT(b.x)], 1u);
    return b;
}
__device__ __forceinline__ void xcd_barrier_complete(unsigned* bar, unsigned x, unsigned& nloc, unsigned& nx) {
    const unsigned G = gridDim.x * gridDim.y * gridDim.z;
    unsigned sum, cnt, mine, sp = 0u;
    for (;;) {
        sum = 0u; cnt = 0u; mine = 0u;
#pragma unroll
        for (unsigned j = 0; j < 16; ++j) { const unsigned c = xb_ld(&bar[XB_XCNT(j)]); sum += c; cnt += (c > 0u) ? 1u : 0u; mine = (j == x) ? c : mine; }
        if (sum == G) break;
        __builtin_amdgcn_s_sleep(1);
        if ((++sp & 255u) == 0u) { if (xb_ld(&bar[XB_TMO])) break; if (sp > XB_SPIN_CAP) { atomicAdd(&bar[XB_TMO], 1u); break; } }
    }
    nloc = mine > 0u ? mine : 1u; nx = cnt > 0u ? cnt : 1u;
}

__device__ __forceinline__ void xcd_barrier(const XcdBarrier& b) {
    asm volatile("s_waitcnt vmcnt(0)" ::: "memory");
    __syncthreads();
    if (threadIdx.x == 0) {
        unsigned* bar = b.bar;
        __builtin_amdgcn_s_waitcnt(0);
        unsigned nloc = b.st[0], nx = b.st[1];
        if (nloc == 0u) { xcd_barrier_complete(bar, b.x, nloc, nx); b.st[0] = nloc; b.st[1] = nx; }
        const unsigned old = xb_add(&bar[XB_XSUB(b.x)], 1u);
        const unsigned gen = old / nloc;
        if (old + 1u == (gen + 1u) * nloc) {
            __builtin_amdgcn_fence(__ATOMIC_RELEASE, "agent");
            asm volatile("s_waitcnt vmcnt(0)" ::: "memory");
            const unsigned og = xb_add(&bar[XB_TOP], 1u);
            const unsigned tg = og / nx;
            if (og + 1u == (tg + 1u) * nx) xb_add(&bar[XB_TOPGEN], 1u);
            else XB_SPIN(xb_ld(&bar[XB_TOPGEN]) == tg, bar);
            __builtin_amdgcn_fence(__ATOMIC_ACQUIRE, "agent");
            xb_add(&bar[XB_XGEN(b.x)], 1u);
            asm volatile("s_waitcnt vmcnt(0)" ::: "memory");
        } else {
            XB_SPIN(xb_ld(&bar[XB_XGEN(b.x)]) == gen, bar);
            __builtin_amdgcn_fence(__ATOMIC_ACQUIRE, "agent");
            asm volatile("s_waitcnt vmcnt(0)" ::: "memory");
        }
    }
    __syncthreads();
}

__device__ __forceinline__ void phase_ada(KP kp0, LAS unsigned char* lds) { KPREF(P, kp0); PHASE_IDS();
    LAS float* cond = (LAS float*)lds;
    LAS float* part = (LAS float*)(lds + 32768);
    const float* c = P.in[I_C];
    for (int i = tid; i < NB * DM; i += 512) { const float v = c[i]; cond[i] = v / (1.0f + __expf(-v)); }
    __syncthreads();
    float* mod = (float*)(P.ws + WS_MOD);
    for (int item = bx; item < 192; item += G) {
        const int l = item / 48, ng = item % 48;
        const float* W = P.in[I_ADA_W] + (size_t)l * DM * 12288 + (size_t)(wave * 256) * 12288 + ng * 256 + lane * 4;
        f32x4 a0 = {0.f, 0.f, 0.f, 0.f}, a1 = a0, a2 = a0, a3 = a0;
#pragma unroll 8
        for (int k = 0; k < 256; ++k) {
            const f32x4 w = *(const f32x4*)(W + (size_t)k * 12288); const int kk = wave * 256 + k;
            a0 += cond[kk] * w; a1 += cond[2048 + kk] * w; a2 += cond[4096 + kk] * w; a3 += cond[6144 + kk] * w;
        }
        LAS float* pp = part + wave * 1024 + lane * 4;
        *(LAS f32x4*)(pp) = a0; *(LAS f32x4*)(pp + 256) = a1; *(LAS f32x4*)(pp + 512) = a2; *(LAS f32x4*)(pp + 768) = a3;
        __syncthreads();
        for (int o = tid; o < 1024; o += 512) {
            float s = 0.f;
#pragma unroll
            for (int w = 0; w < 8; ++w) s += part[w * 1024 + o];
            const int b = o >> 8, cc = o & 255;
            mod[(size_t)(l * 4 + b) * 12288 + ng * 256 + cc] = s + P.in[I_ADA_B][l * 12288 + ng * 256 + cc];
        }
        __syncthreads();
    }
}

__constant__ int TRJOBS[7][6] = {
    {I_EV_W_IN, 2048, 5120, 2, 1, 12}, {I_EV_W_OUT, 2048, 2048, 2, 0, 52}, {I_OD_W_IN, 2048, 2304, 2, 2, 68}, {I_OD_W_OUT, 2048, 2048, 2, 0, 86},
    {I_OD_GLU_W, 1024, 1024, 2, 0, 102}, {I_FFN_W_IN, 2048, 11008, 4, 3, 106}, {I_FFN_W_OUT, 5504, 2048, 4, 0, 278} };
__device__ __forceinline__ int cmap(int type, int n) {
    if (type == 1) { if (n >= 2048) return n; const int tile = n >> 8, j = n & 255, bj = j >> 7, jj = j & 127; return tile * 256 + (jj >> 6) * 128 + bj * 64 + (jj & 63); }
    if (type == 2) {
        if (n >= 1280) return n;
        if (n < 1024) { const int tile = n >> 8, j = n & 255, bj = j >> 7, jj = j & 127; return tile * 256 + (jj >> 5) * 64 + bj * 32 + (jj & 31); }
        const int j = n - 1024, bj = j >> 7, jj = j & 127; if (jj < 64) return 1024 + (jj >> 5) * 64 + bj * 32 + (jj & 31); return 1152 + bj * 64 + (jj - 64);
    }
    if (type == 3) { const int tile = n >> 8, j = n & 255; return (j >> 7) * 5504 + tile * 128 + (j & 127); }
    return n;
}
__device__ __forceinline__ void tr_item(const float* W, int K, int N, bf16* WT, int k0, int srcc0, int dstr0, LAS float* scr, int lane) {
#pragma unroll 8
    for (int i = 0; i < 32; ++i) { const int kk = 2 * i + (lane >> 5); scr[kk * 33 + (lane & 31)] = W[(size_t)(k0 + kk) * N + srcc0 + (lane & 31)]; }
    LDS_WAIT(); asm volatile("" ::: "memory");
    const int c = lane & 7;
#pragma unroll
    for (int j = 0; j < 4; ++j) { const int n = (lane >> 3) + 8 * j; const LAS float* s = scr + (8 * c) * 33 + n;
        u32x4 o; o.x = cvt_pk_bf16(s[0 * 33], s[1 * 33]); o.y = cvt_pk_bf16(s[2 * 33], s[3 * 33]); o.z = cvt_pk_bf16(s[4 * 33], s[5 * 33]); o.w = cvt_pk_bf16(s[6 * 33], s[7 * 33]);
        *(u32x4*)(WT + (size_t)(dstr0 + n) * K + k0 + 8 * c) = o; }
    LDS_WAIT(); asm volatile("" ::: "memory");
}
__device__ __forceinline__ void sincos_rev(double ang, float& s, float& c) {
    double rev = ang * 0.15915494309189535; rev -= floor(rev); const float fr = (float)rev;
    s = __builtin_amdgcn_sinf(fr); c = __builtin_amdgcn_cosf(fr);
}
__device__ __forceinline__ void phase_prep(KP kp0, LAS unsigned char* lds) { KPREF(P, kp0); PHASE_IDS();
    LAS float* scr = (LAS float*)(lds + wave * 16384);
    const int gw = bx * 8 + wave, NGW = G * 8;
    int total = 0;
#pragma unroll
    for (int q = 0; q < 7; ++q) total += TRJOBS[q][3] * (TRJOBS[q][1] / 64) * (TRJOBS[q][2] / 32);
    for (int it = gw; it < total; it += NGW) {
        int r = it, j = 0;
#pragma unroll
        for (int q = 0; q < 6; ++q) { const int cnt = TRJOBS[q][3] * (TRJOBS[q][1] / 64) * (TRJOBS[q][2] / 32); if (j == q && r >= cnt) { r -= cnt; j = q + 1; } }
        const int K = TRJOBS[j][1], N = TRJOBS[j][2], per = (K / 64) * (N / 32), li = r / per, rr = r % per, nblk = N / 32, kb = rr / nblk, nb = rr % nblk;
        const float* src = P.in[TRJOBS[j][0]] + (size_t)li * K * N;
        bf16* dst = (bf16*)(P.ws + (size_t)TRJOBS[j][5] * MiB) + (size_t)li * K * N;
        tr_item(src, K, N, dst, 64 * kb, cmap(TRJOBS[j][4], 32 * nb), 32 * nb, scr, lane);
    }
    for (int it = gw; it < 256; it += NGW) { const int mat = it >> 3, rr = it & 7, kb = rr >> 2, nb = rr & 3, gate = mat & 1, eb = mat >> 1;
        tr_item(P.in[gate ? I_EV_GX_W : I_EV_GA_W] + (size_t)eb * 16384, 128, 128, (bf16*)(P.ws + WS_WGATE) + ((size_t)eb * 256 + gate * 128) * 128, 64 * kb, 32 * nb, 32 * nb, scr, lane); }
    const int gt = bx * 512 + tid, NT = G * 512;
    const int* pos = (const int*)P.in[I_POS];
    float* cosA = (float*)(P.ws + WS_COSA); float* sinA = (float*)(P.ws + WS_SINA); float* cosC = (float*)(P.ws + WS_COSC); float* sinC = (float*)(P.ws + WS_SINC);
    for (int idx = gt; idx < MT * 64; idx += NT) { const int row = idx >> 6, i = idx & 63;
        const double inv = exp2(-(double)i * (13.287712379549449 / 64.0)); float s, c; sincos_rev((double)pos[row] * inv, s, c); cosA[idx] = c; sinA[idx] = s; }
    for (int idx = gt; idx < MT * 32; idx += NT) { const int row = idx >> 5, i = idx & 31;
        const double inv = exp2(-(double)i * (13.287712379549449 / 32.0)); float s, c; sincos_rev((double)pos[row] * inv, s, c); cosC[idx] = c; sinC[idx] = s; }
    for (int idx = gt; idx < 2 * 64 * 64; idx += NT) { const int o = idx >> 12, g = (idx >> 6) & 63;
        const float are = P.in[I_OD_A_RE][idx], aim = P.in[I_OD_A_IM][idx], dt = expf(P.in[I_OD_LOG_DT][o * 64 + g]);
        const float er = expf(are * dt); float s, c; sincos_rev((double)aim * (double)dt, s, c);
        const float abr = er * c, abi = er * s, xr = abr - 1.0f, xi = abi, den = 1.0f / (are * are + aim * aim);
        const float cr = (xr * are + xi * aim) * den, ci = (xi * are - xr * aim) * den;
        f32x2* abar = (f32x2*)(P.ws + WS_S5T + (size_t)o * MiB); f32x2* bbar = (f32x2*)(P.ws + WS_S5T + (size_t)o * MiB + 65536);
        abar[idx & 4095] = (f32x2){abr, abi};
#pragma unroll
        for (int cc = 0; cc < 16; ++cc) { const float br = P.in[I_OD_B_RE][(size_t)idx * 16 + cc], bi = P.in[I_OD_B_IM][(size_t)idx * 16 + cc];
            bbar[(size_t)(idx & 4095) * 16 + cc] = (f32x2){cr * br - ci * bi, cr * bi + ci * br}; }
    }
}

__device__ __forceinline__ void phase_norm(KP kp0, int l, int which) { KPREF(P, kp0); PHASE_IDS();
    const float* x = (l == 0 && which == 0) ? P.in[I_X] : P.out;
    const float* gwt = P.in[which ? I_NORM_FFN : I_NORM_MIX] + l * DM;
    const float* modl = (const float*)(P.ws + WS_MOD) + (size_t)l * 4 * 12288 + (which ? 3 * DM : 0);
    bf16* H = (bf16*)(P.ws + WS_H);
    const int gw = bx * 8 + wave, NGW = G * 8;
    for (int row = gw; row < MT; row += NGW) {
        const f32x4* xr = (const f32x4*)(x + (size_t)row * DM) + lane;
        f32x4 v[8]; float ss = 0.f;
#pragma unroll
        for (int j = 0; j < 8; ++j) { v[j] = xr[64 * j]; ss += (v[j][0] * v[j][0] + v[j][1] * v[j][1]) + (v[j][2] * v[j][2] + v[j][3] * v[j][3]); }
        const float rstd = rsqrtf(wave_sum(ss) * (1.0f / DM) + 1e-6f);
        const float* sh = modl + (size_t)(row >> 11) * 12288; const float* sc = sh + DM;
        u32x2* o8 = (u32x2*)(H + (size_t)row * DM) + lane;
#pragma unroll
        for (int j = 0; j < 8; ++j) { const int col = (lane + 64 * j) * 4;
            const f32x4 g4 = *(const f32x4*)(gwt + col), s4 = *(const f32x4*)(sc + col), h4 = *(const f32x4*)(sh + col);
            const f32x4 y = v[j] * rstd * g4 * (1.0f + s4) + h4;
            u32x2 w; w.x = cvt_pk_bf16(y[0], y[1]); w.y = cvt_pk_bf16(y[2], y[3]); o8[64 * j] = w; }
    }
}
__device__ __forceinline__ void phase_final(KP kp0) { KPREF(P, kp0); PHASE_IDS();
    const float* gwt = P.in[I_NORM_FINAL];
    const int gw = bx * 8 + wave, NGW = G * 8;
    for (int row = gw; row < MT; row += NGW) {
        f32x4* xr = (f32x4*)(P.out + (size_t)row * DM) + lane;
        f32x4 v[8]; float ss = 0.f;
#pragma unroll
        for (int j = 0; j < 8; ++j) { v[j] = xr[64 * j]; ss += (v[j][0] * v[j][0] + v[j][1] * v[j][1]) + (v[j][2] * v[j][2] + v[j][3] * v[j][3]); }
        const float rstd = rsqrtf(wave_sum(ss) * (1.0f / DM) + 1e-6f);
#pragma unroll
        for (int j = 0; j < 8; ++j) { const int col = (lane + 64 * j) * 4; xr[64 * j] = v[j] * rstd * *(const f32x4*)(gwt + col); }
    }
}

__device__ __forceinline__ void phase_attn_a_naive(KP kp0) { KPREF(P, kp0); PHASE_IDS();
    const bf16* Q = (const bf16*)(P.ws + WS_Q); const bf16* K = (const bf16*)(P.ws + WS_K); const bf16* V = (const bf16*)(P.ws + WS_V); bf16* MIX = (bf16*)(P.ws + WS_MIX);
    const int gw = bx * 8 + wave, NGW = G * 8;
    for (int task = gw; task < MT * 8; task += NGW) {
        const int h = task & 7, row = task >> 3, b = row >> 11, t = row & 2047;
        const unsigned qw = *(const unsigned*)(Q + (size_t)row * 1024 + h * 128 + 2 * lane); const float q0 = bf_lo(qw), q1 = bf_hi(qw);
        float m = -INFINITY, l = 0.f, o0 = 0.f, o1 = 0.f;
        for (int pat = 0; pat < 3; ++pat) { const int dil = pat == 0 ? 1 : (pat == 1 ? 4 : 16);
            for (int j = 0; j <= 128; ++j) { const int tk = t - dil * j; if (tk < 0) break;
                const size_t kr = (size_t)(b * SEQ + tk) * 1024 + h * 128 + 2 * lane;
                const unsigned kw = *(const unsigned*)(K + kr), vw = *(const unsigned*)(V + kr);
                const float s = wave_sum(q0 * bf_lo(kw) + q1 * bf_hi(kw));
                const float mn = fmaxf(m, s), corr = exp2f(m - mn), p = exp2f(s - mn);
                l = l * corr + p; o0 = o0 * corr + p * bf_lo(vw); o1 = o1 * corr + p * bf_hi(vw); m = mn; } }
        const float inv = 1.0f / l;
        *(unsigned*)(MIX + (size_t)row * 2048 + h * 128 + 2 * lane) = cvt_pk_bf16(o0 * inv, o1 * inv);
    }
}
__device__ __forceinline__ void phase_attn_c_naive(KP kp0, int o_idx) { KPREF(P, kp0); PHASE_IDS();
    const bf16* Q = (const bf16*)(P.ws + WS_Q); const bf16* K = (const bf16*)(P.ws + WS_K); const bf16* V = (const bf16*)(P.ws + WS_V); bf16* MIX = (bf16*)(P.ws + WS_MIX);
    const int gw = bx * 8 + wave, NGW = G * 8;
    for (int task = gw; task < MT * 16; task += NGW) {
        const int h = task & 15, row = task >> 4, b = row >> 11, t = row & 2047, kvh = h >> 3;
        const float q = bf2f(Q[(size_t)row * 1024 + h * 64 + lane]);
        float m = -INFINITY, l = 0.f, o = 0.f;
        for (int tk = (t >= 127 ? t - 127 : 0); tk <= t; ++tk) {
            const size_t kr = (size_t)(b * SEQ + tk) * 128 + kvh * 64 + lane;
            const float s = wave_sum(q * bf2f(K[kr]));
            const float mn = fmaxf(m, s), corr = exp2f(m - mn), p = exp2f(s - mn);
            l = l * corr + p; o = o * corr + p * bf2f(V[kr]); m = mn; }
        const float sk = P.in[I_OD_SINKS][o_idx * 16 + h] * LOG2E;
        MIX[(size_t)row * 2048 + h * 64 + lane] = f2bf(o / (l + exp2f(sk - m)));
    }
}
__device__ __forceinline__ void phase_lru1_naive(KP kp0, int e) { KPREF(P, kp0); PHASE_IDS();
    const bf16* XB = (const bf16*)(P.ws + WS_XB); float* XC = (float*)(P.ws + WS_XC);
    const float* cw = P.in[I_EV_CONV_W] + (size_t)e * 4 * 1024; const float* cb = P.in[I_EV_CONV_B] + e * 1024;
    const int gt = bx * 512 + tid, NT = G * 512;
    for (int idx = gt; idx < MT * 1024; idx += NT) { const int row = idx >> 10, c = idx & 1023, t = row & 2047;
        float acc = cb[c];
#pragma unroll
        for (int i = 0; i < 4; ++i) { const int tt = t - 3 + i; if (tt >= 0) acc += cw[i * 1024 + c] * bf2f(XB[(size_t)(row - 3 + i) * 1024 + c]); }
        XC[idx] = acc; }
}
__device__ __forceinline__ void phase_lru2_naive(KP kp0, int e) { KPREF(P, kp0); PHASE_IDS();
    const float* XC = (const float*)(P.ws + WS_XC); float* LA = (float*)(P.ws + WS_LA); float* LB = (float*)(P.ws + WS_LB);
    const int gt = bx * 512 + tid, NT = G * 512;
    for (int idx = gt; idx < MT * 1024; idx += NT) { const int row = idx >> 10, c = idx & 1023, blk = c >> 7, j = c & 127;
        const float* xr = XC + (size_t)row * 1024 + blk * 128;
        const float* wa = P.in[I_EV_GA_W] + (size_t)((e * 8 + blk) * 128) * 128 + j; const float* wx = P.in[I_EV_GX_W] + (size_t)((e * 8 + blk) * 128) * 128 + j;
        float sa = P.in[I_EV_GA_B][e * 1024 + c], sx = P.in[I_EV_GX_B][e * 1024 + c];
#pragma unroll 8
        for (int i = 0; i < 128; ++i) { const float xv = xr[i]; sa += xv * wa[i * 128]; sx += xv * wx[i * 128]; }
        const float r = 1.0f / (1.0f + expf(-sa)), ig = 1.0f / (1.0f + expf(-sx));
        const float sp = log1pf(expf(-P.in[I_EV_LAMBDA][e * 1024 + c]));
        const float log_a = -8.0f * r * sp, a = expf(log_a), mult = sqrtf(-expm1f(2.0f * log_a));
        LA[idx] = a; LB[idx] = mult * ig * xr[j]; }
}
__device__ __forceinline__ void phase_lru3_naive(KP kp0) { KPREF(P, kp0); PHASE_IDS();
    const float* LA = (const float*)(P.ws + WS_LA); const float* LB = (const float*)(P.ws + WS_LB); const bf16* YB = (const bf16*)(P.ws + WS_YB); bf16* MIX = (bf16*)(P.ws + WS_MIX);
    if (wave != 0) return;
    for (int task = bx; task < 64; task += G) { const int b = task >> 4, c = (task & 15) * 64 + lane;
        float h = 0.f;
#pragma unroll 8
        for (int t = 0; t < SEQ; ++t) { const size_t idx = (size_t)(b * SEQ + t) * 1024 + c;
            h = LA[idx] * h + LB[idx];
            MIX[(size_t)(b * SEQ + t) * 2048 + 1024 + c] = f2bf(h * bf2f(YB[idx])); } }
}
__device__ __forceinline__ void phase_s5_naive(KP kp0, int o_idx) { KPREF(P, kp0); PHASE_IDS();
    const bf16* U = (const bf16*)(P.ws + WS_XB); bf16* Z = (bf16*)(P.ws + WS_YB);
    if (wave != 0) return;
    for (int bg = bx; bg < 256; bg += G) { const int b = bg >> 6, g = bg & 63;
        const f32x2 ab = ((const f32x2*)(P.ws + WS_S5T + (size_t)o_idx * MiB))[g * 64 + lane];
        const f32x2* bbp = (const f32x2*)(P.ws + WS_S5T + (size_t)o_idx * MiB + 65536) + (size_t)(g * 64 + lane) * 16;
        f32x2 bb[16]; float cre[16], cim[16], dsk[16];
#pragma unroll
        for (int c = 0; c < 16; ++c) { bb[c] = bbp[c];
            cre[c] = P.in[I_OD_C_RE][((size_t)(o_idx * 64 + g) * 16 + c) * 64 + lane]; cim[c] = P.in[I_OD_C_IM][((size_t)(o_idx * 64 + g) * 16 + c) * 64 + lane];
            dsk[c] = P.in[I_OD_D][o_idx * 1024 + g * 16 + c]; }
        float hr = 0.f, hi = 0.f;
        for (int t = 0; t < SEQ; ++t) { const size_t row = (size_t)(b * SEQ + t);
            const u32x4 u0 = *(const u32x4*)(U + row * 1024 + g * 16), u1 = *(const u32x4*)(U + row * 1024 + g * 16 + 8);
            float u[16] = {bf_lo(u0.x), bf_hi(u0.x), bf_lo(u0.y), bf_hi(u0.y), bf_lo(u0.z), bf_hi(u0.z), bf_lo(u0.w), bf_hi(u0.w),
                           bf_lo(u1.x), bf_hi(u1.x), bf_lo(u1.y), bf_hi(u1.y), bf_lo(u1.z), bf_hi(u1.z), bf_lo(u1.w), bf_hi(u1.w)};
            float bur = 0.f, bui = 0.f;
#pragma unroll
            for (int c = 0; c < 16; ++c) { bur += u[c] * bb[c][0]; bui += u[c] * bb[c][1]; }
            const float nr = ab[0] * hr - ab[1] * hi + bur, ni = ab[0] * hi + ab[1] * hr + bui; hr = nr; hi = ni;
            float zo = 0.f;
#pragma unroll
            for (int c = 0; c < 16; ++c) { const float y = wave_sum(hr * cre[c] - hi * cim[c]) + dsk[c] * u[c]; const float z = gelu_tanh(y); zo = (lane == c) ? z : zo; }
            if (lane < 16) Z[row * 1024 + g * 16 + lane] = f2bf(zo); }
    }
}
__device__ __forceinline__ void phase_ffn_fix(KP kp0, int l) { KPREF(P, kp0); PHASE_IDS();
    const float* hf = (const float*)(P.ws + WS_HALO_F); const float* hl = (const float*)(P.ws + WS_HALO_L); bf16* ACT = (bf16*)(P.ws + WS_ACT);
    const float* cw = P.in[I_FFN_CONV_W] + (size_t)l * 3 * DFF2; const float* cb = P.in[I_FFN_CONV_B] + (size_t)l * DFF2;
    const int gt = bx * 512 + tid, NT = G * 512;
    for (int idx = gt; idx < 32 * 2 * DFF; idx += NT) { const int j = idx % DFF, rr = (idx / DFF) & 1, pm = idx / (2 * DFF);
        if ((pm & 7) == 0) continue;
        float o[2];
#pragma unroll
        for (int bj = 0; bj < 2; ++bj) { const int col = bj * DFF + j;
            const float l0 = hl[((size_t)((pm - 1) * 2 + 0) * 2 + bj) * DFF + j], l1 = hl[((size_t)((pm - 1) * 2 + 1) * 2 + bj) * DFF + j];
            const float f0 = hf[((size_t)(pm * 2 + 0) * 2 + bj) * DFF + j], f1 = hf[((size_t)(pm * 2 + 1) * 2 + bj) * DFF + j];
            const float um2 = rr == 0 ? l0 : l1, um1 = rr == 0 ? l1 : f0, u0 = rr == 0 ? f0 : f1;
            o[bj] = cb[col] + cw[col] * um2 + cw[DFF2 + col] * um1 + cw[2 * DFF2 + col] * u0; }
        ACT[(size_t)(pm * 256 + rr) * DFF + j] = f2bf(gelu_tanh(o[0]) * o[1]); }
}

typedef short s16x4 __attribute__((ext_vector_type(4)));
typedef short bf16x8v __attribute__((ext_vector_type(8)));
typedef float f32x16 __attribute__((ext_vector_type(16)));
__device__ __forceinline__ unsigned offb(unsigned row, unsigned ch) { return 256u * row + 16u * (ch ^ (((row & 3u) << 2) | ((row >> 2) & 3u))); }
constexpr int ATT_TILE_BYTES = 64 * 256, ATT_BUF_BYTES = 2 * ATT_TILE_BYTES;
__device__ __forceinline__ bf16x8v cat8(const s16x4 a, const s16x4 b) { return (bf16x8v){a[0], a[1], a[2], a[3], b[0], b[1], b[2], b[3]}; }

template <int MODE>
__device__ __forceinline__ void phase_attn(KP kp0, LAS unsigned char* lds, int o_idx) { KPREF(P, kp0); PHASE_IDS();
    constexpr int NKS = MODE == 0 ? 8 : 4;
    constexpr int NDT = MODE == 0 ? 4 : 2;
    constexpr int NH = 1;
    const bf16* Q = (const bf16*)(P.ws + WS_Q); const bf16* K = (const bf16*)(P.ws + WS_K); const bf16* V = (const bf16*)(P.ws + WS_V); bf16* MIX = (bf16*)(P.ws + WS_MIX);
    const int r = lane & 31, hh = lane >> 5, q4 = (lane & 15) >> 2, p4 = lane & 3, blk = (lane >> 4) & 1;
    unsigned kaddr[NKS], vaddr[2][NDT];
    { const unsigned x = ((r & 3u) << 2) | ((r >> 2) & 3u);
#pragma unroll
      for (int s = 0; s < NKS; ++s) kaddr[s] = 256u * r + 16u * (((unsigned)(2 * s + hh)) ^ x);
#pragma unroll
      for (int t = 0; t < 2; ++t)
#pragma unroll
        for (int c = 0; c < NDT; ++c) { const unsigned row = 8u * t + 4u * hh + q4, ch = 4u * c + 2u * blk + (p4 >> 1);
            vaddr[t][c] = 256u * row + 16u * (ch ^ (((row & 3u) << 2) | ((row >> 2) & 3u))) + 8u * (p4 & 1); } }
    const int nunits = MODE == 0 ? 256 : 512;
    for (int unit = bx; unit < nunits; unit += G) {
        int b, head0, q0, kt0, kt1; size_t kvbase; int kvpitch; unsigned kx = 0u;
        if (MODE == 0) { const int qb = 7 - (unit >> 5), bh = unit & 31; b = bh >> 3; head0 = bh & 7; q0 = qb * 256; kt0 = 0; kt1 = qb * 4 + 3; kvbase = (size_t)b * SEQ * 1024 + head0 * 128; kvpitch = 1024; }
        else { b = unit >> 7; const int kvh = (unit >> 6) & 1; kx = 128u * kvh; q0 = (unit & 63) * 32; head0 = 8 * kvh + wave; kt0 = (q0 >= 127 ? q0 - 127 : 0) >> 6; kt1 = (q0 + 31) >> 6; kvbase = (size_t)b * SEQ * 128; kvpitch = 128; }
        const int qw0 = MODE == 0 ? q0 + 32 * wave : q0;
        const int tq = qw0 + r;
        const size_t qrow = (size_t)b * SEQ + tq;
        bf16x8v qf[NH][NKS];
#pragma unroll
        for (int hd = 0; hd < NH; ++hd)
#pragma unroll
            for (int s = 0; s < NKS; ++s) qf[hd][s] = *(const bf16x8v*)(Q + qrow * 1024 + (MODE == 0 ? head0 * 128 : (head0 + hd) * 64) + 16 * s + 8 * hh);
        f32x16 O[NH][NDT]; float m[NH], l[NH];
#pragma unroll
        for (int hd = 0; hd < NH; ++hd) { m[hd] = -1e30f; l[hd] = 0.f;
#pragma unroll
            for (int c = 0; c < NDT; ++c)
#pragma unroll
                for (int i = 0; i < 16; ++i) O[hd][c][i] = 0.f; }
        const int srow = tid >> 4, sch = tid & 15;
        const unsigned soff0 = offb(srow, sch), soff1 = offb(srow + 32, sch);
        u32x4 kreg[2], vreg[2];
        { const size_t g0 = kvbase + (size_t)(kt0 * 64 + srow) * kvpitch + sch * 8, g1 = g0 + (size_t)32 * kvpitch;
          kreg[0] = *(const u32x4*)(K + g0); kreg[1] = *(const u32x4*)(K + g1); vreg[0] = *(const u32x4*)(V + g0); vreg[1] = *(const u32x4*)(V + g1); }
        __syncthreads();
        *(LAS u32x4*)(lds + soff0) = kreg[0]; *(LAS u32x4*)(lds + soff1) = kreg[1];
        *(LAS u32x4*)(lds + ATT_TILE_BYTES + soff0) = vreg[0]; *(LAS u32x4*)(lds + ATT_TILE_BYTES + soff1) = vreg[1];
        __syncthreads();
        for (int kt = kt0; kt <= kt1; ++kt) {
            const int cur = (kt - kt0) & 1;
            LAS unsigned char* kb_ = lds + cur * ATT_BUF_BYTES; LAS unsigned char* vb_ = kb_ + ATT_TILE_BYTES;
            if (kt < kt1) { const size_t g0 = kvbase + (size_t)((kt + 1) * 64 + srow) * kvpitch + sch * 8, g1 = g0 + (size_t)32 * kvpitch;
                kreg[0] = *(const u32x4*)(K + g0); kreg[1] = *(const u32x4*)(K + g1); vreg[0] = *(const u32x4*)(V + g0); vreg[1] = *(const u32x4*)(V + g1); }
            if (64 * kt <= qw0 + 31) {
                const int dq = tq - 64 * kt - 4 * hh;
#pragma unroll
                for (int hd = 0; hd < NH; ++hd) {
                    f32x16 S[2];
#pragma unroll
                    for (int kb = 0; kb < 2; ++kb) {
#pragma unroll
                        for (int i = 0; i < 16; ++i) S[kb][i] = 0.f;
#pragma unroll
                        for (int s = 0; s < NKS; ++s) { const bf16x8v kf = *(const LAS bf16x8v*)(kb_ + (kaddr[s] ^ kx) + kb * 8192); S[kb] = __builtin_amdgcn_mfma_f32_32x32x16_bf16(kf, qf[hd][s], S[kb], 0, 0, 0); }
                    }
                    float w[2][16]; float tmax = -INFINITY;
#pragma unroll
                    for (int kb = 0; kb < 2; ++kb)
#pragma unroll
                        for (int i = 0; i < 16; ++i) { const int d = dq - (kb * 32 + (i & 3) + 8 * (i >> 2));
                            if (MODE == 0) { const int cnt = (d <= 128 ? 1 : 0) + (((d & 3) == 0 && d <= 512) ? 1 : 0) + ((d & 15) == 0 ? 1 : 0); w[kb][i] = (d >= 0) ? (float)cnt : 0.f; }
                            else w[kb][i] = (d >= 0 && d <= 127) ? 1.f : 0.f;
                            S[kb][i] = (w[kb][i] > 0.f) ? S[kb][i] : -INFINITY; tmax = fmaxf(tmax, S[kb][i]); }
                    tmax = fmaxf(tmax, __shfl_xor(tmax, 32));
                    const float mn = fmaxf(m[hd], tmax), corr = __builtin_amdgcn_exp2f(m[hd] - mn); m[hd] = mn;
                    float ps = 0.f;
#pragma unroll
                    for (int kb = 0; kb < 2; ++kb)
#pragma unroll
                        for (int i = 0; i < 16; ++i) { const float pv = w[kb][i] * __builtin_amdgcn_exp2f(S[kb][i] - mn); S[kb][i] = pv; ps += pv; }
                    l[hd] = l[hd] * corr + ps;
#pragma unroll
                    for (int c = 0; c < NDT; ++c)
#pragma unroll
                        for (int i = 0; i < 16; ++i) O[hd][c][i] *= corr;
#pragma unroll
                    for (int kb = 0; kb < 2; ++kb)
#pragma unroll
                        for (int s2 = 0; s2 < 2; ++s2) {
                            bf16x8v pf; { const unsigned a0 = cvt_pk_bf16(S[kb][8 * s2 + 0], S[kb][8 * s2 + 1]), a1 = cvt_pk_bf16(S[kb][8 * s2 + 2], S[kb][8 * s2 + 3]),
                                                         a2 = cvt_pk_bf16(S[kb][8 * s2 + 4], S[kb][8 * s2 + 5]), a3 = cvt_pk_bf16(S[kb][8 * s2 + 6], S[kb][8 * s2 + 7]);
                                pf = __builtin_bit_cast(bf16x8v, (u32x4){a0, a1, a2, a3}); }
#pragma unroll
                            for (int c = 0; c < NDT; ++c) {
                                const s16x4 v0 = __builtin_amdgcn_ds_read_tr16_b64_v4i16((LAS s16x4*)(vb_ + (vaddr[0][c] ^ kx) + 256 * (32 * kb + 16 * s2)));
                                const s16x4 v1 = __builtin_amdgcn_ds_read_tr16_b64_v4i16((LAS s16x4*)(vb_ + (vaddr[1][c] ^ kx) + 256 * (32 * kb + 16 * s2)));
                                O[hd][c] = __builtin_amdgcn_mfma_f32_32x32x16_bf16(cat8(v0, v1), pf, O[hd][c], 0, 0, 0); }
                        }
                }
            }
            if (kt < kt1) { LAS unsigned char* nb_ = lds + (cur ^ 1) * ATT_BUF_BYTES;
                *(LAS u32x4*)(nb_ + soff0) = kreg[0]; *(LAS u32x4*)(nb_ + soff1) = kreg[1];
                *(LAS u32x4*)(nb_ + ATT_TILE_BYTES + soff0) = vreg[0]; *(LAS u32x4*)(nb_ + ATT_TILE_BYTES + soff1) = vreg[1]; }
            __syncthreads();
        }
#pragma unroll
        for (int hd = 0; hd < NH; ++hd) {
            float lt = l[hd] + __shfl_xor(l[hd], 32);
            if (MODE == 1) lt += __builtin_amdgcn_exp2f(P.in[I_OD_SINKS][o_idx * 16 + head0 + hd] * LOG2E - m[hd]);
            const float inv = 1.0f / lt;
            bf16* orow = MIX + qrow * 2048 + (MODE == 0 ? head0 * 128 : (head0 + hd) * 64);
#pragma unroll
            for (int c = 0; c < NDT; ++c)
#pragma unroll
                for (int g4 = 0; g4 < 4; ++g4) { u32x2 o; o.x = cvt_pk_bf16(O[hd][c][4 * g4 + 0] * inv, O[hd][c][4 * g4 + 1] * inv); o.y = cvt_pk_bf16(O[hd][c][4 * g4 + 2] * inv, O[hd][c][4 * g4 + 3] * inv);
                    *(u32x2*)(orow + 32 * c + 8 * g4 + 4 * hh) = o; }
        }
    }
}

__device__ __forceinline__ void phase_s5(KP kp0, LAS unsigned char* lds, int o_idx) { KPREF(P, kp0); PHASE_IDS();
    const bf16* U = (const bf16*)(P.ws + WS_XB); bf16* Z = (bf16*)(P.ws + WS_YB);
    LAS unsigned char* uL = lds;
    LAS unsigned char* hL = lds + 65536 + wave * 8704;
    LAS float* eL = (LAS float*)(lds + 65536 + 8 * 8704);
    const int r = lane & 31, hh = lane >> 5;
    for (int bg = bx; bg < 256; bg += G) { const int b = bg >> 6, g = bg & 63;
        __syncthreads();
#pragma unroll
        for (int j = 0; j < 8; ++j) { const int n = tid + 512 * j, row = n >> 1, hf = n & 1;
            *(LAS u32x4*)(uL + row * 32 + hf * 16) = *(const u32x4*)(U + (size_t)(b * SEQ + row) * 1024 + g * 16 + hf * 8); }
        const f32x2 ab = ((const f32x2*)(P.ws + WS_S5T + (size_t)o_idx * MiB))[g * 64 + lane];
        const f32x2* bbp = (const f32x2*)(P.ws + WS_S5T + (size_t)o_idx * MiB + 65536) + (size_t)(g * 64 + lane) * 16;
        f32x2 bb[16];
#pragma unroll
        for (int c = 0; c < 16; ++c) bb[c] = bbp[c];
        __syncthreads();
        const int t0 = wave * 256;
        float hr = 0.f, hi = 0.f;
#define S5_STEP(t) { const u32x4 u0 = *(const LAS u32x4*)(uL + (t) * 32), u1 = *(const LAS u32x4*)(uL + (t) * 32 + 16); \
            const float uf[16] = {bf_lo(u0.x), bf_hi(u0.x), bf_lo(u0.y), bf_hi(u0.y), bf_lo(u0.z), bf_hi(u0.z), bf_lo(u0.w), bf_hi(u0.w), bf_lo(u1.x), bf_hi(u1.x), bf_lo(u1.y), bf_hi(u1.y), bf_lo(u1.z), bf_hi(u1.z), bf_lo(u1.w), bf_hi(u1.w)}; \
            float bur = 0.f, bui = 0.f; _Pragma("unroll") for (int c = 0; c < 16; ++c) { bur += uf[c] * bb[c][0]; bui += uf[c] * bb[c][1]; } \
            const float nr = ab[0] * hr - ab[1] * hi + bur, ni = ab[0] * hi + ab[1] * hr + bui; hr = nr; hi = ni; }
        for (int t = t0; t < t0 + 256; ++t) S5_STEP(t)
        eL[(wave * 64 + lane) * 2] = hr; eL[(wave * 64 + lane) * 2 + 1] = hi;
        float pr = ab[0], pi = ab[1];
#pragma unroll
        for (int q = 0; q < 8; ++q) { const float nr = pr * pr - pi * pi, ni = 2.f * pr * pi; pr = nr; pi = ni; }
        __syncthreads();
        hr = 0.f; hi = 0.f;
        for (int w = 0; w < wave; ++w) { const float er = eL[(w * 64 + lane) * 2], ei = eL[(w * 64 + lane) * 2 + 1]; const float nr = pr * hr - pi * hi + er, ni = pr * hi + pi * hr + ei; hr = nr; hi = ni; }
        bf16x8v cf[8];
#pragma unroll
        for (int s = 0; s < 8; ++s) { u32x4 w4 = {0u, 0u, 0u, 0u};
            if (r < 16) { const float* cp = P.in[s < 4 ? I_OD_C_RE : I_OD_C_IM] + ((size_t)(o_idx * 64 + g) * 16 + r) * 64 + 16 * (s & 3) + 8 * hh; const float sg = s < 4 ? 1.f : -1.f;
                const f32x4 c0 = *(const f32x4*)cp, c1 = *(const f32x4*)(cp + 4);
                w4.x = cvt_pk_bf16(sg * c0[0], sg * c0[1]); w4.y = cvt_pk_bf16(sg * c0[2], sg * c0[3]); w4.z = cvt_pk_bf16(sg * c1[0], sg * c1[1]); w4.w = cvt_pk_bf16(sg * c1[2], sg * c1[3]); }
            cf[s] = __builtin_bit_cast(bf16x8v, w4); }
        const float dsk = r < 16 ? P.in[I_OD_D][o_idx * 1024 + g * 16 + r] : 0.f;
        for (int tb = 0; tb < 8; ++tb) {
            for (int tt = 0; tt < 32; ++tt) { const int t = t0 + tb * 32 + tt; S5_STEP(t)
                *(LAS unsigned short*)(hL + tt * 272 + lane * 2) = f2bf(hr); *(LAS unsigned short*)(hL + tt * 272 + 128 + lane * 2) = f2bf(hi); }
            f32x16 Y;
#pragma unroll
            for (int i = 0; i < 16; ++i) Y[i] = 0.f;
#pragma unroll
            for (int s = 0; s < 8; ++s) { const bf16x8v af = *(const LAS bf16x8v*)(hL + r * 272 + 32 * s + 16 * hh); Y = __builtin_amdgcn_mfma_f32_32x32x16_bf16(af, cf[s], Y, 0, 0, 0); }
            if (r < 16) {
#pragma unroll
                for (int i = 0; i < 16; ++i) { const int t = t0 + tb * 32 + (i & 3) + 8 * (i >> 2) + 4 * hh;
                    const float uv = bf2f(*(const LAS unsigned short*)(uL + t * 32 + r * 2));
                    Z[(size_t)(b * SEQ + t) * 1024 + g * 16 + r] = f2bf(gelu_tanh(Y[i] + dsk * uv)); }
            }
        }
#undef S5_STEP
    }
}

__device__ __forceinline__ void phase_lru(KP kp0, LAS unsigned char* lds, int e) { KPREF(P, kp0); PHASE_IDS();
    const bf16* XB = (const bf16*)(P.ws + WS_XB); const bf16* YB = (const bf16*)(P.ws + WS_YB); bf16* MIX = (bf16*)(P.ws + WS_MIX);
    LAS unsigned char* xcL = lds;
    LAS float* aL = (LAS float*)(lds + 69632); LAS float* bL = (LAS float*)(lds + 86016);
    LAS float* sA = (LAS float*)(lds + 102400); LAS float* sB = (LAS float*)(lds + 104448);
    LAS float* carry = (LAS float*)(lds + 106496);
    const int c16 = lane & 15, kq = lane >> 4, cg = tid & 15, rg = tid >> 4;
    for (int item = bx; item < 256; item += G) { const int b = item >> 6, blk = (item >> 3) & 7, oct = item & 7, ch0 = blk * 128 + oct * 16;
        float cw[4][8], cb[8];
#pragma unroll
        for (int q = 0; q < 8; ++q) { cb[q] = P.in[I_EV_CONV_B][e * 1024 + blk * 128 + cg * 8 + q];
#pragma unroll
            for (int i = 0; i < 4; ++i) cw[i][q] = P.in[I_EV_CONV_W][(size_t)(e * 4 + i) * 1024 + blk * 128 + cg * 8 + q]; }
        bf16x8v bfr[4], bfi[4];
        { const bf16* wg = (const bf16*)(P.ws + WS_WGATE) + ((size_t)(e * 8 + blk) * 256 + oct * 16 + c16) * 128 + 8 * kq;
#pragma unroll
          for (int s = 0; s < 4; ++s) { bfr[s] = *(const bf16x8v*)(wg + 32 * s); bfi[s] = *(const bf16x8v*)(wg + 128 * 128 + 32 * s); } }
        const float gab = P.in[I_EV_GA_B][e * 1024 + ch0 + c16], gxb = P.in[I_EV_GX_B][e * 1024 + ch0 + c16];
        const float sp8 = -8.0f * log1pf(expf(-P.in[I_EV_LAMBDA][e * 1024 + ch0 + c16]));
        if (tid < 16) carry[tid] = 0.f;
        for (int tc = 0; tc < 8; ++tc) { const int t0 = tc * 256;
            __syncthreads();
            {
                u32x4 xin[11];
#pragma unroll
                for (int i = 0; i < 11; ++i) { const int tt = t0 + 8 * rg - 3 + i;
                    xin[i] = (tt >= 0) ? *(const u32x4*)(XB + (size_t)(b * SEQ + tt) * 1024 + blk * 128 + cg * 8) : (u32x4){0u, 0u, 0u, 0u}; }
#pragma unroll
                for (int j = 0; j < 8; ++j) { float o[8];
#pragma unroll
                    for (int q = 0; q < 8; ++q) o[q] = cb[q];
#pragma unroll
                    for (int i = 0; i < 4; ++i) { const u32x4 x = xin[j + i];
                        o[0] += cw[i][0] * bf_lo(x.x); o[1] += cw[i][1] * bf_hi(x.x); o[2] += cw[i][2] * bf_lo(x.y); o[3] += cw[i][3] * bf_hi(x.y);
                        o[4] += cw[i][4] * bf_lo(x.z); o[5] += cw[i][5] * bf_hi(x.z); o[6] += cw[i][6] * bf_lo(x.w); o[7] += cw[i][7] * bf_hi(x.w); }
                    u32x4 w; w.x = cvt_pk_bf16(o[0], o[1]); w.y = cvt_pk_bf16(o[2], o[3]); w.z = cvt_pk_bf16(o[4], o[5]); w.w = cvt_pk_bf16(o[6], o[7]);
                    *(LAS u32x4*)(xcL + (8 * rg + j) * 272 + cg * 16) = w; }
            }
            __syncthreads();
#pragma unroll
            for (int rb = 0; rb < 2; ++rb) { const int row0 = 32 * wave + 16 * rb;
                f32x4 accr = {0.f, 0.f, 0.f, 0.f}, acci = {0.f, 0.f, 0.f, 0.f};
#pragma unroll
                for (int s = 0; s < 4; ++s) { const bf16x8v af = *(const LAS bf16x8v*)(xcL + (row0 + c16) * 272 + 64 * s + 16 * kq);
                    accr = __builtin_amdgcn_mfma_f32_16x16x32_bf16(af, bfr[s], accr, 0, 0, 0); acci = __builtin_amdgcn_mfma_f32_16x16x32_bf16(af, bfi[s], acci, 0, 0, 0); }
#pragma unroll
                for (int i = 0; i < 4; ++i) { const int row = row0 + 4 * kq + i;
                    const float rr = 1.0f / (1.0f + __expf(-(accr[i] + gab))), ig = 1.0f / (1.0f + __expf(-(acci[i] + gxb)));
                    const float a = __expf(sp8 * rr), mult = sqrtf(fmaxf(1.0f - a * a, 0.f));
                    const float xv = bf2f(*(const LAS unsigned short*)(xcL + row * 272 + (oct * 16 + c16) * 2));
                    aL[row * 16 + c16] = a; bL[row * 16 + c16] = mult * ig * xv; }
            }
            __syncthreads();
            float av[8], bv[8], A = 1.f, B = 0.f;
#pragma unroll
            for (int i = 0; i < 8; ++i) { av[i] = aL[(8 * rg + i) * 16 + cg]; bv[i] = bL[(8 * rg + i) * 16 + cg]; B = av[i] * B + bv[i]; A *= av[i]; }
            sA[rg * 16 + cg] = A; sB[rg * 16 + cg] = B;
            __syncthreads();
            float h = carry[cg];
            for (int j = 0; j < rg; ++j) h = sA[j * 16 + cg] * h + sB[j * 16 + cg];
#pragma unroll
            for (int i = 0; i < 8; ++i) { h = av[i] * h + bv[i]; const size_t row = (size_t)(b * SEQ + t0 + 8 * rg + i);
                MIX[row * 2048 + 1024 + ch0 + cg] = f2bf(h * bf2f(YB[row * 1024 + ch0 + cg])); }
            __syncthreads();
            if (rg == 31) carry[cg] = h;
        }
    }
}

constexpr int N_PHASES = 2 + 11 * NLAYER + 1;
#ifndef NREP_G
#define NREP_G 1
#endif
#ifndef NREP_M
#define NREP_M 1
#endif
#ifndef NREP_E
#define NREP_E 1
#endif
#ifndef NREP_P
#define NREP_P 1
#endif
#ifndef MK_ONE_LAUNCH
#define MK_ONE_LAUNCH 1
#endif
__global__ void __launch_bounds__(512, 2) fwd(Params P) {
    extern __shared__ __attribute__((aligned(16))) unsigned char lds_raw[];
    LAS unsigned char* lds = (LAS unsigned char*)lds_raw;
    for (int u = threadIdx.x; u < (LDS_BYTES - LDSCTL_OFF) / 4; u += 512) ((LAS unsigned*)(lds + LDSCTL_OFF))[u] = 0u;
    __syncthreads();
    const KP kp = (KP)__builtin_amdgcn_kernarg_segment_ptr();
    const int ph_lo = kp->lo, ph_hi = kp->hi;
    unsigned* barw = (unsigned*)(kp->ws + WS_CTL) + CW_BAR + kp->li * XCD_BAR_WORDS;
    XcdBarrier bar; bar.bar = barw; bar.x = 0; bar.st = nullptr;
    if (ph_hi - ph_lo > 1) bar = xcd_barrier_post(barw, (volatile LAS unsigned*)(lds + LDSCTL_OFF + 64));
#define RUN(p) (ph_lo <= (p) && (p) < ph_hi)
#define SEAM(p) do { if (RUN(p) && RUN((p) + 1)) xcd_barrier(bar); } while (0)

    if (RUN(0)) for (int rep = 0; rep < NREP_P; ++rep) phase_ada(kp, lds);
    SEAM(0);
    if (RUN(1)) for (int rep = 0; rep < NREP_P; ++rep) phase_prep(kp, lds);
    SEAM(1);
    for (int l = 0; l < NLAYER; ++l) {
        const int pb = 2 + 11 * l, e = l >> 1; const bool odd = (l & 1) != 0;
        if (RUN(pb + 0)) for (int rep = 0; rep < NREP_E; ++rep) phase_norm(kp, l, 0);
        SEAM(pb + 0);
        if (RUN(pb + 1)) for (int rep = 0; rep < NREP_G; ++rep) { KPREF(P, kp); int bx = blockIdx.x; asm volatile("" : "+s"(bx)); const int G = gridDim.x; const bf16* H = (const bf16*)(P.ws + WS_H); bf16* Qb = (bf16*)(P.ws + WS_Q);
            if (!odd) { pg8::Gemm g{H, (const bf16*)(P.ws + WS_W_EVIN) + (size_t)e * EVEN_IN * DM, MT, EVEN_IN, DM}; pg8::StaticOrder S; S.init(MT, EVEN_IN, G, bx);
                pg8::EpiEvenIn E{Qb, (const float*)(P.ws + WS_COSA), (const float*)(P.ws + WS_SINA), QSCALE_A};
                pg8::gemm_phase<pg8::EpiEvenIn, pg8::StaticOrder, true, true>(lds, g, S, E); }
            else { pg8::Gemm g{H, (const bf16*)(P.ws + WS_W_ODIN) + (size_t)e * ODD_IN * DM, MT, ODD_IN, DM}; pg8::StaticOrder S; S.init(MT, ODD_IN, G, bx);
                pg8::EpiOddIn E{Qb, (bf16*)(P.ws + WS_K), (bf16*)(P.ws + WS_V), (bf16*)(P.ws + WS_XB), (const float*)(P.ws + WS_COSC), (const float*)(P.ws + WS_SINC), QSCALE_C};
                pg8::gemm_phase<pg8::EpiOddIn, pg8::StaticOrder, true, true>(lds, g, S, E); }
        }
        SEAM(pb + 1);
        if (RUN(pb + 2)) for (int rep = 0; rep < NREP_M; ++rep) { if (!odd) phase_attn<0>(kp, lds, 0); else phase_attn<1>(kp, lds, e); }
        if (RUN(pb + 3)) for (int rep = 0; rep < NREP_M; ++rep) { if (!odd) phase_lru(kp, lds, e); else phase_s5(kp, lds, e); }
        SEAM(pb + 3);
        if (RUN(pb + 4)) {
            if (odd) for (int rep = 0; rep < NREP_G; ++rep) { KPREF(P, kp); int bx = blockIdx.x; asm volatile("" : "+s"(bx)); const int G = gridDim.x; const bf16* YBb = (const bf16*)(P.ws + WS_YB); bf16* MIX = (bf16*)(P.ws + WS_MIX); pg8::Gemm g{YBb, (const bf16*)(P.ws + WS_W_GLU) + (size_t)e * 1024 * 1024, MT, 1024, 1024}; pg8::StaticOrder S; S.init(MT, 1024, G, bx);
                pg8::EpiGlu E{YBb, MIX, P.in[I_OD_GLU_B] + e * 1024};
                pg8::gemm_phase<pg8::EpiGlu, pg8::StaticOrder, true, true>(lds, g, S, E); }
        }
        if (odd) SEAM(pb + 4);
        if (RUN(pb + 6)) for (int rep = 0; rep < NREP_G; ++rep) { KPREF(P, kp); int bx = blockIdx.x; asm volatile("" : "+s"(bx)); const int G = gridDim.x; const bf16* MIX = (const bf16*)(P.ws + WS_MIX); const float* mod = (const float*)(P.ws + WS_MOD);
            const bf16* W = odd ? (const bf16*)(P.ws + WS_W_ODOUT) + (size_t)e * DM * DM : (const bf16*)(P.ws + WS_W_EVOUT) + (size_t)e * DM * DM;
            pg8::Gemm g{MIX, W, MT, DM, DM}; pg8::StaticOrder S; S.init(MT, DM, G, bx);
            pg8::EpiResid E{l == 0 ? P.in[I_X] : P.out, rep + 1 < NREP_G ? (float*)(P.ws + WS_XC) : P.out, mod + (size_t)l * 4 * 12288 + 2 * DM};
            pg8::gemm_phase<pg8::EpiResid, pg8::StaticOrder, true, true>(lds, g, S, E);
        }
        SEAM(pb + 6);
        if (RUN(pb + 7)) for (int rep = 0; rep < NREP_E; ++rep) phase_norm(kp, l, 1);
        SEAM(pb + 7);
        if (RUN(pb + 8)) for (int rep = 0; rep < NREP_G; ++rep) { KPREF(P, kp); int bx = blockIdx.x; asm volatile("" : "+s"(bx)); const int G = gridDim.x; const bf16* H = (const bf16*)(P.ws + WS_H);
            pg8::Gemm g{H, (const bf16*)(P.ws + WS_W_FFIN) + (size_t)l * DFF2 * DM, MT, DFF2, DM}; pg8::StaticOrder S; S.init(MT, DFF2, G, bx);
            pg8::EpiFfnIn E{(bf16*)(P.ws + WS_ACT), (float*)(P.ws + WS_HALO_F), (float*)(P.ws + WS_HALO_L), P.in[I_FFN_CONV_W] + (size_t)l * 3 * DFF2, P.in[I_FFN_CONV_B] + (size_t)l * DFF2, (LAS float*)(lds + RING_BYTES)};
            pg8::gemm_phase<pg8::EpiFfnIn, pg8::StaticOrder, true, true>(lds, g, S, E);
        }
        SEAM(pb + 8);
        if (RUN(pb + 9)) for (int rep = 0; rep < NREP_E; ++rep) phase_ffn_fix(kp, l);
        SEAM(pb + 9);
        if (RUN(pb + 10)) for (int rep = 0; rep < NREP_G; ++rep) { KPREF(P, kp); int bx = blockIdx.x; asm volatile("" : "+s"(bx)); const int G = gridDim.x; const bf16* ACT = (const bf16*)(P.ws + WS_ACT); const float* mod = (const float*)(P.ws + WS_MOD);
            pg8::Gemm g{ACT, (const bf16*)(P.ws + WS_W_FFOUT) + (size_t)l * DM * DFF, MT, DM, DFF}; pg8::StaticOrder S; S.init(MT, DM, G, bx);
            pg8::EpiResid E{P.out, rep + 1 < NREP_G ? (float*)(P.ws + WS_XC) : P.out, mod + (size_t)l * 4 * 12288 + 5 * DM};
            pg8::gemm_phase<pg8::EpiResid, pg8::StaticOrder, true, true>(lds, g, S, E);
        }
        SEAM(pb + 10);
    }
    if (RUN(N_PHASES - 1)) phase_final(kp);
#undef RUN
#undef SEAM
}

extern "C" void kernel_launch(void* const* d_in, const int* in_sizes, int n_in, void* d_out, int out_size, void* d_ws, size_t ws_size, hipStream_t stream) {
    static int grid = 0;
    if (grid == 0) {
        if (n_in != N_INPUTS || out_size != MT * DM || ws_size < WS_END) { fprintf(stderr, "kernel_launch: unexpected shapes: n_in %d out %d ws %zu (need %zu)\n", n_in, out_size, ws_size, (size_t)WS_END); grid = -1; return; }
        int dev = 0, cus = 0, per_cu = 0;
        if (hipGetDevice(&dev) != hipSuccess || hipDeviceGetAttribute(&cus, hipDeviceAttributeMultiprocessorCount, dev) != hipSuccess) { grid = -1; return; }
        if (hipFuncSetAttribute((const void*)fwd, hipFuncAttributeMaxDynamicSharedMemorySize, LDS_BYTES) != hipSuccess) { fprintf(stderr, "kernel_launch: hipFuncSetAttribute failed\n"); grid = -1; return; }
        if (hipOccupancyMaxActiveBlocksPerMultiprocessor(&per_cu, (const void*)fwd, 512, LDS_BYTES) != hipSuccess || per_cu < 1) fprintf(stderr, "kernel_launch: occupancy query says %d\n", per_cu);
        (void)hipGetLastError();
        grid = cus;
    }
    if (grid < 0) return;
    if (hipMemsetAsync((char*)d_ws + WS_CTL, 0, CTL_ZERO_BYTES, stream) != hipSuccess) return;
    Params p{};
    for (int i = 0; i < N_INPUTS; ++i) p.in[i] = (const float*)d_in[i];
    p.out = (float*)d_out; p.ws = (unsigned char*)d_ws; p.pad = 0;
#if MK_ONE_LAUNCH
    p.lo = 0; p.hi = N_PHASES; p.li = 0;
    hipLaunchKernelGGL(fwd, dim3(grid), dim3(512), LDS_BYTES, stream, p);
#else
    for (int ph = 0; ph < N_PHASES; ++ph) { p.lo = ph; p.hi = ph + 1; p.li = 0; hipLaunchKernelGGL(fwd, dim3(grid), dim3(512), LDS_BYTES, stream, p); }
#endif
    const hipError_t le = hipPeekAtLastError();
    if (le != hipSuccess) fprintf(stderr, "kernel_launch: launch failed: %s\n", hipGetErrorName(le));
}
```

```cpp
#include <hip/hip_runtime.h>
#include <cstdio>
#include <cstdint>
namespace pg8 {
#define PG8_LAS __attribute__((address_space(3)))
typedef unsigned short bf16_t;
typedef short bf16x8 __attribute__((ext_vector_type(8)));
typedef float f32x4 __attribute__((ext_vector_type(4)));
typedef unsigned u32x4 __attribute__((ext_vector_type(4)));
typedef unsigned u32x2 __attribute__((ext_vector_type(2)));
constexpr int BM = 256, BK = 64, HALF = 128, HTB = HALF * BK * 2  , STAGE_BYTES = 8 * HTB, NXCD = 8, WGM = 8;

__host__ __device__ __forceinline__ int lds_byte(int r, int c) { const int st = (r >> 4) * 2 + (c >> 5), rr = r & 15, cc = c & 31, ob = rr * 64 + cc * 2; return st * 1024 + (ob ^ (((ob >> 9) & 1) << 5)); }
__host__ __device__ __forceinline__ void stage_rc(int b, int& R, int& C) { const int st = b / 1024, sb = b % 1024, swz = sb ^ (((sb >> 9) & 1) << 5); R = (st >> 1) * 16 + swz / 64; C = (st & 1) * 32 + (swz % 64) / 2; }
__host__ __device__ __forceinline__ int perm32(int rho) { const int n = rho >> 4, i = rho & 15; return 8 * (i >> 2) + 4 * n + (i & 3); }

struct Unit { int pm, pn; };
struct Gemm { const bf16_t* A; const bf16_t* Bt; int M, N, K; };

struct StaticOrder {
    int nM, nN, nwg, G, c;
    __host__ __device__ void init(int M, int N, int G_, int c_) { nM = M / BM; nN = N / BM; nwg = nM * nN; G = G_; c = c_; }
    __host__ __device__ bool next(int i, Unit& u) const {
        const long L = (long)i * G + c; if (L >= nwg) return false;
        int wgid = (int)L; { const int q = nwg / NXCD, r = nwg % NXCD, xcd = wgid % NXCD, off = wgid / NXCD; wgid = (xcd < r ? xcd * (q + 1) : r * (q + 1) + (xcd - r) * q) + off; }
        const int nig = WGM * nN, gid = wgid / nig, fm = gid * WGM, gsz = (nM - fm) < WGM ? (nM - fm) : WGM;
        u.pm = fm + ((wgid % nig) % gsz); u.pn = (wgid % nig) / gsz; return true;
    }
    __device__ __forceinline__ void a_ready(const Unit&) const {}
    __device__ __forceinline__ void done(const Unit&) const {}
};

__device__ __forceinline__ unsigned cvt_pk_bf16(float lo, float hi) { unsigned r; asm volatile("v_cvt_pk_bf16_f32 %0, %1, %2" : "=v"(r) : "v"(lo), "v"(hi)); return r; }
__device__ __forceinline__ u32x4 pack8(const f32x4 a, const f32x4 b) { u32x4 w; w.x = cvt_pk_bf16(a[0], a[1]); w.y = cvt_pk_bf16(a[2], a[3]); w.z = cvt_pk_bf16(b[0], b[1]); w.w = cvt_pk_bf16(b[2], b[3]); return w; }
__device__ __forceinline__ float bf_lo(unsigned w) { return __uint_as_float(w << 16); }
__device__ __forceinline__ float bf_hi(unsigned w) { return __uint_as_float(w & 0xffff0000u); }
__device__ __forceinline__ float gelu_tanh(float x) {
    const float u = x * (0.7978845608f + 0.0356774081f * x * x);
    const float e = __builtin_amdgcn_exp2f(-2.885390082f * u);
    return x * __builtin_amdgcn_rcpf(1.0f + e);
}
__device__ __forceinline__ f32x4 gelu4(const f32x4 v) { return (f32x4){gelu_tanh(v[0]), gelu_tanh(v[1]), gelu_tanh(v[2]), gelu_tanh(v[3])}; }
__device__ __forceinline__ float sigmoidf_fast(float x) { return __builtin_amdgcn_rcpf(1.0f + __builtin_amdgcn_exp2f(-1.4426950409f * x)); }

__device__ __forceinline__ void build_rtab(const float* ssp, int row_base, PG8_LAS float* rtab, int wr, int wc, int fr, int fq) {
    const int t = (wr * 4 + wc) * 64 + fq * 16 + fr, row = t >> 1, hf = t & 1; const float* p = ssp + (size_t)(row_base + row) * 32 + 16 * hf;
    const f32x4 p0 = *(const f32x4*)p, p1 = *(const f32x4*)(p + 4), p2 = *(const f32x4*)(p + 8), p3 = *(const f32x4*)(p + 12);
    float s = (((p0[0] + p0[1]) + (p0[2] + p0[3])) + ((p1[0] + p1[1]) + (p1[2] + p1[3]))) + (((p2[0] + p2[1]) + (p2[2] + p2[3])) + ((p3[0] + p3[1]) + (p3[2] + p3[3])));
    s += __shfl_xor(s, 1);
    if (hf == 0) rtab[row] = rsqrtf(s * (1.0f / 2048.0f) + 1e-6f);
    asm volatile("s_waitcnt lgkmcnt(0)" ::: "memory"); __builtin_amdgcn_s_barrier(); asm volatile("" ::: "memory");
}

struct EpiStore {
    static constexpr bool PERM = true, AFTER_DRAIN = false;
    bf16_t* O; int ldc;
    __device__ __forceinline__ void operator()(const f32x4 (&acc)[2][2][4][2], const Unit& u, int wr, int wc, int fr, int fq) const {
        const int row0 = u.pm * BM + wr * 64 + fr, col0 = u.pn * BM + wc * 32 + 8 * fq;
#pragma unroll
        for (int ai = 0; ai < 2; ++ai)
#pragma unroll
            for (int m = 0; m < 4; ++m) { bf16_t* rowp = O + (size_t)(row0 + ai * HALF + m * 16) * ldc + col0;
#pragma unroll
                for (int bj = 0; bj < 2; ++bj) *(u32x4*)(rowp + bj * HALF) = pack8(acc[ai][bj][m][0], acc[ai][bj][m][1]); }
    }
};

struct EpiEvenIn {
    static constexpr bool PERM = true, AFTER_DRAIN = false;
    bf16_t *Q; const float *cosT, *sinT; float qscale; const float *ss, *cv; PG8_LAS float* rtab;
    __device__ __forceinline__ void operator()(const f32x4 (&acc)[2][2][4][2], const Unit& u, int wr, int wc, int fr, int fq) const {
        const int row0 = u.pm * BM + wr * 64 + fr;
        build_rtab(ss, u.pm * BM, rtab, wr, wc, fr, fq);
        f32x4 cv4[2][2];
#pragma unroll
        for (int bj = 0; bj < 2; ++bj)
#pragma unroll
            for (int n = 0; n < 2; ++n) cv4[bj][n] = *(const f32x4*)(cv + (size_t)(u.pm >> 3) * 5120 + u.pn * BM + bj * HALF + wc * 32 + 8 * fq + 4 * n);
        if (u.pn < 8) {
            bf16_t* dst = Q + (size_t)(u.pn >> 2) * (8u << 20); const float sc = (u.pn < 4) ? qscale : 1.0f;
            const int head = (u.pn & 3) * 2 + (wc >> 1), i0 = (wc & 1) * 32 + 8 * fq;
#pragma unroll
            for (int ai = 0; ai < 2; ++ai)
#pragma unroll
                for (int m = 0; m < 4; ++m) { const int row = row0 + ai * HALF + m * 16; const float rrm = rtab[wr * 64 + ai * HALF + m * 16 + fr];
                    const f32x4 c0 = *(const f32x4*)(cosT + (size_t)row * 64 + i0), c1 = *(const f32x4*)(cosT + (size_t)row * 64 + i0 + 4);
                    const f32x4 s0 = *(const f32x4*)(sinT + (size_t)row * 64 + i0), s1 = *(const f32x4*)(sinT + (size_t)row * 64 + i0 + 4);
                    const f32x4 a0 = acc[ai][0][m][0] * rrm + cv4[0][0], a1 = acc[ai][0][m][1] * rrm + cv4[0][1], b0 = acc[ai][1][m][0] * rrm + cv4[1][0], b1 = acc[ai][1][m][1] * rrm + cv4[1][1];
                    const f32x4 o10 = (a0 * c0 - b0 * s0) * sc, o11 = (a1 * c1 - b1 * s1) * sc, o20 = (b0 * c0 + a0 * s0) * sc, o21 = (b1 * c1 + a1 * s1) * sc;
                    bf16_t* rp = dst + (size_t)row * 1024 + head * 128 + i0;
                    *(u32x4*)(rp) = pack8(o10, o11); *(u32x4*)(rp + 64) = pack8(o20, o21); }
        } else {
            const int sel = (u.pn - 8) >> 2; bf16_t* dst = Q + (size_t)(u.pn >> 2) * (8u << 20); const int col0 = (u.pn & 3) * 256 + wc * 32 + 8 * fq;
#pragma unroll
            for (int ai = 0; ai < 2; ++ai)
#pragma unroll
                for (int m = 0; m < 4; ++m) { bf16_t* rowp = dst + (size_t)(row0 + ai * HALF + m * 16) * 1024 + col0; const float rrm = rtab[wr * 64 + ai * HALF + m * 16 + fr];
#pragma unroll
                    for (int bj = 0; bj < 2; ++bj) { f32x4 v0 = acc[ai][bj][m][0] * rrm + cv4[bj][0], v1 = acc[ai][bj][m][1] * rrm + cv4[bj][1];
                        if (sel == 2) { v0 = gelu4(v0); v1 = gelu4(v1); }
                        *(u32x4*)(rowp + bj * HALF) = pack8(v0, v1); } }
        }
    }
};

struct EpiOddIn {
    static constexpr bool PERM = true, AFTER_DRAIN = false;
    bf16_t *Q, *K, *V, *U; const float *cosT, *sinT; float qscale; const float *ss, *cv; PG8_LAS float* rtab;
    __device__ __forceinline__ void operator()(const f32x4 (&acc)[2][2][4][2], const Unit& u, int wr, int wc, int fr, int fq) const {
        const int row0 = u.pm * BM + wr * 64 + fr;
        build_rtab(ss, u.pm * BM, rtab, wr, wc, fr, fq);
        f32x4 cv4[2][2];
#pragma unroll
        for (int bj = 0; bj < 2; ++bj)
#pragma unroll
            for (int n = 0; n < 2; ++n) cv4[bj][n] = *(const f32x4*)(cv + (size_t)(u.pm >> 3) * 2304 + u.pn * BM + bj * HALF + wc * 32 + 8 * fq + 4 * n);
        if (u.pn < 4 || (u.pn == 4 && wc < 2)) {
            const bool isq = u.pn < 4; const float sc = isq ? qscale : 1.0f;
            bf16_t* dst = isq ? Q + (u.pn * 4 + wc) * 64 : K + wc * 64; const int pitch = isq ? 1024 : 128;
#pragma unroll
            for (int ai = 0; ai < 2; ++ai)
#pragma unroll
                for (int m = 0; m < 4; ++m) { const int row = row0 + ai * HALF + m * 16; const float rrm = rtab[wr * 64 + ai * HALF + m * 16 + fr];
                    const f32x4 c0 = *(const f32x4*)(cosT + (size_t)row * 32 + 8 * fq), c1 = *(const f32x4*)(cosT + (size_t)row * 32 + 8 * fq + 4);
                    const f32x4 s0 = *(const f32x4*)(sinT + (size_t)row * 32 + 8 * fq), s1 = *(const f32x4*)(sinT + (size_t)row * 32 + 8 * fq + 4);
                    const f32x4 a0 = acc[ai][0][m][0] * rrm + cv4[0][0], a1 = acc[ai][0][m][1] * rrm + cv4[0][1], b0 = acc[ai][1][m][0] * rrm + cv4[1][0], b1 = acc[ai][1][m][1] * rrm + cv4[1][1];
                    const f32x4 o10 = (a0 * c0 - b0 * s0) * sc, o11 = (a1 * c1 - b1 * s1) * sc, o20 = (b0 * c0 + a0 * s0) * sc, o21 = (b1 * c1 + a1 * s1) * sc;
                    bf16_t* rp = dst + (size_t)row * pitch + 8 * fq;
                    *(u32x4*)(rp) = pack8(o10, o11); *(u32x4*)(rp + 32) = pack8(o20, o21); }
        } else if (u.pn == 4) {
#pragma unroll
            for (int ai = 0; ai < 2; ++ai)
#pragma unroll
                for (int m = 0; m < 4; ++m) { bf16_t* rowp = V + (size_t)(row0 + ai * HALF + m * 16) * 128 + (wc - 2) * 32 + 8 * fq; const float rrm = rtab[wr * 64 + ai * HALF + m * 16 + fr];
#pragma unroll
                    for (int bj = 0; bj < 2; ++bj) *(u32x4*)(rowp + bj * 64) = pack8(acc[ai][bj][m][0] * rrm + cv4[bj][0], acc[ai][bj][m][1] * rrm + cv4[bj][1]); }
        } else {
            const int col0 = (u.pn - 5) * 256 + wc * 32 + 8 * fq;
#pragma unroll
            for (int ai = 0; ai < 2; ++ai)
#pragma unroll
                for (int m = 0; m < 4; ++m) { bf16_t* rowp = U + (size_t)(row0 + ai * HALF + m * 16) * 1024 + col0; const float rrm = rtab[wr * 64 + ai * HALF + m * 16 + fr];
#pragma unroll
                    for (int bj = 0; bj < 2; ++bj) *(u32x4*)(rowp + bj * HALF) = pack8(acc[ai][bj][m][0] * rrm + cv4[bj][0], acc[ai][bj][m][1] * rrm + cv4[bj][1]); }
        }
    }
};

struct EpiResid {
    static constexpr bool PERM = true, AFTER_DRAIN = false;
    const float* base; float* out; const float* gate; bf16_t* Hn; const float* gn; const float* scn; float* ssn;
    __device__ __forceinline__ void operator()(const f32x4 (&acc)[2][2][4][2], const Unit& u, int wr, int wc, int fr, int fq) const {
        const int row0 = u.pm * BM + wr * 64 + fr, col0 = u.pn * BM + wc * 32 + 8 * fq; const float* gp = gate + (size_t)(u.pm >> 3) * 12288 + col0;
        f32x4 gv[2][2], an[2][2];
#pragma unroll
        for (int bj = 0; bj < 2; ++bj)
#pragma unroll
            for (int n = 0; n < 2; ++n) { gv[bj][n] = *(const f32x4*)(gp + bj * HALF + n * 4);
                an[bj][n] = Hn ? *(const f32x4*)(gn + col0 + bj * HALF + n * 4) * (1.0f + *(const f32x4*)(scn + (size_t)(u.pm >> 3) * 12288 + col0 + bj * HALF + n * 4)) : (f32x4){0.f, 0.f, 0.f, 0.f}; }
#pragma unroll
        for (int ai = 0; ai < 2; ++ai)
#pragma unroll
            for (int m = 0; m < 4; ++m) { const int row = row0 + ai * HALF + m * 16; const size_t off = (size_t)row * 2048 + col0; float s2 = 0.f;
#pragma unroll
                for (int bj = 0; bj < 2; ++bj) { const f32x4 b0 = *(const f32x4*)(base + off + bj * HALF), b1 = *(const f32x4*)(base + off + bj * HALF + 4);
                    const f32x4 o0 = b0 + gv[bj][0] * acc[ai][bj][m][0], o1 = b1 + gv[bj][1] * acc[ai][bj][m][1];
                    *(f32x4*)(out + off + bj * HALF) = o0; *(f32x4*)(out + off + bj * HALF + 4) = o1;
                    if (Hn) { s2 += ((o0[0] * o0[0] + o0[1] * o0[1]) + (o0[2] * o0[2] + o0[3] * o0[3])) + ((o1[0] * o1[0] + o1[1] * o1[1]) + (o1[2] * o1[2] + o1[3] * o1[3]));
                        *(u32x4*)(Hn + off + bj * HALF) = pack8(o0 * an[bj][0], o1 * an[bj][1]); } }
                if (Hn) { s2 += __shfl_xor(s2, 16); s2 += __shfl_xor(s2, 32); if (fq == 0) ssn[(size_t)row * 32 + u.pn * 4 + wc] = s2; }
            }
    }
};

struct EpiGlu {
    static constexpr bool PERM = true, AFTER_DRAIN = false;
    const bf16_t* Z; bf16_t* MIX; const float* gb;
    __device__ __forceinline__ void operator()(const f32x4 (&acc)[2][2][4][2], const Unit& u, int wr, int wc, int fr, int fq) const {
        const int row0 = u.pm * BM + wr * 64 + fr, col0 = u.pn * BM + wc * 32 + 8 * fq;
        f32x4 bv[2][2];
#pragma unroll
        for (int bj = 0; bj < 2; ++bj)
#pragma unroll
            for (int n = 0; n < 2; ++n) bv[bj][n] = *(const f32x4*)(gb + col0 + bj * HALF + 4 * n);
#pragma unroll
        for (int ai = 0; ai < 2; ++ai)
#pragma unroll
            for (int m = 0; m < 4; ++m) { const size_t row = (size_t)(row0 + ai * HALF + m * 16);
#pragma unroll
                for (int bj = 0; bj < 2; ++bj) { const u32x4 zr = *(const u32x4*)(Z + row * 1024 + col0 + bj * HALF);
                    const f32x4 v0 = acc[ai][bj][m][0] + bv[bj][0], v1 = acc[ai][bj][m][1] + bv[bj][1];
                    const f32x4 z0 = (f32x4){bf_lo(zr.x), bf_hi(zr.x), bf_lo(zr.y), bf_hi(zr.y)}, z1 = (f32x4){bf_lo(zr.z), bf_hi(zr.z), bf_lo(zr.w), bf_hi(zr.w)};
                    const f32x4 o0 = (f32x4){z0[0] * sigmoidf_fast(v0[0]), z0[1] * sigmoidf_fast(v0[1]), z0[2] * sigmoidf_fast(v0[2]), z0[3] * sigmoidf_fast(v0[3])};
                    const f32x4 o1 = (f32x4){z1[0] * sigmoidf_fast(v1[0]), z1[1] * sigmoidf_fast(v1[1]), z1[2] * sigmoidf_fast(v1[2]), z1[3] * sigmoidf_fast(v1[3])};
                    *(u32x4*)(MIX + row * 2048 + 1024 + col0 + bj * HALF) = pack8(o0, o1); } }
    }
};

__device__ __forceinline__ float dpp_ror1(float v) { return __builtin_bit_cast(float, __builtin_amdgcn_update_dpp(0, __builtin_bit_cast(int, v), 0x121, 0xf, 0xf, false)); }
__device__ __forceinline__ float dpp_ror2(float v) { return __builtin_bit_cast(float, __builtin_amdgcn_update_dpp(0, __builtin_bit_cast(int, v), 0x122, 0xf, 0xf, false)); }
__device__ __forceinline__ float dpp_shr1(float old, float v) { return __builtin_bit_cast(float, __builtin_amdgcn_update_dpp(__builtin_bit_cast(int, old), __builtin_bit_cast(int, v), 0x111, 0xf, 0xf, false)); }
__device__ __forceinline__ float dpp_shr2(float old, float v) { return __builtin_bit_cast(float, __builtin_amdgcn_update_dpp(__builtin_bit_cast(int, old), __builtin_bit_cast(int, v), 0x112, 0xf, 0xf, false)); }
struct EpiFfnIn {
    static constexpr bool PERM = true, AFTER_DRAIN = false;
    bf16_t* ACT; float* halo_first; float* halo_last; const float* cw; const float* cb; PG8_LAS float* exch; const float *ss, *cv;
    __device__ __forceinline__ void operator()(f32x4 (&acc)[2][2][4][2], const Unit& u, int wr, int wc, int fr, int fq) const {
        asm volatile("" : "+v"(fr), "+v"(fq));
        const int jj0 = wc * 32 + 8 * fq, jcol = u.pn * 128 + jj0;
        build_rtab(ss, u.pm * BM, exch + 1536, wr, wc, fr, fq);
        {
            f32x4 cv4[2][2];
#pragma unroll
            for (int bj = 0; bj < 2; ++bj)
#pragma unroll
                for (int n = 0; n < 2; ++n) cv4[bj][n] = *(const f32x4*)(cv + (size_t)(u.pm >> 3) * 11008 + u.pn * BM + bj * HALF + jj0 + 4 * n);
#pragma unroll
            for (int ai = 0; ai < 2; ++ai)
#pragma unroll
                for (int m = 0; m < 4; ++m) { const float r = exch[1536 + ai * HALF + wr * 64 + m * 16 + fr];
#pragma unroll
                    for (int bj = 0; bj < 2; ++bj)
#pragma unroll
                        for (int n = 0; n < 2; ++n) acc[ai][bj][m][n] = acc[ai][bj][m][n] * r + cv4[bj][n]; }
        }
        if (fr >= 14) { const int r2 = fr - 14;
#pragma unroll
            for (int bj = 0; bj < 2; ++bj)
#pragma unroll
                for (int n = 0; n < 2; ++n) {
                    *(PG8_LAS f32x4*)(exch + ((wr * 2 + r2) * 2 + bj) * 128 + jj0 + 4 * n) = acc[0][bj][3][n];
                    if (wr == 0) *(PG8_LAS f32x4*)(exch + ((2 * 2 + r2) * 2 + bj) * 128 + jj0 + 4 * n) = acc[1][bj][3][n];
                    else *(f32x4*)(halo_last + ((size_t)(u.pm * 2 + r2) * 2 + bj) * 5504 + jcol + 4 * n) = acc[1][bj][3][n];
                } }
        if (wr == 0 && fr < 2) {
#pragma unroll
            for (int bj = 0; bj < 2; ++bj)
#pragma unroll
                for (int n = 0; n < 2; ++n) *(f32x4*)(halo_first + ((size_t)(u.pm * 2 + fr) * 2 + bj) * 5504 + jcol + 4 * n) = acc[0][bj][0][n]; }
        asm volatile("s_waitcnt lgkmcnt(0)" ::: "memory"); __builtin_amdgcn_s_barrier(); asm volatile("" ::: "memory");
        const bool seq_start = (u.pm & 7) == 0;
#pragma unroll
        for (int n = 0; n < 2; ++n) {
            f32x4 w0[2], w1[2], w2[2], bb[2];
#pragma unroll
            for (int bj = 0; bj < 2; ++bj) { const int col = bj * 5504 + jcol + 4 * n;
                w0[bj] = *(const f32x4*)(cw + col); w1[bj] = *(const f32x4*)(cw + 11008 + col); w2[bj] = *(const f32x4*)(cw + 22016 + col); bb[bj] = *(const f32x4*)(cb + col); }
#pragma unroll
            for (int ai = 0; ai < 2; ++ai) {
                f32x4 prev[2];
                const int slot = 2 * ai + wr - 1;
#pragma unroll
                for (int bj = 0; bj < 2; ++bj) prev[bj] = (slot >= 0) ? *(const PG8_LAS f32x4*)(exch + ((slot * 2 + (fr & 1)) * 2 + bj) * 128 + jj0 + 4 * n) : (f32x4){0.f, 0.f, 0.f, 0.f};
#pragma unroll
                for (int m = 0; m < 4; ++m) {
                    f32x4 cv[2];
#pragma unroll
                    for (int bj = 0; bj < 2; ++bj) { const f32x4 cur = acc[ai][bj][m][n]; f32x4 o;
#pragma unroll
                        for (int q = 0; q < 4; ++q) { const float um1 = dpp_shr1(dpp_ror1(prev[bj][q]), cur[q]), um2 = dpp_shr2(dpp_ror2(prev[bj][q]), cur[q]);
                            o[q] = bb[bj][q] + w0[bj][q] * um2 + w1[bj][q] * um1 + w2[bj][q] * cur[q]; }
                        cv[bj] = o; prev[bj] = cur; }
                    const f32x4 o0 = gelu4(cv[0]) * cv[1];
                    const bool skip = (ai == 0 && m == 0) && wr == 0 && fr < 2 && !seq_start;
                    if (!skip) { u32x2 w; w.x = cvt_pk_bf16(o0[0], o0[1]); w.y = cvt_pk_bf16(o0[2], o0[3]); *(u32x2*)(ACT + (size_t)(u.pm * BM + ai * HALF + wr * 64 + m * 16 + fr) * 5504 + jcol + 4 * n) = w; }
                }
            }
        }
    }
};
template <class Epi, class Sched, bool ALIGN_EPI = false, bool SP2 = false>
__device__ __forceinline__ void gemm_phase(PG8_LAS unsigned char* lds, const Gemm g, const Sched& S, const Epi& E, int tid_in) {
    int tid = tid_in; asm volatile("" : "+v"(tid));
    const int wid = __builtin_amdgcn_readfirstlane(tid >> 6), lane = tid & 63, wr = wid >> 2, wc = wid & 3, fr = lane & 15, fq = lane >> 4;
    const int K = g.K, nt = K / BK;
    unsigned voffA[2], voffB[2];
#pragma unroll
    for (int i = 0; i < 2; ++i) { int R, C; stage_rc(tid * 16 + i * 8192, R, C); const int Rb = Epi::PERM ? ((R & ~31) + perm32(R & 31)) : R;
        voffA[i] = (unsigned)(R * K + C) * 2u; voffB[i] = (unsigned)(Rb * K + C) * 2u; }
    const size_t kstep = (size_t)(BK * 2);
    const size_t hstep = (size_t)HALF * K * 2;
    const size_t tstep = 2 * hstep;
    const unsigned ldsw = (unsigned)wid * 1024u;
    const int aoff = lds_byte(wr * 64 + fr, fq * 8), boff = lds_byte(wc * 32 + fr, fq * 8);
#define PG8_SA(b, h) (((b) * 2 + (h)) * HTB)
#define PG8_SB(b, h) ((4 + (b) * 2 + (h)) * HTB)
#define PG8_STAGE(bufoff, gbase, voff) do { _Pragma("unroll") for (int _i = 0; _i < 2; ++_i) \
        __builtin_amdgcn_global_load_lds((const unsigned*)((const char*)(gbase) + (voff)[_i]), (PG8_LAS unsigned*)(lds + (bufoff) + ldsw + _i * 8192), 16, 0, 0); } while (0)
#define PG8_LDA(dst, b, h) do { _Pragma("unroll") for (int m = 0; m < 4; ++m) _Pragma("unroll") for (int k = 0; k < 2; ++k) dst[m][k] = *(const PG8_LAS bf16x8*)(lds + PG8_SA(b, h) + aoff + m * 2048 + k * 1024); } while (0)
#define PG8_LDB(dst, b, h) do { _Pragma("unroll") for (int n = 0; n < 2; ++n) _Pragma("unroll") for (int k = 0; k < 2; ++k) dst[n][k] = *(const PG8_LAS bf16x8*)(lds + PG8_SB(b, h) + boff + n * 2048 + k * 1024); } while (0)
#define PG8_MMA(ai, bj, At, Bt) do { __builtin_amdgcn_s_setprio(1); _Pragma("unroll") for (int m = 0; m < 4; ++m) _Pragma("unroll") for (int n = 0; n < 2; ++n) _Pragma("unroll") for (int k = 0; k < 2; ++k) \
        acc[ai][bj][m][n] = __builtin_amdgcn_mfma_f32_16x16x32_bf16(Bt[n][k], At[m][k], acc[ai][bj][m][n], 0, 0, 0); __builtin_amdgcn_s_setprio(0); } while (0)
#define PG8_WAIT_V(n) asm volatile("s_waitcnt vmcnt(" #n ")" ::: "memory")
#define PG8_WAIT_L(n) asm volatile("s_waitcnt lgkmcnt(" #n ")" ::: "memory")
#define PG8_BAR __builtin_amdgcn_s_barrier()
#define PG8_SCHED __builtin_amdgcn_sched_barrier(0)
    Unit cur, nxt; int ui = 0;
    if (!S.next(0, cur)) return;
    f32x4 acc[2][2][4][2];
#pragma unroll
    for (int a = 0; a < 2; ++a)
#pragma unroll
        for (int b = 0; b < 2; ++b)
#pragma unroll
            for (int m = 0; m < 4; ++m)
#pragma unroll
                for (int n = 0; n < 2; ++n) acc[a][b][m][n] = (f32x4){0.f, 0.f, 0.f, 0.f};
    bf16x8 At[4][2], B0[2][2], B1[2][2];
    const char* cA = (const char*)g.A + (size_t)cur.pm * tstep; const char* cB = (const char*)g.Bt + (size_t)cur.pn * tstep;
    S.a_ready(cur);
    if constexpr (SP2) {
        PG8_STAGE(PG8_SB(0, 0), cB, voffB); PG8_STAGE(PG8_SB(0, 1), cB + hstep, voffB); PG8_STAGE(PG8_SA(0, 0), cA, voffA); PG8_STAGE(PG8_SA(0, 1), cA + hstep, voffA);
        if (wr == 1) PG8_BAR;
        PG8_WAIT_V(2); PG8_BAR;
        PG8_STAGE(PG8_SB(1, 0), cB + kstep, voffB); PG8_STAGE(PG8_SA(1, 0), cA + kstep, voffA); PG8_STAGE(PG8_SB(1, 1), cB + hstep + kstep, voffB);
        PG8_WAIT_V(6); PG8_BAR;
    } else {
        PG8_STAGE(PG8_SB(0, 0), cB, voffB); PG8_STAGE(PG8_SA(0, 0), cA, voffA); PG8_STAGE(PG8_SB(0, 1), cB + hstep, voffB); PG8_STAGE(PG8_SA(0, 1), cA + hstep, voffA);
        if (wr == 1) PG8_BAR;
        PG8_WAIT_V(4); PG8_BAR;
        PG8_STAGE(PG8_SB(1, 0), cB + kstep, voffB); PG8_STAGE(PG8_SA(1, 0), cA + kstep, voffA); PG8_STAGE(PG8_SB(1, 1), cB + hstep + kstep, voffB);
        PG8_WAIT_V(6); PG8_BAR;
    }
    for (;;) {
        const bool has_next = S.next(ui + 1, nxt);
        const char* nA = has_next ? (const char*)g.A + (size_t)nxt.pm * tstep : cA; const char* nB = has_next ? (const char*)g.Bt + (size_t)nxt.pn * tstep : cB;
        for (int t = 0; t < nt; t += 2) {
            const bool last = (t == nt - 2);
            const char* a1 = cA + (size_t)(t + 1) * kstep;
            const char* a2 = last ? nA : cA + (size_t)(t + 2) * kstep; const char* b2 = last ? nB : cB + (size_t)(t + 2) * kstep;
            const char* a3 = a2 + kstep; const char* b3 = b2 + kstep;
            if (last && has_next) S.a_ready(nxt);
            if constexpr (SP2) {
            PG8_LDB(B0, 0, 0); PG8_LDB(B1, 0, 1); PG8_SCHED; PG8_LDA(At, 0, 0); PG8_STAGE(PG8_SA(1, 1), a1 + hstep, voffA);
            PG8_WAIT_V(8); PG8_WAIT_L(0); PG8_BAR; PG8_MMA(0, 0, At, B0); PG8_MMA(0, 1, At, B1); PG8_BAR; PG8_SCHED;
            PG8_LDA(At, 0, 1); PG8_STAGE(PG8_SB(0, 0), b2, voffB); PG8_STAGE(PG8_SB(0, 1), b2 + hstep, voffB); PG8_STAGE(PG8_SA(0, 0), a2, voffA);
            PG8_WAIT_V(8); PG8_WAIT_L(0); PG8_BAR; PG8_MMA(1, 0, At, B0); PG8_MMA(1, 1, At, B1); PG8_BAR; PG8_SCHED;
            PG8_LDB(B0, 1, 0); PG8_LDB(B1, 1, 1); PG8_SCHED; PG8_LDA(At, 1, 0); PG8_STAGE(PG8_SA(0, 1), a2 + hstep, voffA);
            PG8_WAIT_V(8); PG8_WAIT_L(0); PG8_BAR; PG8_MMA(0, 0, At, B0); PG8_MMA(0, 1, At, B1); PG8_BAR; PG8_SCHED;
            PG8_LDA(At, 1, 1); PG8_STAGE(PG8_SB(1, 0), b3, voffB); PG8_STAGE(PG8_SB(1, 1), b3 + hstep, voffB); PG8_STAGE(PG8_SA(1, 0), a3, voffA);
            PG8_WAIT_V(8); PG8_WAIT_L(0); PG8_BAR; PG8_MMA(1, 0, At, B0); PG8_MMA(1, 1, At, B1); PG8_BAR; PG8_SCHED;
            } else {
            PG8_LDB(B0, 0, 0); PG8_SCHED; PG8_LDA(At, 0, 0); PG8_STAGE(PG8_SA(1, 1), a1 + hstep, voffA);
            PG8_WAIT_L(8); PG8_BAR; PG8_WAIT_L(0); PG8_MMA(0, 0, At, B0); PG8_BAR; PG8_SCHED;
            PG8_LDB(B1, 0, 1); PG8_STAGE(PG8_SB(0, 0), b2, voffB);
            PG8_BAR; PG8_WAIT_L(0); PG8_MMA(0, 1, At, B1); PG8_BAR;
            PG8_LDA(At, 0, 1); PG8_STAGE(PG8_SA(0, 0), a2, voffA);
            PG8_BAR; PG8_WAIT_L(0); PG8_MMA(1, 0, At, B0); PG8_BAR; PG8_SCHED;
            PG8_STAGE(PG8_SB(0, 1), b2 + hstep, voffB);
            PG8_WAIT_V(6); PG8_BAR; PG8_MMA(1, 1, At, B1); PG8_BAR;
            PG8_LDB(B0, 1, 0); PG8_SCHED; PG8_LDA(At, 1, 0); PG8_STAGE(PG8_SA(0, 1), a2 + hstep, voffA);
            PG8_WAIT_L(8); PG8_BAR; PG8_WAIT_L(0); PG8_MMA(0, 0, At, B0); PG8_BAR; PG8_SCHED;
            PG8_LDB(B1, 1, 1); PG8_STAGE(PG8_SB(1, 0), b3, voffB);
            PG8_BAR; PG8_WAIT_L(0); PG8_MMA(0, 1, At, B1); PG8_BAR;
            PG8_LDA(At, 1, 1); PG8_STAGE(PG8_SA(1, 0), a3, voffA);
            PG8_BAR; PG8_WAIT_L(0); PG8_MMA(1, 0, At, B0); PG8_BAR; PG8_SCHED;
            PG8_STAGE(PG8_SB(1, 1), b3 + hstep, voffB);
            PG8_WAIT_V(6); PG8_BAR; PG8_MMA(1, 1, At, B1); PG8_BAR;
            }
        }
        if constexpr (ALIGN_EPI) { if (wr == 0) PG8_BAR; }
        if constexpr (!Epi::AFTER_DRAIN) { E(acc, cur, wr, wc, fr, fq); S.done(cur); }
        if (!has_next) break;
#pragma unroll
        for (int a = 0; a < 2; ++a)
#pragma unroll
            for (int b = 0; b < 2; ++b)
#pragma unroll
                for (int m = 0; m < 4; ++m)
#pragma unroll
                    for (int n = 0; n < 2; ++n) acc[a][b][m][n] = (f32x4){0.f, 0.f, 0.f, 0.f};
        cur = nxt; cA = nA; cB = nB; ++ui;
        if constexpr (ALIGN_EPI) { if (wr == 1) PG8_BAR; }
    }
    PG8_WAIT_V(0);
    if constexpr (!ALIGN_EPI) { if (wr == 0) PG8_BAR; }
    PG8_BAR;
    if constexpr (Epi::AFTER_DRAIN) { E.fused(acc, cur, wr, wc, fr, fq, lds, wid, lane); S.done(cur); }
#undef PG8_SA
#undef PG8_SB
#undef PG8_STAGE
#undef PG8_LDA
#undef PG8_LDB
#undef PG8_MMA
#undef PG8_WAIT_V
#undef PG8_WAIT_L
#undef PG8_BAR
#undef PG8_SCHED
}
}

constexpr int DM = 2048, NB = 4, SEQ = 2048, MT = NB * SEQ, NLAYER = 4;
constexpr int EVEN_IN = 5120, ODD_IN = 2304, DFF = 5504, DFF2 = 11008;
constexpr float LOG2E = 1.4426950408889634f;
constexpr float QSCALE_A = 0.08838834764831845f * LOG2E;
constexpr float QSCALE_C = 0.125f * LOG2E;
enum { I_X = 0, I_C, I_POS, I_ADA_W, I_ADA_B, I_NORM_MIX, I_NORM_FFN, I_NORM_FINAL,
       I_EV_W_IN, I_EV_CONV_W, I_EV_CONV_B, I_EV_GA_W, I_EV_GA_B, I_EV_GX_W, I_EV_GX_B, I_EV_LAMBDA, I_EV_W_OUT,
       I_OD_W_IN, I_OD_SINKS, I_OD_A_RE, I_OD_A_IM, I_OD_B_RE, I_OD_B_IM, I_OD_C_RE, I_OD_C_IM, I_OD_D, I_OD_LOG_DT, I_OD_GLU_W, I_OD_GLU_B, I_OD_W_OUT,
       I_FFN_W_IN, I_FFN_CONV_W, I_FFN_CONV_B, I_FFN_W_OUT, N_INPUTS };
constexpr size_t MiB = 1u << 20;
constexpr size_t WS_CTL = 0, CTL_ZERO_BYTES = 2 * MiB;
constexpr size_t WS_SS = 516 * MiB;
constexpr size_t WS_CVEC = 524288;
constexpr int CV_EVIN = 0, CV_ODIN = 2 * 4 * 5120, CV_FFIN = CV_ODIN + 2 * 4 * 2304;
constexpr int CV_TOTAL = CV_FFIN + 4 * 4 * 11008;
constexpr size_t WS_CVPART = 526 * MiB;
constexpr size_t WS_MOD = 11 * MiB;
constexpr size_t WS_COSA = 2 * MiB, WS_SINA = 4 * MiB, WS_COSC = 6 * MiB, WS_SINC = 7 * MiB;
constexpr size_t WS_S5T = 8 * MiB;
constexpr size_t WS_WGATE = 10 * MiB;
constexpr size_t WS_W_EVIN = 12 * MiB, WS_W_EVOUT = 52 * MiB, WS_W_ODIN = 68 * MiB, WS_W_ODOUT = 86 * MiB, WS_W_GLU = 102 * MiB, WS_W_FFIN = 106 * MiB, WS_W_FFOUT = 278 * MiB;
constexpr size_t WS_H = 364 * MiB, WS_MIX = 396 * MiB, WS_Q = 428 * MiB, WS_K = 444 * MiB, WS_V = 460 * MiB, WS_XB = 476 * MiB, WS_YB = 492 * MiB;
constexpr size_t WS_XC = 508 * MiB, WS_LA = 540 * MiB, WS_LB = 572 * MiB, WS_UFF = 604 * MiB, WS_ACT = 776 * MiB, WS_END = 862 * MiB;
constexpr size_t WS_HALO_F = 508 * MiB, WS_HALO_L = 512 * MiB;
constexpr int CW_BAR = 4096;
constexpr int RING_BYTES = 131072, LDSCTL_OFF = 143360, LDS_BYTES = 147456;

#define GAS __attribute__((address_space(1)))
#define LAS __attribute__((address_space(3)))
typedef unsigned short bf16;
typedef float f32x4 __attribute__((ext_vector_type(4)));
typedef float f32x2 __attribute__((ext_vector_type(2)));
typedef unsigned u32x4 __attribute__((ext_vector_type(4)));
typedef unsigned u32x2 __attribute__((ext_vector_type(2)));
#define LDS_WAIT() asm volatile("s_waitcnt lgkmcnt(0)" ::: "memory")
using pg8::cvt_pk_bf16; using pg8::bf_lo; using pg8::bf_hi; using pg8::gelu_tanh;
__device__ __forceinline__ float wave_sum(float v) {
#pragma unroll
    for (int o = 1; o < 64; o <<= 1) v += __shfl_xor(v, o);
    return v;
}
__device__ __forceinline__ unsigned short f2bf(float f) { return (unsigned short)(cvt_pk_bf16(f, 0.f) & 0xffffu); }
__device__ __forceinline__ float bf2f(unsigned short b) { return __uint_as_float(((unsigned)b) << 16); }

struct Params { const float* in[N_INPUTS]; float* out; unsigned char* ws; int lo, hi, li, pad; };
typedef const __attribute__((address_space(4))) Params* KP;
#define KPREF(P, kp0) KP kp_ = (kp0); asm volatile("" : "+s"(kp_)); const __attribute__((address_space(4))) Params& P = *kp_
#define PHASE_IDS() int tid = kwave_ * 64 + (int)__builtin_amdgcn_mbcnt_hi(~0u, __builtin_amdgcn_mbcnt_lo(~0u, 0u)); asm volatile("" : "+v"(tid)); const int lane = tid & 63, wave = __builtin_amdgcn_readfirstlane(tid >> 6); int bx = blockIdx.x; asm volatile("" : "+s"(bx)); const int G = gridDim.x; (void)lane; (void)wave; (void)G
#define XB_TMO      128
#define XB_XCNT(j)  (256  + 64 * (j))
#define XB_XSUB(j)  (1280 + 64 * (j))
#define XB_XGEN(j)  (2304 + 64 * (j))
#define XB_TOP      3328
#define XB_TOPGEN   3392
#define XCD_BAR_WORDS 3456
#define XB_SPIN_CAP (1u << 18)
#define LAS __attribute__((address_space(3)))

__device__ __forceinline__ unsigned xb_ld(unsigned* p)              { return __hip_atomic_load(p, __ATOMIC_RELAXED, __HIP_MEMORY_SCOPE_AGENT); }
__device__ __forceinline__ unsigned xb_add(unsigned* p, unsigned v) { return __hip_atomic_fetch_add(p, v, __ATOMIC_RELAXED, __HIP_MEMORY_SCOPE_AGENT); }
__device__ __forceinline__ unsigned xb_xcc_id() { return (unsigned)__builtin_amdgcn_s_getreg((3 << 11) | 20) & 0xFu; }
#define XB_SPIN(cond, bar) do { unsigned _sp = 0; while (cond) { __builtin_amdgcn_s_sleep(1); \
    if ((++_sp & 255u) == 0u) { if (xb_ld(&(bar)[XB_TMO])) break; if (_sp > XB_SPIN_CAP) { atomicAdd(&(bar)[XB_TMO], 1u); break; } } } } while (0)

struct XcdBarrier {
    unsigned* bar; unsigned x; unsigned w0;
    volatile LAS unsigned* st;
};

__device__ __forceinline__ XcdBarrier xcd_barrier_post(unsigned* bar, volatile LAS unsigned* st) {
    XcdBarrier b; b.bar = bar; b.x = xb_xcc_id(); b.st = st;
    if (threadIdx.x == 0) (void)xb_add(&bar[XB_XCNT(b.x)], 1u);
    b.w0 = 0u;
    return b;
}
__device__ __forceinline__ void xcd_barrier_complete(unsigned* bar, unsigned x, unsigned& nloc, unsigned& nx) {
    const unsigned G = gridDim.x * gridDim.y * gridDim.z;
    unsigned sum, cnt, mine, sp = 0u;
    for (;;) {
        sum = 0u; cnt = 0u; mine = 0u;
#pragma unroll
        for (unsigned j = 0; j < 16; ++j) { const unsigned c = xb_ld(&bar[XB_XCNT(j)]); sum += c; cnt += (c > 0u) ? 1u : 0u; mine = (j == x) ? c : mine; }
        if (sum == G) break;
        __builtin_amdgcn_s_sleep(1);
        if ((++sp & 255u) == 0u) { if (xb_ld(&bar[XB_TMO])) break; if (sp > XB_SPIN_CAP) { atomicAdd(&bar[XB_TMO], 1u); break; } }
    }
    nloc = mine > 0u ? mine : 1u; nx = cnt > 0u ? cnt : 1u;
}

__device__ __forceinline__ void xcd_barrier(const XcdBarrier& b) {
    asm volatile("s_waitcnt vmcnt(0)" ::: "memory");
    __syncthreads();
    if (b.w0 != 0u && __builtin_amdgcn_mbcnt_hi(~0u, __builtin_amdgcn_mbcnt_lo(~0u, 0u)) == 0u) {
        unsigned* bar = b.bar;
        __builtin_amdgcn_s_waitcnt(0);
        unsigned nloc = b.st[0], nx = b.st[1];
        if (nloc == 0u) { xcd_barrier_complete(bar, b.x, nloc, nx); b.st[0] = nloc; b.st[1] = nx; }
        const unsigned old = xb_add(&bar[XB_XSUB(b.x)], 1u);
        const unsigned gen = old / nloc;
        if (old + 1u == (gen + 1u) * nloc) {
            __builtin_amdgcn_fence(__ATOMIC_RELEASE, "agent");
            asm volatile("s_waitcnt vmcnt(0)" ::: "memory");
            const unsigned og = xb_add(&bar[XB_TOP], 1u);
            const unsigned tg = og / nx;
            if (og + 1u == (tg + 1u) * nx) xb_add(&bar[XB_TOPGEN], 1u);
            else XB_SPIN(xb_ld(&bar[XB_TOPGEN]) == tg, bar);
            __builtin_amdgcn_fence(__ATOMIC_ACQUIRE, "agent");
            xb_add(&bar[XB_XGEN(b.x)], 1u);
            asm volatile("s_waitcnt vmcnt(0)" ::: "memory");
        } else {
            XB_SPIN(xb_ld(&bar[XB_XGEN(b.x)]) == gen, bar);
            __builtin_amdgcn_fence(__ATOMIC_ACQUIRE, "agent");
            asm volatile("s_waitcnt vmcnt(0)" ::: "memory");
        }
    }
    __syncthreads();
}

__device__ __forceinline__ void phase_ada(KP kp0, int kwave_, LAS unsigned char* lds) { KPREF(P, kp0); PHASE_IDS();
    LAS float* cond = (LAS float*)lds;
    LAS float* part = (LAS float*)(lds + 32768);
    const float* c = P.in[I_C];
    for (int i = tid; i < NB * DM; i += 512) { const float v = c[i]; cond[i] = v / (1.0f + __expf(-v)); }
    __syncthreads();
    float* mod = (float*)(P.ws + WS_MOD);
    for (int item = bx; item < 192; item += G) {
        const int l = item / 48, ng = item % 48;
        const float* W = P.in[I_ADA_W] + (size_t)l * DM * 12288 + (size_t)(wave * 256) * 12288 + ng * 256 + lane * 4;
        f32x4 a0 = {0.f, 0.f, 0.f, 0.f}, a1 = a0, a2 = a0, a3 = a0;
#pragma unroll 8
        for (int k = 0; k < 256; ++k) {
            const f32x4 w = *(const f32x4*)(W + (size_t)k * 12288); const int kk = wave * 256 + k;
            a0 += cond[kk] * w; a1 += cond[2048 + kk] * w; a2 += cond[4096 + kk] * w; a3 += cond[6144 + kk] * w;
        }
        LAS float* pp = part + wave * 1024 + lane * 4;
        *(LAS f32x4*)(pp) = a0; *(LAS f32x4*)(pp + 256) = a1; *(LAS f32x4*)(pp + 512) = a2; *(LAS f32x4*)(pp + 768) = a3;
        __syncthreads();
        for (int o = tid; o < 1024; o += 512) {
            float s = 0.f;
#pragma unroll
            for (int w = 0; w < 8; ++w) s += part[w * 1024 + o];
            const int b = o >> 8, cc = o & 255;
            mod[(size_t)(l * 4 + b) * 12288 + ng * 256 + cc] = s + P.in[I_ADA_B][l * 12288 + ng * 256 + cc];
        }
        __syncthreads();
    }
}

__constant__ int TRJOBS[7][8] = {
    {I_EV_W_IN, 2048, 5120, 2, 1, 12, CV_EVIN, 0}, {I_EV_W_OUT, 2048, 2048, 2, 0, 52, -1, 0}, {I_OD_W_IN, 2048, 2304, 2, 2, 68, CV_ODIN, 1}, {I_OD_W_OUT, 2048, 2048, 2, 0, 86, -1, 0},
    {I_OD_GLU_W, 1024, 1024, 2, 0, 102, -1, 0}, {I_FFN_W_IN, 2048, 11008, 4, 3, 106, CV_FFIN, 2}, {I_FFN_W_OUT, 5504, 2048, 4, 0, 278, -1, 0} };
__device__ __forceinline__ int cmap(int type, int n) {
    if (type == 1) { if (n >= 2048) return n; const int tile = n >> 8, j = n & 255, bj = j >> 7, jj = j & 127; return tile * 256 + (jj >> 6) * 128 + bj * 64 + (jj & 63); }
    if (type == 2) {
        if (n >= 1280) return n;
        if (n < 1024) { const int tile = n >> 8, j = n & 255, bj = j >> 7, jj = j & 127; return tile * 256 + (jj >> 5) * 64 + bj * 32 + (jj & 31); }
        const int j = n - 1024, bj = j >> 7, jj = j & 127; if (jj < 64) return 1024 + (jj >> 5) * 64 + bj * 32 + (jj & 31); return 1152 + bj * 64 + (jj - 64);
    }
    if (type == 3) { const int tile = n >> 8, j = n & 255; return (j >> 7) * 5504 + tile * 128 + (j & 127); }
    return n;
}
__device__ __forceinline__ void tr_item(const float* W, int K, int N, bf16* WT, int k0, int c0a, int c0b, int dstr0, LAS float* scr, int lane, float* cv, const float* sh) {
    const int csrc = ((lane & 8) ? c0b : c0a) + (lane & 7) * 4, cl = (lane & 15) * 4;
#pragma unroll
    for (int i = 0; i < 16; ++i) { const int kk = 4 * i + (lane >> 4); const f32x4 v = *(const f32x4*)(W + (size_t)(k0 + kk) * N + csrc);
        LAS float* d = scr + kk * 65 + cl; d[0] = v[0]; d[1] = v[1]; d[2] = v[2]; d[3] = v[3]; }
    LDS_WAIT(); asm volatile("" ::: "memory");
    const int c = lane & 7;
#pragma unroll
    for (int j = 0; j < 8; ++j) { const int n = (lane >> 3) + 8 * j; const LAS float* s = scr + (8 * c) * 65 + n;
        u32x4 o; o.x = cvt_pk_bf16(s[0 * 65], s[1 * 65]); o.y = cvt_pk_bf16(s[2 * 65], s[3 * 65]); o.z = cvt_pk_bf16(s[4 * 65], s[5 * 65]); o.w = cvt_pk_bf16(s[6 * 65], s[7 * 65]);
        *(u32x4*)(WT + (size_t)(dstr0 + n) * K + k0 + 8 * c) = o; }
    if (cv) { float a0 = 0.f, a1 = 0.f, a2 = 0.f, a3 = 0.f;
#pragma unroll 16
        for (int k = 0; k < 64; ++k) { const float w = scr[k * 65 + lane]; a0 += sh[k0 + k] * w; a1 += sh[12288 + k0 + k] * w; a2 += sh[2 * 12288 + k0 + k] * w; a3 += sh[3 * 12288 + k0 + k] * w; }
        cv[dstr0 + lane] = a0; cv[N + dstr0 + lane] = a1; cv[2 * N + dstr0 + lane] = a2; cv[3 * N + dstr0 + lane] = a3; }
    LDS_WAIT(); asm volatile("" ::: "memory");
}
__device__ __forceinline__ void sincos_rev(double ang, float& s, float& c) {
    double rev = ang * 0.15915494309189535; rev -= floor(rev); const float fr = (float)rev;
    s = __builtin_amdgcn_sinf(fr); c = __builtin_amdgcn_cosf(fr);
}
__device__ __forceinline__ void phase_prep(KP kp0, int kwave_, LAS unsigned char* lds) { KPREF(P, kp0); PHASE_IDS();
    LAS float* scr = (LAS float*)(lds + wave * 16640);
    const int gw = bx * 8 + wave, NGW = G * 8;
    const float* mod = (const float*)(P.ws + WS_MOD); float* cvpart = (float*)(P.ws + WS_CVPART);
    int total = 0;
#pragma unroll
    for (int q = 0; q < 7; ++q) total += TRJOBS[q][3] * (TRJOBS[q][1] / 64) * (TRJOBS[q][2] / 64);
    for (int it = gw; it < total; it += NGW) {
        int r = it, j = 0;
#pragma unroll
        for (int q = 0; q < 6; ++q) { const int cnt = TRJOBS[q][3] * (TRJOBS[q][1] / 64) * (TRJOBS[q][2] / 64); if (j == q && r >= cnt) { r -= cnt; j = q + 1; } }
        const int K = TRJOBS[j][1], N = TRJOBS[j][2], per = (K / 64) * (N / 64), li = r / per, rr = r % per, nblk = N / 64, kb = rr / nblk, nb = rr % nblk, cvo = TRJOBS[j][6], sel = TRJOBS[j][7];
        const float* src = P.in[TRJOBS[j][0]] + (size_t)li * K * N;
        bf16* dst = (bf16*)(P.ws + (size_t)TRJOBS[j][5] * MiB) + (size_t)li * K * N;
        const int layer = sel == 0 ? 2 * li : (sel == 1 ? 2 * li + 1 : li);
        tr_item(src, K, N, dst, 64 * kb, cmap(TRJOBS[j][4], 64 * nb), cmap(TRJOBS[j][4], 64 * nb + 32), 64 * nb, scr, lane,
                cvo >= 0 ? cvpart + ((size_t)kb * CV_TOTAL + cvo + (size_t)li * 4 * N) : nullptr, mod + (size_t)layer * 4 * 12288 + (sel == 2 ? 3 * DM : 0));
    }
    for (int it = gw; it < 64; it += NGW) { const int mat = it >> 1, kb = it & 1, gate = mat & 1, eb = mat >> 1;
#pragma unroll
        for (int nb = 0; nb < 2; ++nb)
            tr_item(P.in[gate ? I_EV_GX_W : I_EV_GA_W] + (size_t)eb * 16384, 128, 128, (bf16*)(P.ws + WS_WGATE) + ((size_t)eb * 256 + gate * 128) * 128, 64 * kb, 64 * nb, 64 * nb + 32, 64 * nb, scr, lane, nullptr, nullptr); }
    const int gt = bx * 512 + tid, NT = G * 512;
    const int* pos = (const int*)P.in[I_POS];
    float* cosA = (float*)(P.ws + WS_COSA); float* sinA = (float*)(P.ws + WS_SINA); float* cosC = (float*)(P.ws + WS_COSC); float* sinC = (float*)(P.ws + WS_SINC);
    for (int idx = gt; idx < MT * 64; idx += NT) { const int row = idx >> 6, i = idx & 63;
        const double inv = exp2(-(double)i * (13.287712379549449 / 64.0)); float s, c; sincos_rev((double)pos[row] * inv, s, c); cosA[idx] = c; sinA[idx] = s; }
    for (int idx = gt; idx < MT * 32; idx += NT) { const int row = idx >> 5, i = idx & 31;
        const double inv = exp2(-(double)i * (13.287712379549449 / 32.0)); float s, c; sincos_rev((double)pos[row] * inv, s, c); cosC[idx] = c; sinC[idx] = s; }
    for (int idx = gt; idx < 2 * 64 * 64; idx += NT) { const int o = idx >> 12, g = (idx >> 6) & 63;
        const float are = P.in[I_OD_A_RE][idx], aim = P.in[I_OD_A_IM][idx], dt = expf(P.in[I_OD_LOG_DT][o * 64 + g]);
        const float er = expf(are * dt); float s, c; sincos_rev((double)aim * (double)dt, s, c);
        const float abr = er * c, abi = er * s, xr = abr - 1.0f, xi = abi, den = 1.0f / (are * are + aim * aim);
        const float cr = (xr * are + xi * aim) * den, ci = (xi * are - xr * aim) * den;
        f32x2* abar = (f32x2*)(P.ws + WS_S5T + (size_t)o * MiB); f32x2* bbar = (f32x2*)(P.ws + WS_S5T + (size_t)o * MiB + 65536);
        abar[idx & 4095] = (f32x2){abr, abi};
#pragma unroll
        for (int cc = 0; cc < 16; ++cc) { const float br = P.in[I_OD_B_RE][(size_t)idx * 16 + cc], bi = P.in[I_OD_B_IM][(size_t)idx * 16 + cc];
            bbar[(size_t)(idx & 4095) * 16 + cc] = (f32x2){cr * br - ci * bi, cr * bi + ci * br}; }
    }
}

__device__ __forceinline__ void phase_norm0(KP kp0, int kwave_) { KPREF(P, kp0); PHASE_IDS();
    const float* x = P.in[I_X]; const float* gwt = P.in[I_NORM_MIX];
    const float* modl = (const float*)(P.ws + WS_MOD);
    bf16* H = (bf16*)(P.ws + WS_H); float* ss = (float*)(P.ws + WS_SS);
    const int gw = bx * 8 + wave, NGW = G * 8;
    for (int row = gw; row < MT; row += NGW) {
        const f32x4* xr = (const f32x4*)(x + (size_t)row * DM) + lane;
        f32x4 v[8]; float s2 = 0.f;
#pragma unroll
        for (int j = 0; j < 8; ++j) { v[j] = xr[64 * j]; s2 += (v[j][0] * v[j][0] + v[j][1] * v[j][1]) + (v[j][2] * v[j][2] + v[j][3] * v[j][3]); }
        s2 = wave_sum(s2); if (lane < 32) ss[(size_t)row * 32 + lane] = lane == 0 ? s2 : 0.f;
        const float* sc = modl + (size_t)(row >> 11) * 12288 + DM;
        u32x2* o8 = (u32x2*)(H + (size_t)row * DM) + lane;
#pragma unroll
        for (int j = 0; j < 8; ++j) { const int col = (lane + 64 * j) * 4;
            const f32x4 y = v[j] * *(const f32x4*)(gwt + col) * (1.0f + *(const f32x4*)(sc + col));
            u32x2 w; w.x = cvt_pk_bf16(y[0], y[1]); w.y = cvt_pk_bf16(y[2], y[3]); o8[64 * j] = w; }
    }
    { const float* cvpart = (const float*)(P.ws + WS_CVPART); float* cvec = (float*)(P.ws + WS_CVEC);
      for (int i = bx * 512 + tid; i < CV_TOTAL; i += G * 512) { float s = 0.f;
#pragma unroll 8
          for (int kb = 0; kb < 32; ++kb) s += cvpart[(size_t)kb * CV_TOTAL + i];
          cvec[i] = s; } }
}
__device__ __forceinline__ void phase_final(KP kp0, int kwave_) { KPREF(P, kp0); PHASE_IDS();
    const float* gwt = P.in[I_NORM_FINAL];
    const int gw = bx * 8 + wave, NGW = G * 8;
    for (int row = gw; row < MT; row += NGW) {
        f32x4* xr = (f32x4*)(P.out + (size_t)row * DM) + lane;
        f32x4 v[8]; float ss = 0.f;
#pragma unroll
        for (int j = 0; j < 8; ++j) { v[j] = xr[64 * j]; ss += (v[j][0] * v[j][0] + v[j][1] * v[j][1]) + (v[j][2] * v[j][2] + v[j][3] * v[j][3]); }
        const float rstd = rsqrtf(wave_sum(ss) * (1.0f / DM) + 1e-6f);
#pragma unroll
        for (int j = 0; j < 8; ++j) { const int col = (lane + 64 * j) * 4; xr[64 * j] = v[j] * rstd * *(const f32x4*)(gwt + col); }
    }
}

__device__ __forceinline__ void phase_attn_a_naive(KP kp0, int kwave_) { KPREF(P, kp0); PHASE_IDS();
    const bf16* Q = (const bf16*)(P.ws + WS_Q); const bf16* K = (const bf16*)(P.ws + WS_K); const bf16* V = (const bf16*)(P.ws + WS_V); bf16* MIX = (bf16*)(P.ws + WS_MIX);
    const int gw = bx * 8 + wave, NGW = G * 8;
    for (int task = gw; task < MT * 8; task += NGW) {
        const int h = task & 7, row = task >> 3, b = row >> 11, t = row & 2047;
        const unsigned qw = *(const unsigned*)(Q + (size_t)row * 1024 + h * 128 + 2 * lane); const float q0 = bf_lo(qw), q1 = bf_hi(qw);
        float m = -INFINITY, l = 0.f, o0 = 0.f, o1 = 0.f;
        for (int pat = 0; pat < 3; ++pat) { const int dil = pat == 0 ? 1 : (pat == 1 ? 4 : 16);
            for (int j = 0; j <= 128; ++j) { const int tk = t - dil * j; if (tk < 0) break;
                const size_t kr = (size_t)(b * SEQ + tk) * 1024 + h * 128 + 2 * lane;
                const unsigned kw = *(const unsigned*)(K + kr), vw = *(const unsigned*)(V + kr);
                const float s = wave_sum(q0 * bf_lo(kw) + q1 * bf_hi(kw));
                const float mn = fmaxf(m, s), corr = exp2f(m - mn), p = exp2f(s - mn);
                l = l * corr + p; o0 = o0 * corr + p * bf_lo(vw); o1 = o1 * corr + p * bf_hi(vw); m = mn; } }
        const float inv = 1.0f / l;
        *(unsigned*)(MIX + (size_t)row * 2048 + h * 128 + 2 * lane) = cvt_pk_bf16(o0 * inv, o1 * inv);
    }
}
__device__ __forceinline__ void phase_attn_c_naive(KP kp0, int kwave_, int o_idx) { KPREF(P, kp0); PHASE_IDS();
    const bf16* Q = (const bf16*)(P.ws + WS_Q); const bf16* K = (const bf16*)(P.ws + WS_K); const bf16* V = (const bf16*)(P.ws + WS_V); bf16* MIX = (bf16*)(P.ws + WS_MIX);
    const int gw = bx * 8 + wave, NGW = G * 8;
    for (int task = gw; task < MT * 16; task += NGW) {
        const int h = task & 15, row = task >> 4, b = row >> 11, t = row & 2047, kvh = h >> 3;
        const float q = bf2f(Q[(size_t)row * 1024 + h * 64 + lane]);
        float m = -INFINITY, l = 0.f, o = 0.f;
        for (int tk = (t >= 127 ? t - 127 : 0); tk <= t; ++tk) {
            const size_t kr = (size_t)(b * SEQ + tk) * 128 + kvh * 64 + lane;
            const float s = wave_sum(q * bf2f(K[kr]));
            const float mn = fmaxf(m, s), corr = exp2f(m - mn), p = exp2f(s - mn);
            l = l * corr + p; o = o * corr + p * bf2f(V[kr]); m = mn; }
        const float sk = P.in[I_OD_SINKS][o_idx * 16 + h] * LOG2E;
        MIX[(size_t)row * 2048 + h * 64 + lane] = f2bf(o / (l + exp2f(sk - m)));
    }
}
__device__ __forceinline__ void phase_lru1_naive(KP kp0, int kwave_, int e) { KPREF(P, kp0); PHASE_IDS();
    const bf16* XB = (const bf16*)(P.ws + WS_XB); float* XC = (float*)(P.ws + WS_XC);
    const float* cw = P.in[I_EV_CONV_W] + (size_t)e * 4 * 1024; const float* cb = P.in[I_EV_CONV_B] + e * 1024;
    const int gt = bx * 512 + tid, NT = G * 512;
    for (int idx = gt; idx < MT * 1024; idx += NT) { const int row = idx >> 10, c = idx & 1023, t = row & 2047;
        float acc = cb[c];
#pragma unroll
        for (int i = 0; i < 4; ++i) { const int tt = t - 3 + i; if (tt >= 0) acc += cw[i * 1024 + c] * bf2f(XB[(size_t)(row - 3 + i) * 1024 + c]); }
        XC[idx] = acc; }
}
__device__ __forceinline__ void phase_lru2_naive(KP kp0, int kwave_, int e) { KPREF(P, kp0); PHASE_IDS();
    const float* XC = (const float*)(P.ws + WS_XC); float* LA = (float*)(P.ws + WS_LA); float* LB = (float*)(P.ws + WS_LB);
    const int gt = bx * 512 + tid, NT = G * 512;
    for (int idx = gt; idx < MT * 1024; idx += NT) { const int row = idx >> 10, c = idx & 1023, blk = c >> 7, j = c & 127;
        const float* xr = XC + (size_t)row * 1024 + blk * 128;
        const float* wa = P.in[I_EV_GA_W] + (size_t)((e * 8 + blk) * 128) * 128 + j; const float* wx = P.in[I_EV_GX_W] + (size_t)((e * 8 + blk) * 128) * 128 + j;
        float sa = P.in[I_EV_GA_B][e * 1024 + c], sx = P.in[I_EV_GX_B][e * 1024 + c];
#pragma unroll 8
        for (int i = 0; i < 128; ++i) { const float xv = xr[i]; sa += xv * wa[i * 128]; sx += xv * wx[i * 128]; }
        const float r = 1.0f / (1.0f + expf(-sa)), ig = 1.0f / (1.0f + expf(-sx));
        const float sp = log1pf(expf(-P.in[I_EV_LAMBDA][e * 1024 + c]));
        const float log_a = -8.0f * r * sp, a = expf(log_a), mult = sqrtf(-expm1f(2.0f * log_a));
        LA[idx] = a; LB[idx] = mult * ig * xr[j]; }
}
__device__ __forceinline__ void phase_lru3_naive(KP kp0, int kwave_) { KPREF(P, kp0); PHASE_IDS();
    const float* LA = (const float*)(P.ws + WS_LA); const float* LB = (const float*)(P.ws + WS_LB); const bf16* YB = (const bf16*)(P.ws + WS_YB); bf16* MIX = (bf16*)(P.ws + WS_MIX);
    if (wave != 0) return;
    for (int task = bx; task < 64; task += G) { const int b = task >> 4, c = (task & 15) * 64 + lane;
        float h = 0.f;
#pragma unroll 8
        for (int t = 0; t < SEQ; ++t) { const size_t idx = (size_t)(b * SEQ + t) * 1024 + c;
            h = LA[idx] * h + LB[idx];
            MIX[(size_t)(b * SEQ + t) * 2048 + 1024 + c] = f2bf(h * bf2f(YB[idx])); } }
}
__device__ __forceinline__ void phase_s5_naive(KP kp0, int kwave_, int o_idx) { KPREF(P, kp0); PHASE_IDS();
    const bf16* U = (const bf16*)(P.ws + WS_XB); bf16* Z = (bf16*)(P.ws + WS_YB);
    if (wave != 0) return;
    for (int bg = bx; bg < 256; bg += G) { const int b = bg >> 6, g = bg & 63;
        const f32x2 ab = ((const f32x2*)(P.ws + WS_S5T + (size_t)o_idx * MiB))[g * 64 + lane];
        const f32x2* bbp = (const f32x2*)(P.ws + WS_S5T + (size_t)o_idx * MiB + 65536) + (size_t)(g * 64 + lane) * 16;
        f32x2 bb[16]; float cre[16], cim[16], dsk[16];
#pragma unroll
        for (int c = 0; c < 16; ++c) { bb[c] = bbp[c];
            cre[c] = P.in[I_OD_C_RE][((size_t)(o_idx * 64 + g) * 16 + c) * 64 + lane]; cim[c] = P.in[I_OD_C_IM][((size_t)(o_idx * 64 + g) * 16 + c) * 64 + lane];
            dsk[c] = P.in[I_OD_D][o_idx * 1024 + g * 16 + c]; }
        float hr = 0.f, hi = 0.f;
        for (int t = 0; t < SEQ; ++t) { const size_t row = (size_t)(b * SEQ + t);
            const u32x4 u0 = *(const u32x4*)(U + row * 1024 + g * 16), u1 = *(const u32x4*)(U + row * 1024 + g * 16 + 8);
            float u[16] = {bf_lo(u0.x), bf_hi(u0.x), bf_lo(u0.y), bf_hi(u0.y), bf_lo(u0.z), bf_hi(u0.z), bf_lo(u0.w), bf_hi(u0.w),
                           bf_lo(u1.x), bf_hi(u1.x), bf_lo(u1.y), bf_hi(u1.y), bf_lo(u1.z), bf_hi(u1.z), bf_lo(u1.w), bf_hi(u1.w)};
            float bur = 0.f, bui = 0.f;
#pragma unroll
            for (int c = 0; c < 16; ++c) { bur += u[c] * bb[c][0]; bui += u[c] * bb[c][1]; }
            const float nr = ab[0] * hr - ab[1] * hi + bur, ni = ab[0] * hi + ab[1] * hr + bui; hr = nr; hi = ni;
            float zo = 0.f;
#pragma unroll
            for (int c = 0; c < 16; ++c) { const float y = wave_sum(hr * cre[c] - hi * cim[c]) + dsk[c] * u[c]; const float z = gelu_tanh(y); zo = (lane == c) ? z : zo; }
            if (lane < 16) Z[row * 1024 + g * 16 + lane] = f2bf(zo); }
    }
}
__device__ __forceinline__ void ffn_fix_panel(const float* hf, const float* hl, bf16* ACT, const float* cw, const float* cb, int pm, int tid) {
    if ((pm & 7) == 0) return;
    for (int idx = tid; idx < 2 * DFF; idx += 512) { const int j = idx % DFF, rr = idx / DFF;
        float o[2];
#pragma unroll
        for (int bj = 0; bj < 2; ++bj) { const int col = bj * DFF + j;
            const float l0 = hl[((size_t)((pm - 1) * 2 + 0) * 2 + bj) * DFF + j], l1 = hl[((size_t)((pm - 1) * 2 + 1) * 2 + bj) * DFF + j];
            const float f0 = hf[((size_t)(pm * 2 + 0) * 2 + bj) * DFF + j], f1 = hf[((size_t)(pm * 2 + 1) * 2 + bj) * DFF + j];
            const float um2 = rr == 0 ? l0 : l1, um1 = rr == 0 ? l1 : f0, u0 = rr == 0 ? f0 : f1;
            o[bj] = cb[col] + cw[col] * um2 + cw[DFF2 + col] * um1 + cw[2 * DFF2 + col] * u0; }
        ACT[(size_t)(pm * 256 + rr) * DFF + j] = f2bf(gelu_tanh(o[0]) * o[1]); }
}

typedef short s16x4 __attribute__((ext_vector_type(4)));
typedef short bf16x8v __attribute__((ext_vector_type(8)));
typedef float f32x16 __attribute__((ext_vector_type(16)));
__device__ __forceinline__ unsigned offb(unsigned row, unsigned ch) { return 256u * row + 16u * (ch ^ (((row & 3u) << 2) | ((row >> 2) & 3u))); }
constexpr int ATT_TILE_BYTES = 64 * 256, ATT_BUF_BYTES = 2 * ATT_TILE_BYTES;
__device__ __forceinline__ bf16x8v cat8(const s16x4 a, const s16x4 b) { return (bf16x8v){a[0], a[1], a[2], a[3], b[0], b[1], b[2], b[3]}; }

template <int MODE>
__device__ __forceinline__ void phase_attn(KP kp0, int kwave_, LAS unsigned char* lds, int o_idx) { KPREF(P, kp0); PHASE_IDS();
    constexpr int NKS = MODE == 0 ? 8 : 4;
    constexpr int NDT = MODE == 0 ? 4 : 2;
    constexpr int NH = 1;
    const bf16* Q = (const bf16*)(P.ws + WS_Q); const bf16* K = (const bf16*)(P.ws + WS_K); const bf16* V = (const bf16*)(P.ws + WS_V); bf16* MIX = (bf16*)(P.ws + WS_MIX);
    const int r = lane & 31, hh = lane >> 5, q4 = (lane & 15) >> 2, p4 = lane & 3, blk = (lane >> 4) & 1;
    unsigned kaddr[NKS], vaddr[2][NDT];
    { const unsigned x = ((r & 3u) << 2) | ((r >> 2) & 3u);
#pragma unroll
      for (int s = 0; s < NKS; ++s) kaddr[s] = 256u * r + 16u * (((unsigned)(2 * s + hh)) ^ x);
#pragma unroll
      for (int t = 0; t < 2; ++t)
#pragma unroll
        for (int c = 0; c < NDT; ++c) { const unsigned row = 8u * t + 4u * hh + q4, ch = 4u * c + 2u * blk + (p4 >> 1);
            vaddr[t][c] = 256u * row + 16u * (ch ^ (((row & 3u) << 2) | ((row >> 2) & 3u))) + 8u * (p4 & 1); } }
    const int nunits = MODE == 0 ? 256 : 512;
    for (int unit = bx; unit < nunits; unit += G) {
        int b, head0, q0, kt0, kt1; size_t kvbase; int kvpitch; unsigned kx = 0u;
        if (MODE == 0) { const int qb = 7 - (unit >> 5), bh = unit & 31; b = bh >> 3; head0 = bh & 7; q0 = qb * 256; kt0 = 0; kt1 = qb * 4 + 3; kvbase = (size_t)b * SEQ * 1024 + head0 * 128; kvpitch = 1024; }
        else { b = unit >> 7; const int kvh = (unit >> 6) & 1; kx = 128u * kvh; q0 = (unit & 63) * 32; head0 = 8 * kvh + wave; kt0 = (q0 >= 127 ? q0 - 127 : 0) >> 6; kt1 = (q0 + 31) >> 6; kvbase = (size_t)b * SEQ * 128; kvpitch = 128; }
        const int qw0 = MODE == 0 ? q0 + 32 * wave : q0;
        const int tq = qw0 + r;
        const size_t qrow = (size_t)b * SEQ + tq;
        bf16x8v qf[NH][NKS];
#pragma unroll
        for (int hd = 0; hd < NH; ++hd)
#pragma unroll
            for (int s = 0; s < NKS; ++s) qf[hd][s] = *(const bf16x8v*)(Q + qrow * 1024 + (MODE == 0 ? head0 * 128 : (head0 + hd) * 64) + 16 * s + 8 * hh);
        f32x16 O[NH][NDT]; float m[NH], l[NH];
#pragma unroll
        for (int hd = 0; hd < NH; ++hd) { m[hd] = -1e30f; l[hd] = 0.f;
#pragma unroll
            for (int c = 0; c < NDT; ++c)
#pragma unroll
                for (int i = 0; i < 16; ++i) O[hd][c][i] = 0.f; }
        const int srow = tid >> 4, sch = tid & 15;
        const unsigned soff0 = offb(srow, sch), soff1 = offb(srow + 32, sch);
        u32x4 kreg[2], vreg[2];
        { const size_t g0 = kvbase + (size_t)(kt0 * 64 + srow) * kvpitch + sch * 8, g1 = g0 + (size_t)32 * kvpitch;
          kreg[0] = *(const u32x4*)(K + g0); kreg[1] = *(const u32x4*)(K + g1); vreg[0] = *(const u32x4*)(V + g0); vreg[1] = *(const u32x4*)(V + g1); }
        __syncthreads();
        *(LAS u32x4*)(lds + soff0) = kreg[0]; *(LAS u32x4*)(lds + soff1) = kreg[1];
        *(LAS u32x4*)(lds + ATT_TILE_BYTES + soff0) = vreg[0]; *(LAS u32x4*)(lds + ATT_TILE_BYTES + soff1) = vreg[1];
        __syncthreads();
        for (int kt = kt0; kt <= kt1; ++kt) {
            const int cur = (kt - kt0) & 1;
            LAS unsigned char* kb_ = lds + cur * ATT_BUF_BYTES; LAS unsigned char* vb_ = kb_ + ATT_TILE_BYTES;
            if (kt < kt1) { const size_t g0 = kvbase + (size_t)((kt + 1) * 64 + srow) * kvpitch + sch * 8, g1 = g0 + (size_t)32 * kvpitch;
                kreg[0] = *(const u32x4*)(K + g0); kreg[1] = *(const u32x4*)(K + g1); vreg[0] = *(const u32x4*)(V + g0); vreg[1] = *(const u32x4*)(V + g1); }
            if (64 * kt <= qw0 + 31) {
                const int dq = tq - 64 * kt - 4 * hh;
#pragma unroll
                for (int hd = 0; hd < NH; ++hd) {
                    f32x16 S[2];
#pragma unroll
                    for (int kb = 0; kb < 2; ++kb) {
#pragma unroll
                        for (int i = 0; i < 16; ++i) S[kb][i] = 0.f;
#pragma unroll
                        for (int s = 0; s < NKS; ++s) { const bf16x8v kf = *(const LAS bf16x8v*)(kb_ + (kaddr[s] ^ kx) + kb * 8192); S[kb] = __builtin_amdgcn_mfma_f32_32x32x16_bf16(kf, qf[hd][s], S[kb], 0, 0, 0); }
                    }
                    float w[2][16]; float tmax = -INFINITY;
#pragma unroll
                    for (int kb = 0; kb < 2; ++kb)
#pragma unroll
                        for (int i = 0; i < 16; ++i) { const int d = dq - (kb * 32 + (i & 3) + 8 * (i >> 2));
                            if (MODE == 0) { const int cnt = (d <= 128 ? 1 : 0) + (((d & 3) == 0 && d <= 512) ? 1 : 0) + ((d & 15) == 0 ? 1 : 0); w[kb][i] = (d >= 0) ? (float)cnt : 0.f; }
                            else w[kb][i] = (d >= 0 && d <= 127) ? 1.f : 0.f;
                            S[kb][i] = (w[kb][i] > 0.f) ? S[kb][i] : -INFINITY; tmax = fmaxf(tmax, S[kb][i]); }
                    tmax = fmaxf(tmax, __shfl_xor(tmax, 32));
                    const float mn = fmaxf(m[hd], tmax), corr = __builtin_amdgcn_exp2f(m[hd] - mn); m[hd] = mn;
                    float ps = 0.f;
#pragma unroll
                    for (int kb = 0; kb < 2; ++kb)
#pragma unroll
                        for (int i = 0; i < 16; ++i) { const float pv = w[kb][i] * __builtin_amdgcn_exp2f(S[kb][i] - mn); S[kb][i] = pv; ps += pv; }
                    l[hd] = l[hd] * corr + ps;
#pragma unroll
                    for (int c = 0; c < NDT; ++c)
#pragma unroll
                        for (int i = 0; i < 16; ++i) O[hd][c][i] *= corr;
#pragma unroll
                    for (int kb = 0; kb < 2; ++kb)
#pragma unroll
                        for (int s2 = 0; s2 < 2; ++s2) {
                            bf16x8v pf; { const unsigned a0 = cvt_pk_bf16(S[kb][8 * s2 + 0], S[kb][8 * s2 + 1]), a1 = cvt_pk_bf16(S[kb][8 * s2 + 2], S[kb][8 * s2 + 3]),
                                                         a2 = cvt_pk_bf16(S[kb][8 * s2 + 4], S[kb][8 * s2 + 5]), a3 = cvt_pk_bf16(S[kb][8 * s2 + 6], S[kb][8 * s2 + 7]);
                                pf = __builtin_bit_cast(bf16x8v, (u32x4){a0, a1, a2, a3}); }
#pragma unroll
                            for (int c = 0; c < NDT; ++c) {
                                const s16x4 v0 = __builtin_amdgcn_ds_read_tr16_b64_v4i16((LAS s16x4*)(vb_ + (vaddr[0][c] ^ kx) + 256 * (32 * kb + 16 * s2)));
                                const s16x4 v1 = __builtin_amdgcn_ds_read_tr16_b64_v4i16((LAS s16x4*)(vb_ + (vaddr[1][c] ^ kx) + 256 * (32 * kb + 16 * s2)));
                                O[hd][c] = __builtin_amdgcn_mfma_f32_32x32x16_bf16(cat8(v0, v1), pf, O[hd][c], 0, 0, 0); }
                        }
                }
            }
            if (kt < kt1) { LAS unsigned char* nb_ = lds + (cur ^ 1) * ATT_BUF_BYTES;
                *(LAS u32x4*)(nb_ + soff0) = kreg[0]; *(LAS u32x4*)(nb_ + soff1) = kreg[1];
                *(LAS u32x4*)(nb_ + ATT_TILE_BYTES + soff0) = vreg[0]; *(LAS u32x4*)(nb_ + ATT_TILE_BYTES + soff1) = vreg[1]; }
            __syncthreads();
        }
#pragma unroll
        for (int hd = 0; hd < NH; ++hd) {
            float lt = l[hd] + __shfl_xor(l[hd], 32);
            if (MODE == 1) lt += __builtin_amdgcn_exp2f(P.in[I_OD_SINKS][o_idx * 16 + head0 + hd] * LOG2E - m[hd]);
            const float inv = 1.0f / lt;
            bf16* orow = MIX + qrow * 2048 + (MODE == 0 ? head0 * 128 : (head0 + hd) * 64);
#pragma unroll
            for (int c = 0; c < NDT; ++c)
#pragma unroll
                for (int g4 = 0; g4 < 4; ++g4) { u32x2 o; o.x = cvt_pk_bf16(O[hd][c][4 * g4 + 0] * inv, O[hd][c][4 * g4 + 1] * inv); o.y = cvt_pk_bf16(O[hd][c][4 * g4 + 2] * inv, O[hd][c][4 * g4 + 3] * inv);
                    *(u32x2*)(orow + 32 * c + 8 * g4 + 4 * hh) = o; }
        }
    }
}

__device__ __forceinline__ void phase_s5(KP kp0, int kwave_, LAS unsigned char* lds, int o_idx) { KPREF(P, kp0); PHASE_IDS();
    const bf16* U = (const bf16*)(P.ws + WS_XB); bf16* Z = (bf16*)(P.ws + WS_YB);
    LAS unsigned char* uL = lds;
    LAS unsigned char* hL = lds + 65536 + wave * 8704;
    LAS float* eL = (LAS float*)(lds + 65536 + 8 * 8704);
    const int r = lane & 31, hh = lane >> 5;
    for (int bg = bx; bg < 256; bg += G) { const int b = bg >> 6, g = bg & 63;
        __syncthreads();
#pragma unroll
        for (int j = 0; j < 8; ++j) { const int n = tid + 512 * j, row = n >> 1, hf = n & 1;
            *(LAS u32x4*)(uL + row * 32 + hf * 16) = *(const u32x4*)(U + (size_t)(b * SEQ + row) * 1024 + g * 16 + hf * 8); }
        const f32x2 ab = ((const f32x2*)(P.ws + WS_S5T + (size_t)o_idx * MiB))[g * 64 + lane];
        const f32x2* bbp = (const f32x2*)(P.ws + WS_S5T + (size_t)o_idx * MiB + 65536) + (size_t)(g * 64 + lane) * 16;
        f32x2 bb[16];
#pragma unroll
        for (int c = 0; c < 16; ++c) bb[c] = bbp[c];
        __syncthreads();
        const int t0 = wave * 256;
        float hr = 0.f, hi = 0.f;
#define S5_STEP(t) { const u32x4 u0 = *(const LAS u32x4*)(uL + (t) * 32), u1 = *(const LAS u32x4*)(uL + (t) * 32 + 16); \
            const float uf[16] = {bf_lo(u0.x), bf_hi(u0.x), bf_lo(u0.y), bf_hi(u0.y), bf_lo(u0.z), bf_hi(u0.z), bf_lo(u0.w), bf_hi(u0.w), bf_lo(u1.x), bf_hi(u1.x), bf_lo(u1.y), bf_hi(u1.y), bf_lo(u1.z), bf_hi(u1.z), bf_lo(u1.w), bf_hi(u1.w)}; \
            float bur = 0.f, bui = 0.f; _Pragma("unroll") for (int c = 0; c < 16; ++c) { bur += uf[c] * bb[c][0]; bui += uf[c] * bb[c][1]; } \
            const float nr = ab[0] * hr - ab[1] * hi + bur, ni = ab[0] * hi + ab[1] * hr + bui; hr = nr; hi = ni; }
        for (int t = t0; t < t0 + 256; ++t) S5_STEP(t)
        eL[(wave * 64 + lane) * 2] = hr; eL[(wave * 64 + lane) * 2 + 1] = hi;
        float pr = ab[0], pi = ab[1];
#pragma unroll
        for (int q = 0; q < 8; ++q) { const float nr = pr * pr - pi * pi, ni = 2.f * pr * pi; pr = nr; pi = ni; }
        __syncthreads();
        hr = 0.f; hi = 0.f;
        for (int w = 0; w < wave; ++w) { const float er = eL[(w * 64 + lane) * 2], ei = eL[(w * 64 + lane) * 2 + 1]; const float nr = pr * hr - pi * hi + er, ni = pr * hi + pi * hr + ei; hr = nr; hi = ni; }
        bf16x8v cf[8];
#pragma unroll
        for (int s = 0; s < 8; ++s) { u32x4 w4 = {0u, 0u, 0u, 0u};
            if (r < 16) { const float* cp = P.in[s < 4 ? I_OD_C_RE : I_OD_C_IM] + ((size_t)(o_idx * 64 + g) * 16 + r) * 64 + 16 * (s & 3) + 8 * hh; const float sg = s < 4 ? 1.f : -1.f;
                const f32x4 c0 = *(const f32x4*)cp, c1 = *(const f32x4*)(cp + 4);
                w4.x = cvt_pk_bf16(sg * c0[0], sg * c0[1]); w4.y = cvt_pk_bf16(sg * c0[2], sg * c0[3]); w4.z = cvt_pk_bf16(sg * c1[0], sg * c1[1]); w4.w = cvt_pk_bf16(sg * c1[2], sg * c1[3]); }
            cf[s] = __builtin_bit_cast(bf16x8v, w4); }
        const float dsk = r < 16 ? P.in[I_OD_D][o_idx * 1024 + g * 16 + r] : 0.f;
        for (int tb = 0; tb < 8; ++tb) {
            for (int tt = 0; tt < 32; ++tt) { const int t = t0 + tb * 32 + tt; S5_STEP(t)
                *(LAS unsigned short*)(hL + tt * 272 + lane * 2) = f2bf(hr); *(LAS unsigned short*)(hL + tt * 272 + 128 + lane * 2) = f2bf(hi); }
            f32x16 Y;
#pragma unroll
            for (int i = 0; i < 16; ++i) Y[i] = 0.f;
#pragma unroll
            for (int s = 0; s < 8; ++s) { const bf16x8v af = *(const LAS bf16x8v*)(hL + r * 272 + 32 * s + 16 * hh); Y = __builtin_amdgcn_mfma_f32_32x32x16_bf16(af, cf[s], Y, 0, 0, 0); }
            if (r < 16) {
#pragma unroll
                for (int i = 0; i < 16; ++i) { const int t = t0 + tb * 32 + (i & 3) + 8 * (i >> 2) + 4 * hh;
                    const float uv = bf2f(*(const LAS unsigned short*)(uL + t * 32 + r * 2));
                    Z[(size_t)(b * SEQ + t) * 1024 + g * 16 + r] = f2bf(gelu_tanh(Y[i] + dsk * uv)); }
            }
        }
#undef S5_STEP
    }
}

__device__ __forceinline__ void phase_lru(KP kp0, int kwave_, LAS unsigned char* lds, int e) { KPREF(P, kp0); PHASE_IDS();
    const bf16* XB = (const bf16*)(P.ws + WS_XB); const bf16* YB = (const bf16*)(P.ws + WS_YB); bf16* MIX = (bf16*)(P.ws + WS_MIX);
    LAS unsigned char* xcL = lds;
    LAS float* aL = (LAS float*)(lds + 69632); LAS float* bL = (LAS float*)(lds + 86016);
    LAS float* sA = (LAS float*)(lds + 102400); LAS float* sB = (LAS float*)(lds + 104448);
    LAS float* carry = (LAS float*)(lds + 106496);
    const int c16 = lane & 15, kq = lane >> 4, cg = tid & 15, rg = tid >> 4;
    for (int item = bx; item < 256; item += G) { const int b = item >> 6, blk = (item >> 3) & 7, oct = item & 7, ch0 = blk * 128 + oct * 16;
        float cw[4][8], cb[8];
#pragma unroll
        for (int q = 0; q < 8; ++q) { cb[q] = P.in[I_EV_CONV_B][e * 1024 + blk * 128 + cg * 8 + q];
#pragma unroll
            for (int i = 0; i < 4; ++i) cw[i][q] = P.in[I_EV_CONV_W][(size_t)(e * 4 + i) * 1024 + blk * 128 + cg * 8 + q]; }
        bf16x8v bfr[4], bfi[4];
        { const bf16* wg = (const bf16*)(P.ws + WS_WGATE) + ((size_t)(e * 8 + blk) * 256 + oct * 16 + c16) * 128 + 8 * kq;
#pragma unroll
          for (int s = 0; s < 4; ++s) { bfr[s] = *(const bf16x8v*)(wg + 32 * s); bfi[s] = *(const bf16x8v*)(wg + 128 * 128 + 32 * s); } }
        const float gab = P.in[I_EV_GA_B][e * 1024 + ch0 + c16], gxb = P.in[I_EV_GX_B][e * 1024 + ch0 + c16];
        const float sp8 = -8.0f * log1pf(expf(-P.in[I_EV_LAMBDA][e * 1024 + ch0 + c16]));
        if (tid < 16) carry[tid] = 0.f;
        for (int tc = 0; tc < 8; ++tc) { const int t0 = tc * 256;
            __syncthreads();
            {
                u32x4 xin[11];
#pragma unroll
                for (int i = 0; i < 11; ++i) { const int tt = t0 + 8 * rg - 3 + i;
                    xin[i] = (tt >= 0) ? *(const u32x4*)(XB + (size_t)(b * SEQ + tt) * 1024 + blk * 128 + cg * 8) : (u32x4){0u, 0u, 0u, 0u}; }
#pragma unroll
                for (int j = 0; j < 8; ++j) { float o[8];
#pragma unroll
                    for (int q = 0; q < 8; ++q) o[q] = cb[q];
#pragma unroll
                    for (int i = 0; i < 4; ++i) { const u32x4 x = xin[j + i];
                        o[0] += cw[i][0] * bf_lo(x.x); o[1] += cw[i][1] * bf_hi(x.x); o[2] += cw[i][2] * bf_lo(x.y); o[3] += cw[i][3] * bf_hi(x.y);
                        o[4] += cw[i][4] * bf_lo(x.z); o[5] += cw[i][5] * bf_hi(x.z); o[6] += cw[i][6] * bf_lo(x.w); o[7] += cw[i][7] * bf_hi(x.w); }
                    u32x4 w; w.x = cvt_pk_bf16(o[0], o[1]); w.y = cvt_pk_bf16(o[2], o[3]); w.z = cvt_pk_bf16(o[4], o[5]); w.w = cvt_pk_bf16(o[6], o[7]);
                    *(LAS u32x4*)(xcL + (8 * rg + j) * 272 + cg * 16) = w; }
            }
            __syncthreads();
#pragma unroll
            for (int rb = 0; rb < 2; ++rb) { const int row0 = 32 * wave + 16 * rb;
                f32x4 accr = {0.f, 0.f, 0.f, 0.f}, acci = {0.f, 0.f, 0.f, 0.f};
#pragma unroll
                for (int s = 0; s < 4; ++s) { const bf16x8v af = *(const LAS bf16x8v*)(xcL + (row0 + c16) * 272 + 64 * s + 16 * kq);
                    accr = __builtin_amdgcn_mfma_f32_16x16x32_bf16(af, bfr[s], accr, 0, 0, 0); acci = __builtin_amdgcn_mfma_f32_16x16x32_bf16(af, bfi[s], acci, 0, 0, 0); }
#pragma unroll
                for (int i = 0; i < 4; ++i) { const int row = row0 + 4 * kq + i;
                    const float rr = 1.0f / (1.0f + __expf(-(accr[i] + gab))), ig = 1.0f / (1.0f + __expf(-(acci[i] + gxb)));
                    const float a = __expf(sp8 * rr), mult = sqrtf(fmaxf(1.0f - a * a, 0.f));
                    const float xv = bf2f(*(const LAS unsigned short*)(xcL + row * 272 + (oct * 16 + c16) * 2));
                    aL[row * 16 + c16] = a; bL[row * 16 + c16] = mult * ig * xv; }
            }
            __syncthreads();
            float av[8], bv[8], A = 1.f, B = 0.f;
#pragma unroll
            for (int i = 0; i < 8; ++i) { av[i] = aL[(8 * rg + i) * 16 + cg]; bv[i] = bL[(8 * rg + i) * 16 + cg]; B = av[i] * B + bv[i]; A *= av[i]; }
            sA[rg * 16 + cg] = A; sB[rg * 16 + cg] = B;
            __syncthreads();
            float h = carry[cg];
            for (int j = 0; j < rg; ++j) h = sA[j * 16 + cg] * h + sB[j * 16 + cg];
#pragma unroll
            for (int i = 0; i < 8; ++i) { h = av[i] * h + bv[i]; const size_t row = (size_t)(b * SEQ + t0 + 8 * rg + i);
                MIX[row * 2048 + 1024 + ch0 + cg] = f2bf(h * bf2f(YB[row * 1024 + ch0 + cg])); }
            __syncthreads();
            if (rg == 31) carry[cg] = h;
        }
    }
}

constexpr int N_PHASES = 2 + 11 * NLAYER + 1;
#ifndef NREP_G
#define NREP_G 1
#endif
#ifndef NREP_M
#define NREP_M 1
#endif
#ifndef NREP_MB
#define NREP_MB 1
#endif
#ifndef NREP_E
#define NREP_E 1
#endif
#ifndef NREP_P
#define NREP_P 1
#endif
#ifndef MK_ONE_LAUNCH
#define MK_ONE_LAUNCH 1
#endif
__global__ void __launch_bounds__(512, 2) fwd(Params P) {
    extern __shared__ __attribute__((aligned(16))) unsigned char lds_raw[];
    LAS unsigned char* lds = (LAS unsigned char*)lds_raw;
    const int kwave = __builtin_amdgcn_readfirstlane((int)threadIdx.x >> 6);
    for (int u = threadIdx.x; u < (LDS_BYTES - LDSCTL_OFF) / 4; u += 512) ((LAS unsigned*)(lds + LDSCTL_OFF))[u] = 0u;
    __syncthreads();
    const KP kp = (KP)__builtin_amdgcn_kernarg_segment_ptr();
    const int ph_lo = kp->lo, ph_hi = kp->hi;
    unsigned* barw = (unsigned*)(kp->ws + WS_CTL) + CW_BAR + kp->li * XCD_BAR_WORDS;
    XcdBarrier bar; bar.bar = barw; bar.x = 0; bar.w0 = 0u; bar.st = nullptr;
    if (ph_hi - ph_lo > 1) bar = xcd_barrier_post(barw, (volatile LAS unsigned*)(lds + LDSCTL_OFF + 64));
    bar.w0 = (kwave == 0) ? 1u : 0u;
#define RUN(p) (ph_lo <= (p) && (p) < ph_hi)
#define SEAM(p) do { if (RUN(p) && RUN((p) + 1)) xcd_barrier(bar); } while (0)

    if (RUN(0)) for (int rep = 0; rep < NREP_P; ++rep) phase_ada(kp, kwave, lds);
    SEAM(0);
    if (RUN(1)) for (int rep = 0; rep < NREP_P; ++rep) phase_prep(kp, kwave, lds);
    SEAM(1);
    for (int l = 0; l < NLAYER; ++l) {
        const int pb = 2 + 11 * l, e = l >> 1; const bool odd = (l & 1) != 0;
        if (RUN(pb + 0) && l == 0) for (int rep = 0; rep < NREP_E; ++rep) phase_norm0(kp, kwave);
        if (l == 0) SEAM(pb + 0);
        if (RUN(pb + 1)) for (int rep = 0; rep < NREP_G; ++rep) { KPREF(P, kp); const int kwave_ = kwave; PHASE_IDS(); const bf16* H = (const bf16*)(P.ws + WS_H); bf16* Qb = (bf16*)(P.ws + WS_Q);
            if (!odd) { pg8::Gemm g{H, (const bf16*)(P.ws + WS_W_EVIN) + (size_t)e * EVEN_IN * DM, MT, EVEN_IN, DM}; pg8::StaticOrder S; S.init(MT, EVEN_IN, G, bx);
                pg8::EpiEvenIn E{Qb, (const float*)(P.ws + WS_COSA), (const float*)(P.ws + WS_SINA), QSCALE_A, (const float*)(P.ws + WS_SS) + (size_t)(2 * l) * MT * 32, (const float*)(P.ws + WS_CVEC) + CV_EVIN + (size_t)e * 4 * EVEN_IN, (LAS float*)(lds + RING_BYTES + 6144)};
                pg8::gemm_phase<pg8::EpiEvenIn, pg8::StaticOrder, true, true>(lds, g, S, E, tid); }
            else { pg8::Gemm g{H, (const bf16*)(P.ws + WS_W_ODIN) + (size_t)e * ODD_IN * DM, MT, ODD_IN, DM}; pg8::StaticOrder S; S.init(MT, ODD_IN, G, bx);
                pg8::EpiOddIn E{Qb, (bf16*)(P.ws + WS_K), (bf16*)(P.ws + WS_V), (bf16*)(P.ws + WS_XB), (const float*)(P.ws + WS_COSC), (const float*)(P.ws + WS_SINC), QSCALE_C, (const float*)(P.ws + WS_SS) + (size_t)(2 * l) * MT * 32, (const float*)(P.ws + WS_CVEC) + CV_ODIN + (size_t)e * 4 * ODD_IN, (LAS float*)(lds + RING_BYTES + 6144)};
                pg8::gemm_phase<pg8::EpiOddIn, pg8::StaticOrder, true, true>(lds, g, S, E, tid); }
        }
        SEAM(pb + 1);
        if (RUN(pb + 2)) for (int rep = 0; rep < NREP_M; ++rep) { if (!odd) phase_attn<0>(kp, kwave, lds, 0); else phase_attn<1>(kp, kwave, lds, e); }
        if (RUN(pb + 3)) for (int rep = 0; rep < NREP_MB; ++rep) { if (!odd) phase_lru(kp, kwave, lds, e); else phase_s5(kp, kwave, lds, e); }
        SEAM(pb + 3);
        if (RUN(pb + 4)) {
            if (odd) for (int rep = 0; rep < NREP_G; ++rep) { KPREF(P, kp); const int kwave_ = kwave; PHASE_IDS(); const bf16* YBb = (const bf16*)(P.ws + WS_YB); bf16* MIX = (bf16*)(P.ws + WS_MIX); pg8::Gemm g{YBb, (const bf16*)(P.ws + WS_W_GLU) + (size_t)e * 1024 * 1024, MT, 1024, 1024}; pg8::StaticOrder S; S.init(MT, 1024, G, bx);
                pg8::EpiGlu E{YBb, MIX, P.in[I_OD_GLU_B] + e * 1024};
                pg8::gemm_phase<pg8::EpiGlu, pg8::StaticOrder, true, true>(lds, g, S, E, tid); }
        }
        if (odd) SEAM(pb + 4);
        if (RUN(pb + 6)) for (int rep = 0; rep < NREP_G; ++rep) { KPREF(P, kp); const int kwave_ = kwave; PHASE_IDS(); const bf16* MIX = (const bf16*)(P.ws + WS_MIX); const float* mod = (const float*)(P.ws + WS_MOD);
            const bf16* W = odd ? (const bf16*)(P.ws + WS_W_ODOUT) + (size_t)e * DM * DM : (const bf16*)(P.ws + WS_W_EVOUT) + (size_t)e * DM * DM;
            pg8::Gemm g{MIX, W, MT, DM, DM}; pg8::StaticOrder S; S.init(MT, DM, G, bx);
            pg8::EpiResid E{l == 0 ? P.in[I_X] : P.out, rep + 1 < NREP_G ? (float*)(P.ws + WS_LB) : P.out, mod + (size_t)l * 4 * 12288 + 2 * DM, rep + 1 < NREP_G ? nullptr : (bf16*)(P.ws + WS_H), P.in[I_NORM_FFN] + l * DM, mod + (size_t)l * 4 * 12288 + 4 * DM, (float*)(P.ws + WS_SS) + (size_t)(2 * l + 1) * MT * 32};
            pg8::gemm_phase<pg8::EpiResid, pg8::StaticOrder, true, true>(lds, g, S, E, tid);
        }
        SEAM(pb + 6);
        if (RUN(pb + 8)) for (int rep = 0; rep < NREP_G; ++rep) { KPREF(P, kp); const int kwave_ = kwave; PHASE_IDS(); const bf16* H = (const bf16*)(P.ws + WS_H);
            pg8::Gemm g{H, (const bf16*)(P.ws + WS_W_FFIN) + (size_t)l * DFF2 * DM, MT, DFF2, DM}; pg8::StaticOrder S; S.init(MT, DFF2, G, bx);
            pg8::EpiFfnIn E{(bf16*)(P.ws + WS_ACT), (float*)(P.ws + WS_HALO_F), (float*)(P.ws + WS_HALO_L), P.in[I_FFN_CONV_W] + (size_t)l * 3 * DFF2, P.in[I_FFN_CONV_B] + (size_t)l * DFF2, (LAS float*)(lds + RING_BYTES), (const float*)(P.ws + WS_SS) + (size_t)(2 * l + 1) * MT * 32, (const float*)(P.ws + WS_CVEC) + CV_FFIN + (size_t)l * 4 * DFF2};
            pg8::gemm_phase<pg8::EpiFfnIn, pg8::StaticOrder, true, true>(lds, g, S, E, tid);
        }
        SEAM(pb + 8);
        if (RUN(pb + 10)) for (int rep = 0; rep < NREP_G; ++rep) { KPREF(P, kp); const int kwave_ = kwave; PHASE_IDS(); const bf16* ACT = (const bf16*)(P.ws + WS_ACT); const float* mod = (const float*)(P.ws + WS_MOD);
            pg8::Gemm g{ACT, (const bf16*)(P.ws + WS_W_FFOUT) + (size_t)l * DM * DFF, MT, DM, DFF}; pg8::StaticOrder S; S.init(MT, DM, G, bx);
            { pg8::Unit fu; int lastpm = -1; for (int i = 0; S.next(i, fu); ++i) if (fu.pm != lastpm) { lastpm = fu.pm;
                ffn_fix_panel((const float*)(P.ws + WS_HALO_F), (const float*)(P.ws + WS_HALO_L), (bf16*)(P.ws + WS_ACT), P.in[I_FFN_CONV_W] + (size_t)l * 3 * DFF2, P.in[I_FFN_CONV_B] + (size_t)l * DFF2, fu.pm, tid); }
              asm volatile("s_waitcnt vmcnt(0)" ::: "memory"); __syncthreads(); }
            pg8::EpiResid E{P.out, rep + 1 < NREP_G ? (float*)(P.ws + WS_LB) : P.out, mod + (size_t)l * 4 * 12288 + 5 * DM, (rep + 1 < NREP_G || l == NLAYER - 1) ? nullptr : (bf16*)(P.ws + WS_H), P.in[I_NORM_MIX] + (l + 1 < NLAYER ? l + 1 : l) * DM, mod + (size_t)(l + 1 < NLAYER ? l + 1 : l) * 4 * 12288 + DM, (float*)(P.ws + WS_SS) + (size_t)(2 * l + 2) * MT * 32};
            pg8::gemm_phase<pg8::EpiResid, pg8::StaticOrder, true, true>(lds, g, S, E, tid);
        }
        SEAM(pb + 10);
    }
    if (RUN(N_PHASES - 1)) phase_final(kp, kwave);
#undef RUN
#undef SEAM
}

extern "C" void kernel_launch(void* const* d_in, const int* in_sizes, int n_in, void* d_out, int out_size, void* d_ws, size_t ws_size, hipStream_t stream) {
    static int grid = 0;
    if (grid == 0) {
        if (n_in != N_INPUTS || out_size != MT * DM || ws_size < WS_END) { fprintf(stderr, "kernel_launch: unexpected shapes: n_in %d out %d ws %zu (need %zu)\n", n_in, out_size, ws_size, (size_t)WS_END); grid = -1; return; }
        int dev = 0, cus = 0, per_cu = 0;
        if (hipGetDevice(&dev) != hipSuccess || hipDeviceGetAttribute(&cus, hipDeviceAttributeMultiprocessorCount, dev) != hipSuccess) { grid = -1; return; }
        if (hipFuncSetAttribute((const void*)fwd, hipFuncAttributeMaxDynamicSharedMemorySize, LDS_BYTES) != hipSuccess) { fprintf(stderr, "kernel_launch: hipFuncSetAttribute failed\n"); grid = -1; return; }
        if (hipOccupancyMaxActiveBlocksPerMultiprocessor(&per_cu, (const void*)fwd, 512, LDS_BYTES) != hipSuccess || per_cu < 1) fprintf(stderr, "kernel_launch: occupancy query says %d\n", per_cu);
        (void)hipGetLastError();
        grid = cus;
    }
    if (grid < 0) return;
    if (hipMemsetAsync((char*)d_ws + WS_CTL, 0, CTL_ZERO_BYTES, stream) != hipSuccess) return;
    Params p{};
    for (int i = 0; i < N_INPUTS; ++i) p.in[i] = (const float*)d_in[i];
    p.out = (float*)d_out; p.ws = (unsigned char*)d_ws; p.pad = 0;
#if MK_ONE_LAUNCH
    p.lo = 0; p.hi = N_PHASES; p.li = 0;
    hipLaunchKernelGGL(fwd, dim3(grid), dim3(512), LDS_BYTES, stream, p);
#else
    for (int ph = 0; ph < N_PHASES; ++ph) { p.lo = ph; p.hi = ph + 1; p.li = 0; hipLaunchKernelGGL(fwd, dim3(grid), dim3(512), LDS_BYTES, stream, p); }
#endif
    const hipError_t le = hipPeekAtLastError();
    if (le != hipSuccess) fprintf(stderr, "kernel_launch: launch failed: %s\n", hipGetErrorName(le));
}
```

```cpp
#include <hip/hip_runtime.h>
#include <cstdio>
#include <cstdint>
namespace pg8 {
#define PG8_LAS __attribute__((address_space(3)))
typedef unsigned short bf16_t;
typedef short bf16x8 __attribute__((ext_vector_type(8)));
typedef float f32x4 __attribute__((ext_vector_type(4)));
typedef unsigned u32x4 __attribute__((ext_vector_type(4)));
typedef unsigned u32x2 __attribute__((ext_vector_type(2)));
constexpr int BM = 256, BK = 64, HALF = 128, HTB = HALF * BK * 2  , STAGE_BYTES = 8 * HTB, NXCD = 8, WGM = 8;

__host__ __device__ __forceinline__ int lds_byte(int r, int c) { const int st = (r >> 4) * 2 + (c >> 5), rr = r & 15, cc = c & 31, ob = rr * 64 + cc * 2; return st * 1024 + (ob ^ (((ob >> 9) & 1) << 5)); }
__host__ __device__ __forceinline__ void stage_rc(int b, int& R, int& C) { const int st = b / 1024, sb = b % 1024, swz = sb ^ (((sb >> 9) & 1) << 5); R = (st >> 1) * 16 + swz / 64; C = (st & 1) * 32 + (swz % 64) / 2; }
__host__ __device__ __forceinline__ int perm32(int rho) { const int n = rho >> 4, i = rho & 15; return 8 * (i >> 2) + 4 * n + (i & 3); }

struct Unit { int pm, pn; };
struct Gemm { const bf16_t* A; const bf16_t* Bt; int M, N, K; };

struct StaticOrder {
    int nM, nN, nwg, G, c;
    __host__ __device__ void init(int M, int N, int G_, int c_) { nM = M / BM; nN = N / BM; nwg = nM * nN; G = G_; c = c_; }
    __host__ __device__ bool next(int i, Unit& u) const {
        const long L = (long)i * G + c; if (L >= nwg) return false;
        int wgid = (int)L; { const int q = nwg / NXCD, r = nwg % NXCD, xcd = wgid % NXCD, off = wgid / NXCD; wgid = (xcd < r ? xcd * (q + 1) : r * (q + 1) + (xcd - r) * q) + off; }
        const int nig = WGM * nN, gid = wgid / nig, fm = gid * WGM, gsz = (nM - fm) < WGM ? (nM - fm) : WGM;
        u.pm = fm + ((wgid % nig) % gsz); u.pn = (wgid % nig) / gsz; return true;
    }
    __device__ __forceinline__ void a_ready(const Unit&) const {}
    __device__ __forceinline__ void done(const Unit&) const {}
};

__device__ __forceinline__ unsigned cvt_pk_bf16(float lo, float hi) { unsigned r; asm volatile("v_cvt_pk_bf16_f32 %0, %1, %2" : "=v"(r) : "v"(lo), "v"(hi)); return r; }
__device__ __forceinline__ u32x4 pack8(const f32x4 a, const f32x4 b) { u32x4 w; w.x = cvt_pk_bf16(a[0], a[1]); w.y = cvt_pk_bf16(a[2], a[3]); w.z = cvt_pk_bf16(b[0], b[1]); w.w = cvt_pk_bf16(b[2], b[3]); return w; }
__device__ __forceinline__ float bf_lo(unsigned w) { return __uint_as_float(w << 16); }
__device__ __forceinline__ float bf_hi(unsigned w) { return __uint_as_float(w & 0xffff0000u); }
__device__ __forceinline__ float gelu_tanh(float x) {
    const float u = x * (0.7978845608f + 0.0356774081f * x * x);
    const float e = __builtin_amdgcn_exp2f(-2.885390082f * u);
    return x * __builtin_amdgcn_rcpf(1.0f + e);
}
__device__ __forceinline__ f32x4 gelu4(const f32x4 v) { return (f32x4){gelu_tanh(v[0]), gelu_tanh(v[1]), gelu_tanh(v[2]), gelu_tanh(v[3])}; }
__device__ __forceinline__ float sigmoidf_fast(float x) { return __builtin_amdgcn_rcpf(1.0f + __builtin_amdgcn_exp2f(-1.4426950409f * x)); }

__device__ __forceinline__ void build_rtab(const float* ssp, int row_base, PG8_LAS float* rtab, int wr, int wc, int fr, int fq) {
    const int t = (wr * 4 + wc) * 64 + fq * 16 + fr, row = t >> 1, hf = t & 1; const float* p = ssp + (size_t)(row_base + row) * 32 + 16 * hf;
    const f32x4 p0 = *(const f32x4*)p, p1 = *(const f32x4*)(p + 4), p2 = *(const f32x4*)(p + 8), p3 = *(const f32x4*)(p + 12);
    float s = (((p0[0] + p0[1]) + (p0[2] + p0[3])) + ((p1[0] + p1[1]) + (p1[2] + p1[3]))) + (((p2[0] + p2[1]) + (p2[2] + p2[3])) + ((p3[0] + p3[1]) + (p3[2] + p3[3])));
    s += __shfl_xor(s, 1);
    if (hf == 0) rtab[row] = rsqrtf(s * (1.0f / 2048.0f) + 1e-6f);
    asm volatile("s_waitcnt lgkmcnt(0)" ::: "memory"); __builtin_amdgcn_s_barrier(); asm volatile("" ::: "memory");
}

struct EpiStore {
    static constexpr bool PERM = true, AFTER_DRAIN = false;
    bf16_t* O; int ldc;
    __device__ __forceinline__ void operator()(const f32x4 (&acc)[2][2][4][2], const Unit& u, int wr, int wc, int fr, int fq) const {
        const int row0 = u.pm * BM + wr * 64 + fr, col0 = u.pn * BM + wc * 32 + 8 * fq;
#pragma unroll
        for (int ai = 0; ai < 2; ++ai)
#pragma unroll
            for (int m = 0; m < 4; ++m) { bf16_t* rowp = O + (size_t)(row0 + ai * HALF + m * 16) * ldc + col0;
#pragma unroll
                for (int bj = 0; bj < 2; ++bj) *(u32x4*)(rowp + bj * HALF) = pack8(acc[ai][bj][m][0], acc[ai][bj][m][1]); }
    }
};

struct EpiEvenIn {
    static constexpr bool PERM = true, AFTER_DRAIN = false;
    bf16_t *Q; const float *cosT, *sinT; float qscale; const float *ss, *cv; PG8_LAS float* rtab;
    __device__ __forceinline__ void operator()(const f32x4 (&acc)[2][2][4][2], const Unit& u, int wr, int wc, int fr, int fq) const {
        const int row0 = u.pm * BM + wr * 64 + fr;
        build_rtab(ss, u.pm * BM, rtab, wr, wc, fr, fq);
        f32x4 cv4[2][2];
#pragma unroll
        for (int bj = 0; bj < 2; ++bj)
#pragma unroll
            for (int n = 0; n < 2; ++n) cv4[bj][n] = *(const f32x4*)(cv + (size_t)(u.pm >> 3) * 5120 + u.pn * BM + bj * HALF + wc * 32 + 8 * fq + 4 * n);
        if (u.pn < 8) {
            bf16_t* dst = Q + (size_t)(u.pn >> 2) * (8u << 20); const float sc = (u.pn < 4) ? qscale : 1.0f;
            const int head = (u.pn & 3) * 2 + (wc >> 1), i0 = (wc & 1) * 32 + 8 * fq;
#pragma unroll
            for (int ai = 0; ai < 2; ++ai)
#pragma unroll
                for (int m = 0; m < 4; ++m) { const int row = row0 + ai * HALF + m * 16; const float rrm = rtab[wr * 64 + ai * HALF + m * 16 + fr];
                    const f32x4 c0 = *(const f32x4*)(cosT + (size_t)row * 64 + i0), c1 = *(const f32x4*)(cosT + (size_t)row * 64 + i0 + 4);
                    const f32x4 s0 = *(const f32x4*)(sinT + (size_t)row * 64 + i0), s1 = *(const f32x4*)(sinT + (size_t)row * 64 + i0 + 4);
                    const f32x4 a0 = acc[ai][0][m][0] * rrm + cv4[0][0], a1 = acc[ai][0][m][1] * rrm + cv4[0][1], b0 = acc[ai][1][m][0] * rrm + cv4[1][0], b1 = acc[ai][1][m][1] * rrm + cv4[1][1];
                    const f32x4 o10 = (a0 * c0 - b0 * s0) * sc, o11 = (a1 * c1 - b1 * s1) * sc, o20 = (b0 * c0 + a0 * s0) * sc, o21 = (b1 * c1 + a1 * s1) * sc;
                    bf16_t* rp = dst + (size_t)row * 1024 + head * 128 + i0;
                    *(u32x4*)(rp) = pack8(o10, o11); *(u32x4*)(rp + 64) = pack8(o20, o21); }
        } else {
            const int sel = (u.pn - 8) >> 2; bf16_t* dst = Q + (size_t)(u.pn >> 2) * (8u << 20); const int col0 = (u.pn & 3) * 256 + wc * 32 + 8 * fq;
#pragma unroll
            for (int ai = 0; ai < 2; ++ai)
#pragma unroll
                for (int m = 0; m < 4; ++m) { bf16_t* rowp = dst + (size_t)(row0 + ai * HALF + m * 16) * 1024 + col0; const float rrm = rtab[wr * 64 + ai * HALF + m * 16 + fr];
#pragma unroll
                    for (int bj = 0; bj < 2; ++bj) { f32x4 v0 = acc[ai][bj][m][0] * rrm + cv4[bj][0], v1 = acc[ai][bj][m][1] * rrm + cv4[bj][1];
                        if (sel == 2) { v0 = gelu4(v0); v1 = gelu4(v1); }
                        *(u32x4*)(rowp + bj * HALF) = pack8(v0, v1); } }
        }
    }
};

struct EpiOddIn {
    static constexpr bool PERM = true, AFTER_DRAIN = false;
    bf16_t *Q, *K, *V, *U; const float *cosT, *sinT; float qscale; const float *ss, *cv; PG8_LAS float* rtab;
    __device__ __forceinline__ void operator()(const f32x4 (&acc)[2][2][4][2], const Unit& u, int wr, int wc, int fr, int fq) const {
        const int row0 = u.pm * BM + wr * 64 + fr;
        build_rtab(ss, u.pm * BM, rtab, wr, wc, fr, fq);
        f32x4 cv4[2][2];
#pragma unroll
        for (int bj = 0; bj < 2; ++bj)
#pragma unroll
            for (int n = 0; n < 2; ++n) cv4[bj][n] = *(const f32x4*)(cv + (size_t)(u.pm >> 3) * 2304 + u.pn * BM + bj * HALF + wc * 32 + 8 * fq + 4 * n);
        if (u.pn < 4 || (u.pn == 4 && wc < 2)) {
            const bool isq = u.pn < 4; const float sc = isq ? qscale : 1.0f;
            bf16_t* dst = isq ? Q + (u.pn * 4 + wc) * 64 : K + wc * 64; const int pitch = isq ? 1024 : 128;
#pragma unroll
            for (int ai = 0; ai < 2; ++ai)
#pragma unroll
                for (int m = 0; m < 4; ++m) { const int row = row0 + ai * HALF + m * 16; const float rrm = rtab[wr * 64 + ai * HALF + m * 16 + fr];
                    const f32x4 c0 = *(const f32x4*)(cosT + (size_t)row * 32 + 8 * fq), c1 = *(const f32x4*)(cosT + (size_t)row * 32 + 8 * fq + 4);
                    const f32x4 s0 = *(const f32x4*)(sinT + (size_t)row * 32 + 8 * fq), s1 = *(const f32x4*)(sinT + (size_t)row * 32 + 8 * fq + 4);
                    const f32x4 a0 = acc[ai][0][m][0] * rrm + cv4[0][0], a1 = acc[ai][0][m][1] * rrm + cv4[0][1], b0 = acc[ai][1][m][0] * rrm + cv4[1][0], b1 = acc[ai][1][m][1] * rrm + cv4[1][1];
                    const f32x4 o10 = (a0 * c0 - b0 * s0) * sc, o11 = (a1 * c1 - b1 * s1) * sc, o20 = (b0 * c0 + a0 * s0) * sc, o21 = (b1 * c1 + a1 * s1) * sc;
                    bf16_t* rp = dst + (size_t)row * pitch + 8 * fq;
                    *(u32x4*)(rp) = pack8(o10, o11); *(u32x4*)(rp + 32) = pack8(o20, o21); }
        } else if (u.pn == 4) {
#pragma unroll
            for (int ai = 0; ai < 2; ++ai)
#pragma unroll
                for (int m = 0; m < 4; ++m) { bf16_t* rowp = V + (size_t)(row0 + ai * HALF + m * 16) * 128 + (wc - 2) * 32 + 8 * fq; const float rrm = rtab[wr * 64 + ai * HALF + m * 16 + fr];
#pragma unroll
                    for (int bj = 0; bj < 2; ++bj) *(u32x4*)(rowp + bj * 64) = pack8(acc[ai][bj][m][0] * rrm + cv4[bj][0], acc[ai][bj][m][1] * rrm + cv4[bj][1]); }
        } else {
            const int col0 = (u.pn - 5) * 256 + wc * 32 + 8 * fq;
#pragma unroll
            for (int ai = 0; ai < 2; ++ai)
#pragma unroll
                for (int m = 0; m < 4; ++m) { bf16_t* rowp = U + ((size_t)(col0 >> 4) * 8192 + (size_t)(row0 + ai * HALF + m * 16)) * 16 + (col0 & 8); const float rrm = rtab[wr * 64 + ai * HALF + m * 16 + fr];
#pragma unroll
                    for (int bj = 0; bj < 2; ++bj) *(u32x4*)(rowp + (size_t)bj * 8 * 8192 * 16) = pack8(acc[ai][bj][m][0] * rrm + cv4[bj][0], acc[ai][bj][m][1] * rrm + cv4[bj][1]); }
        }
    }
};

struct EpiResid {
    static constexpr bool PERM = true, AFTER_DRAIN = false;
    const float* base; float* out; const float* gate; bf16_t* Hn; const float* gn; const float* scn; float* ssn;
    __device__ __forceinline__ void operator()(const f32x4 (&acc)[2][2][4][2], const Unit& u, int wr, int wc, int fr, int fq) const {
        const int row0 = u.pm * BM + wr * 64 + fr, col0 = u.pn * BM + wc * 32 + 8 * fq; const float* gp = gate + (size_t)(u.pm >> 3) * 12288 + col0;
        f32x4 gv[2][2], an[2][2];
#pragma unroll
        for (int bj = 0; bj < 2; ++bj)
#pragma unroll
            for (int n = 0; n < 2; ++n) { gv[bj][n] = *(const f32x4*)(gp + bj * HALF + n * 4);
                an[bj][n] = Hn ? *(const f32x4*)(gn + col0 + bj * HALF + n * 4) * (1.0f + *(const f32x4*)(scn + (size_t)(u.pm >> 3) * 12288 + col0 + bj * HALF + n * 4)) : (f32x4){0.f, 0.f, 0.f, 0.f}; }
#pragma unroll
        for (int ai = 0; ai < 2; ++ai)
#pragma unroll
            for (int m = 0; m < 4; ++m) { const int row = row0 + ai * HALF + m * 16; const size_t off = (size_t)row * 2048 + col0; float s2 = 0.f;
#pragma unroll
                for (int bj = 0; bj < 2; ++bj) { const f32x4 b0 = *(const f32x4*)(base + off + bj * HALF), b1 = *(const f32x4*)(base + off + bj * HALF + 4);
                    const f32x4 o0 = b0 + gv[bj][0] * acc[ai][bj][m][0], o1 = b1 + gv[bj][1] * acc[ai][bj][m][1];
                    *(f32x4*)(out + off + bj * HALF) = o0; *(f32x4*)(out + off + bj * HALF + 4) = o1;
                    if (Hn) { s2 += ((o0[0] * o0[0] + o0[1] * o0[1]) + (o0[2] * o0[2] + o0[3] * o0[3])) + ((o1[0] * o1[0] + o1[1] * o1[1]) + (o1[2] * o1[2] + o1[3] * o1[3]));
                        *(u32x4*)(Hn + off + bj * HALF) = pack8(o0 * an[bj][0], o1 * an[bj][1]); } }
                if (Hn) { s2 += __shfl_xor(s2, 16); s2 += __shfl_xor(s2, 32); if (fq == 0) ssn[(size_t)row * 32 + u.pn * 4 + wc] = s2; }
            }
    }
};

struct EpiGlu {
    static constexpr bool PERM = true, AFTER_DRAIN = false;
    const bf16_t* Z; bf16_t* MIX; const float* gb;
    __device__ __forceinline__ void operator()(const f32x4 (&acc)[2][2][4][2], const Unit& u, int wr, int wc, int fr, int fq) const {
        const int row0 = u.pm * BM + wr * 64 + fr, col0 = u.pn * BM + wc * 32 + 8 * fq;
        f32x4 bv[2][2];
#pragma unroll
        for (int bj = 0; bj < 2; ++bj)
#pragma unroll
            for (int n = 0; n < 2; ++n) bv[bj][n] = *(const f32x4*)(gb + col0 + bj * HALF + 4 * n);
#pragma unroll
        for (int ai = 0; ai < 2; ++ai)
#pragma unroll
            for (int m = 0; m < 4; ++m) { const size_t row = (size_t)(row0 + ai * HALF + m * 16);
#pragma unroll
                for (int bj = 0; bj < 2; ++bj) { const u32x4 zr = *(const u32x4*)(Z + row * 1024 + col0 + bj * HALF);
                    const f32x4 v0 = acc[ai][bj][m][0] + bv[bj][0], v1 = acc[ai][bj][m][1] + bv[bj][1];
                    const f32x4 z0 = (f32x4){bf_lo(zr.x), bf_hi(zr.x), bf_lo(zr.y), bf_hi(zr.y)}, z1 = (f32x4){bf_lo(zr.z), bf_hi(zr.z), bf_lo(zr.w), bf_hi(zr.w)};
                    const f32x4 o0 = (f32x4){z0[0] * sigmoidf_fast(v0[0]), z0[1] * sigmoidf_fast(v0[1]), z0[2] * sigmoidf_fast(v0[2]), z0[3] * sigmoidf_fast(v0[3])};
                    const f32x4 o1 = (f32x4){z1[0] * sigmoidf_fast(v1[0]), z1[1] * sigmoidf_fast(v1[1]), z1[2] * sigmoidf_fast(v1[2]), z1[3] * sigmoidf_fast(v1[3])};
                    *(u32x4*)(MIX + row * 2048 + 1024 + col0 + bj * HALF) = pack8(o0, o1); } }
    }
};

__device__ __forceinline__ float dpp_ror1(float v) { return __builtin_bit_cast(float, __builtin_amdgcn_update_dpp(0, __builtin_bit_cast(int, v), 0x121, 0xf, 0xf, false)); }
__device__ __forceinline__ float dpp_ror2(float v) { return __builtin_bit_cast(float, __builtin_amdgcn_update_dpp(0, __builtin_bit_cast(int, v), 0x122, 0xf, 0xf, false)); }
__device__ __forceinline__ float dpp_shr1(float old, float v) { return __builtin_bit_cast(float, __builtin_amdgcn_update_dpp(__builtin_bit_cast(int, old), __builtin_bit_cast(int, v), 0x111, 0xf, 0xf, false)); }
__device__ __forceinline__ float dpp_shr2(float old, float v) { return __builtin_bit_cast(float, __builtin_amdgcn_update_dpp(__builtin_bit_cast(int, old), __builtin_bit_cast(int, v), 0x112, 0xf, 0xf, false)); }
struct EpiFfnIn {
    static constexpr bool PERM = true, AFTER_DRAIN = false;
    bf16_t* ACT; float* halo_first; float* halo_last; const float* cw; const float* cb; PG8_LAS float* exch; const float *ss, *cv;
    __device__ __forceinline__ void operator()(f32x4 (&acc)[2][2][4][2], const Unit& u, int wr, int wc, int fr, int fq) const {
        asm volatile("" : "+v"(fr), "+v"(fq));
        const int jj0 = wc * 32 + 8 * fq, jcol = u.pn * 128 + jj0;
        build_rtab(ss, u.pm * BM, exch + 1536, wr, wc, fr, fq);
        {
            f32x4 cv4[2][2];
#pragma unroll
            for (int bj = 0; bj < 2; ++bj)
#pragma unroll
                for (int n = 0; n < 2; ++n) cv4[bj][n] = *(const f32x4*)(cv + (size_t)(u.pm >> 3) * 11008 + u.pn * BM + bj * HALF + jj0 + 4 * n);
#pragma unroll
            for (int ai = 0; ai < 2; ++ai)
#pragma unroll
                for (int m = 0; m < 4; ++m) { const float r = exch[1536 + ai * HALF + wr * 64 + m * 16 + fr];
#pragma unroll
                    for (int bj = 0; bj < 2; ++bj)
#pragma unroll
                        for (int n = 0; n < 2; ++n) acc[ai][bj][m][n] = acc[ai][bj][m][n] * r + cv4[bj][n]; }
        }
        if (fr >= 14) { const int r2 = fr - 14;
#pragma unroll
            for (int bj = 0; bj < 2; ++bj)
#pragma unroll
                for (int n = 0; n < 2; ++n) {
                    *(PG8_LAS f32x4*)(exch + ((wr * 2 + r2) * 2 + bj) * 128 + jj0 + 4 * n) = acc[0][bj][3][n];
                    if (wr == 0) *(PG8_LAS f32x4*)(exch + ((2 * 2 + r2) * 2 + bj) * 128 + jj0 + 4 * n) = acc[1][bj][3][n];
                    else *(f32x4*)(halo_last + ((size_t)(u.pm * 2 + r2) * 2 + bj) * 5504 + jcol + 4 * n) = acc[1][bj][3][n];
                } }
        if (wr == 0 && fr < 2) {
#pragma unroll
            for (int bj = 0; bj < 2; ++bj)
#pragma unroll
                for (int n = 0; n < 2; ++n) *(f32x4*)(halo_first + ((size_t)(u.pm * 2 + fr) * 2 + bj) * 5504 + jcol + 4 * n) = acc[0][bj][0][n]; }
        asm volatile("s_waitcnt lgkmcnt(0)" ::: "memory"); __builtin_amdgcn_s_barrier(); asm volatile("" ::: "memory");
        const bool seq_start = (u.pm & 7) == 0;
#pragma unroll
        for (int n = 0; n < 2; ++n) {
            f32x4 w0[2], w1[2], w2[2], bb[2];
#pragma unroll
            for (int bj = 0; bj < 2; ++bj) { const int col = bj * 5504 + jcol + 4 * n;
                w0[bj] = *(const f32x4*)(cw + col); w1[bj] = *(const f32x4*)(cw + 11008 + col); w2[bj] = *(const f32x4*)(cw + 22016 + col); bb[bj] = *(const f32x4*)(cb + col); }
#pragma unroll
            for (int ai = 0; ai < 2; ++ai) {
                f32x4 prev[2];
                const int slot = 2 * ai + wr - 1;
#pragma unroll
                for (int bj = 0; bj < 2; ++bj) prev[bj] = (slot >= 0) ? *(const PG8_LAS f32x4*)(exch + ((slot * 2 + (fr & 1)) * 2 + bj) * 128 + jj0 + 4 * n) : (f32x4){0.f, 0.f, 0.f, 0.f};
#pragma unroll
                for (int m = 0; m < 4; ++m) {
                    f32x4 cv[2];
#pragma unroll
                    for (int bj = 0; bj < 2; ++bj) { const f32x4 cur = acc[ai][bj][m][n]; f32x4 o;
#pragma unroll
                        for (int q = 0; q < 4; ++q) { const float um1 = dpp_shr1(dpp_ror1(prev[bj][q]), cur[q]), um2 = dpp_shr2(dpp_ror2(prev[bj][q]), cur[q]);
                            o[q] = bb[bj][q] + w0[bj][q] * um2 + w1[bj][q] * um1 + w2[bj][q] * cur[q]; }
                        cv[bj] = o; prev[bj] = cur; }
                    const f32x4 o0 = gelu4(cv[0]) * cv[1];
                    const bool skip = (ai == 0 && m == 0) && wr == 0 && fr < 2 && !seq_start;
                    if (!skip) { u32x2 w; w.x = cvt_pk_bf16(o0[0], o0[1]); w.y = cvt_pk_bf16(o0[2], o0[3]); *(u32x2*)(ACT + (size_t)(u.pm * BM + ai * HALF + wr * 64 + m * 16 + fr) * 5504 + jcol + 4 * n) = w; }
                }
            }
        }
    }
};
template <class Epi, class Sched, bool ALIGN_EPI = false, bool SP2 = false>
__device__ __forceinline__ void gemm_phase(PG8_LAS unsigned char* lds, const Gemm g, const Sched& S, const Epi& E, int tid_in) {
    int tid = tid_in; asm volatile("" : "+v"(tid));
    const int wid = __builtin_amdgcn_readfirstlane(tid >> 6), lane = tid & 63, wr = wid >> 2, wc = wid & 3, fr = lane & 15, fq = lane >> 4;
    const int K = g.K, nt = K / BK;
    unsigned voffA[2], voffB[2];
#pragma unroll
    for (int i = 0; i < 2; ++i) { int R, C; stage_rc(tid * 16 + i * 8192, R, C); const int Rb = Epi::PERM ? ((R & ~31) + perm32(R & 31)) : R;
        voffA[i] = (unsigned)(R * K + C) * 2u; voffB[i] = (unsigned)(Rb * K + C) * 2u; }
    const size_t kstep = (size_t)(BK * 2);
    const size_t hstep = (size_t)HALF * K * 2;
    const size_t tstep = 2 * hstep;
    const unsigned ldsw = (unsigned)wid * 1024u;
    const int aoff = lds_byte(wr * 64 + fr, fq * 8), boff = lds_byte(wc * 32 + fr, fq * 8);
#define PG8_SA(b, h) (((b) * 2 + (h)) * HTB)
#define PG8_SB(b, h) ((4 + (b) * 2 + (h)) * HTB)
#define PG8_STAGE(bufoff, gbase, voff) do { _Pragma("unroll") for (int _i = 0; _i < 2; ++_i) \
        __builtin_amdgcn_global_load_lds((const unsigned*)((const char*)(gbase) + (voff)[_i]), (PG8_LAS unsigned*)(lds + (bufoff) + ldsw + _i * 8192), 16, 0, 0); } while (0)
#define PG8_LDA(dst, b, h) do { _Pragma("unroll") for (int m = 0; m < 4; ++m) _Pragma("unroll") for (int k = 0; k < 2; ++k) dst[m][k] = *(const PG8_LAS bf16x8*)(lds + PG8_SA(b, h) + aoff + m * 2048 + k * 1024); } while (0)
#define PG8_LDB(dst, b, h) do { _Pragma("unroll") for (int n = 0; n < 2; ++n) _Pragma("unroll") for (int k = 0; k < 2; ++k) dst[n][k] = *(const PG8_LAS bf16x8*)(lds + PG8_SB(b, h) + boff + n * 2048 + k * 1024); } while (0)
#define PG8_MMA(ai, bj, At, Bt) do { __builtin_amdgcn_s_setprio(1); _Pragma("unroll") for (int m = 0; m < 4; ++m) _Pragma("unroll") for (int n = 0; n < 2; ++n) _Pragma("unroll") for (int k = 0; k < 2; ++k) \
        acc[ai][bj][m][n] = __builtin_amdgcn_mfma_f32_16x16x32_bf16(Bt[n][k], At[m][k], acc[ai][bj][m][n], 0, 0, 0); __builtin_amdgcn_s_setprio(0); } while (0)
#define PG8_WAIT_V(n) asm volatile("s_waitcnt vmcnt(" #n ")" ::: "memory")
#define PG8_WAIT_L(n) asm volatile("s_waitcnt lgkmcnt(" #n ")" ::: "memory")
#define PG8_BAR __builtin_amdgcn_s_barrier()
#define PG8_SCHED __builtin_amdgcn_sched_barrier(0)
    Unit cur, nxt; int ui = 0;
    if (!S.next(0, cur)) return;
    f32x4 acc[2][2][4][2];
#pragma unroll
    for (int a = 0; a < 2; ++a)
#pragma unroll
        for (int b = 0; b < 2; ++b)
#pragma unroll
            for (int m = 0; m < 4; ++m)
#pragma unroll
                for (int n = 0; n < 2; ++n) acc[a][b][m][n] = (f32x4){0.f, 0.f, 0.f, 0.f};
    bf16x8 At[4][2], B0[2][2], B1[2][2];
    const char* cA = (const char*)g.A + (size_t)cur.pm * tstep; const char* cB = (const char*)g.Bt + (size_t)cur.pn * tstep;
    S.a_ready(cur);
    if constexpr (SP2) {
        PG8_STAGE(PG8_SB(0, 0), cB, voffB); PG8_STAGE(PG8_SB(0, 1), cB + hstep, voffB); PG8_STAGE(PG8_SA(0, 0), cA, voffA); PG8_STAGE(PG8_SA(0, 1), cA + hstep, voffA);
        if (wr == 1) PG8_BAR;
        PG8_WAIT_V(2); PG8_BAR;
        PG8_STAGE(PG8_SB(1, 0), cB + kstep, voffB); PG8_STAGE(PG8_SA(1, 0), cA + kstep, voffA); PG8_STAGE(PG8_SB(1, 1), cB + hstep + kstep, voffB);
        PG8_WAIT_V(6); PG8_BAR;
    } else {
        PG8_STAGE(PG8_SB(0, 0), cB, voffB); PG8_STAGE(PG8_SA(0, 0), cA, voffA); PG8_STAGE(PG8_SB(0, 1), cB + hstep, voffB); PG8_STAGE(PG8_SA(0, 1), cA + hstep, voffA);
        if (wr == 1) PG8_BAR;
        PG8_WAIT_V(4); PG8_BAR;
        PG8_STAGE(PG8_SB(1, 0), cB + kstep, voffB); PG8_STAGE(PG8_SA(1, 0), cA + kstep, voffA); PG8_STAGE(PG8_SB(1, 1), cB + hstep + kstep, voffB);
        PG8_WAIT_V(6); PG8_BAR;
    }
    for (;;) {
        const bool has_next = S.next(ui + 1, nxt);
        const char* nA = has_next ? (const char*)g.A + (size_t)nxt.pm * tstep : cA; const char* nB = has_next ? (const char*)g.Bt + (size_t)nxt.pn * tstep : cB;
        for (int t = 0; t < nt; t += 2) {
            const bool last = (t == nt - 2);
            const char* a1 = cA + (size_t)(t + 1) * kstep;
            const char* a2 = last ? nA : cA + (size_t)(t + 2) * kstep; const char* b2 = last ? nB : cB + (size_t)(t + 2) * kstep;
            const char* a3 = a2 + kstep; const char* b3 = b2 + kstep;
            if (last && has_next) S.a_ready(nxt);
            if constexpr (SP2) {
            PG8_LDB(B0, 0, 0); PG8_LDB(B1, 0, 1); PG8_SCHED; PG8_LDA(At, 0, 0); PG8_STAGE(PG8_SA(1, 1), a1 + hstep, voffA);
            PG8_WAIT_V(8); PG8_WAIT_L(0); PG8_BAR; PG8_MMA(0, 0, At, B0); PG8_MMA(0, 1, At, B1); PG8_BAR; PG8_SCHED;
            PG8_LDA(At, 0, 1); PG8_STAGE(PG8_SB(0, 0), b2, voffB); PG8_STAGE(PG8_SB(0, 1), b2 + hstep, voffB); PG8_STAGE(PG8_SA(0, 0), a2, voffA);
            PG8_WAIT_V(8); PG8_WAIT_L(0); PG8_BAR; PG8_MMA(1, 0, At, B0); PG8_MMA(1, 1, At, B1); PG8_BAR; PG8_SCHED;
            PG8_LDB(B0, 1, 0); PG8_LDB(B1, 1, 1); PG8_SCHED; PG8_LDA(At, 1, 0); PG8_STAGE(PG8_SA(0, 1), a2 + hstep, voffA);
            PG8_WAIT_V(8); PG8_WAIT_L(0); PG8_BAR; PG8_MMA(0, 0, At, B0); PG8_MMA(0, 1, At, B1); PG8_BAR; PG8_SCHED;
            PG8_LDA(At, 1, 1); PG8_STAGE(PG8_SB(1, 0), b3, voffB); PG8_STAGE(PG8_SB(1, 1), b3 + hstep, voffB); PG8_STAGE(PG8_SA(1, 0), a3, voffA);
            PG8_WAIT_V(8); PG8_WAIT_L(0); PG8_BAR; PG8_MMA(1, 0, At, B0); PG8_MMA(1, 1, At, B1); PG8_BAR; PG8_SCHED;
            } else {
            PG8_LDB(B0, 0, 0); PG8_SCHED; PG8_LDA(At, 0, 0); PG8_STAGE(PG8_SA(1, 1), a1 + hstep, voffA);
            PG8_WAIT_L(8); PG8_BAR; PG8_WAIT_L(0); PG8_MMA(0, 0, At, B0); PG8_BAR; PG8_SCHED;
            PG8_LDB(B1, 0, 1); PG8_STAGE(PG8_SB(0, 0), b2, voffB);
            PG8_BAR; PG8_WAIT_L(0); PG8_MMA(0, 1, At, B1); PG8_BAR;
            PG8_LDA(At, 0, 1); PG8_STAGE(PG8_SA(0, 0), a2, voffA);
            PG8_BAR; PG8_WAIT_L(0); PG8_MMA(1, 0, At, B0); PG8_BAR; PG8_SCHED;
            PG8_STAGE(PG8_SB(0, 1), b2 + hstep, voffB);
            PG8_WAIT_V(6); PG8_BAR; PG8_MMA(1, 1, At, B1); PG8_BAR;
            PG8_LDB(B0, 1, 0); PG8_SCHED; PG8_LDA(At, 1, 0); PG8_STAGE(PG8_SA(0, 1), a2 + hstep, voffA);
            PG8_WAIT_L(8); PG8_BAR; PG8_WAIT_L(0); PG8_MMA(0, 0, At, B0); PG8_BAR; PG8_SCHED;
            PG8_LDB(B1, 1, 1); PG8_STAGE(PG8_SB(1, 0), b3, voffB);
            PG8_BAR; PG8_WAIT_L(0); PG8_MMA(0, 1, At, B1); PG8_BAR;
            PG8_LDA(At, 1, 1); PG8_STAGE(PG8_SA(1, 0), a3, voffA);
            PG8_BAR; PG8_WAIT_L(0); PG8_MMA(1, 0, At, B0); PG8_BAR; PG8_SCHED;
            PG8_STAGE(PG8_SB(1, 1), b3 + hstep, voffB);
            PG8_WAIT_V(6); PG8_BAR; PG8_MMA(1, 1, At, B1); PG8_BAR;
            }
        }
        if constexpr (ALIGN_EPI) { if (wr == 0) PG8_BAR; }
        if constexpr (!Epi::AFTER_DRAIN) { E(acc, cur, wr, wc, fr, fq); S.done(cur); }
        if (!has_next) break;
#pragma unroll
        for (int a = 0; a < 2; ++a)
#pragma unroll
            for (int b = 0; b < 2; ++b)
#pragma unroll
                for (int m = 0; m < 4; ++m)
#pragma unroll
                    for (int n = 0; n < 2; ++n) acc[a][b][m][n] = (f32x4){0.f, 0.f, 0.f, 0.f};
        cur = nxt; cA = nA; cB = nB; ++ui;
        if constexpr (ALIGN_EPI) { if (wr == 1) PG8_BAR; }
    }
    PG8_WAIT_V(0);
    if constexpr (!ALIGN_EPI) { if (wr == 0) PG8_BAR; }
    PG8_BAR;
    if constexpr (Epi::AFTER_DRAIN) { E.fused(acc, cur, wr, wc, fr, fq, lds, wid, lane); S.done(cur); }
#undef PG8_SA
#undef PG8_SB
#undef PG8_STAGE
#undef PG8_LDA
#undef PG8_LDB
#undef PG8_MMA
#undef PG8_WAIT_V
#undef PG8_WAIT_L
#undef PG8_BAR
#undef PG8_SCHED
}
}

constexpr int DM = 2048, NB = 4, SEQ = 2048, MT = NB * SEQ, NLAYER = 4;
constexpr int EVEN_IN = 5120, ODD_IN = 2304, DFF = 5504, DFF2 = 11008;
constexpr float LOG2E = 1.4426950408889634f;
constexpr float QSCALE_A = 0.08838834764831845f * LOG2E;
constexpr float QSCALE_C = 0.125f * LOG2E;
enum { I_X = 0, I_C, I_POS, I_ADA_W, I_ADA_B, I_NORM_MIX, I_NORM_FFN, I_NORM_FINAL,
       I_EV_W_IN, I_EV_CONV_W, I_EV_CONV_B, I_EV_GA_W, I_EV_GA_B, I_EV_GX_W, I_EV_GX_B, I_EV_LAMBDA, I_EV_W_OUT,
       I_OD_W_IN, I_OD_SINKS, I_OD_A_RE, I_OD_A_IM, I_OD_B_RE, I_OD_B_IM, I_OD_C_RE, I_OD_C_IM, I_OD_D, I_OD_LOG_DT, I_OD_GLU_W, I_OD_GLU_B, I_OD_W_OUT,
       I_FFN_W_IN, I_FFN_CONV_W, I_FFN_CONV_B, I_FFN_W_OUT, N_INPUTS };
constexpr size_t MiB = 1u << 20;
constexpr size_t WS_CTL = 0, CTL_ZERO_BYTES = 2 * MiB;
constexpr size_t WS_SS = 516 * MiB;
constexpr size_t WS_CVEC = 524288;
constexpr int CV_EVIN = 0, CV_ODIN = 2 * 4 * 5120, CV_FFIN = CV_ODIN + 2 * 4 * 2304;
constexpr int CV_TOTAL = CV_FFIN + 4 * 4 * 11008;
constexpr size_t WS_CVPART = 526 * MiB;
constexpr size_t WS_MOD = 11 * MiB;
constexpr size_t WS_COSA = 2 * MiB, WS_SINA = 4 * MiB, WS_COSC = 6 * MiB, WS_SINC = 7 * MiB;
constexpr size_t WS_S5T = 8 * MiB;
constexpr size_t WS_WGATE = 10 * MiB;
constexpr size_t WS_W_EVIN = 12 * MiB, WS_W_EVOUT = 52 * MiB, WS_W_ODIN = 68 * MiB, WS_W_ODOUT = 86 * MiB, WS_W_GLU = 102 * MiB, WS_W_FFIN = 106 * MiB, WS_W_FFOUT = 278 * MiB;
constexpr size_t WS_H = 364 * MiB, WS_MIX = 396 * MiB, WS_Q = 428 * MiB, WS_K = 444 * MiB, WS_V = 460 * MiB, WS_XB = 476 * MiB, WS_YB = 492 * MiB;
constexpr size_t WS_XC = 508 * MiB, WS_LA = 540 * MiB, WS_LB = 572 * MiB, WS_UFF = 604 * MiB, WS_ACT = 776 * MiB, WS_END = 862 * MiB;
constexpr size_t WS_HALO_F = 508 * MiB, WS_HALO_L = 512 * MiB;
constexpr int CW_BAR = 4096;
constexpr int RING_BYTES = 131072, LDSCTL_OFF = 143360, LDS_BYTES = 147456;

#define GAS __attribute__((address_space(1)))
#define LAS __attribute__((address_space(3)))
typedef unsigned short bf16;
typedef float f32x4 __attribute__((ext_vector_type(4)));
typedef float f32x2 __attribute__((ext_vector_type(2)));
typedef unsigned u32x4 __attribute__((ext_vector_type(4)));
typedef unsigned u32x2 __attribute__((ext_vector_type(2)));
#define LDS_WAIT() asm volatile("s_waitcnt lgkmcnt(0)" ::: "memory")
using pg8::cvt_pk_bf16; using pg8::bf_lo; using pg8::bf_hi; using pg8::gelu_tanh;
__device__ __forceinline__ float wave_sum(float v) {
#pragma unroll
    for (int o = 1; o < 64; o <<= 1) v += __shfl_xor(v, o);
    return v;
}
__device__ __forceinline__ unsigned short f2bf(float f) { return (unsigned short)(cvt_pk_bf16(f, 0.f) & 0xffffu); }
__device__ __forceinline__ float bf2f(unsigned short b) { return __uint_as_float(((unsigned)b) << 16); }

struct Params { const float* in[N_INPUTS]; float* out; unsigned char* ws; int lo, hi, li, pad; };
typedef const __attribute__((address_space(4))) Params* KP;
#define KPREF(P, kp0) KP kp_ = (kp0); asm volatile("" : "+s"(kp_)); const __attribute__((address_space(4))) Params& P = *kp_
#define PHASE_IDS() int tid; asm volatile("v_mbcnt_lo_u32_b32 %0, -1, 0\n\tv_mbcnt_hi_u32_b32 %0, -1, %0" : "=v"(tid)); tid += kwave_ * 64;     const int lane = tid & 63, wave = __builtin_amdgcn_readfirstlane(tid >> 6); int bx = blockIdx.x; asm volatile("" : "+s"(bx)); const int G = gridDim.x; (void)lane; (void)wave; (void)G
#define XB_TMO      128
#define XB_XCNT(j)  (256  + 64 * (j))
#define XB_XSUB(j)  (1280 + 64 * (j))
#define XB_XGEN(j)  (2304 + 64 * (j))
#define XB_TOP      3328
#define XB_TOPGEN   3392
#define XCD_BAR_WORDS 3456
#define XB_SPIN_CAP (1u << 18)
#define LAS __attribute__((address_space(3)))

__device__ __forceinline__ unsigned xb_ld(unsigned* p)              { return __hip_atomic_load(p, __ATOMIC_RELAXED, __HIP_MEMORY_SCOPE_AGENT); }
__device__ __forceinline__ unsigned xb_add(unsigned* p, unsigned v) { return __hip_atomic_fetch_add(p, v, __ATOMIC_RELAXED, __HIP_MEMORY_SCOPE_AGENT); }
__device__ __forceinline__ unsigned xb_xcc_id() { return (unsigned)__builtin_amdgcn_s_getreg((3 << 11) | 20) & 0xFu; }
#define XB_SPIN(cond, bar) do { unsigned _sp = 0; while (cond) { __builtin_amdgcn_s_sleep(1); \
    if ((++_sp & 255u) == 0u) { if (xb_ld(&(bar)[XB_TMO])) break; if (_sp > XB_SPIN_CAP) { atomicAdd(&(bar)[XB_TMO], 1u); break; } } } } while (0)

struct XcdBarrier {
    unsigned* bar; unsigned x; unsigned w0;
    volatile LAS unsigned* st;
};

__device__ __forceinline__ XcdBarrier xcd_barrier_post(unsigned* bar, volatile LAS unsigned* st) {
    XcdBarrier b; b.bar = bar; b.x = xb_xcc_id(); b.st = st;
    if (threadIdx.x == 0) (void)xb_add(&bar[XB_XCNT(b.x)], 1u);
    b.w0 = 0u;
    return b;
}
__device__ __forceinline__ void xcd_barrier_complete(unsigned* bar, unsigned x, unsigned& nloc, unsigned& nx) {
    const unsigned G = gridDim.x * gridDim.y * gridDim.z;
    unsigned sum, cnt, mine, sp = 0u;
    for (;;) {
        sum = 0u; cnt = 0u; mine = 0u;
#pragma unroll
        for (unsigned j = 0; j < 16; ++j) { const unsigned c = xb_ld(&bar[XB_XCNT(j)]); sum += c; cnt += (c > 0u) ? 1u : 0u; mine = (j == x) ? c : mine; }
        if (sum == G) break;
        __builtin_amdgcn_s_sleep(1);
        if ((++sp & 255u) == 0u) { if (xb_ld(&bar[XB_TMO])) break; if (sp > XB_SPIN_CAP) { atomicAdd(&bar[XB_TMO], 1u); break; } }
    }
    nloc = mine > 0u ? mine : 1u; nx = cnt > 0u ? cnt : 1u;
}

__device__ __forceinline__ void xcd_barrier(const XcdBarrier& b) {
    asm volatile("s_waitcnt vmcnt(0)" ::: "memory");
    __syncthreads();
    if (b.w0 != 0u && __builtin_amdgcn_mbcnt_hi(~0u, __builtin_amdgcn_mbcnt_lo(~0u, 0u)) == 0u) {
        unsigned* bar = b.bar;
        __builtin_amdgcn_s_waitcnt(0);
        unsigned nloc = b.st[0], nx = b.st[1];
        if (nloc == 0u) { xcd_barrier_complete(bar, b.x, nloc, nx); b.st[0] = nloc; b.st[1] = nx; }
        const unsigned old = xb_add(&bar[XB_XSUB(b.x)], 1u);
        const unsigned gen = old / nloc;
        if (old + 1u == (gen + 1u) * nloc) {
            __builtin_amdgcn_fence(__ATOMIC_RELEASE, "agent");
            asm volatile("s_waitcnt vmcnt(0)" ::: "memory");
            const unsigned og = xb_add(&bar[XB_TOP], 1u);
            const unsigned tg = og / nx;
            if (og + 1u == (tg + 1u) * nx) xb_add(&bar[XB_TOPGEN], 1u);
            else XB_SPIN(xb_ld(&bar[XB_TOPGEN]) == tg, bar);
            __builtin_amdgcn_fence(__ATOMIC_ACQUIRE, "agent");
            xb_add(&bar[XB_XGEN(b.x)], 1u);
            asm volatile("s_waitcnt vmcnt(0)" ::: "memory");
        } else {
            XB_SPIN(xb_ld(&bar[XB_XGEN(b.x)]) == gen, bar);
            __builtin_amdgcn_fence(__ATOMIC_ACQUIRE, "agent");
            asm volatile("s_waitcnt vmcnt(0)" ::: "memory");
        }
    }
    __syncthreads();
}
__device__ __forceinline__ void sincos_rev(double ang, float& s, float& c) {
    double rev = ang * 0.15915494309189535; rev -= floor(rev); const float fr = (float)rev;
    s = __builtin_amdgcn_sinf(fr); c = __builtin_amdgcn_cosf(fr);
}

constexpr size_t WS_S5TT = 604 * MiB, WS_S5T2 = 690 * MiB, WS_S5A32 = 707 * MiB;
__device__ __forceinline__ void s5_pre(KP kp0, LAS unsigned char* lds, int og, int tid) { KPREF(P, kp0);
    LAS float* apr = (LAS float*)lds; LAS float* api = apr + 33 * 64;
    LAS float* bbr = api + 33 * 64; LAS float* bbi = bbr + 1024;
    LAS float* cre = bbi + 1024; LAS float* cim = cre + 1024;
    LAS float* kern = cim + 1024;
    const int o = og >> 6, g = og & 63;
    const float dt = expf(P.in[I_OD_LOG_DT][og]);
    __syncthreads();
    for (int idx = tid; idx < 33 * 64; idx += 512) { const int k = idx >> 6, p = idx & 63; const float are = P.in[I_OD_A_RE][og * 64 + p], aim = P.in[I_OD_A_IM][og * 64 + p];
        const float er = expf((float)k * are * dt); float s, c; sincos_rev((double)k * (double)aim * (double)dt, s, c); apr[idx] = er * c; api[idx] = er * s; }
    for (int idx = tid; idx < 1024; idx += 512) { cre[idx] = P.in[I_OD_C_RE][(size_t)og * 1024 + idx]; cim[idx] = P.in[I_OD_C_IM][(size_t)og * 1024 + idx]; }
    __syncthreads();
    for (int idx = tid; idx < 1024; idx += 512) { const int p = idx >> 4; const float are = P.in[I_OD_A_RE][og * 64 + p], aim = P.in[I_OD_A_IM][og * 64 + p];
        const float xr = apr[64 + p] - 1.0f, xi = api[64 + p], den = 1.0f / (are * are + aim * aim), cr = (xr * are + xi * aim) * den, ci = (xi * are - xr * aim) * den;
        const float br = P.in[I_OD_B_RE][(size_t)og * 1024 + idx], bi = P.in[I_OD_B_IM][(size_t)og * 1024 + idx];
        bbr[idx] = cr * br - ci * bi; bbi[idx] = cr * bi + ci * br; }
    if (tid < 64) ((f32x2*)(P.ws + WS_S5A32))[og * 64 + tid] = (f32x2){apr[32 * 64 + tid], api[32 * 64 + tid]};
    __syncthreads();
    {
        const int pair = tid & 255, cp = pair >> 4, c = pair & 15, kh = tid >> 8; float acc[16];
#pragma unroll
        for (int kk = 0; kk < 16; ++kk) acc[kk] = 0.f;
        for (int p = 0; p < 64; ++p) { const float gr = cre[cp * 64 + p] * bbr[p * 16 + c] - cim[cp * 64 + p] * bbi[p * 16 + c], gi = cre[cp * 64 + p] * bbi[p * 16 + c] + cim[cp * 64 + p] * bbr[p * 16 + c];
#pragma unroll
            for (int kk = 0; kk < 16; ++kk) acc[kk] += gr * apr[(16 * kh + kk) * 64 + p] - gi * api[(16 * kh + kk) * 64 + p]; }
#pragma unroll
        for (int kk = 0; kk < 16; ++kk) kern[(16 * kh + kk) * 256 + pair] = acc[kk];
    }
    __syncthreads();
    bf16* TT = (bf16*)(P.ws + WS_S5TT) + (size_t)og * 512 * 640; bf16* T2 = (bf16*)(P.ws + WS_S5T2) + (size_t)og * 128 * 512;
    for (int idx = tid; idx < 512 * 64; idx += 512) { const int n = idx >> 6, ic = idx & 63, i = ic >> 1, ch = ic & 1, j = n >> 4, cp = n & 15; float v[8];
#pragma unroll
        for (int cc = 0; cc < 8; ++cc) v[cc] = (j >= i) ? kern[(j - i) * 256 + cp * 16 + 8 * ch + cc] : 0.f;
        u32x4 w; w.x = cvt_pk_bf16(v[0], v[1]); w.y = cvt_pk_bf16(v[2], v[3]); w.z = cvt_pk_bf16(v[4], v[5]); w.w = cvt_pk_bf16(v[6], v[7]);
        *(u32x4*)(TT + (size_t)n * 640 + i * 16 + 8 * ch) = w; }
    for (int idx = tid; idx < 512 * 16; idx += 512) { const int n = idx >> 4, q = idx & 15, j = n >> 4, cp = n & 15, im = q >> 3, p0 = (q & 7) * 8; float v[8];
#pragma unroll
        for (int cc = 0; cc < 8; ++cc) { const int p = p0 + cc; const float ar = apr[(j + 1) * 64 + p], ai = api[(j + 1) * 64 + p], cr = cre[cp * 64 + p], ci = cim[cp * 64 + p];
            v[cc] = im ? -(cr * ai + ci * ar) : (cr * ar - ci * ai); }
        u32x4 w; w.x = cvt_pk_bf16(v[0], v[1]); w.y = cvt_pk_bf16(v[2], v[3]); w.z = cvt_pk_bf16(v[4], v[5]); w.w = cvt_pk_bf16(v[6], v[7]);
        *(u32x4*)(TT + (size_t)n * 640 + 512 + 64 * im + p0) = w; }
    for (int idx = tid; idx < 128 * 64; idx += 512) { const int comp = idx >> 6, ic = idx & 63, i = ic >> 1, ch = ic & 1, p = comp & 63, im = comp >> 6; float v[8];
        const float ar = apr[(31 - i) * 64 + p], ai = api[(31 - i) * 64 + p];
#pragma unroll
        for (int cc = 0; cc < 8; ++cc) { const float br = bbr[p * 16 + 8 * ch + cc], bi = bbi[p * 16 + 8 * ch + cc]; v[cc] = im ? (ar * bi + ai * br) : (ar * br - ai * bi); }
        u32x4 w; w.x = cvt_pk_bf16(v[0], v[1]); w.y = cvt_pk_bf16(v[2], v[3]); w.z = cvt_pk_bf16(v[4], v[5]); w.w = cvt_pk_bf16(v[6], v[7]);
        *(u32x4*)(T2 + (size_t)comp * 512 + i * 16 + 8 * ch) = w; }
}


__device__ __forceinline__ void phase_ada(KP kp0, int kwave_, LAS unsigned char* lds) { KPREF(P, kp0); PHASE_IDS();
    LAS float* cond = (LAS float*)lds;
    LAS float* part = (LAS float*)(lds + 32768);
    const float* c = P.in[I_C];
    for (int i = tid; i < NB * DM; i += 512) { const float v = c[i]; cond[i] = v / (1.0f + __expf(-v)); }
    __syncthreads();
    float* mod = (float*)(P.ws + WS_MOD);
    for (int item = bx; item < 192; item += G) {
        const int l = item / 48, ng = item % 48;
        const float* W = P.in[I_ADA_W] + (size_t)l * DM * 12288 + (size_t)(wave * 256) * 12288 + ng * 256 + lane * 4;
        f32x4 a0 = {0.f, 0.f, 0.f, 0.f}, a1 = a0, a2 = a0, a3 = a0;
#pragma unroll 8
        for (int k = 0; k < 256; ++k) {
            const f32x4 w = *(const f32x4*)(W + (size_t)k * 12288); const int kk = wave * 256 + k;
            a0 += cond[kk] * w; a1 += cond[2048 + kk] * w; a2 += cond[4096 + kk] * w; a3 += cond[6144 + kk] * w;
        }
        LAS float* pp = part + wave * 1024 + lane * 4;
        *(LAS f32x4*)(pp) = a0; *(LAS f32x4*)(pp + 256) = a1; *(LAS f32x4*)(pp + 512) = a2; *(LAS f32x4*)(pp + 768) = a3;
        __syncthreads();
        for (int o = tid; o < 1024; o += 512) {
            float s = 0.f;
#pragma unroll
            for (int w = 0; w < 8; ++w) s += part[w * 1024 + o];
            const int b = o >> 8, cc = o & 255;
            mod[(size_t)(l * 4 + b) * 12288 + ng * 256 + cc] = s + P.in[I_ADA_B][l * 12288 + ng * 256 + cc];
        }
        __syncthreads();
    }
    if (bx >= 192 || G < 256) for (int og = (G < 256 ? bx : bx - 192); og < 128; og += (G < 256 ? G : 64)) s5_pre(kp0, lds, og, tid);
}

__constant__ int TRJOBS[7][8] = {
    {I_EV_W_IN, 2048, 5120, 2, 1, 12, CV_EVIN, 0}, {I_EV_W_OUT, 2048, 2048, 2, 0, 52, -1, 0}, {I_OD_W_IN, 2048, 2304, 2, 2, 68, CV_ODIN, 1}, {I_OD_W_OUT, 2048, 2048, 2, 0, 86, -1, 0},
    {I_OD_GLU_W, 1024, 1024, 2, 0, 102, -1, 0}, {I_FFN_W_IN, 2048, 11008, 4, 3, 106, CV_FFIN, 2}, {I_FFN_W_OUT, 5504, 2048, 4, 0, 278, -1, 0} };
__device__ __forceinline__ int cmap(int type, int n) {
    if (type == 1) { if (n >= 2048) return n; const int tile = n >> 8, j = n & 255, bj = j >> 7, jj = j & 127; return tile * 256 + (jj >> 6) * 128 + bj * 64 + (jj & 63); }
    if (type == 2) {
        if (n >= 1280) return n;
        if (n < 1024) { const int tile = n >> 8, j = n & 255, bj = j >> 7, jj = j & 127; return tile * 256 + (jj >> 5) * 64 + bj * 32 + (jj & 31); }
        const int j = n - 1024, bj = j >> 7, jj = j & 127; if (jj < 64) return 1024 + (jj >> 5) * 64 + bj * 32 + (jj & 31); return 1152 + bj * 64 + (jj - 64);
    }
    if (type == 3) { const int tile = n >> 8, j = n & 255; return (j >> 7) * 5504 + tile * 128 + (j & 127); }
    return n;
}
__device__ __forceinline__ void tr_item(const float* W, int K, int N, bf16* WT, int k0, int c0a, int c0b, int dstr0, LAS float* scr, int lane, float* cv, const float* sh) {
    const int csrc = ((lane & 8) ? c0b : c0a) + (lane & 7) * 4, cl = (lane & 15) * 4;
#pragma unroll
    for (int i = 0; i < 16; ++i) { const int kk = 4 * i + (lane >> 4); const f32x4 v = *(const f32x4*)(W + (size_t)(k0 + kk) * N + csrc);
        LAS float* d = scr + kk * 65 + cl; d[0] = v[0]; d[1] = v[1]; d[2] = v[2]; d[3] = v[3]; }
    LDS_WAIT(); asm volatile("" ::: "memory");
    const int c = lane & 7;
#pragma unroll
    for (int j = 0; j < 8; ++j) { const int n = (lane >> 3) + 8 * j; const LAS float* s = scr + (8 * c) * 65 + n;
        u32x4 o; o.x = cvt_pk_bf16(s[0 * 65], s[1 * 65]); o.y = cvt_pk_bf16(s[2 * 65], s[3 * 65]); o.z = cvt_pk_bf16(s[4 * 65], s[5 * 65]); o.w = cvt_pk_bf16(s[6 * 65], s[7 * 65]);
        *(u32x4*)(WT + (size_t)(dstr0 + n) * K + k0 + 8 * c) = o; }
    if (cv) { float a0 = 0.f, a1 = 0.f, a2 = 0.f, a3 = 0.f;
#pragma unroll 16
        for (int k = 0; k < 64; ++k) { const float w = scr[k * 65 + lane]; a0 += sh[k0 + k] * w; a1 += sh[12288 + k0 + k] * w; a2 += sh[2 * 12288 + k0 + k] * w; a3 += sh[3 * 12288 + k0 + k] * w; }
        cv[dstr0 + lane] = a0; cv[N + dstr0 + lane] = a1; cv[2 * N + dstr0 + lane] = a2; cv[3 * N + dstr0 + lane] = a3; }
    LDS_WAIT(); asm volatile("" ::: "memory");
}
__device__ __forceinline__ void phase_prep(KP kp0, int kwave_, LAS unsigned char* lds) { KPREF(P, kp0); PHASE_IDS();
    LAS float* scr = (LAS float*)(lds + wave * 16640);
    const int gw = bx * 8 + wave, NGW = G * 8;
    const float* mod = (const float*)(P.ws + WS_MOD); float* cvpart = (float*)(P.ws + WS_CVPART);
    int total = 0;
#pragma unroll
    for (int q = 0; q < 7; ++q) total += TRJOBS[q][3] * (TRJOBS[q][1] / 64) * (TRJOBS[q][2] / 64);
    for (int it = gw; it < total; it += NGW) {
        int r = it, j = 0;
#pragma unroll
        for (int q = 0; q < 6; ++q) { const int cnt = TRJOBS[q][3] * (TRJOBS[q][1] / 64) * (TRJOBS[q][2] / 64); if (j == q && r >= cnt) { r -= cnt; j = q + 1; } }
        const int K = TRJOBS[j][1], N = TRJOBS[j][2], per = (K / 64) * (N / 64), li = r / per, rr = r % per, nblk = N / 64, kb = rr / nblk, nb = rr % nblk, cvo = TRJOBS[j][6], sel = TRJOBS[j][7];
        const float* src = P.in[TRJOBS[j][0]] + (size_t)li * K * N;
        bf16* dst = (bf16*)(P.ws + (size_t)TRJOBS[j][5] * MiB) + (size_t)li * K * N;
        const int layer = sel == 0 ? 2 * li : (sel == 1 ? 2 * li + 1 : li);
        tr_item(src, K, N, dst, 64 * kb, cmap(TRJOBS[j][4], 64 * nb), cmap(TRJOBS[j][4], 64 * nb + 32), 64 * nb, scr, lane,
                cvo >= 0 ? cvpart + ((size_t)kb * CV_TOTAL + cvo + (size_t)li * 4 * N) : nullptr, mod + (size_t)layer * 4 * 12288 + (sel == 2 ? 3 * DM : 0));
    }
    for (int it = gw; it < 64; it += NGW) { const int mat = it >> 1, kb = it & 1, gate = mat & 1, eb = mat >> 1;
#pragma unroll
        for (int nb = 0; nb < 2; ++nb)
            tr_item(P.in[gate ? I_EV_GX_W : I_EV_GA_W] + (size_t)eb * 16384, 128, 128, (bf16*)(P.ws + WS_WGATE) + ((size_t)eb * 256 + gate * 128) * 128, 64 * kb, 64 * nb, 64 * nb + 32, 64 * nb, scr, lane, nullptr, nullptr); }
    const int gt = bx * 512 + tid, NT = G * 512;
    const int* pos = (const int*)P.in[I_POS];
    float* cosA = (float*)(P.ws + WS_COSA); float* sinA = (float*)(P.ws + WS_SINA); float* cosC = (float*)(P.ws + WS_COSC); float* sinC = (float*)(P.ws + WS_SINC);
    for (int idx = gt; idx < MT * 64; idx += NT) { const int row = idx >> 6, i = idx & 63;
        const double inv = exp2(-(double)i * (13.287712379549449 / 64.0)); float s, c; sincos_rev((double)pos[row] * inv, s, c); cosA[idx] = c; sinA[idx] = s; }
    for (int idx = gt; idx < MT * 32; idx += NT) { const int row = idx >> 5, i = idx & 31;
        const double inv = exp2(-(double)i * (13.287712379549449 / 32.0)); float s, c; sincos_rev((double)pos[row] * inv, s, c); cosC[idx] = c; sinC[idx] = s; }
    for (int idx = gt; idx < 2 * 64 * 64; idx += NT) { const int o = idx >> 12, g = (idx >> 6) & 63;
        const float are = P.in[I_OD_A_RE][idx], aim = P.in[I_OD_A_IM][idx], dt = expf(P.in[I_OD_LOG_DT][o * 64 + g]);
        const float er = expf(are * dt); float s, c; sincos_rev((double)aim * (double)dt, s, c);
        const float abr = er * c, abi = er * s, xr = abr - 1.0f, xi = abi, den = 1.0f / (are * are + aim * aim);
        const float cr = (xr * are + xi * aim) * den, ci = (xi * are - xr * aim) * den;
        f32x2* abar = (f32x2*)(P.ws + WS_S5T + (size_t)o * MiB); f32x2* bbar = (f32x2*)(P.ws + WS_S5T + (size_t)o * MiB + 65536);
        abar[idx & 4095] = (f32x2){abr, abi};
#pragma unroll
        for (int cc = 0; cc < 16; ++cc) { const float br = P.in[I_OD_B_RE][(size_t)idx * 16 + cc], bi = P.in[I_OD_B_IM][(size_t)idx * 16 + cc];
            bbar[(size_t)(idx & 4095) * 16 + cc] = (f32x2){cr * br - ci * bi, cr * bi + ci * br}; }
    }
}

__device__ __forceinline__ void phase_norm0(KP kp0, int kwave_) { KPREF(P, kp0); PHASE_IDS();
    const float* x = P.in[I_X]; const float* gwt = P.in[I_NORM_MIX];
    const float* modl = (const float*)(P.ws + WS_MOD);
    bf16* H = (bf16*)(P.ws + WS_H); float* ss = (float*)(P.ws + WS_SS);
    const int gw = bx * 8 + wave, NGW = G * 8;
    for (int row = gw; row < MT; row += NGW) {
        const f32x4* xr = (const f32x4*)(x + (size_t)row * DM) + lane;
        f32x4 v[8]; float s2 = 0.f;
#pragma unroll
        for (int j = 0; j < 8; ++j) { v[j] = xr[64 * j]; s2 += (v[j][0] * v[j][0] + v[j][1] * v[j][1]) + (v[j][2] * v[j][2] + v[j][3] * v[j][3]); }
        s2 = wave_sum(s2); if (lane < 32) ss[(size_t)row * 32 + lane] = lane == 0 ? s2 : 0.f;
        const float* sc = modl + (size_t)(row >> 11) * 12288 + DM;
        u32x2* o8 = (u32x2*)(H + (size_t)row * DM) + lane;
#pragma unroll
        for (int j = 0; j < 8; ++j) { const int col = (lane + 64 * j) * 4;
            const f32x4 y = v[j] * *(const f32x4*)(gwt + col) * (1.0f + *(const f32x4*)(sc + col));
            u32x2 w; w.x = cvt_pk_bf16(y[0], y[1]); w.y = cvt_pk_bf16(y[2], y[3]); o8[64 * j] = w; }
    }
    { const float* cvpart = (const float*)(P.ws + WS_CVPART); float* cvec = (float*)(P.ws + WS_CVEC);
      for (int i = bx * 512 + tid; i < CV_TOTAL; i += G * 512) { float s = 0.f;
#pragma unroll 8
          for (int kb = 0; kb < 32; ++kb) s += cvpart[(size_t)kb * CV_TOTAL + i];
          cvec[i] = s; } }
}
__device__ __forceinline__ void phase_final(KP kp0, int kwave_) { KPREF(P, kp0); PHASE_IDS();
    const float* gwt = P.in[I_NORM_FINAL];
    const int gw = bx * 8 + wave, NGW = G * 8;
    for (int row = gw; row < MT; row += NGW) {
        f32x4* xr = (f32x4*)(P.out + (size_t)row * DM) + lane;
        f32x4 v[8]; float ss = 0.f;
#pragma unroll
        for (int j = 0; j < 8; ++j) { v[j] = xr[64 * j]; ss += (v[j][0] * v[j][0] + v[j][1] * v[j][1]) + (v[j][2] * v[j][2] + v[j][3] * v[j][3]); }
        const float rstd = rsqrtf(wave_sum(ss) * (1.0f / DM) + 1e-6f);
#pragma unroll
        for (int j = 0; j < 8; ++j) { const int col = (lane + 64 * j) * 4; xr[64 * j] = v[j] * rstd * *(const f32x4*)(gwt + col); }
    }
}

__device__ __forceinline__ void phase_attn_a_naive(KP kp0, int kwave_) { KPREF(P, kp0); PHASE_IDS();
    const bf16* Q = (const bf16*)(P.ws + WS_Q); const bf16* K = (const bf16*)(P.ws + WS_K); const bf16* V = (const bf16*)(P.ws + WS_V); bf16* MIX = (bf16*)(P.ws + WS_MIX);
    const int gw = bx * 8 + wave, NGW = G * 8;
    for (int task = gw; task < MT * 8; task += NGW) {
        const int h = task & 7, row = task >> 3, b = row >> 11, t = row & 2047;
        const unsigned qw = *(const unsigned*)(Q + (size_t)row * 1024 + h * 128 + 2 * lane); const float q0 = bf_lo(qw), q1 = bf_hi(qw);
        float m = -INFINITY, l = 0.f, o0 = 0.f, o1 = 0.f;
        for (int pat = 0; pat < 3; ++pat) { const int dil = pat == 0 ? 1 : (pat == 1 ? 4 : 16);
            for (int j = 0; j <= 128; ++j) { const int tk = t - dil * j; if (tk < 0) break;
                const size_t kr = (size_t)(b * SEQ + tk) * 1024 + h * 128 + 2 * lane;
                const unsigned kw = *(const unsigned*)(K + kr), vw = *(const unsigned*)(V + kr);
                const float s = wave_sum(q0 * bf_lo(kw) + q1 * bf_hi(kw));
                const float mn = fmaxf(m, s), corr = exp2f(m - mn), p = exp2f(s - mn);
                l = l * corr + p; o0 = o0 * corr + p * bf_lo(vw); o1 = o1 * corr + p * bf_hi(vw); m = mn; } }
        const float inv = 1.0f / l;
        *(unsigned*)(MIX + (size_t)row * 2048 + h * 128 + 2 * lane) = cvt_pk_bf16(o0 * inv, o1 * inv);
    }
}
__device__ __forceinline__ void phase_attn_c_naive(KP kp0, int kwave_, int o_idx) { KPREF(P, kp0); PHASE_IDS();
    const bf16* Q = (const bf16*)(P.ws + WS_Q); const bf16* K = (const bf16*)(P.ws + WS_K); const bf16* V = (const bf16*)(P.ws + WS_V); bf16* MIX = (bf16*)(P.ws + WS_MIX);
    const int gw = bx * 8 + wave, NGW = G * 8;
    for (int task = gw; task < MT * 16; task += NGW) {
        const int h = task & 15, row = task >> 4, b = row >> 11, t = row & 2047, kvh = h >> 3;
        const float q = bf2f(Q[(size_t)row * 1024 + h * 64 + lane]);
        float m = -INFINITY, l = 0.f, o = 0.f;
        for (int tk = (t >= 127 ? t - 127 : 0); tk <= t; ++tk) {
            const size_t kr = (size_t)(b * SEQ + tk) * 128 + kvh * 64 + lane;
            const float s = wave_sum(q * bf2f(K[kr]));
            const float mn = fmaxf(m, s), corr = exp2f(m - mn), p = exp2f(s - mn);
            l = l * corr + p; o = o * corr + p * bf2f(V[kr]); m = mn; }
        const float sk = P.in[I_OD_SINKS][o_idx * 16 + h] * LOG2E;
        MIX[(size_t)row * 2048 + h * 64 + lane] = f2bf(o / (l + exp2f(sk - m)));
    }
}
__device__ __forceinline__ void phase_lru1_naive(KP kp0, int kwave_, int e) { KPREF(P, kp0); PHASE_IDS();
    const bf16* XB = (const bf16*)(P.ws + WS_XB); float* XC = (float*)(P.ws + WS_XC);
    const float* cw = P.in[I_EV_CONV_W] + (size_t)e * 4 * 1024; const float* cb = P.in[I_EV_CONV_B] + e * 1024;
    const int gt = bx * 512 + tid, NT = G * 512;
    for (int idx = gt; idx < MT * 1024; idx += NT) { const int row = idx >> 10, c = idx & 1023, t = row & 2047;
        float acc = cb[c];
#pragma unroll
        for (int i = 0; i < 4; ++i) { const int tt = t - 3 + i; if (tt >= 0) acc += cw[i * 1024 + c] * bf2f(XB[(size_t)(row - 3 + i) * 1024 + c]); }
        XC[idx] = acc; }
}
__device__ __forceinline__ void phase_lru2_naive(KP kp0, int kwave_, int e) { KPREF(P, kp0); PHASE_IDS();
    const float* XC = (const float*)(P.ws + WS_XC); float* LA = (float*)(P.ws + WS_LA); float* LB = (float*)(P.ws + WS_LB);
    const int gt = bx * 512 + tid, NT = G * 512;
    for (int idx = gt; idx < MT * 1024; idx += NT) { const int row = idx >> 10, c = idx & 1023, blk = c >> 7, j = c & 127;
        const float* xr = XC + (size_t)row * 1024 + blk * 128;
        const float* wa = P.in[I_EV_GA_W] + (size_t)((e * 8 + blk) * 128) * 128 + j; const float* wx = P.in[I_EV_GX_W] + (size_t)((e * 8 + blk) * 128) * 128 + j;
        float sa = P.in[I_EV_GA_B][e * 1024 + c], sx = P.in[I_EV_GX_B][e * 1024 + c];
#pragma unroll 8
        for (int i = 0; i < 128; ++i) { const float xv = xr[i]; sa += xv * wa[i * 128]; sx += xv * wx[i * 128]; }
        const float r = 1.0f / (1.0f + expf(-sa)), ig = 1.0f / (1.0f + expf(-sx));
        const float sp = log1pf(expf(-P.in[I_EV_LAMBDA][e * 1024 + c]));
        const float log_a = -8.0f * r * sp, a = expf(log_a), mult = sqrtf(-expm1f(2.0f * log_a));
        LA[idx] = a; LB[idx] = mult * ig * xr[j]; }
}
__device__ __forceinline__ void phase_lru3_naive(KP kp0, int kwave_) { KPREF(P, kp0); PHASE_IDS();
    const float* LA = (const float*)(P.ws + WS_LA); const float* LB = (const float*)(P.ws + WS_LB); const bf16* YB = (const bf16*)(P.ws + WS_YB); bf16* MIX = (bf16*)(P.ws + WS_MIX);
    if (wave != 0) return;
    for (int task = bx; task < 64; task += G) { const int b = task >> 4, c = (task & 15) * 64 + lane;
        float h = 0.f;
#pragma unroll 8
        for (int t = 0; t < SEQ; ++t) { const size_t idx = (size_t)(b * SEQ + t) * 1024 + c;
            h = LA[idx] * h + LB[idx];
            MIX[(size_t)(b * SEQ + t) * 2048 + 1024 + c] = f2bf(h * bf2f(YB[idx])); } }
}
__device__ __forceinline__ void phase_s5_naive(KP kp0, int kwave_, int o_idx) { KPREF(P, kp0); PHASE_IDS();
    const bf16* U = (const bf16*)(P.ws + WS_XB); bf16* Z = (bf16*)(P.ws + WS_YB);
    if (wave != 0) return;
    for (int bg = bx; bg < 256; bg += G) { const int b = bg >> 6, g = bg & 63;
        const f32x2 ab = ((const f32x2*)(P.ws + WS_S5T + (size_t)o_idx * MiB))[g * 64 + lane];
        const f32x2* bbp = (const f32x2*)(P.ws + WS_S5T + (size_t)o_idx * MiB + 65536) + (size_t)(g * 64 + lane) * 16;
        f32x2 bb[16]; float cre[16], cim[16], dsk[16];
#pragma unroll
        for (int c = 0; c < 16; ++c) { bb[c] = bbp[c];
            cre[c] = P.in[I_OD_C_RE][((size_t)(o_idx * 64 + g) * 16 + c) * 64 + lane]; cim[c] = P.in[I_OD_C_IM][((size_t)(o_idx * 64 + g) * 16 + c) * 64 + lane];
            dsk[c] = P.in[I_OD_D][o_idx * 1024 + g * 16 + c]; }
        float hr = 0.f, hi = 0.f;
        for (int t = 0; t < SEQ; ++t) { const size_t row = (size_t)(b * SEQ + t);
            const u32x4 u0 = *(const u32x4*)(U + row * 1024 + g * 16), u1 = *(const u32x4*)(U + row * 1024 + g * 16 + 8);
            float u[16] = {bf_lo(u0.x), bf_hi(u0.x), bf_lo(u0.y), bf_hi(u0.y), bf_lo(u0.z), bf_hi(u0.z), bf_lo(u0.w), bf_hi(u0.w),
                           bf_lo(u1.x), bf_hi(u1.x), bf_lo(u1.y), bf_hi(u1.y), bf_lo(u1.z), bf_hi(u1.z), bf_lo(u1.w), bf_hi(u1.w)};
            float bur = 0.f, bui = 0.f;
#pragma unroll
            for (int c = 0; c < 16; ++c) { bur += u[c] * bb[c][0]; bui += u[c] * bb[c][1]; }
            const float nr = ab[0] * hr - ab[1] * hi + bur, ni = ab[0] * hi + ab[1] * hr + bui; hr = nr; hi = ni;
            float zo = 0.f;
#pragma unroll
            for (int c = 0; c < 16; ++c) { const float y = wave_sum(hr * cre[c] - hi * cim[c]) + dsk[c] * u[c]; const float z = gelu_tanh(y); zo = (lane == c) ? z : zo; }
            if (lane < 16) Z[row * 1024 + g * 16 + lane] = f2bf(zo); }
    }
}
__device__ __forceinline__ void ffn_fix_panel(const float* hf, const float* hl, bf16* ACT, const float* cw, const float* cb, int pm, int tid) {
    if ((pm & 7) == 0) return;
    for (int idx = tid; idx < 2 * DFF; idx += 512) { const int j = idx % DFF, rr = idx / DFF;
        float o[2];
#pragma unroll
        for (int bj = 0; bj < 2; ++bj) { const int col = bj * DFF + j;
            const float l0 = hl[((size_t)((pm - 1) * 2 + 0) * 2 + bj) * DFF + j], l1 = hl[((size_t)((pm - 1) * 2 + 1) * 2 + bj) * DFF + j];
            const float f0 = hf[((size_t)(pm * 2 + 0) * 2 + bj) * DFF + j], f1 = hf[((size_t)(pm * 2 + 1) * 2 + bj) * DFF + j];
            const float um2 = rr == 0 ? l0 : l1, um1 = rr == 0 ? l1 : f0, u0 = rr == 0 ? f0 : f1;
            o[bj] = cb[col] + cw[col] * um2 + cw[DFF2 + col] * um1 + cw[2 * DFF2 + col] * u0; }
        ACT[(size_t)(pm * 256 + rr) * DFF + j] = f2bf(gelu_tanh(o[0]) * o[1]); }
}

typedef short s16x4 __attribute__((ext_vector_type(4)));
typedef short bf16x8v __attribute__((ext_vector_type(8)));
typedef float f32x16 __attribute__((ext_vector_type(16)));
__device__ __forceinline__ unsigned offb(unsigned row, unsigned ch) { return 256u * row + 16u * (ch ^ (((row & 3u) << 2) | ((row >> 2) & 3u))); }
constexpr int ATT_TILE_BYTES = 64 * 256, ATT_BUF_BYTES = 2 * ATT_TILE_BYTES;
__device__ __forceinline__ bf16x8v cat8(const s16x4 a, const s16x4 b) { return (bf16x8v){a[0], a[1], a[2], a[3], b[0], b[1], b[2], b[3]}; }

template <int MODE>
__device__ __forceinline__ void phase_attn(KP kp0, int kwave_, LAS unsigned char* lds, int o_idx) { KPREF(P, kp0); PHASE_IDS();
    constexpr int NKS = MODE == 0 ? 8 : 4;
    constexpr int NDT = MODE == 0 ? 4 : 2;
    constexpr int NH = 1;
    const bf16* Q = (const bf16*)(P.ws + WS_Q); const bf16* K = (const bf16*)(P.ws + WS_K); const bf16* V = (const bf16*)(P.ws + WS_V); bf16* MIX = (bf16*)(P.ws + WS_MIX);
    const int r = lane & 31, hh = lane >> 5, q4 = (lane & 15) >> 2, p4 = lane & 3, blk = (lane >> 4) & 1;
    unsigned kaddr[NKS], vaddr[2][NDT];
    { const unsigned x = ((r & 3u) << 2) | ((r >> 2) & 3u);
#pragma unroll
      for (int s = 0; s < NKS; ++s) kaddr[s] = 256u * r + 16u * (((unsigned)(2 * s + hh)) ^ x);
#pragma unroll
      for (int t = 0; t < 2; ++t)
#pragma unroll
        for (int c = 0; c < NDT; ++c) { const unsigned row = 8u * t + 4u * hh + q4, ch = 4u * c + 2u * blk + (p4 >> 1);
            vaddr[t][c] = 256u * row + 16u * (ch ^ (((row & 3u) << 2) | ((row >> 2) & 3u))) + 8u * (p4 & 1); } }
    const int nunits = MODE == 0 ? 256 : 512;
    for (int unit = bx; unit < nunits; unit += G) {
        int b, head0, q0, kt0, kt1; size_t kvbase; int kvpitch; unsigned kx = 0u;
        if (MODE == 0) { const int qb = 7 - (unit >> 5), bh = unit & 31; b = bh >> 3; head0 = bh & 7; q0 = qb * 256; kt0 = qb >= 2 ? 4 * (qb - 2) : 0; kt1 = qb * 4 + 3; kvbase = (size_t)b * SEQ * 1024 + head0 * 128; kvpitch = 1024; }
        else { b = unit >> 7; const int kvh = (unit >> 6) & 1; kx = 128u * kvh; q0 = (unit & 63) * 32; head0 = 8 * kvh + wave; kt0 = (q0 >= 127 ? q0 - 127 : 0) >> 6; kt1 = (q0 + 31) >> 6; kvbase = (size_t)b * SEQ * 128; kvpitch = 128; }
        const int tq = MODE == 0 ? q0 + 16 * (r & 15) + 2 * wave + (r >> 4) : q0 + r;
        const size_t qrow = (size_t)b * SEQ + tq;
        bf16x8v qf[NH][NKS];
#pragma unroll
        for (int hd = 0; hd < NH; ++hd)
#pragma unroll
            for (int s = 0; s < NKS; ++s) qf[hd][s] = *(const bf16x8v*)(Q + qrow * 1024 + (MODE == 0 ? head0 * 128 : (head0 + hd) * 64) + 16 * s + 8 * hh);
        f32x16 O[NH][NDT]; float m[NH], l[NH];
#pragma unroll
        for (int hd = 0; hd < NH; ++hd) { m[hd] = -1e30f; l[hd] = 0.f;
#pragma unroll
            for (int c = 0; c < NDT; ++c)
#pragma unroll
                for (int i = 0; i < 16; ++i) O[hd][c][i] = 0.f; }
        const int srow = tid >> 4, sch = tid & 15;
        const unsigned soff0 = offb(srow, sch), soff1 = offb(srow + 32, sch);
        u32x4 kreg[2], vreg[2];
        { const size_t g0 = kvbase + (size_t)(kt0 * 64 + srow) * kvpitch + sch * 8, g1 = g0 + (size_t)32 * kvpitch;
          kreg[0] = *(const u32x4*)(K + g0); kreg[1] = *(const u32x4*)(K + g1); vreg[0] = *(const u32x4*)(V + g0); vreg[1] = *(const u32x4*)(V + g1); }
        __syncthreads();
        *(LAS u32x4*)(lds + soff0) = kreg[0]; *(LAS u32x4*)(lds + soff1) = kreg[1];
        *(LAS u32x4*)(lds + ATT_TILE_BYTES + soff0) = vreg[0]; *(LAS u32x4*)(lds + ATT_TILE_BYTES + soff1) = vreg[1];
        __syncthreads();
        for (int kt = kt0; kt <= kt1; ++kt) {
            const int cur = (kt - kt0) & 1;
            LAS unsigned char* kb_ = lds + cur * ATT_BUF_BYTES; LAS unsigned char* vb_ = kb_ + ATT_TILE_BYTES;
            if (kt < kt1) { const size_t g0 = kvbase + (size_t)((kt + 1) * 64 + srow) * kvpitch + sch * 8, g1 = g0 + (size_t)32 * kvpitch;
                kreg[0] = *(const u32x4*)(K + g0); kreg[1] = *(const u32x4*)(K + g1); vreg[0] = *(const u32x4*)(V + g0); vreg[1] = *(const u32x4*)(V + g1); }
            {
                const int dq = tq - 64 * kt - 4 * hh;
#pragma unroll
                for (int hd = 0; hd < NH; ++hd) {
                    f32x16 S[2];
#pragma unroll
                    for (int kb = 0; kb < 2; ++kb) {
#pragma unroll
                        for (int i = 0; i < 16; ++i) S[kb][i] = 0.f;
#pragma unroll
                        for (int s = 0; s < NKS; ++s) { const bf16x8v kf = *(const LAS bf16x8v*)(kb_ + (kaddr[s] ^ kx) + kb * 8192); S[kb] = __builtin_amdgcn_mfma_f32_32x32x16_bf16(kf, qf[hd][s], S[kb], 0, 0, 0); }
                    }
                    float w[2][16]; float tmax = -INFINITY;
#pragma unroll
                    for (int kb = 0; kb < 2; ++kb)
#pragma unroll
                        for (int i = 0; i < 16; ++i) { const int d = dq - (kb * 32 + (i & 3) + 8 * (i >> 2));
                            if (MODE == 0) { const int cnt = (d <= 128 ? 1 : 0) + (((d & 3) == 0 && d <= 512) ? 1 : 0) + ((d & 15) == 0 ? 1 : 0); w[kb][i] = (d >= 0) ? (float)cnt : 0.f; }
                            else w[kb][i] = (d >= 0 && d <= 127) ? 1.f : 0.f;
                            S[kb][i] = (w[kb][i] > 0.f) ? S[kb][i] : -INFINITY; tmax = fmaxf(tmax, S[kb][i]); }
                    tmax = fmaxf(tmax, __shfl_xor(tmax, 32));
                    const float mn = fmaxf(m[hd], tmax), corr = __builtin_amdgcn_exp2f(m[hd] - mn); m[hd] = mn;
                    float ps = 0.f;
#pragma unroll
                    for (int kb = 0; kb < 2; ++kb)
#pragma unroll
                        for (int i = 0; i < 16; ++i) { const float pv = w[kb][i] * __builtin_amdgcn_exp2f(S[kb][i] - mn); S[kb][i] = pv; ps += pv; }
                    l[hd] = l[hd] * corr + ps;
#pragma unroll
                    for (int c = 0; c < NDT; ++c)
#pragma unroll
                        for (int i = 0; i < 16; ++i) O[hd][c][i] *= corr;
#pragma unroll
                    for (int kb = 0; kb < 2; ++kb)
#pragma unroll
                        for (int s2 = 0; s2 < 2; ++s2) {
                            bf16x8v pf; { const unsigned a0 = cvt_pk_bf16(S[kb][8 * s2 + 0], S[kb][8 * s2 + 1]), a1 = cvt_pk_bf16(S[kb][8 * s2 + 2], S[kb][8 * s2 + 3]),
                                                         a2 = cvt_pk_bf16(S[kb][8 * s2 + 4], S[kb][8 * s2 + 5]), a3 = cvt_pk_bf16(S[kb][8 * s2 + 6], S[kb][8 * s2 + 7]);
                                pf = __builtin_bit_cast(bf16x8v, (u32x4){a0, a1, a2, a3}); }
#pragma unroll
                            for (int c = 0; c < NDT; ++c) {
                                const s16x4 v0 = __builtin_amdgcn_ds_read_tr16_b64_v4i16((LAS s16x4*)(vb_ + (vaddr[0][c] ^ kx) + 256 * (32 * kb + 16 * s2)));
                                const s16x4 v1 = __builtin_amdgcn_ds_read_tr16_b64_v4i16((LAS s16x4*)(vb_ + (vaddr[1][c] ^ kx) + 256 * (32 * kb + 16 * s2)));
                                O[hd][c] = __builtin_amdgcn_mfma_f32_32x32x16_bf16(cat8(v0, v1), pf, O[hd][c], 0, 0, 0); }
                        }
                }
            }
            if (kt < kt1) { LAS unsigned char* nb_ = lds + (cur ^ 1) * ATT_BUF_BYTES;
                *(LAS u32x4*)(nb_ + soff0) = kreg[0]; *(LAS u32x4*)(nb_ + soff1) = kreg[1];
                *(LAS u32x4*)(nb_ + ATT_TILE_BYTES + soff0) = vreg[0]; *(LAS u32x4*)(nb_ + ATT_TILE_BYTES + soff1) = vreg[1]; }
            __syncthreads();
        }
        if (MODE == 0 && kt0 > 0) {
            LAS unsigned char* pk = lds + wave * 16384; LAS unsigned char* pv = pk + 8192;
            const int nfar = 4 * kt0;
            for (int s = 0; s * 16 < nfar; ++s) {
#pragma unroll
                for (int jh = 0; jh < 2; ++jh) { u32x4 kf[4], vf[4];
#pragma unroll
                    for (int j = 0; j < 4; ++j) { const int row = (lane >> 4) + 4 * (4 * jh + j), keypos = 2 * wave + (row >> 4) + 16 * (16 * s + (row & 15)); const size_t g0 = kvbase + (size_t)keypos * kvpitch + (lane & 15) * 8;
                        kf[j] = *(const u32x4*)(K + g0); vf[j] = *(const u32x4*)(V + g0); }
#pragma unroll
                    for (int j = 0; j < 4; ++j) { const unsigned so = offb((lane >> 4) + 4 * (4 * jh + j), lane & 15); *(LAS u32x4*)(pk + so) = kf[j]; *(LAS u32x4*)(pv + so) = vf[j]; } }
                f32x16 S;
#pragma unroll
                for (int i = 0; i < 16; ++i) S[i] = 0.f;
#pragma unroll
                for (int s8 = 0; s8 < NKS; ++s8) { const bf16x8v kfr = *(const LAS bf16x8v*)(pk + kaddr[s8]); S = __builtin_amdgcn_mfma_f32_32x32x16_bf16(kfr, qf[0][s8], S, 0, 0, 0); }
                float tmax = -INFINITY;
#pragma unroll
                for (int i = 0; i < 16; ++i) { const bool ok = (i >> 3) == (r >> 4); S[i] = ok ? S[i] : -INFINITY; tmax = fmaxf(tmax, S[i]); }
                tmax = fmaxf(tmax, __shfl_xor(tmax, 32));
                const float mn = fmaxf(m[0], tmax), corr = __builtin_amdgcn_exp2f(m[0] - mn); m[0] = mn;
                float ps = 0.f;
#pragma unroll
                for (int i = 0; i < 16; ++i) { const float pvv = __builtin_amdgcn_exp2f(S[i] - mn); S[i] = pvv; ps += pvv; }
                l[0] = l[0] * corr + ps;
#pragma unroll
                for (int c = 0; c < NDT; ++c)
#pragma unroll
                    for (int i = 0; i < 16; ++i) O[0][c][i] *= corr;
#pragma unroll
                for (int s2 = 0; s2 < 2; ++s2) {
                    bf16x8v pf; { const unsigned a0 = cvt_pk_bf16(S[8 * s2 + 0], S[8 * s2 + 1]), a1 = cvt_pk_bf16(S[8 * s2 + 2], S[8 * s2 + 3]), a2 = cvt_pk_bf16(S[8 * s2 + 4], S[8 * s2 + 5]), a3 = cvt_pk_bf16(S[8 * s2 + 6], S[8 * s2 + 7]);
                        pf = __builtin_bit_cast(bf16x8v, (u32x4){a0, a1, a2, a3}); }
#pragma unroll
                    for (int c = 0; c < NDT; ++c) {
                        const s16x4 v0 = __builtin_amdgcn_ds_read_tr16_b64_v4i16((LAS s16x4*)(pv + vaddr[0][c] + 256 * (16 * s2)));
                        const s16x4 v1 = __builtin_amdgcn_ds_read_tr16_b64_v4i16((LAS s16x4*)(pv + vaddr[1][c] + 256 * (16 * s2)));
                        O[0][c] = __builtin_amdgcn_mfma_f32_32x32x16_bf16(cat8(v0, v1), pf, O[0][c], 0, 0, 0); }
                }
            }
        }
#pragma unroll
        for (int hd = 0; hd < NH; ++hd) {
            float lt = l[hd] + __shfl_xor(l[hd], 32);
            if (MODE == 1) lt += __builtin_amdgcn_exp2f(P.in[I_OD_SINKS][o_idx * 16 + head0 + hd] * LOG2E - m[hd]);
            const float inv = 1.0f / lt;
            bf16* orow = MIX + qrow * 2048 + (MODE == 0 ? head0 * 128 : (head0 + hd) * 64);
#pragma unroll
            for (int c = 0; c < NDT; ++c)
#pragma unroll
                for (int g4 = 0; g4 < 4; ++g4) { u32x2 o; o.x = cvt_pk_bf16(O[hd][c][4 * g4 + 0] * inv, O[hd][c][4 * g4 + 1] * inv); o.y = cvt_pk_bf16(O[hd][c][4 * g4 + 2] * inv, O[hd][c][4 * g4 + 3] * inv);
                    *(u32x2*)(orow + 32 * c + 8 * g4 + 4 * hh) = o; }
        }
    }
    __syncthreads();
}
__device__ __forceinline__ void phase_s5(KP kp0, int kwave_, LAS unsigned char* lds, int o_idx) { KPREF(P, kp0); PHASE_IDS();
    const bf16* Ug = (const bf16*)(P.ws + WS_XB); bf16* Z = (bf16*)(P.ws + WS_YB);
    constexpr int UP = 1296;
    LAS unsigned char* uc = lds; LAS float* eL = (LAS float*)(lds + 64 * UP);
    const int r = lane & 31, hh = lane >> 5;
    for (int bg = bx; bg < 256; bg += G) { const int b = bg >> 6, g = bg & 63, og = o_idx * 64 + g;
        const bf16* TT = (const bf16*)(P.ws + WS_S5TT) + (size_t)og * 512 * 640; const bf16* T2 = (const bf16*)(P.ws + WS_S5T2) + (size_t)og * 128 * 512;
        __syncthreads();
        { const int row = tid >> 3, piece = tid & 7; const bf16* src = Ug + ((size_t)g * MT + (size_t)b * SEQ + 32 * row) * 16 + piece * 64;
#pragma unroll
          for (int q = 0; q < 8; ++q) *(LAS u32x4*)(uc + row * UP + (piece * 8 + q) * 16) = *(const u32x4*)(src + q * 8); }
        __syncthreads();
        {
            const int rt = wave & 1, ct = wave >> 1; f32x16 acc;
#pragma unroll
            for (int i = 0; i < 16; ++i) acc[i] = 0.f;
            const bf16* bp = T2 + (size_t)(32 * ct + r) * 512 + 8 * hh;
#pragma unroll 8
            for (int s = 0; s < 32; ++s) { const bf16x8v bf = *(const bf16x8v*)(bp + 16 * s); const bf16x8v af = *(const LAS bf16x8v*)(uc + (32 * rt + r) * UP + 32 * s + 16 * hh);
                acc = __builtin_amdgcn_mfma_f32_32x32x16_bf16(af, bf, acc, 0, 0, 0); }
#pragma unroll
            for (int i = 0; i < 16; ++i) eL[(32 * rt + (i & 3) + 8 * (i >> 2) + 4 * hh) * 128 + 32 * ct + r] = acc[i];
        }
        __syncthreads();
        if (wave == 0) { const f32x2 a32 = ((const f32x2*)(P.ws + WS_S5A32))[og * 64 + lane]; float hr = 0.f, hi = 0.f;
            for (int ch = 0; ch < 64; ++ch) { *(LAS unsigned short*)(uc + ch * UP + 1024 + lane * 2) = f2bf(hr); *(LAS unsigned short*)(uc + ch * UP + 1152 + lane * 2) = f2bf(hi);
                const float er = eL[ch * 128 + lane], ei = eL[ch * 128 + 64 + lane]; const float nr = a32[0] * hr - a32[1] * hi + er, ni = a32[0] * hi + a32[1] * hr + ei; hr = nr; hi = ni; } }
        __syncthreads();
        const float dsk = P.in[I_OD_D][o_idx * 1024 + g * 16 + (r & 15)];
#pragma unroll
        for (int cti = 0; cti < 2; ++cti) { const int ct = wave + 8 * cti; f32x16 acc0, acc1;
#pragma unroll
            for (int i = 0; i < 16; ++i) { acc0[i] = 0.f; acc1[i] = 0.f; }
            const bf16* bp = TT + (size_t)(32 * ct + r) * 640 + 8 * hh;
#pragma unroll 8
            for (int s = 0; s < 40; ++s) { const bf16x8v bf = *(const bf16x8v*)(bp + 16 * s);
                const bf16x8v a0 = *(const LAS bf16x8v*)(uc + r * UP + 32 * s + 16 * hh), a1 = *(const LAS bf16x8v*)(uc + (32 + r) * UP + 32 * s + 16 * hh);
                acc0 = __builtin_amdgcn_mfma_f32_32x32x16_bf16(a0, bf, acc0, 0, 0, 0); acc1 = __builtin_amdgcn_mfma_f32_32x32x16_bf16(a1, bf, acc1, 0, 0, 0); }
            const int n = 32 * ct + r, j = n >> 4, cp = n & 15;
#pragma unroll
            for (int rt = 0; rt < 2; ++rt)
#pragma unroll
                for (int i = 0; i < 16; ++i) { const int ch = 32 * rt + (i & 3) + 8 * (i >> 2) + 4 * hh; const float y = (rt ? acc1[i] : acc0[i]) + dsk * bf2f(*(const LAS unsigned short*)(uc + ch * UP + n * 2));
                    Z[((size_t)b * SEQ + 32 * ch + j) * 1024 + g * 16 + cp] = f2bf(gelu_tanh(y)); }
        }
    }
}

__device__ __forceinline__ void phase_lru(KP kp0, int kwave_, LAS unsigned char* lds, int e) { KPREF(P, kp0); PHASE_IDS();
    const bf16* XB = (const bf16*)(P.ws + WS_XB); const bf16* YB = (const bf16*)(P.ws + WS_YB); bf16* MIX = (bf16*)(P.ws + WS_MIX);
    LAS unsigned char* xcL = lds;
    LAS float* aL = (LAS float*)(lds + 69632); LAS float* bL = (LAS float*)(lds + 86016);
    LAS float* sA = (LAS float*)(lds + 102400); LAS float* sB = (LAS float*)(lds + 104448);
    LAS float* carry = (LAS float*)(lds + 106496);
    const int c16 = lane & 15, kq = lane >> 4, cg = tid & 15, rg = tid >> 4;
    for (int item = bx; item < 256; item += G) { const int b = item >> 6, blk = (item >> 3) & 7, oct = item & 7, ch0 = blk * 128 + oct * 16;
        float cw[4][8], cb[8];
#pragma unroll
        for (int q = 0; q < 8; ++q) { cb[q] = P.in[I_EV_CONV_B][e * 1024 + blk * 128 + cg * 8 + q];
#pragma unroll
            for (int i = 0; i < 4; ++i) cw[i][q] = P.in[I_EV_CONV_W][(size_t)(e * 4 + i) * 1024 + blk * 128 + cg * 8 + q]; }
        bf16x8v bfr[4], bfi[4];
        { const bf16* wg = (const bf16*)(P.ws + WS_WGATE) + ((size_t)(e * 8 + blk) * 256 + oct * 16 + c16) * 128 + 8 * kq;
#pragma unroll
          for (int s = 0; s < 4; ++s) { bfr[s] = *(const bf16x8v*)(wg + 32 * s); bfi[s] = *(const bf16x8v*)(wg + 128 * 128 + 32 * s); } }
        const float gab = P.in[I_EV_GA_B][e * 1024 + ch0 + c16], gxb = P.in[I_EV_GX_B][e * 1024 + ch0 + c16];
        const float sp8 = -8.0f * log1pf(expf(-P.in[I_EV_LAMBDA][e * 1024 + ch0 + c16]));
        if (tid < 16) carry[tid] = 0.f;
        for (int tc = 0; tc < 8; ++tc) { const int t0 = tc * 256;
            __syncthreads();
            {
                u32x4 xin[11];
#pragma unroll
                for (int i = 0; i < 11; ++i) { const int tt = t0 + 8 * rg - 3 + i;
                    xin[i] = (tt >= 0) ? *(const u32x4*)(XB + (size_t)(b * SEQ + tt) * 1024 + blk * 128 + cg * 8) : (u32x4){0u, 0u, 0u, 0u}; }
#pragma unroll
                for (int j = 0; j < 8; ++j) { float o[8];
#pragma unroll
                    for (int q = 0; q < 8; ++q) o[q] = cb[q];
#pragma unroll
                    for (int i = 0; i < 4; ++i) { const u32x4 x = xin[j + i];
                        o[0] += cw[i][0] * bf_lo(x.x); o[1] += cw[i][1] * bf_hi(x.x); o[2] += cw[i][2] * bf_lo(x.y); o[3] += cw[i][3] * bf_hi(x.y);
                        o[4] += cw[i][4] * bf_lo(x.z); o[5] += cw[i][5] * bf_hi(x.z); o[6] += cw[i][6] * bf_lo(x.w); o[7] += cw[i][7] * bf_hi(x.w); }
                    u32x4 w; w.x = cvt_pk_bf16(o[0], o[1]); w.y = cvt_pk_bf16(o[2], o[3]); w.z = cvt_pk_bf16(o[4], o[5]); w.w = cvt_pk_bf16(o[6], o[7]);
                    *(LAS u32x4*)(xcL + (8 * rg + j) * 272 + cg * 16) = w; }
            }
            __syncthreads();
#pragma unroll
            for (int rb = 0; rb < 2; ++rb) { const int row0 = 32 * wave + 16 * rb;
                f32x4 accr = {0.f, 0.f, 0.f, 0.f}, acci = {0.f, 0.f, 0.f, 0.f};
#pragma unroll
                for (int s = 0; s < 4; ++s) { const bf16x8v af = *(const LAS bf16x8v*)(xcL + (row0 + c16) * 272 + 64 * s + 16 * kq);
                    accr = __builtin_amdgcn_mfma_f32_16x16x32_bf16(af, bfr[s], accr, 0, 0, 0); acci = __builtin_amdgcn_mfma_f32_16x16x32_bf16(af, bfi[s], acci, 0, 0, 0); }
#pragma unroll
                for (int i = 0; i < 4; ++i) { const int row = row0 + 4 * kq + i;
                    const float rr = 1.0f / (1.0f + __expf(-(accr[i] + gab))), ig = 1.0f / (1.0f + __expf(-(acci[i] + gxb)));
                    const float a = __expf(sp8 * rr), mult = sqrtf(fmaxf(1.0f - a * a, 0.f));
                    const float xv = bf2f(*(const LAS unsigned short*)(xcL + row * 272 + (oct * 16 + c16) * 2));
                    aL[row * 16 + c16] = a; bL[row * 16 + c16] = mult * ig * xv; }
            }
            __syncthreads();
            float av[8], bv[8], A = 1.f, B = 0.f;
#pragma unroll
            for (int i = 0; i < 8; ++i) { av[i] = aL[(8 * rg + i) * 16 + cg]; bv[i] = bL[(8 * rg + i) * 16 + cg]; B = av[i] * B + bv[i]; A *= av[i]; }
            sA[rg * 16 + cg] = A; sB[rg * 16 + cg] = B;
            __syncthreads();
            float h = carry[cg];
            for (int j = 0; j < rg; ++j) h = sA[j * 16 + cg] * h + sB[j * 16 + cg];
#pragma unroll
            for (int i = 0; i < 8; ++i) { h = av[i] * h + bv[i]; const size_t row = (size_t)(b * SEQ + t0 + 8 * rg + i);
                MIX[row * 2048 + 1024 + ch0 + cg] = f2bf(h * bf2f(YB[row * 1024 + ch0 + cg])); }
            __syncthreads();
            if (rg == 31) carry[cg] = h;
        }
    }
}

constexpr int N_PHASES = 2 + 11 * NLAYER + 1;
#ifndef NREP_G
#define NREP_G 1
#endif
#ifndef NREP_M
#define NREP_M 1
#endif
#ifndef NREP_MB
#define NREP_MB 1
#endif
#ifndef NREP_BAR
#define NREP_BAR 1
#endif
#ifndef NREP_E
#define NREP_E 1
#endif
#ifndef NREP_P
#define NREP_P 1
#endif
#ifndef MK_ONE_LAUNCH
#define MK_ONE_LAUNCH 1
#endif
__global__ void __launch_bounds__(512, 2) fwd(Params P) {
    extern __shared__ __attribute__((aligned(16))) unsigned char lds_raw[];
    LAS unsigned char* lds = (LAS unsigned char*)lds_raw;
    const int kwave = __builtin_amdgcn_readfirstlane((int)threadIdx.x >> 6);
    for (int u = threadIdx.x; u < (LDS_BYTES - LDSCTL_OFF) / 4; u += 512) ((LAS unsigned*)(lds + LDSCTL_OFF))[u] = 0u;
    __syncthreads();
    const KP kp = (KP)__builtin_amdgcn_kernarg_segment_ptr();
    const int ph_lo = kp->lo, ph_hi = kp->hi;
    unsigned* barw = (unsigned*)(kp->ws + WS_CTL) + CW_BAR + kp->li * XCD_BAR_WORDS;
    XcdBarrier bar; bar.bar = barw; bar.x = 0; bar.w0 = 0u; bar.st = nullptr;
    if (ph_hi - ph_lo > 1) bar = xcd_barrier_post(barw, (volatile LAS unsigned*)(lds + LDSCTL_OFF + 64));
    bar.w0 = (kwave == 0) ? 1u : 0u;
#define RUN(p) (ph_lo <= (p) && (p) < ph_hi)
#define SEAM(p) do { if (RUN(p) && RUN((p) + 1)) for (int rb_ = 0; rb_ < NREP_BAR; ++rb_) xcd_barrier(bar); } while (0)

    if (RUN(0)) for (int rep = 0; rep < NREP_P; ++rep) phase_ada(kp, kwave, lds);
    SEAM(0);
    if (RUN(1)) for (int rep = 0; rep < NREP_P; ++rep) phase_prep(kp, kwave, lds);
    SEAM(1);
    for (int l = 0; l < NLAYER; ++l) {
        const int pb = 2 + 11 * l, e = l >> 1; const bool odd = (l & 1) != 0;
        if (RUN(pb + 0) && l == 0) for (int rep = 0; rep < NREP_E; ++rep) phase_norm0(kp, kwave);
        if (l == 0) SEAM(pb + 0);
        if (RUN(pb + 1)) for (int rep = 0; rep < NREP_G; ++rep) { KPREF(P, kp); const int kwave_ = kwave; PHASE_IDS(); const bf16* H = (const bf16*)(P.ws + WS_H); bf16* Qb = (bf16*)(P.ws + WS_Q);
            if (!odd) { pg8::Gemm g{H, (const bf16*)(P.ws + WS_W_EVIN) + (size_t)e * EVEN_IN * DM, MT, EVEN_IN, DM}; pg8::StaticOrder S; S.init(MT, EVEN_IN, G, bx);
                pg8::EpiEvenIn E{Qb, (const float*)(P.ws + WS_COSA), (const float*)(P.ws + WS_SINA), QSCALE_A, (const float*)(P.ws + WS_SS) + (size_t)(2 * l) * MT * 32, (const float*)(P.ws + WS_CVEC) + CV_EVIN + (size_t)e * 4 * EVEN_IN, (LAS float*)(lds + RING_BYTES + 6144)};
                pg8::gemm_phase<pg8::EpiEvenIn, pg8::StaticOrder, true, true>(lds, g, S, E, tid); }
            else { pg8::Gemm g{H, (const bf16*)(P.ws + WS_W_ODIN) + (size_t)e * ODD_IN * DM, MT, ODD_IN, DM}; pg8::StaticOrder S; S.init(MT, ODD_IN, G, bx);
                pg8::EpiOddIn E{Qb, (bf16*)(P.ws + WS_K), (bf16*)(P.ws + WS_V), (bf16*)(P.ws + WS_XB), (const float*)(P.ws + WS_COSC), (const float*)(P.ws + WS_SINC), QSCALE_C, (const float*)(P.ws + WS_SS) + (size_t)(2 * l) * MT * 32, (const float*)(P.ws + WS_CVEC) + CV_ODIN + (size_t)e * 4 * ODD_IN, (LAS float*)(lds + RING_BYTES + 6144)};
                pg8::gemm_phase<pg8::EpiOddIn, pg8::StaticOrder, true, true>(lds, g, S, E, tid); }
        }
        SEAM(pb + 1);
        if (RUN(pb + 2)) for (int rep = 0; rep < NREP_M; ++rep) { if (!odd) phase_attn<0>(kp, kwave, lds, 0); else phase_attn<1>(kp, kwave, lds, e); }
        if (RUN(pb + 3)) for (int rep = 0; rep < (odd ? NREP_MB : 1); ++rep) { if (!odd) phase_lru(kp, kwave, lds, e); else phase_s5(kp, kwave, lds, e); }
        SEAM(pb + 3);
        if (RUN(pb + 4)) {
            if (odd) for (int rep = 0; rep < NREP_G; ++rep) { KPREF(P, kp); const int kwave_ = kwave; PHASE_IDS(); const bf16* YBb = (const bf16*)(P.ws + WS_YB); bf16* MIX = (bf16*)(P.ws + WS_MIX); pg8::Gemm g{YBb, (const bf16*)(P.ws + WS_W_GLU) + (size_t)e * 1024 * 1024, MT, 1024, 1024}; pg8::StaticOrder S; S.init(MT, 1024, G, bx);
                pg8::EpiGlu E{YBb, MIX, P.in[I_OD_GLU_B] + e * 1024};
                pg8::gemm_phase<pg8::EpiGlu, pg8::StaticOrder, true, true>(lds, g, S, E, tid); }
        }
        if (odd) SEAM(pb + 4);
        if (RUN(pb + 6)) for (int rep = 0; rep < NREP_G; ++rep) { KPREF(P, kp); const int kwave_ = kwave; PHASE_IDS(); const bf16* MIX = (const bf16*)(P.ws + WS_MIX); const float* mod = (const float*)(P.ws + WS_MOD);
            const bf16* W = odd ? (const bf16*)(P.ws + WS_W_ODOUT) + (size_t)e * DM * DM : (const bf16*)(P.ws + WS_W_EVOUT) + (size_t)e * DM * DM;
            pg8::Gemm g{MIX, W, MT, DM, DM}; pg8::StaticOrder S; S.init(MT, DM, G, bx);
            pg8::EpiResid E{l == 0 ? P.in[I_X] : P.out, rep + 1 < NREP_G ? (float*)(P.ws + 710 * MiB) : P.out, mod + (size_t)l * 4 * 12288 + 2 * DM, rep + 1 < NREP_G ? nullptr : (bf16*)(P.ws + WS_H), P.in[I_NORM_FFN] + l * DM, mod + (size_t)l * 4 * 12288 + 4 * DM, (float*)(P.ws + WS_SS) + (size_t)(2 * l + 1) * MT * 32};
            pg8::gemm_phase<pg8::EpiResid, pg8::StaticOrder, true, true>(lds, g, S, E, tid);
        }
        SEAM(pb + 6);
        if (RUN(pb + 8)) for (int rep = 0; rep < NREP_G; ++rep) { KPREF(P, kp); const int kwave_ = kwave; PHASE_IDS(); const bf16* H = (const bf16*)(P.ws + WS_H);
            pg8::Gemm g{H, (const bf16*)(P.ws + WS_W_FFIN) + (size_t)l * DFF2 * DM, MT, DFF2, DM}; pg8::StaticOrder S; S.init(MT, DFF2, G, bx);
            pg8::EpiFfnIn E{(bf16*)(P.ws + WS_ACT), (float*)(P.ws + WS_HALO_F), (float*)(P.ws + WS_HALO_L), P.in[I_FFN_CONV_W] + (size_t)l * 3 * DFF2, P.in[I_FFN_CONV_B] + (size_t)l * DFF2, (LAS float*)(lds + RING_BYTES), (const float*)(P.ws + WS_SS) + (size_t)(2 * l + 1) * MT * 32, (const float*)(P.ws + WS_CVEC) + CV_FFIN + (size_t)l * 4 * DFF2};
            pg8::gemm_phase<pg8::EpiFfnIn, pg8::StaticOrder, true, true>(lds, g, S, E, tid);
        }
        SEAM(pb + 8);
        if (RUN(pb + 10)) for (int rep = 0; rep < NREP_G; ++rep) { KPREF(P, kp); const int kwave_ = kwave; PHASE_IDS(); const bf16* ACT = (const bf16*)(P.ws + WS_ACT); const float* mod = (const float*)(P.ws + WS_MOD);
            pg8::Gemm g{ACT, (const bf16*)(P.ws + WS_W_FFOUT) + (size_t)l * DM * DFF, MT, DM, DFF}; pg8::StaticOrder S; S.init(MT, DM, G, bx);
            { pg8::Unit fu; int lastpm = -1; for (int i = 0; S.next(i, fu); ++i) if (fu.pm != lastpm) { lastpm = fu.pm;
                ffn_fix_panel((const float*)(P.ws + WS_HALO_F), (const float*)(P.ws + WS_HALO_L), (bf16*)(P.ws + WS_ACT), P.in[I_FFN_CONV_W] + (size_t)l * 3 * DFF2, P.in[I_FFN_CONV_B] + (size_t)l * DFF2, fu.pm, tid); }
              asm volatile("s_waitcnt vmcnt(0)" ::: "memory"); __syncthreads(); }
            pg8::EpiResid E{P.out, rep + 1 < NREP_G ? (float*)(P.ws + 710 * MiB) : P.out, mod + (size_t)l * 4 * 12288 + 5 * DM, (rep + 1 < NREP_G || l == NLAYER - 1) ? nullptr : (bf16*)(P.ws + WS_H), P.in[I_NORM_MIX] + (l + 1 < NLAYER ? l + 1 : l) * DM, mod + (size_t)(l + 1 < NLAYER ? l + 1 : l) * 4 * 12288 + DM, (float*)(P.ws + WS_SS) + (size_t)(2 * l + 2) * MT * 32};
            pg8::gemm_phase<pg8::EpiResid, pg8::StaticOrder, true, true>(lds, g, S, E, tid);
        }
        SEAM(pb + 10);
    }
    if (RUN(N_PHASES - 1)) phase_final(kp, kwave);
#undef RUN
#undef SEAM
}

extern "C" void kernel_launch(void* const* d_in, const int* in_sizes, int n_in, void* d_out, int out_size, void* d_ws, size_t ws_size, hipStream_t stream) {
    static int grid = 0;
    if (grid == 0) {
        if (n_in != N_INPUTS || out_size != MT * DM || ws_size < WS_END) { fprintf(stderr, "kernel_launch: unexpected shapes: n_in %d out %d ws %zu (need %zu)\n", n_in, out_size, ws_size, (size_t)WS_END); grid = -1; return; }
        int dev = 0, cus = 0, per_cu = 0;
        if (hipGetDevice(&dev) != hipSuccess || hipDeviceGetAttribute(&cus, hipDeviceAttributeMultiprocessorCount, dev) != hipSuccess) { grid = -1; return; }
        if (hipFuncSetAttribute((const void*)fwd, hipFuncAttributeMaxDynamicSharedMemorySize, LDS_BYTES) != hipSuccess) { fprintf(stderr, "kernel_launch: hipFuncSetAttribute failed\n"); grid = -1; return; }
        if (hipOccupancyMaxActiveBlocksPerMultiprocessor(&per_cu, (const void*)fwd, 512, LDS_BYTES) != hipSuccess || per_cu < 1) fprintf(stderr, "kernel_launch: occupancy query says %d\n", per_cu);
        (void)hipGetLastError();
        grid = cus;
    }
    if (grid < 0) return;
    if (hipMemsetAsync((char*)d_ws + WS_CTL, 0, CTL_ZERO_BYTES, stream) != hipSuccess) return;
    Params p{};
    for (int i = 0; i < N_INPUTS; ++i) p.in[i] = (const float*)d_in[i];
    p.out = (float*)d_out; p.ws = (unsigned char*)d_ws; p.pad = 0;
#if MK_ONE_LAUNCH
    p.lo = 0; p.hi = N_PHASES; p.li = 0;
    hipLaunchKernelGGL(fwd, dim3(grid), dim3(512), LDS_BYTES, stream, p);
#else
    for (int ph = 0; ph < N_PHASES; ++ph) { p.lo = ph; p.hi = ph + 1; p.li = 0; hipLaunchKernelGGL(fwd, dim3(grid), dim3(512), LDS_BYTES, stream, p); }
#endif
    const hipError_t le = hipPeekAtLastError();
    if (le != hipSuccess) fprintf(stderr, "kernel_launch: launch failed: %s\n", hipGetErrorName(le));
}
```

```cpp
#include <hip/hip_runtime.h>
#include <cstdio>
#include <cstdint>
namespace pg8 {
#define PG8_LAS __attribute__((address_space(3)))
typedef unsigned short bf16_t;
typedef short bf16x8 __attribute__((ext_vector_type(8)));
typedef float f32x4 __attribute__((ext_vector_type(4)));
typedef unsigned u32x4 __attribute__((ext_vector_type(4)));
typedef unsigned u32x2 __attribute__((ext_vector_type(2)));
constexpr int BM = 256, BK = 64, HALF = 128, HTB = HALF * BK * 2  , STAGE_BYTES = 8 * HTB, NXCD = 8, WGM = 8;

__host__ __device__ __forceinline__ int lds_byte(int r, int c) { const int st = (r >> 4) * 2 + (c >> 5), rr = r & 15, cc = c & 31, ob = rr * 64 + cc * 2; return st * 1024 + (ob ^ (((ob >> 9) & 1) << 5)); }
__host__ __device__ __forceinline__ void stage_rc(int b, int& R, int& C) { const int st = b / 1024, sb = b % 1024, swz = sb ^ (((sb >> 9) & 1) << 5); R = (st >> 1) * 16 + swz / 64; C = (st & 1) * 32 + (swz % 64) / 2; }
__host__ __device__ __forceinline__ int perm32(int rho) { const int n = rho >> 4, i = rho & 15; return 8 * (i >> 2) + 4 * n + (i & 3); }

struct Unit { int pm, pn; };
struct Gemm { const bf16_t* A; const bf16_t* Bt; int M, N, K; };

struct StaticOrder {
    int nM, nN, nwg, G, c;
    __host__ __device__ __forceinline__ void init(int M, int N, int G_, int c_) { nM = M / BM; nN = N / BM; nwg = nM * nN; G = G_; c = c_; }
    __host__ __device__ __forceinline__ bool next(int i, Unit& u) const {
        const long L = (long)i * G + c; if (L >= nwg) return false;
        int wgid = (int)L; { const int q = nwg / NXCD, r = nwg % NXCD, xcd = wgid % NXCD, off = wgid / NXCD; wgid = (xcd < r ? xcd * (q + 1) : r * (q + 1) + (xcd - r) * q) + off; }
        const int nig = WGM * nN, gid = wgid / nig, fm = gid * WGM, gsz = (nM - fm) < WGM ? (nM - fm) : WGM;
        u.pm = fm + ((wgid % nig) % gsz); u.pn = (wgid % nig) / gsz; return true;
    }
    __device__ __forceinline__ void a_ready(const Unit&) const {}
    __device__ __forceinline__ void done(const Unit&) const {}
};

__device__ __forceinline__ unsigned cvt_pk_bf16(float lo, float hi) { unsigned r; asm volatile("v_cvt_pk_bf16_f32 %0, %1, %2" : "=v"(r) : "v"(lo), "v"(hi)); return r; }
__device__ __forceinline__ u32x4 pack8(const f32x4 a, const f32x4 b) { u32x4 w; w.x = cvt_pk_bf16(a[0], a[1]); w.y = cvt_pk_bf16(a[2], a[3]); w.z = cvt_pk_bf16(b[0], b[1]); w.w = cvt_pk_bf16(b[2], b[3]); return w; }
__device__ __forceinline__ float bf_lo(unsigned w) { return __uint_as_float(w << 16); }
__device__ __forceinline__ float bf_hi(unsigned w) { return __uint_as_float(w & 0xffff0000u); }
__device__ __forceinline__ float gelu_tanh(float x) {
    const float u = x * (0.7978845608f + 0.0356774081f * x * x);
    const float e = __builtin_amdgcn_exp2f(-2.885390082f * u);
    return x * __builtin_amdgcn_rcpf(1.0f + e);
}
__device__ __forceinline__ f32x4 gelu4(const f32x4 v) { return (f32x4){gelu_tanh(v[0]), gelu_tanh(v[1]), gelu_tanh(v[2]), gelu_tanh(v[3])}; }
__device__ __forceinline__ float sigmoidf_fast(float x) { return __builtin_amdgcn_rcpf(1.0f + __builtin_amdgcn_exp2f(-1.4426950409f * x)); }

__device__ __forceinline__ void build_rtab(const float* ssp, int row_base, PG8_LAS float* rtab, int wr, int wc, int fr, int fq) {
    const int t = (wr * 4 + wc) * 64 + fq * 16 + fr, row = t >> 1, hf = t & 1; const float* p = ssp + (size_t)(row_base + row) * 32 + 16 * hf;
    const f32x4 p0 = *(const f32x4*)p, p1 = *(const f32x4*)(p + 4), p2 = *(const f32x4*)(p + 8), p3 = *(const f32x4*)(p + 12);
    float s = (((p0[0] + p0[1]) + (p0[2] + p0[3])) + ((p1[0] + p1[1]) + (p1[2] + p1[3]))) + (((p2[0] + p2[1]) + (p2[2] + p2[3])) + ((p3[0] + p3[1]) + (p3[2] + p3[3])));
    s += __shfl_xor(s, 1);
    if (hf == 0) rtab[row] = rsqrtf(s * (1.0f / 2048.0f) + 1e-6f);
    asm volatile("s_waitcnt lgkmcnt(0)" ::: "memory"); __builtin_amdgcn_s_barrier(); asm volatile("" ::: "memory");
}

struct EpiStore {
    static constexpr bool PERM = true, AFTER_DRAIN = false;
    bf16_t* O; int ldc;
    __device__ __forceinline__ void operator()(const f32x4 (&acc)[2][2][4][2], const Unit& u, int wr, int wc, int fr, int fq) const {
        const int row0 = u.pm * BM + wr * 64 + fr, col0 = u.pn * BM + wc * 32 + 8 * fq;
#pragma unroll
        for (int ai = 0; ai < 2; ++ai)
#pragma unroll
            for (int m = 0; m < 4; ++m) { bf16_t* rowp = O + (size_t)(row0 + ai * HALF + m * 16) * ldc + col0;
#pragma unroll
                for (int bj = 0; bj < 2; ++bj) *(u32x4*)(rowp + bj * HALF) = pack8(acc[ai][bj][m][0], acc[ai][bj][m][1]); }
    }
};

struct EpiEvenIn {
    static constexpr bool PERM = true, AFTER_DRAIN = false;
    bf16_t *Q; const float *cosT, *sinT; float qscale; const float *ss, *cv; PG8_LAS float* rtab;
    __device__ __forceinline__ void operator()(const f32x4 (&acc)[2][2][4][2], const Unit& u, int wr, int wc, int fr, int fq) const {
        const int row0 = u.pm * BM + wr * 64 + fr;
        build_rtab(ss, u.pm * BM, rtab, wr, wc, fr, fq);
        f32x4 cv4[2][2];
#pragma unroll
        for (int bj = 0; bj < 2; ++bj)
#pragma unroll
            for (int n = 0; n < 2; ++n) cv4[bj][n] = *(const f32x4*)(cv + (size_t)(u.pm >> 3) * 5120 + u.pn * BM + bj * HALF + wc * 32 + 8 * fq + 4 * n);
        if (u.pn < 8) {
            bf16_t* dst = Q + (size_t)(u.pn >> 2) * (8u << 20); const float sc = (u.pn < 4) ? qscale : 1.0f;
            const int head = (u.pn & 3) * 2 + (wc >> 1), i0 = (wc & 1) * 32 + 8 * fq;
#pragma unroll
            for (int ai = 0; ai < 2; ++ai) {
#pragma unroll
              for (int mh = 0; mh < 2; ++mh) {
                f32x4 cs[2][4];
#pragma unroll
                for (int m2 = 0; m2 < 2; ++m2) { const int m = m2; const size_t tr = (size_t)(row0 + ai * HALF + (2 * mh + m2) * 16) * 64 + i0;
                    cs[m][0] = *(const f32x4*)(cosT + tr); cs[m][1] = *(const f32x4*)(cosT + tr + 4); cs[m][2] = *(const f32x4*)(sinT + tr); cs[m][3] = *(const f32x4*)(sinT + tr + 4); }
#pragma unroll
                for (int m2 = 0; m2 < 2; ++m2) { const int m = 2 * mh + m2; const int row = row0 + ai * HALF + m * 16; const float rrm = rtab[wr * 64 + ai * HALF + m * 16 + fr];
                    const f32x4 c0 = cs[m2][0], c1 = cs[m2][1], s0 = cs[m2][2], s1 = cs[m2][3];
                    const f32x4 a0 = acc[ai][0][m][0] * rrm + cv4[0][0], a1 = acc[ai][0][m][1] * rrm + cv4[0][1], b0 = acc[ai][1][m][0] * rrm + cv4[1][0], b1 = acc[ai][1][m][1] * rrm + cv4[1][1];
                    const f32x4 o10 = (a0 * c0 - b0 * s0) * sc, o11 = (a1 * c1 - b1 * s1) * sc, o20 = (b0 * c0 + a0 * s0) * sc, o21 = (b1 * c1 + a1 * s1) * sc;
                    bf16_t* rp = dst + (size_t)row * 1024 + head * 128 + i0;
                    *(u32x4*)(rp) = pack8(o10, o11); *(u32x4*)(rp + 64) = pack8(o20, o21); } } }
        } else {
            const int sel = (u.pn - 8) >> 2; bf16_t* dst = Q + (size_t)(u.pn >> 2) * (8u << 20); const int col0 = (u.pn & 3) * 256 + wc * 32 + 8 * fq;
#pragma unroll
            for (int ai = 0; ai < 2; ++ai)
#pragma unroll
                for (int m = 0; m < 4; ++m) { bf16_t* rowp = dst + (size_t)(row0 + ai * HALF + m * 16) * 1024 + col0; const float rrm = rtab[wr * 64 + ai * HALF + m * 16 + fr];
#pragma unroll
                    for (int bj = 0; bj < 2; ++bj) { f32x4 v0 = acc[ai][bj][m][0] * rrm + cv4[bj][0], v1 = acc[ai][bj][m][1] * rrm + cv4[bj][1];
                        if (sel == 2) { v0 = gelu4(v0); v1 = gelu4(v1); }
                        *(u32x4*)(rowp + bj * HALF) = pack8(v0, v1); } }
        }
    }
};

struct EpiOddIn {
    static constexpr bool PERM = true, AFTER_DRAIN = false;
    bf16_t *Q, *K, *V, *U; const float *cosT, *sinT; float qscale; const float *ss, *cv; PG8_LAS float* rtab;
    __device__ __forceinline__ void operator()(const f32x4 (&acc)[2][2][4][2], const Unit& u, int wr, int wc, int fr, int fq) const {
        const int row0 = u.pm * BM + wr * 64 + fr;
        build_rtab(ss, u.pm * BM, rtab, wr, wc, fr, fq);
        f32x4 cv4[2][2];
#pragma unroll
        for (int bj = 0; bj < 2; ++bj)
#pragma unroll
            for (int n = 0; n < 2; ++n) cv4[bj][n] = *(const f32x4*)(cv + (size_t)(u.pm >> 3) * 2304 + u.pn * BM + bj * HALF + wc * 32 + 8 * fq + 4 * n);
        if (u.pn < 4 || (u.pn == 4 && wc < 2)) {
            const bool isq = u.pn < 4; const float sc = isq ? qscale : 1.0f;
            bf16_t* dst = isq ? Q + (u.pn * 4 + wc) * 64 : K + wc * 64; const int pitch = isq ? 1024 : 128;
#pragma unroll
            for (int ai = 0; ai < 2; ++ai) {
#pragma unroll
              for (int mh = 0; mh < 2; ++mh) {
                f32x4 cs[2][4];
#pragma unroll
                for (int m2 = 0; m2 < 2; ++m2) { const int m = m2; const size_t tr = (size_t)(row0 + ai * HALF + (2 * mh + m2) * 16) * 32 + 8 * fq;
                    cs[m][0] = *(const f32x4*)(cosT + tr); cs[m][1] = *(const f32x4*)(cosT + tr + 4); cs[m][2] = *(const f32x4*)(sinT + tr); cs[m][3] = *(const f32x4*)(sinT + tr + 4); }
#pragma unroll
                for (int m2 = 0; m2 < 2; ++m2) { const int m = 2 * mh + m2; const int row = row0 + ai * HALF + m * 16; const float rrm = rtab[wr * 64 + ai * HALF + m * 16 + fr];
                    const f32x4 c0 = cs[m2][0], c1 = cs[m2][1], s0 = cs[m2][2], s1 = cs[m2][3];
                    const f32x4 a0 = acc[ai][0][m][0] * rrm + cv4[0][0], a1 = acc[ai][0][m][1] * rrm + cv4[0][1], b0 = acc[ai][1][m][0] * rrm + cv4[1][0], b1 = acc[ai][1][m][1] * rrm + cv4[1][1];
                    const f32x4 o10 = (a0 * c0 - b0 * s0) * sc, o11 = (a1 * c1 - b1 * s1) * sc, o20 = (b0 * c0 + a0 * s0) * sc, o21 = (b1 * c1 + a1 * s1) * sc;
                    bf16_t* rp = dst + (size_t)row * pitch + 8 * fq;
                    *(u32x4*)(rp) = pack8(o10, o11); *(u32x4*)(rp + 32) = pack8(o20, o21); } } }
        } else if (u.pn == 4) {
#pragma unroll
            for (int ai = 0; ai < 2; ++ai)
#pragma unroll
                for (int m = 0; m < 4; ++m) { bf16_t* rowp = V + (size_t)(row0 + ai * HALF + m * 16) * 128 + (wc - 2) * 32 + 8 * fq; const float rrm = rtab[wr * 64 + ai * HALF + m * 16 + fr];
#pragma unroll
                    for (int bj = 0; bj < 2; ++bj) *(u32x4*)(rowp + bj * 64) = pack8(acc[ai][bj][m][0] * rrm + cv4[bj][0], acc[ai][bj][m][1] * rrm + cv4[bj][1]); }
        } else {
            const int col0 = (u.pn - 5) * 256 + wc * 32 + 8 * fq;
#pragma unroll
            for (int ai = 0; ai < 2; ++ai)
#pragma unroll
                for (int m = 0; m < 4; ++m) { bf16_t* rowp = U + ((size_t)(col0 >> 4) * 8192 + (size_t)(row0 + ai * HALF + m * 16)) * 16 + (col0 & 8); const float rrm = rtab[wr * 64 + ai * HALF + m * 16 + fr];
#pragma unroll
                    for (int bj = 0; bj < 2; ++bj) *(u32x4*)(rowp + (size_t)bj * 8 * 8192 * 16) = pack8(acc[ai][bj][m][0] * rrm + cv4[bj][0], acc[ai][bj][m][1] * rrm + cv4[bj][1]); }
        }
    }
};

struct EpiResid {
    static constexpr bool PERM = true, AFTER_DRAIN = false;
    const float* base; float* out; const float* gate; bf16_t* Hn; const float* gn; const float* scn; float* ssn;
    __device__ __forceinline__ void operator()(const f32x4 (&acc)[2][2][4][2], const Unit& u, int wr, int wc, int fr, int fq) const {
        const int row0 = u.pm * BM + wr * 64 + fr, col0 = u.pn * BM + wc * 32 + 8 * fq; const float* gp = gate + (size_t)(u.pm >> 3) * 12288 + col0;
        f32x4 gv[2][2], an[2][2];
#pragma unroll
        for (int bj = 0; bj < 2; ++bj)
#pragma unroll
            for (int n = 0; n < 2; ++n) { gv[bj][n] = *(const f32x4*)(gp + bj * HALF + n * 4);
                an[bj][n] = Hn ? *(const f32x4*)(gn + col0 + bj * HALF + n * 4) * (1.0f + *(const f32x4*)(scn + (size_t)(u.pm >> 3) * 12288 + col0 + bj * HALF + n * 4)) : (f32x4){0.f, 0.f, 0.f, 0.f}; }
#pragma unroll
        for (int ai = 0; ai < 2; ++ai) {
#pragma unroll
          for (int mh = 0; mh < 2; ++mh) {
            f32x4 bs[2][2][2];
#pragma unroll
            for (int m2 = 0; m2 < 2; ++m2) { const size_t off = (size_t)(row0 + ai * HALF + (2 * mh + m2) * 16) * 2048 + col0;
#pragma unroll
                for (int bj = 0; bj < 2; ++bj) { bs[m2][bj][0] = *(const f32x4*)(base + off + bj * HALF); bs[m2][bj][1] = *(const f32x4*)(base + off + bj * HALF + 4); } }
#pragma unroll
            for (int m2 = 0; m2 < 2; ++m2) { const int m = 2 * mh + m2; const int row = row0 + ai * HALF + m * 16; const size_t off = (size_t)row * 2048 + col0; float s2 = 0.f;
#pragma unroll
                for (int bj = 0; bj < 2; ++bj) {
                    const f32x4 o0 = bs[m2][bj][0] + gv[bj][0] * acc[ai][bj][m][0], o1 = bs[m2][bj][1] + gv[bj][1] * acc[ai][bj][m][1];
                    *(f32x4*)(out + off + bj * HALF) = o0; *(f32x4*)(out + off + bj * HALF + 4) = o1;
                    if (Hn) { s2 += ((o0[0] * o0[0] + o0[1] * o0[1]) + (o0[2] * o0[2] + o0[3] * o0[3])) + ((o1[0] * o1[0] + o1[1] * o1[1]) + (o1[2] * o1[2] + o1[3] * o1[3]));
                        *(u32x4*)(Hn + off + bj * HALF) = pack8(o0 * an[bj][0], o1 * an[bj][1]); } }
                if (Hn) { s2 += __shfl_xor(s2, 16); s2 += __shfl_xor(s2, 32); if (fq == 0) ssn[(size_t)row * 32 + u.pn * 4 + wc] = s2; }
            }
          }
        }
    }
};

struct EpiGlu {
    static constexpr bool PERM = true, AFTER_DRAIN = false;
    const bf16_t* Z; bf16_t* MIX; const float* gb;
    __device__ __forceinline__ void operator()(const f32x4 (&acc)[2][2][4][2], const Unit& u, int wr, int wc, int fr, int fq) const {
        const int row0 = u.pm * BM + wr * 64 + fr, col0 = u.pn * BM + wc * 32 + 8 * fq;
        f32x4 bv[2][2];
#pragma unroll
        for (int bj = 0; bj < 2; ++bj)
#pragma unroll
            for (int n = 0; n < 2; ++n) bv[bj][n] = *(const f32x4*)(gb + col0 + bj * HALF + 4 * n);
#pragma unroll
        for (int ai = 0; ai < 2; ++ai) {
#pragma unroll
          for (int mh = 0; mh < 2; ++mh) {
            u32x4 zq[2][2];
#pragma unroll
            for (int m2 = 0; m2 < 2; ++m2)
#pragma unroll
                for (int bj = 0; bj < 2; ++bj) zq[m2][bj] = *(const u32x4*)(Z + (size_t)(row0 + ai * HALF + (2 * mh + m2) * 16) * 1024 + col0 + bj * HALF);
#pragma unroll
            for (int m2 = 0; m2 < 2; ++m2) { const int m = 2 * mh + m2; const size_t row = (size_t)(row0 + ai * HALF + m * 16);
#pragma unroll
                for (int bj = 0; bj < 2; ++bj) { const u32x4 zr = zq[m2][bj];
                    const f32x4 v0 = acc[ai][bj][m][0] + bv[bj][0], v1 = acc[ai][bj][m][1] + bv[bj][1];
                    const f32x4 z0 = (f32x4){bf_lo(zr.x), bf_hi(zr.x), bf_lo(zr.y), bf_hi(zr.y)}, z1 = (f32x4){bf_lo(zr.z), bf_hi(zr.z), bf_lo(zr.w), bf_hi(zr.w)};
                    const f32x4 o0 = (f32x4){z0[0] * sigmoidf_fast(v0[0]), z0[1] * sigmoidf_fast(v0[1]), z0[2] * sigmoidf_fast(v0[2]), z0[3] * sigmoidf_fast(v0[3])};
                    const f32x4 o1 = (f32x4){z1[0] * sigmoidf_fast(v1[0]), z1[1] * sigmoidf_fast(v1[1]), z1[2] * sigmoidf_fast(v1[2]), z1[3] * sigmoidf_fast(v1[3])};
                    *(u32x4*)(MIX + row * 2048 + 1024 + col0 + bj * HALF) = pack8(o0, o1); } } } }
    }
};

__device__ __forceinline__ float dpp_ror1(float v) { return __builtin_bit_cast(float, __builtin_amdgcn_update_dpp(0, __builtin_bit_cast(int, v), 0x121, 0xf, 0xf, false)); }
__device__ __forceinline__ float dpp_ror2(float v) { return __builtin_bit_cast(float, __builtin_amdgcn_update_dpp(0, __builtin_bit_cast(int, v), 0x122, 0xf, 0xf, false)); }
__device__ __forceinline__ float dpp_shr1(float old, float v) { return __builtin_bit_cast(float, __builtin_amdgcn_update_dpp(__builtin_bit_cast(int, old), __builtin_bit_cast(int, v), 0x111, 0xf, 0xf, false)); }
__device__ __forceinline__ float dpp_shr2(float old, float v) { return __builtin_bit_cast(float, __builtin_amdgcn_update_dpp(__builtin_bit_cast(int, old), __builtin_bit_cast(int, v), 0x112, 0xf, 0xf, false)); }
struct EpiFfnIn {
    static constexpr bool PERM = true, AFTER_DRAIN = false;
    bf16_t* ACT; float* halo_first; float* halo_last; const float* cw; const float* cb; PG8_LAS float* exch; const float *ss, *cv;
    __device__ __forceinline__ void operator()(f32x4 (&acc)[2][2][4][2], const Unit& u, int wr, int wc, int fr, int fq) const {
        asm volatile("" : "+v"(fr), "+v"(fq));
        const int jj0 = wc * 32 + 8 * fq, jcol = u.pn * 128 + jj0;
        build_rtab(ss, u.pm * BM, exch + 1536, wr, wc, fr, fq);
        {
            f32x4 cv4[2][2];
#pragma unroll
            for (int bj = 0; bj < 2; ++bj)
#pragma unroll
                for (int n = 0; n < 2; ++n) cv4[bj][n] = *(const f32x4*)(cv + (size_t)(u.pm >> 3) * 11008 + u.pn * BM + bj * HALF + jj0 + 4 * n);
#pragma unroll
            for (int ai = 0; ai < 2; ++ai)
#pragma unroll
                for (int m = 0; m < 4; ++m) { const float r = exch[1536 + ai * HALF + wr * 64 + m * 16 + fr];
#pragma unroll
                    for (int bj = 0; bj < 2; ++bj)
#pragma unroll
                        for (int n = 0; n < 2; ++n) acc[ai][bj][m][n] = acc[ai][bj][m][n] * r + cv4[bj][n]; }
        }
        if (fr >= 14) { const int r2 = fr - 14;
#pragma unroll
            for (int bj = 0; bj < 2; ++bj)
#pragma unroll
                for (int n = 0; n < 2; ++n) {
                    *(PG8_LAS f32x4*)(exch + ((wr * 2 + r2) * 2 + bj) * 128 + jj0 + 4 * n) = acc[0][bj][3][n];
                    if (wr == 0) *(PG8_LAS f32x4*)(exch + ((2 * 2 + r2) * 2 + bj) * 128 + jj0 + 4 * n) = acc[1][bj][3][n];
                    else *(f32x4*)(halo_last + ((size_t)(u.pm * 2 + r2) * 2 + bj) * 5504 + jcol + 4 * n) = acc[1][bj][3][n];
                } }
        if (wr == 0 && fr < 2) {
#pragma unroll
            for (int bj = 0; bj < 2; ++bj)
#pragma unroll
                for (int n = 0; n < 2; ++n) *(f32x4*)(halo_first + ((size_t)(u.pm * 2 + fr) * 2 + bj) * 5504 + jcol + 4 * n) = acc[0][bj][0][n]; }
        asm volatile("s_waitcnt lgkmcnt(0)" ::: "memory"); __builtin_amdgcn_s_barrier(); asm volatile("" ::: "memory");
        const bool seq_start = (u.pm & 7) == 0;
#pragma unroll
        for (int n = 0; n < 2; ++n) {
            f32x4 w0[2], w1[2], w2[2], bb[2];
#pragma unroll
            for (int bj = 0; bj < 2; ++bj) { const int col = bj * 5504 + jcol + 4 * n;
                w0[bj] = *(const f32x4*)(cw + col); w1[bj] = *(const f32x4*)(cw + 11008 + col); w2[bj] = *(const f32x4*)(cw + 22016 + col); bb[bj] = *(const f32x4*)(cb + col); }
#pragma unroll
            for (int ai = 0; ai < 2; ++ai) {
                f32x4 prev[2];
                const int slot = 2 * ai + wr - 1;
#pragma unroll
                for (int bj = 0; bj < 2; ++bj) prev[bj] = (slot >= 0) ? *(const PG8_LAS f32x4*)(exch + ((slot * 2 + (fr & 1)) * 2 + bj) * 128 + jj0 + 4 * n) : (f32x4){0.f, 0.f, 0.f, 0.f};
#pragma unroll
                for (int m = 0; m < 4; ++m) {
                    f32x4 cv[2];
#pragma unroll
                    for (int bj = 0; bj < 2; ++bj) { const f32x4 cur = acc[ai][bj][m][n]; f32x4 o;
#pragma unroll
                        for (int q = 0; q < 4; ++q) { const float um1 = dpp_shr1(dpp_ror1(prev[bj][q]), cur[q]), um2 = dpp_shr2(dpp_ror2(prev[bj][q]), cur[q]);
                            o[q] = bb[bj][q] + w0[bj][q] * um2 + w1[bj][q] * um1 + w2[bj][q] * cur[q]; }
                        cv[bj] = o; prev[bj] = cur; }
                    const f32x4 o0 = gelu4(cv[0]) * cv[1];
                    const bool skip = (ai == 0 && m == 0) && wr == 0 && fr < 2 && !seq_start;
                    if (!skip) { u32x2 w; w.x = cvt_pk_bf16(o0[0], o0[1]); w.y = cvt_pk_bf16(o0[2], o0[3]); *(u32x2*)(ACT + (size_t)(u.pm * BM + ai * HALF + wr * 64 + m * 16 + fr) * 5504 + jcol + 4 * n) = w; }
                }
            }
        }
    }
};
template <class Epi, class Sched, bool ALIGN_EPI = false, bool SP2 = false>
__device__ __forceinline__ void gemm_phase(PG8_LAS unsigned char* lds, const Gemm g, const Sched& S, const Epi& E, int tid_in) {
    int tid = tid_in; asm volatile("" : "+v"(tid));
    const int wid = __builtin_amdgcn_readfirstlane(tid >> 6), lane = tid & 63, wr = wid >> 2, wc = wid & 3, fr = lane & 15, fq = lane >> 4;
    const int K = g.K, nt = K / BK;
    unsigned voffA[2], voffB[2];
#pragma unroll
    for (int i = 0; i < 2; ++i) { int R, C; stage_rc(tid * 16 + i * 8192, R, C); const int Rb = Epi::PERM ? ((R & ~31) + perm32(R & 31)) : R;
        voffA[i] = (unsigned)(R * K + C) * 2u; voffB[i] = (unsigned)(Rb * K + C) * 2u; }
    const size_t kstep = (size_t)(BK * 2);
    const size_t hstep = (size_t)HALF * K * 2;
    const size_t tstep = 2 * hstep;
    const unsigned ldsw = (unsigned)wid * 1024u;
    const int aoff = lds_byte(wr * 64 + fr, fq * 8), boff = lds_byte(wc * 32 + fr, fq * 8);
#define PG8_SA(b, h) (((b) * 2 + (h)) * HTB)
#define PG8_SB(b, h) ((4 + (b) * 2 + (h)) * HTB)
#define PG8_STAGE(bufoff, gbase, voff) do { _Pragma("unroll") for (int _i = 0; _i < 2; ++_i) \
        __builtin_amdgcn_global_load_lds((const unsigned*)((const char*)(gbase) + (voff)[_i]), (PG8_LAS unsigned*)(lds + (bufoff) + ldsw + _i * 8192), 16, 0, 0); } while (0)
#define PG8_LDA(dst, b, h) do { _Pragma("unroll") for (int m = 0; m < 4; ++m) _Pragma("unroll") for (int k = 0; k < 2; ++k) dst[m][k] = *(const PG8_LAS bf16x8*)(lds + PG8_SA(b, h) + aoff + m * 2048 + k * 1024); } while (0)
#define PG8_LDB(dst, b, h) do { _Pragma("unroll") for (int n = 0; n < 2; ++n) _Pragma("unroll") for (int k = 0; k < 2; ++k) dst[n][k] = *(const PG8_LAS bf16x8*)(lds + PG8_SB(b, h) + boff + n * 2048 + k * 1024); } while (0)
#define PG8_MMA(ai, bj, At, Bt) do { __builtin_amdgcn_s_setprio(1); _Pragma("unroll") for (int m = 0; m < 4; ++m) _Pragma("unroll") for (int n = 0; n < 2; ++n) _Pragma("unroll") for (int k = 0; k < 2; ++k) \
        acc[ai][bj][m][n] = __builtin_amdgcn_mfma_f32_16x16x32_bf16(Bt[n][k], At[m][k], acc[ai][bj][m][n], 0, 0, 0); __builtin_amdgcn_s_setprio(0); } while (0)
#define PG8_WAIT_V(n) asm volatile("s_waitcnt vmcnt(" #n ")" ::: "memory")
#define PG8_WAIT_L(n) asm volatile("s_waitcnt lgkmcnt(" #n ")" ::: "memory")
#define PG8_BAR __builtin_amdgcn_s_barrier()
#define PG8_SCHED __builtin_amdgcn_sched_barrier(0)
    Unit cur, nxt; int ui = 0;
    if (!S.next(0, cur)) return;
    f32x4 acc[2][2][4][2];
#pragma unroll
    for (int a = 0; a < 2; ++a)
#pragma unroll
        for (int b = 0; b < 2; ++b)
#pragma unroll
            for (int m = 0; m < 4; ++m)
#pragma unroll
                for (int n = 0; n < 2; ++n) acc[a][b][m][n] = (f32x4){0.f, 0.f, 0.f, 0.f};
    bf16x8 At[4][2], B0[2][2], B1[2][2];
    const char* cA = (const char*)g.A + (size_t)cur.pm * tstep; const char* cB = (const char*)g.Bt + (size_t)cur.pn * tstep;
    S.a_ready(cur);
    if constexpr (SP2) {
        PG8_STAGE(PG8_SB(0, 0), cB, voffB); PG8_STAGE(PG8_SB(0, 1), cB + hstep, voffB); PG8_STAGE(PG8_SA(0, 0), cA, voffA); PG8_STAGE(PG8_SA(0, 1), cA + hstep, voffA);
        if (wr == 1) PG8_BAR;
        PG8_WAIT_V(2); PG8_BAR;
        PG8_STAGE(PG8_SB(1, 0), cB + kstep, voffB); PG8_STAGE(PG8_SA(1, 0), cA + kstep, voffA); PG8_STAGE(PG8_SB(1, 1), cB + hstep + kstep, voffB);
        PG8_WAIT_V(6); PG8_BAR;
    } else {
        PG8_STAGE(PG8_SB(0, 0), cB, voffB); PG8_STAGE(PG8_SA(0, 0), cA, voffA); PG8_STAGE(PG8_SB(0, 1), cB + hstep, voffB); PG8_STAGE(PG8_SA(0, 1), cA + hstep, voffA);
        if (wr == 1) PG8_BAR;
        PG8_WAIT_V(4); PG8_BAR;
        PG8_STAGE(PG8_SB(1, 0), cB + kstep, voffB); PG8_STAGE(PG8_SA(1, 0), cA + kstep, voffA); PG8_STAGE(PG8_SB(1, 1), cB + hstep + kstep, voffB);
        PG8_WAIT_V(6); PG8_BAR;
    }
    for (;;) {
        const bool has_next = S.next(ui + 1, nxt);
        const char* nA = has_next ? (const char*)g.A + (size_t)nxt.pm * tstep : cA; const char* nB = has_next ? (const char*)g.Bt + (size_t)nxt.pn * tstep : cB;
        for (int t = 0; t < nt; t += 2) {
            const bool last = (t == nt - 2);
            const char* a1 = cA + (size_t)(t + 1) * kstep;
            const char* a2 = last ? nA : cA + (size_t)(t + 2) * kstep; const char* b2 = last ? nB : cB + (size_t)(t + 2) * kstep;
            const char* a3 = a2 + kstep; const char* b3 = b2 + kstep;
            if (last && has_next) S.a_ready(nxt);
            if constexpr (SP2) {
            PG8_LDB(B0, 0, 0); PG8_LDB(B1, 0, 1); PG8_SCHED; PG8_LDA(At, 0, 0); PG8_STAGE(PG8_SA(1, 1), a1 + hstep, voffA);
            PG8_WAIT_V(8); PG8_WAIT_L(0); PG8_BAR; PG8_MMA(0, 0, At, B0); PG8_MMA(0, 1, At, B1); PG8_BAR; PG8_SCHED;
            PG8_LDA(At, 0, 1); PG8_STAGE(PG8_SB(0, 0), b2, voffB); PG8_STAGE(PG8_SB(0, 1), b2 + hstep, voffB); PG8_STAGE(PG8_SA(0, 0), a2, voffA);
            PG8_WAIT_V(8); PG8_WAIT_L(0); PG8_BAR; PG8_MMA(1, 0, At, B0); PG8_MMA(1, 1, At, B1); PG8_BAR; PG8_SCHED;
            PG8_LDB(B0, 1, 0); PG8_LDB(B1, 1, 1); PG8_SCHED; PG8_LDA(At, 1, 0); PG8_STAGE(PG8_SA(0, 1), a2 + hstep, voffA);
            PG8_WAIT_V(8); PG8_WAIT_L(0); PG8_BAR; PG8_MMA(0, 0, At, B0); PG8_MMA(0, 1, At, B1); PG8_BAR; PG8_SCHED;
            PG8_LDA(At, 1, 1); PG8_STAGE(PG8_SB(1, 0), b3, voffB); PG8_STAGE(PG8_SB(1, 1), b3 + hstep, voffB); PG8_STAGE(PG8_SA(1, 0), a3, voffA);
            PG8_WAIT_V(8); PG8_WAIT_L(0); PG8_BAR; PG8_MMA(1, 0, At, B0); PG8_MMA(1, 1, At, B1); PG8_BAR; PG8_SCHED;
            } else {
            PG8_LDB(B0, 0, 0); PG8_SCHED; PG8_LDA(At, 0, 0); PG8_STAGE(PG8_SA(1, 1), a1 + hstep, voffA);
            PG8_WAIT_L(8); PG8_BAR; PG8_WAIT_L(0); PG8_MMA(0, 0, At, B0); PG8_BAR; PG8_SCHED;
            PG8_LDB(B1, 0, 1); PG8_STAGE(PG8_SB(0, 0), b2, voffB);
            PG8_BAR; PG8_WAIT_L(0); PG8_MMA(0, 1, At, B1); PG8_BAR;
            PG8_LDA(At, 0, 1); PG8_STAGE(PG8_SA(0, 0), a2, voffA);
            PG8_BAR; PG8_WAIT_L(0); PG8_MMA(1, 0, At, B0); PG8_BAR; PG8_SCHED;
            PG8_STAGE(PG8_SB(0, 1), b2 + hstep, voffB);
            PG8_WAIT_V(6); PG8_BAR; PG8_MMA(1, 1, At, B1); PG8_BAR;
            PG8_LDB(B0, 1, 0); PG8_SCHED; PG8_LDA(At, 1, 0); PG8_STAGE(PG8_SA(0, 1), a2 + hstep, voffA);
            PG8_WAIT_L(8); PG8_BAR; PG8_WAIT_L(0); PG8_MMA(0, 0, At, B0); PG8_BAR; PG8_SCHED;
            PG8_LDB(B1, 1, 1); PG8_STAGE(PG8_SB(1, 0), b3, voffB);
            PG8_BAR; PG8_WAIT_L(0); PG8_MMA(0, 1, At, B1); PG8_BAR;
            PG8_LDA(At, 1, 1); PG8_STAGE(PG8_SA(1, 0), a3, voffA);
            PG8_BAR; PG8_WAIT_L(0); PG8_MMA(1, 0, At, B0); PG8_BAR; PG8_SCHED;
            PG8_STAGE(PG8_SB(1, 1), b3 + hstep, voffB);
            PG8_WAIT_V(6); PG8_BAR; PG8_MMA(1, 1, At, B1); PG8_BAR;
            }
        }
        if constexpr (ALIGN_EPI) { if (wr == 0) PG8_BAR; }
        if constexpr (!Epi::AFTER_DRAIN) { E(acc, cur, wr, wc, fr, fq); S.done(cur); }
        if (!has_next) break;
#pragma unroll
        for (int a = 0; a < 2; ++a)
#pragma unroll
            for (int b = 0; b < 2; ++b)
#pragma unroll
                for (int m = 0; m < 4; ++m)
#pragma unroll
                    for (int n = 0; n < 2; ++n) acc[a][b][m][n] = (f32x4){0.f, 0.f, 0.f, 0.f};
        cur = nxt; cA = nA; cB = nB; ++ui;
        if constexpr (ALIGN_EPI) { if (wr == 1) PG8_BAR; }
    }
    PG8_WAIT_V(0);
    if constexpr (!ALIGN_EPI) { if (wr == 0) PG8_BAR; }
    PG8_BAR;
    if constexpr (Epi::AFTER_DRAIN) { E.fused(acc, cur, wr, wc, fr, fq, lds, wid, lane); S.done(cur); }
#undef PG8_SA
#undef PG8_SB
#undef PG8_STAGE
#undef PG8_LDA
#undef PG8_LDB
#undef PG8_MMA
#undef PG8_WAIT_V
#undef PG8_WAIT_L
#undef PG8_BAR
#undef PG8_SCHED
}
}

constexpr int DM = 2048, NB = 4, SEQ = 2048, MT = NB * SEQ, NLAYER = 4;
constexpr int EVEN_IN = 5120, ODD_IN = 2304, DFF = 5504, DFF2 = 11008;
constexpr float LOG2E = 1.4426950408889634f;
constexpr float QSCALE_A = 0.08838834764831845f * LOG2E;
constexpr float QSCALE_C = 0.125f * LOG2E;
enum { I_X = 0, I_C, I_POS, I_ADA_W, I_ADA_B, I_NORM_MIX, I_NORM_FFN, I_NORM_FINAL,
       I_EV_W_IN, I_EV_CONV_W, I_EV_CONV_B, I_EV_GA_W, I_EV_GA_B, I_EV_GX_W, I_EV_GX_B, I_EV_LAMBDA, I_EV_W_OUT,
       I_OD_W_IN, I_OD_SINKS, I_OD_A_RE, I_OD_A_IM, I_OD_B_RE, I_OD_B_IM, I_OD_C_RE, I_OD_C_IM, I_OD_D, I_OD_LOG_DT, I_OD_GLU_W, I_OD_GLU_B, I_OD_W_OUT,
       I_FFN_W_IN, I_FFN_CONV_W, I_FFN_CONV_B, I_FFN_W_OUT, N_INPUTS };
constexpr size_t MiB = 1u << 20;
constexpr size_t WS_CTL = 0, CTL_ZERO_BYTES = 2 * MiB;
constexpr size_t WS_SS = 516 * MiB;
constexpr size_t WS_CVEC = 524288;
constexpr int CV_EVIN = 0, CV_ODIN = 2 * 4 * 5120, CV_FFIN = CV_ODIN + 2 * 4 * 2304;
constexpr int CV_TOTAL = CV_FFIN + 4 * 4 * 11008;
constexpr size_t WS_CVPART = 526 * MiB;
constexpr size_t WS_MOD = 11 * MiB;
constexpr size_t WS_COSA = 2 * MiB, WS_SINA = 4 * MiB, WS_COSC = 6 * MiB, WS_SINC = 7 * MiB;
constexpr size_t WS_S5T = 8 * MiB;
constexpr size_t WS_WGATE = 10 * MiB;
constexpr size_t WS_W_EVIN = 12 * MiB, WS_W_EVOUT = 52 * MiB, WS_W_ODIN = 68 * MiB, WS_W_ODOUT = 86 * MiB, WS_W_GLU = 102 * MiB, WS_W_FFIN = 106 * MiB, WS_W_FFOUT = 278 * MiB;
constexpr size_t WS_H = 364 * MiB, WS_MIX = 396 * MiB, WS_Q = 428 * MiB, WS_K = 444 * MiB, WS_V = 460 * MiB, WS_XB = 476 * MiB, WS_YB = 492 * MiB;
constexpr size_t WS_XC = 508 * MiB, WS_LA = 540 * MiB, WS_LB = 572 * MiB, WS_UFF = 604 * MiB, WS_ACT = 776 * MiB, WS_END = 862 * MiB;
constexpr size_t WS_HALO_F = 508 * MiB, WS_HALO_L = 512 * MiB;
constexpr int CW_BAR = 4096;
constexpr int RING_BYTES = 131072, LDSCTL_OFF = 143360, LDS_BYTES = 147456;

#define GAS __attribute__((address_space(1)))
#define LAS __attribute__((address_space(3)))
typedef unsigned short bf16;
typedef float f32x4 __attribute__((ext_vector_type(4)));
typedef float f32x2 __attribute__((ext_vector_type(2)));
typedef unsigned u32x4 __attribute__((ext_vector_type(4)));
typedef unsigned u32x2 __attribute__((ext_vector_type(2)));
#define LDS_WAIT() asm volatile("s_waitcnt lgkmcnt(0)" ::: "memory")
using pg8::cvt_pk_bf16; using pg8::bf_lo; using pg8::bf_hi; using pg8::gelu_tanh;
__device__ __forceinline__ float wave_sum(float v) {
#pragma unroll
    for (int o = 1; o < 64; o <<= 1) v += __shfl_xor(v, o);
    return v;
}
__device__ __forceinline__ unsigned short f2bf(float f) { return (unsigned short)(cvt_pk_bf16(f, 0.f) & 0xffffu); }
__device__ __forceinline__ float bf2f(unsigned short b) { return __uint_as_float(((unsigned)b) << 16); }

struct Params { const float* in[N_INPUTS]; float* out; unsigned char* ws; int lo, hi, li, pad; };
typedef const __attribute__((address_space(4))) Params* KP;
#define KPREF(P, kp0) KP kp_ = (kp0); asm volatile("" : "+s"(kp_)); const __attribute__((address_space(4))) Params& P = *kp_
#define PHASE_IDS() int tid; asm volatile("v_mbcnt_lo_u32_b32 %0, -1, 0\n\tv_mbcnt_hi_u32_b32 %0, -1, %0" : "=v"(tid)); tid += kwave_ * 64;     const int lane = tid & 63, wave = __builtin_amdgcn_readfirstlane(tid >> 6); int bx = blockIdx.x; asm volatile("" : "+s"(bx)); const int G = gridDim.x; (void)lane; (void)wave; (void)G
#define FRESH_IDS() int ftid; asm volatile("v_mbcnt_lo_u32_b32 %0, -1, 0\n\tv_mbcnt_hi_u32_b32 %0, -1, %0" : "=v"(ftid)); const int flane = ftid, fwave = kwave; ftid += kwave * 64; int fbx = blockIdx.x; asm volatile("" : "+s"(fbx)); (void)flane; (void)fwave
#ifndef TAIL_INPROJ
#define TAIL_INPROJ 1
#endif
#define XB_TMO      128
#define XB_XCNT(j)  (256  + 64 * (j))
#define XB_XSUB(j)  (1280 + 64 * (j))
#define XB_XGEN(j)  (2304 + 64 * (j))
#define XB_TOP      3328
#define XB_TOPGEN   3392
#define XCD_BAR_WORDS 3456
#define XB_SPIN_CAP (1u << 18)
#define LAS __attribute__((address_space(3)))

__device__ __forceinline__ unsigned xb_ld(unsigned* p)              { return __hip_atomic_load(p, __ATOMIC_RELAXED, __HIP_MEMORY_SCOPE_AGENT); }
__device__ __forceinline__ unsigned xb_add(unsigned* p, unsigned v) { return __hip_atomic_fetch_add(p, v, __ATOMIC_RELAXED, __HIP_MEMORY_SCOPE_AGENT); }
__device__ __forceinline__ unsigned xb_xcc_id() { return (unsigned)__builtin_amdgcn_s_getreg((3 << 11) | 20) & 0xFu; }
#define XB_SPIN(cond, bar) do { unsigned _sp = 0; while (cond) { __builtin_amdgcn_s_sleep(1); \
    if ((++_sp & 255u) == 0u) { if (xb_ld(&(bar)[XB_TMO])) break; if (_sp > XB_SPIN_CAP) { atomicAdd(&(bar)[XB_TMO], 1u); break; } } } } while (0)

struct XcdBarrier {
    unsigned* bar; unsigned x; unsigned w0;
    volatile LAS unsigned* st;
};

__device__ __forceinline__ XcdBarrier xcd_barrier_post(unsigned* bar, volatile LAS unsigned* st) {
    XcdBarrier b; b.bar = bar; b.x = xb_xcc_id(); b.st = st;
    if (threadIdx.x == 0) (void)xb_add(&bar[XB_XCNT(b.x)], 1u);
    b.w0 = 0u;
    return b;
}
__device__ __forceinline__ void xcd_barrier_complete(unsigned* bar, unsigned x, unsigned& nloc, unsigned& nx) {
    const unsigned G = gridDim.x * gridDim.y * gridDim.z;
    unsigned sum, cnt, mine, sp = 0u;
    for (;;) {
        sum = 0u; cnt = 0u; mine = 0u;
#pragma unroll
        for (unsigned j = 0; j < 16; ++j) { const unsigned c = xb_ld(&bar[XB_XCNT(j)]); sum += c; cnt += (c > 0u) ? 1u : 0u; mine = (j == x) ? c : mine; }
        if (sum == G) break;
        __builtin_amdgcn_s_sleep(1);
        if ((++sp & 255u) == 0u) { if (xb_ld(&bar[XB_TMO])) break; if (sp > XB_SPIN_CAP) { atomicAdd(&bar[XB_TMO], 1u); break; } }
    }
    nloc = mine > 0u ? mine : 1u; nx = cnt > 0u ? cnt : 1u;
}

__device__ __forceinline__ void xcd_barrier(const XcdBarrier& b) {
    asm volatile("s_waitcnt vmcnt(0)" ::: "memory");
    __syncthreads();
    if (b.w0 != 0u && __builtin_amdgcn_mbcnt_hi(~0u, __builtin_amdgcn_mbcnt_lo(~0u, 0u)) == 0u) {
        unsigned* bar = b.bar;
        __builtin_amdgcn_s_waitcnt(0);
        unsigned nloc = b.st[0], nx = b.st[1];
        if (nloc == 0u) { xcd_barrier_complete(bar, b.x, nloc, nx); b.st[0] = nloc; b.st[1] = nx; }
        const unsigned old = xb_add(&bar[XB_XSUB(b.x)], 1u);
        const unsigned gen = old / nloc;
        if (old + 1u == (gen + 1u) * nloc) {
            __builtin_amdgcn_fence(__ATOMIC_RELEASE, "agent");
            asm volatile("s_waitcnt vmcnt(0)" ::: "memory");
            const unsigned og = xb_add(&bar[XB_TOP], 1u);
            const unsigned tg = og / nx;
            if (og + 1u == (tg + 1u) * nx) xb_add(&bar[XB_TOPGEN], 1u);
            else XB_SPIN(xb_ld(&bar[XB_TOPGEN]) == tg, bar);
            __builtin_amdgcn_fence(__ATOMIC_ACQUIRE, "agent");
            xb_add(&bar[XB_XGEN(b.x)], 1u);
            asm volatile("s_waitcnt vmcnt(0)" ::: "memory");
        } else {
            XB_SPIN(xb_ld(&bar[XB_XGEN(b.x)]) == gen, bar);
            __builtin_amdgcn_fence(__ATOMIC_ACQUIRE, "agent");
            asm volatile("s_waitcnt vmcnt(0)" ::: "memory");
        }
    }
    __syncthreads();
}
__device__ __forceinline__ void sincos_rev(double ang, float& s, float& c) {
    double rev = ang * 0.15915494309189535; rev -= floor(rev); const float fr = (float)rev;
    s = __builtin_amdgcn_sinf(fr); c = __builtin_amdgcn_cosf(fr);
}

constexpr size_t WS_S5TT = 604 * MiB, WS_S5T2 = 690 * MiB, WS_S5A32 = 707 * MiB;
__device__ __forceinline__ void s5_pre(KP kp0, LAS unsigned char* lds, int og, int tid) { KPREF(P, kp0);
    LAS float* apr = (LAS float*)lds; LAS float* api = apr + 33 * 64;
    LAS float* bbr = api + 33 * 64; LAS float* bbi = bbr + 1024;
    LAS float* cre = bbi + 1024; LAS float* cim = cre + 1024;
    LAS float* kern = cim + 1024;
    const int o = og >> 6, g = og & 63;
    const float dt = expf(P.in[I_OD_LOG_DT][og]);
    __syncthreads();
    for (int idx = tid; idx < 33 * 64; idx += 512) { const int k = idx >> 6, p = idx & 63; const float are = P.in[I_OD_A_RE][og * 64 + p], aim = P.in[I_OD_A_IM][og * 64 + p];
        const float er = expf((float)k * are * dt); float s, c; sincos_rev((double)k * (double)aim * (double)dt, s, c); apr[idx] = er * c; api[idx] = er * s; }
    for (int idx = tid; idx < 1024; idx += 512) { cre[idx] = P.in[I_OD_C_RE][(size_t)og * 1024 + idx]; cim[idx] = P.in[I_OD_C_IM][(size_t)og * 1024 + idx]; }
    __syncthreads();
    for (int idx = tid; idx < 1024; idx += 512) { const int p = idx >> 4; const float are = P.in[I_OD_A_RE][og * 64 + p], aim = P.in[I_OD_A_IM][og * 64 + p];
        const float xr = apr[64 + p] - 1.0f, xi = api[64 + p], den = 1.0f / (are * are + aim * aim), cr = (xr * are + xi * aim) * den, ci = (xi * are - xr * aim) * den;
        const float br = P.in[I_OD_B_RE][(size_t)og * 1024 + idx], bi = P.in[I_OD_B_IM][(size_t)og * 1024 + idx];
        bbr[idx] = cr * br - ci * bi; bbi[idx] = cr * bi + ci * br; }
    if (tid < 64) ((f32x2*)(P.ws + WS_S5A32))[og * 64 + tid] = (f32x2){apr[32 * 64 + tid], api[32 * 64 + tid]};
    __syncthreads();
    {
        const int pair = tid & 255, cp = pair >> 4, c = pair & 15, kh = tid >> 8; float acc[16];
#pragma unroll
        for (int kk = 0; kk < 16; ++kk) acc[kk] = 0.f;
        for (int p = 0; p < 64; ++p) { const float gr = cre[cp * 64 + p] * bbr[p * 16 + c] - cim[cp * 64 + p] * bbi[p * 16 + c], gi = cre[cp * 64 + p] * bbi[p * 16 + c] + cim[cp * 64 + p] * bbr[p * 16 + c];
#pragma unroll
            for (int kk = 0; kk < 16; ++kk) acc[kk] += gr * apr[(16 * kh + kk) * 64 + p] - gi * api[(16 * kh + kk) * 64 + p]; }
#pragma unroll
        for (int kk = 0; kk < 16; ++kk) kern[(16 * kh + kk) * 256 + pair] = acc[kk];
    }
    __syncthreads();
    bf16* TT = (bf16*)(P.ws + WS_S5TT) + (size_t)og * 512 * 640; bf16* T2 = (bf16*)(P.ws + WS_S5T2) + (size_t)og * 128 * 512;
    for (int idx = tid; idx < 512 * 64; idx += 512) { const int n = idx >> 6, ic = idx & 63, i = ic >> 1, ch = ic & 1, j = n >> 4, cp = n & 15; float v[8];
#pragma unroll
        for (int cc = 0; cc < 8; ++cc) v[cc] = (j >= i) ? kern[(j - i) * 256 + cp * 16 + 8 * ch + cc] : 0.f;
        u32x4 w; w.x = cvt_pk_bf16(v[0], v[1]); w.y = cvt_pk_bf16(v[2], v[3]); w.z = cvt_pk_bf16(v[4], v[5]); w.w = cvt_pk_bf16(v[6], v[7]);
        *(u32x4*)(TT + (size_t)n * 640 + i * 16 + 8 * ch) = w; }
    for (int idx = tid; idx < 512 * 16; idx += 512) { const int n = idx >> 4, q = idx & 15, j = n >> 4, cp = n & 15, im = q >> 3, p0 = (q & 7) * 8; float v[8];
#pragma unroll
        for (int cc = 0; cc < 8; ++cc) { const int p = p0 + cc; const float ar = apr[(j + 1) * 64 + p], ai = api[(j + 1) * 64 + p], cr = cre[cp * 64 + p], ci = cim[cp * 64 + p];
            v[cc] = im ? -(cr * ai + ci * ar) : (cr * ar - ci * ai); }
        u32x4 w; w.x = cvt_pk_bf16(v[0], v[1]); w.y = cvt_pk_bf16(v[2], v[3]); w.z = cvt_pk_bf16(v[4], v[5]); w.w = cvt_pk_bf16(v[6], v[7]);
        *(u32x4*)(TT + (size_t)n * 640 + 512 + 64 * im + p0) = w; }
    for (int idx = tid; idx < 128 * 64; idx += 512) { const int comp = idx >> 6, ic = idx & 63, i = ic >> 1, ch = ic & 1, p = comp & 63, im = comp >> 6; float v[8];
        const float ar = apr[(31 - i) * 64 + p], ai = api[(31 - i) * 64 + p];
#pragma unroll
        for (int cc = 0; cc < 8; ++cc) { const float br = bbr[p * 16 + 8 * ch + cc], bi = bbi[p * 16 + 8 * ch + cc]; v[cc] = im ? (ar * bi + ai * br) : (ar * br - ai * bi); }
        u32x4 w; w.x = cvt_pk_bf16(v[0], v[1]); w.y = cvt_pk_bf16(v[2], v[3]); w.z = cvt_pk_bf16(v[4], v[5]); w.w = cvt_pk_bf16(v[6], v[7]);
        *(u32x4*)(T2 + (size_t)comp * 512 + i * 16 + 8 * ch) = w; }
}


__device__ __forceinline__ void phase_ada(KP kp0, int kwave_, LAS unsigned char* lds) { KPREF(P, kp0); PHASE_IDS();
    LAS float* cond = (LAS float*)lds;
    LAS float* part = (LAS float*)(lds + 32768);
    const float* c = P.in[I_C];
    for (int i = tid; i < NB * DM; i += 512) { const float v = c[i]; cond[i] = v / (1.0f + __expf(-v)); }
    __syncthreads();
    float* mod = (float*)(P.ws + WS_MOD);
    for (int item = bx; item < 192; item += G) {
        const int l = item / 48, ng = item % 48;
        const float* W = P.in[I_ADA_W] + (size_t)l * DM * 12288 + (size_t)(wave * 256) * 12288 + ng * 256 + lane * 4;
        f32x4 a0 = {0.f, 0.f, 0.f, 0.f}, a1 = a0, a2 = a0, a3 = a0;
#pragma unroll 8
        for (int k = 0; k < 256; ++k) {
            const f32x4 w = *(const f32x4*)(W + (size_t)k * 12288); const int kk = wave * 256 + k;
            a0 += cond[kk] * w; a1 += cond[2048 + kk] * w; a2 += cond[4096 + kk] * w; a3 += cond[6144 + kk] * w;
        }
        LAS float* pp = part + wave * 1024 + lane * 4;
        *(LAS f32x4*)(pp) = a0; *(LAS f32x4*)(pp + 256) = a1; *(LAS f32x4*)(pp + 512) = a2; *(LAS f32x4*)(pp + 768) = a3;
        __syncthreads();
        for (int o = tid; o < 1024; o += 512) {
            float s = 0.f;
#pragma unroll
            for (int w = 0; w < 8; ++w) s += part[w * 1024 + o];
            const int b = o >> 8, cc = o & 255;
            mod[(size_t)(l * 4 + b) * 12288 + ng * 256 + cc] = s + P.in[I_ADA_B][l * 12288 + ng * 256 + cc];
        }
        __syncthreads();
    }
    if (bx >= 192 || G < 256) for (int og = (G < 256 ? bx : bx - 192); og < (G == 256 ? 64 : 128); og += (G < 256 ? G : 64)) s5_pre(kp0, lds, og, tid);
}

__device__ __forceinline__ int cmap(int type, int n) {
    if (type == 1) { if (n >= 2048) return n; const int tile = n >> 8, j = n & 255, bj = j >> 7, jj = j & 127; return tile * 256 + (jj >> 6) * 128 + bj * 64 + (jj & 63); }
    if (type == 2) {
        if (n >= 1280) return n;
        if (n < 1024) { const int tile = n >> 8, j = n & 255, bj = j >> 7, jj = j & 127; return tile * 256 + (jj >> 5) * 64 + bj * 32 + (jj & 31); }
        const int j = n - 1024, bj = j >> 7, jj = j & 127; if (jj < 64) return 1024 + (jj >> 5) * 64 + bj * 32 + (jj & 31); return 1152 + bj * 64 + (jj - 64);
    }
    if (type == 3) { const int tile = n >> 8, j = n & 255; return (j >> 7) * 5504 + tile * 128 + (j & 127); }
    return n;
}
__device__ __forceinline__ void tr_item(const float* W, int K, int N, bf16* WT, int k0, int c0a, int c0b, int dstr0, LAS float* scr, int lane, float* cv, const float* sh) {
    const int csrc = ((lane & 8) ? c0b : c0a) + (lane & 7) * 4, cl = (lane & 15) * 4;
#pragma unroll
    for (int i = 0; i < 16; ++i) { const int kk = 4 * i + (lane >> 4); const f32x4 v = __builtin_nontemporal_load((const f32x4*)(W + (size_t)(k0 + kk) * N + csrc));
        LAS float* d = scr + kk * 65 + cl; d[0] = v[0]; d[1] = v[1]; d[2] = v[2]; d[3] = v[3]; }
    LDS_WAIT(); asm volatile("" ::: "memory");
    const int c = lane & 7;
#pragma unroll
    for (int j = 0; j < 8; ++j) { const int n = (lane >> 3) + 8 * j; const LAS float* s = scr + (8 * c) * 65 + n;
        u32x4 o; o.x = cvt_pk_bf16(s[0 * 65], s[1 * 65]); o.y = cvt_pk_bf16(s[2 * 65], s[3 * 65]); o.z = cvt_pk_bf16(s[4 * 65], s[5 * 65]); o.w = cvt_pk_bf16(s[6 * 65], s[7 * 65]);
        __builtin_nontemporal_store(o, (u32x4*)(WT + (size_t)(dstr0 + n) * K + k0 + 8 * c)); }
    if (cv) { float a0 = 0.f, a1 = 0.f, a2 = 0.f, a3 = 0.f;
#pragma unroll 16
        for (int k = 0; k < 64; ++k) { const float w = scr[k * 65 + lane]; a0 += sh[k0 + k] * w; a1 += sh[12288 + k0 + k] * w; a2 += sh[2 * 12288 + k0 + k] * w; a3 += sh[3 * 12288 + k0 + k] * w; }
        cv[dstr0 + lane] = a0; cv[N + dstr0 + lane] = a1; cv[2 * N + dstr0 + lane] = a2; cv[3 * N + dstr0 + lane] = a3; }
    LDS_WAIT(); asm volatile("" ::: "memory");
}
constexpr int CONV_EVEN = 11872, CONV_ODD = 10688;
__device__ __forceinline__ int conv_total(int L) { return (L & 1) ? CONV_ODD : CONV_EVEN; }
__device__ __forceinline__ void conv_item(KP kp0, int L, int idx, LAS float* scr, int lane) { KPREF(P, kp0);
    const float* mod = (const float*)(P.ws + WS_MOD) + (size_t)L * 4 * 12288; float* cvpart = (float*)(P.ws + WS_CVPART);
    const int e = L >> 1; const bool odd = (L & 1) != 0;
    int r = idx, in_idx, K, N, ctype = 0, cvo = -1; size_t wsoff; const float* sh = mod; size_t li_off;
    const int n_in = odd ? 1152 : 2560, n_aux = odd ? 256 : 32;
    if (r < n_in) { in_idx = odd ? I_OD_W_IN : I_EV_W_IN; K = 2048; N = odd ? ODD_IN : EVEN_IN; ctype = odd ? 2 : 1; wsoff = odd ? WS_W_ODIN : WS_W_EVIN; cvo = odd ? CV_ODIN + e * 4 * ODD_IN : CV_EVIN + e * 4 * EVEN_IN; li_off = (size_t)e * K * N; }
    else if ((r -= n_in) < n_aux) {
        if (!odd) { const int mat = r >> 1, kb = r & 1, gate = mat & 1, eb = e * 8 + (mat >> 1);
#pragma unroll
            for (int nb = 0; nb < 2; ++nb)
                tr_item(P.in[gate ? I_EV_GX_W : I_EV_GA_W] + (size_t)eb * 16384, 128, 128, (bf16*)(P.ws + WS_WGATE) + ((size_t)eb * 256 + gate * 128) * 128, 64 * kb, 64 * nb, 64 * nb + 32, 64 * nb, scr, lane, nullptr, nullptr);
            return; }
        in_idx = I_OD_GLU_W; K = 1024; N = 1024; wsoff = WS_W_GLU; li_off = (size_t)e * K * N; }
    else if ((r -= n_aux) < 1024) { in_idx = odd ? I_OD_W_OUT : I_EV_W_OUT; K = 2048; N = 2048; wsoff = odd ? WS_W_ODOUT : WS_W_EVOUT; li_off = (size_t)e * K * N; }
    else if ((r -= 1024) < 5504) { in_idx = I_FFN_W_IN; K = 2048; N = DFF2; ctype = 3; wsoff = WS_W_FFIN; cvo = CV_FFIN + L * 4 * DFF2; sh = mod + 3 * DM; li_off = (size_t)L * K * N; }
    else { r -= 5504; in_idx = I_FFN_W_OUT; K = DFF; N = 2048; wsoff = WS_W_FFOUT; li_off = (size_t)L * K * N; }
    const int nblk = N / 64, kb = r / nblk, nb = r % nblk;
    tr_item(P.in[in_idx] + li_off, K, N, (bf16*)(P.ws + wsoff) + li_off, 64 * kb, cmap(ctype, 64 * nb), cmap(ctype, 64 * nb + 32), 64 * nb, scr, lane,
            cvo >= 0 ? cvpart + ((size_t)kb * CV_TOTAL + cvo) : nullptr, sh);
}
__device__ __forceinline__ void conv_range(KP kp0, LAS unsigned char* lds, int L, int first, int last, int rank, int nranks, int wave, int lane) {
    LAS float* scr = (LAS float*)(lds + wave * 16640);
    for (int it = first + rank * 8 + wave; it < last; it += nranks * 8) conv_item(kp0, L, it, scr, lane);
}
__device__ __forceinline__ void cvec_reduce(KP kp0, int L, int bx, int G, int tid) { KPREF(P, kp0);
    const float* cvpart = (const float*)(P.ws + WS_CVPART); float* cvec = (float*)(P.ws + WS_CVEC);
    const int e = L >> 1, n_in = (L & 1) ? 4 * ODD_IN : 4 * EVEN_IN, o_in = (L & 1) ? CV_ODIN + e * 4 * ODD_IN : CV_EVIN + e * 4 * EVEN_IN, o_ff = CV_FFIN + L * 4 * DFF2;
    for (int i = bx * 512 + tid; i < n_in + 4 * DFF2; i += G * 512) { const int off = i < n_in ? o_in + i : o_ff + (i - n_in); float v[32];
#pragma unroll
        for (int kb = 0; kb < 32; ++kb) v[kb] = cvpart[(size_t)kb * CV_TOTAL + off];
        float s = 0.f;
#pragma unroll
        for (int kb = 0; kb < 32; ++kb) s += v[kb];
        cvec[off] = s; }
}
__device__ __forceinline__ int conv_up(int L, bool tails) { return !tails ? conv_total(L) : (L == 0 ? CONV_EVEN : (TAIL_INPROJ ? (L == 1 ? 3776 : (L == 2 ? 1408 : 5312)) : (L == 2 ? 8064 : 6848))); }
__device__ __forceinline__ void phase_prep(KP kp0, int kwave_, LAS unsigned char* lds, bool tails) { KPREF(P, kp0); PHASE_IDS();
    {
        LAS float* scr = (LAS float*)(lds + wave * 16640);
        const int t0 = conv_up(0, tails), t1 = t0 + conv_up(1, tails), t2 = t1 + conv_up(2, tails), t3 = t2 + conv_up(3, tails);
        for (int it = bx * 8 + wave; it < t3; it += G * 8) { const int L = it < t0 ? 0 : (it < t1 ? 1 : (it < t2 ? 2 : 3)); conv_item(kp0, L, it - (L == 0 ? 0 : (L == 1 ? t0 : (L == 2 ? t1 : t2))), scr, lane); }
    }
    const int gw = bx * 8 + wave, NGW = G * 8; (void)gw; (void)NGW;
    const int gt = bx * 512 + tid, NT = G * 512;
    const int* pos = (const int*)P.in[I_POS];
    float* cosA = (float*)(P.ws + WS_COSA); float* sinA = (float*)(P.ws + WS_SINA); float* cosC = (float*)(P.ws + WS_COSC); float* sinC = (float*)(P.ws + WS_SINC);
    for (int idx = gt; idx < MT * 64; idx += NT) { const int row = idx >> 6, i = idx & 63;
        const double inv = exp2(-(double)i * (13.287712379549449 / 64.0)); float s, c; sincos_rev((double)pos[row] * inv, s, c); cosA[idx] = c; sinA[idx] = s; }
    for (int idx = gt; idx < MT * 32; idx += NT) { const int row = idx >> 5, i = idx & 31;
        const double inv = exp2(-(double)i * (13.287712379549449 / 32.0)); float s, c; sincos_rev((double)pos[row] * inv, s, c); cosC[idx] = c; sinC[idx] = s; }
    for (int idx = gt; idx < 2 * 64 * 64; idx += NT) { const int o = idx >> 12, g = (idx >> 6) & 63;
        const float are = P.in[I_OD_A_RE][idx], aim = P.in[I_OD_A_IM][idx], dt = expf(P.in[I_OD_LOG_DT][o * 64 + g]);
        const float er = expf(are * dt); float s, c; sincos_rev((double)aim * (double)dt, s, c);
        const float abr = er * c, abi = er * s, xr = abr - 1.0f, xi = abi, den = 1.0f / (are * are + aim * aim);
        const float cr = (xr * are + xi * aim) * den, ci = (xi * are - xr * aim) * den;
        f32x2* abar = (f32x2*)(P.ws + WS_S5T + (size_t)o * MiB); f32x2* bbar = (f32x2*)(P.ws + WS_S5T + (size_t)o * MiB + 65536);
        abar[idx & 4095] = (f32x2){abr, abi};
#pragma unroll
        for (int cc = 0; cc < 16; ++cc) { const float br = P.in[I_OD_B_RE][(size_t)idx * 16 + cc], bi = P.in[I_OD_B_IM][(size_t)idx * 16 + cc];
            bbar[(size_t)(idx & 4095) * 16 + cc] = (f32x2){cr * br - ci * bi, cr * bi + ci * br}; }
    }
}

__device__ __forceinline__ void phase_norm0(KP kp0, int kwave_) { KPREF(P, kp0); PHASE_IDS();
    const float* x = P.in[I_X]; const float* gwt = P.in[I_NORM_MIX];
    const float* modl = (const float*)(P.ws + WS_MOD);
    bf16* H = (bf16*)(P.ws + WS_H); float* ss = (float*)(P.ws + WS_SS);
    const int gw = bx * 8 + wave, NGW = G * 8;
    for (int row = gw; row < MT; row += NGW) {
        const f32x4* xr = (const f32x4*)(x + (size_t)row * DM) + lane;
        f32x4 v[8]; float s2 = 0.f;
#pragma unroll
        for (int j = 0; j < 8; ++j) { v[j] = xr[64 * j]; s2 += (v[j][0] * v[j][0] + v[j][1] * v[j][1]) + (v[j][2] * v[j][2] + v[j][3] * v[j][3]); }
        s2 = wave_sum(s2); if (lane < 32) ss[(size_t)row * 32 + lane] = lane == 0 ? s2 : 0.f;
        const float* sc = modl + (size_t)(row >> 11) * 12288 + DM;
        u32x2* o8 = (u32x2*)(H + (size_t)row * DM) + lane;
#pragma unroll
        for (int j = 0; j < 8; ++j) { const int col = (lane + 64 * j) * 4;
            const f32x4 y = v[j] * *(const f32x4*)(gwt + col) * (1.0f + *(const f32x4*)(sc + col));
            u32x2 w; w.x = cvt_pk_bf16(y[0], y[1]); w.y = cvt_pk_bf16(y[2], y[3]); o8[64 * j] = w; }
    }
    cvec_reduce(kp0, 0, bx, G, tid);
}
__device__ __forceinline__ void phase_final(KP kp0, int kwave_) { KPREF(P, kp0); PHASE_IDS();
    const float* gwt = P.in[I_NORM_FINAL];
    const int gw = bx * 8 + wave, NGW = G * 8;
    for (int row = gw; row < MT; row += NGW) {
        f32x4* xr = (f32x4*)(P.out + (size_t)row * DM) + lane;
        f32x4 v[8]; float ss = 0.f;
#pragma unroll
        for (int j = 0; j < 8; ++j) { v[j] = xr[64 * j]; ss += (v[j][0] * v[j][0] + v[j][1] * v[j][1]) + (v[j][2] * v[j][2] + v[j][3] * v[j][3]); }
        const float rstd = rsqrtf(wave_sum(ss) * (1.0f / DM) + 1e-6f);
#pragma unroll
        for (int j = 0; j < 8; ++j) { const int col = (lane + 64 * j) * 4; xr[64 * j] = v[j] * rstd * *(const f32x4*)(gwt + col); }
    }
}

__device__ __forceinline__ void phase_attn_a_naive(KP kp0, int kwave_) { KPREF(P, kp0); PHASE_IDS();
    const bf16* Q = (const bf16*)(P.ws + WS_Q); const bf16* K = (const bf16*)(P.ws + WS_K); const bf16* V = (const bf16*)(P.ws + WS_V); bf16* MIX = (bf16*)(P.ws + WS_MIX);
    const int gw = bx * 8 + wave, NGW = G * 8;
    for (int task = gw; task < MT * 8; task += NGW) {
        const int h = task & 7, row = task >> 3, b = row >> 11, t = row & 2047;
        const unsigned qw = *(const unsigned*)(Q + (size_t)row * 1024 + h * 128 + 2 * lane); const float q0 = bf_lo(qw), q1 = bf_hi(qw);
        float m = -INFINITY, l = 0.f, o0 = 0.f, o1 = 0.f;
        for (int pat = 0; pat < 3; ++pat) { const int dil = pat == 0 ? 1 : (pat == 1 ? 4 : 16);
            for (int j = 0; j <= 128; ++j) { const int tk = t - dil * j; if (tk < 0) break;
                const size_t kr = (size_t)(b * SEQ + tk) * 1024 + h * 128 + 2 * lane;
                const unsigned kw = *(const unsigned*)(K + kr), vw = *(const unsigned*)(V + kr);
                const float s = wave_sum(q0 * bf_lo(kw) + q1 * bf_hi(kw));
                const float mn = fmaxf(m, s), corr = exp2f(m - mn), p = exp2f(s - mn);
                l = l * corr + p; o0 = o0 * corr + p * bf_lo(vw); o1 = o1 * corr + p * bf_hi(vw); m = mn; } }
        const float inv = 1.0f / l;
        *(unsigned*)(MIX + (size_t)row * 2048 + h * 128 + 2 * lane) = cvt_pk_bf16(o0 * inv, o1 * inv);
    }
}
__device__ __forceinline__ void phase_attn_c_naive(KP kp0, int kwave_, int o_idx) { KPREF(P, kp0); PHASE_IDS();
    const bf16* Q = (const bf16*)(P.ws + WS_Q); const bf16* K = (const bf16*)(P.ws + WS_K); const bf16* V = (const bf16*)(P.ws + WS_V); bf16* MIX = (bf16*)(P.ws + WS_MIX);
    const int gw = bx * 8 + wave, NGW = G * 8;
    for (int task = gw; task < MT * 16; task += NGW) {
        const int h = task & 15, row = task >> 4, b = row >> 11, t = row & 2047, kvh = h >> 3;
        const float q = bf2f(Q[(size_t)row * 1024 + h * 64 + lane]);
        float m = -INFINITY, l = 0.f, o = 0.f;
        for (int tk = (t >= 127 ? t - 127 : 0); tk <= t; ++tk) {
            const size_t kr = (size_t)(b * SEQ + tk) * 128 + kvh * 64 + lane;
            const float s = wave_sum(q * bf2f(K[kr]));
            const float mn = fmaxf(m, s), corr = exp2f(m - mn), p = exp2f(s - mn);
            l = l * corr + p; o = o * corr + p * bf2f(V[kr]); m = mn; }
        const float sk = P.in[I_OD_SINKS][o_idx * 16 + h] * LOG2E;
        MIX[(size_t)row * 2048 + h * 64 + lane] = f2bf(o / (l + exp2f(sk - m)));
    }
}
__device__ __forceinline__ void phase_lru1_naive(KP kp0, int kwave_, int e) { KPREF(P, kp0); PHASE_IDS();
    const bf16* XB = (const bf16*)(P.ws + WS_XB); float* XC = (float*)(P.ws + WS_XC);
    const float* cw = P.in[I_EV_CONV_W] + (size_t)e * 4 * 1024; const float* cb = P.in[I_EV_CONV_B] + e * 1024;
    const int gt = bx * 512 + tid, NT = G * 512;
    for (int idx = gt; idx < MT * 1024; idx += NT) { const int row = idx >> 10, c = idx & 1023, t = row & 2047;
        float acc = cb[c];
#pragma unroll
        for (int i = 0; i < 4; ++i) { const int tt = t - 3 + i; if (tt >= 0) acc += cw[i * 1024 + c] * bf2f(XB[(size_t)(row - 3 + i) * 1024 + c]); }
        XC[idx] = acc; }
}
__device__ __forceinline__ void phase_lru2_naive(KP kp0, int kwave_, int e) { KPREF(P, kp0); PHASE_IDS();
    const float* XC = (const float*)(P.ws + WS_XC); float* LA = (float*)(P.ws + WS_LA); float* LB = (float*)(P.ws + WS_LB);
    const int gt = bx * 512 + tid, NT = G * 512;
    for (int idx = gt; idx < MT * 1024; idx += NT) { const int row = idx >> 10, c = idx & 1023, blk = c >> 7, j = c & 127;
        const float* xr = XC + (size_t)row * 1024 + blk * 128;
        const float* wa = P.in[I_EV_GA_W] + (size_t)((e * 8 + blk) * 128) * 128 + j; const float* wx = P.in[I_EV_GX_W] + (size_t)((e * 8 + blk) * 128) * 128 + j;
        float sa = P.in[I_EV_GA_B][e * 1024 + c], sx = P.in[I_EV_GX_B][e * 1024 + c];
#pragma unroll 8
        for (int i = 0; i < 128; ++i) { const float xv = xr[i]; sa += xv * wa[i * 128]; sx += xv * wx[i * 128]; }
        const float r = 1.0f / (1.0f + expf(-sa)), ig = 1.0f / (1.0f + expf(-sx));
        const float sp = log1pf(expf(-P.in[I_EV_LAMBDA][e * 1024 + c]));
        const float log_a = -8.0f * r * sp, a = expf(log_a), mult = sqrtf(-expm1f(2.0f * log_a));
        LA[idx] = a; LB[idx] = mult * ig * xr[j]; }
}
__device__ __forceinline__ void phase_lru3_naive(KP kp0, int kwave_) { KPREF(P, kp0); PHASE_IDS();
    const float* LA = (const float*)(P.ws + WS_LA); const float* LB = (const float*)(P.ws + WS_LB); const bf16* YB = (const bf16*)(P.ws + WS_YB); bf16* MIX = (bf16*)(P.ws + WS_MIX);
    if (wave != 0) return;
    for (int task = bx; task < 64; task += G) { const int b = task >> 4, c = (task & 15) * 64 + lane;
        float h = 0.f;
#pragma unroll 8
        for (int t = 0; t < SEQ; ++t) { const size_t idx = (size_t)(b * SEQ + t) * 1024 + c;
            h = LA[idx] * h + LB[idx];
            MIX[(size_t)(b * SEQ + t) * 2048 + 1024 + c] = f2bf(h * bf2f(YB[idx])); } }
}
__device__ __forceinline__ void phase_s5_naive(KP kp0, int kwave_, int o_idx) { KPREF(P, kp0); PHASE_IDS();
    const bf16* U = (const bf16*)(P.ws + WS_XB); bf16* Z = (bf16*)(P.ws + WS_YB);
    if (wave != 0) return;
    for (int bg = bx; bg < 256; bg += G) { const int b = bg >> 6, g = bg & 63;
        const f32x2 ab = ((const f32x2*)(P.ws + WS_S5T + (size_t)o_idx * MiB))[g * 64 + lane];
        const f32x2* bbp = (const f32x2*)(P.ws + WS_S5T + (size_t)o_idx * MiB + 65536) + (size_t)(g * 64 + lane) * 16;
        f32x2 bb[16]; float cre[16], cim[16], dsk[16];
#pragma unroll
        for (int c = 0; c < 16; ++c) { bb[c] = bbp[c];
            cre[c] = P.in[I_OD_C_RE][((size_t)(o_idx * 64 + g) * 16 + c) * 64 + lane]; cim[c] = P.in[I_OD_C_IM][((size_t)(o_idx * 64 + g) * 16 + c) * 64 + lane];
            dsk[c] = P.in[I_OD_D][o_idx * 1024 + g * 16 + c]; }
        float hr = 0.f, hi = 0.f;
        for (int t = 0; t < SEQ; ++t) { const size_t row = (size_t)(b * SEQ + t);
            const u32x4 u0 = *(const u32x4*)(U + row * 1024 + g * 16), u1 = *(const u32x4*)(U + row * 1024 + g * 16 + 8);
            float u[16] = {bf_lo(u0.x), bf_hi(u0.x), bf_lo(u0.y), bf_hi(u0.y), bf_lo(u0.z), bf_hi(u0.z), bf_lo(u0.w), bf_hi(u0.w),
                           bf_lo(u1.x), bf_hi(u1.x), bf_lo(u1.y), bf_hi(u1.y), bf_lo(u1.z), bf_hi(u1.z), bf_lo(u1.w), bf_hi(u1.w)};
            float bur = 0.f, bui = 0.f;
#pragma unroll
            for (int c = 0; c < 16; ++c) { bur += u[c] * bb[c][0]; bui += u[c] * bb[c][1]; }
            const float nr = ab[0] * hr - ab[1] * hi + bur, ni = ab[0] * hi + ab[1] * hr + bui; hr = nr; hi = ni;
            float zo = 0.f;
#pragma unroll
            for (int c = 0; c < 16; ++c) { const float y = wave_sum(hr * cre[c] - hi * cim[c]) + dsk[c] * u[c]; const float z = gelu_tanh(y); zo = (lane == c) ? z : zo; }
            if (lane < 16) Z[row * 1024 + g * 16 + lane] = f2bf(zo); }
    }
}
__device__ __forceinline__ void ffn_fix_panel(const float* hf, const float* hl, bf16* ACT, const float* cw, const float* cb, int pm, int tid) {
    if ((pm & 7) == 0) return;
    for (int idx = tid; idx < 2 * DFF; idx += 512) { const int j = idx % DFF, rr = idx / DFF;
        float o[2];
#pragma unroll
        for (int bj = 0; bj < 2; ++bj) { const int col = bj * DFF + j;
            const float l0 = hl[((size_t)((pm - 1) * 2 + 0) * 2 + bj) * DFF + j], l1 = hl[((size_t)((pm - 1) * 2 + 1) * 2 + bj) * DFF + j];
            const float f0 = hf[((size_t)(pm * 2 + 0) * 2 + bj) * DFF + j], f1 = hf[((size_t)(pm * 2 + 1) * 2 + bj) * DFF + j];
            const float um2 = rr == 0 ? l0 : l1, um1 = rr == 0 ? l1 : f0, u0 = rr == 0 ? f0 : f1;
            o[bj] = cb[col] + cw[col] * um2 + cw[DFF2 + col] * um1 + cw[2 * DFF2 + col] * u0; }
        ACT[(size_t)(pm * 256 + rr) * DFF + j] = f2bf(gelu_tanh(o[0]) * o[1]); }
}

typedef short s16x4 __attribute__((ext_vector_type(4)));
typedef short bf16x8v __attribute__((ext_vector_type(8)));
typedef float f32x16 __attribute__((ext_vector_type(16)));
__device__ __forceinline__ unsigned offb(unsigned row, unsigned ch) { return 256u * row + 16u * (ch ^ (((row & 3u) << 2) | ((row >> 2) & 3u))); }
constexpr int ATT_TILE_BYTES = 64 * 256, ATT_BUF_BYTES = 2 * ATT_TILE_BYTES;
__device__ __forceinline__ bf16x8v cat8(const s16x4 a, const s16x4 b) { return (bf16x8v){a[0], a[1], a[2], a[3], b[0], b[1], b[2], b[3]}; }

template <int MODE>
__device__ __forceinline__ void phase_attn(KP kp0, int kwave_, LAS unsigned char* lds, int o_idx) { KPREF(P, kp0); PHASE_IDS();
    constexpr int NKS = MODE == 0 ? 8 : 4;
    constexpr int NDT = MODE == 0 ? 4 : 2;
    constexpr int NH = 1;
    const bf16* Q = (const bf16*)(P.ws + WS_Q); const bf16* K = (const bf16*)(P.ws + WS_K); const bf16* V = (const bf16*)(P.ws + WS_V); bf16* MIX = (bf16*)(P.ws + WS_MIX);
    const int r = lane & 31, hh = lane >> 5, q4 = (lane & 15) >> 2, p4 = lane & 3, blk = (lane >> 4) & 1;
    unsigned kaddr[NKS], vaddr[2][NDT];
    { const unsigned x = ((r & 3u) << 2) | ((r >> 2) & 3u);
#pragma unroll
      for (int s = 0; s < NKS; ++s) kaddr[s] = 256u * r + 16u * (((unsigned)(2 * s + hh)) ^ x);
#pragma unroll
      for (int t = 0; t < 2; ++t)
#pragma unroll
        for (int c = 0; c < NDT; ++c) { const unsigned row = 8u * t + 4u * hh + q4, ch = 4u * c + 2u * blk + (p4 >> 1);
            vaddr[t][c] = 256u * row + 16u * (ch ^ (((row & 3u) << 2) | ((row >> 2) & 3u))) + 8u * (p4 & 1); } }
    const int nunits = MODE == 0 ? 256 : 512;
    for (int unit = bx; unit < nunits; unit += G) {
        int b, head0, q0, kt0, kt1; size_t kvbase; int kvpitch; unsigned kx = 0u;
        if (MODE == 0) { const int qb = 7 - (unit >> 5), bh = unit & 31; b = bh >> 3; head0 = bh & 7; q0 = qb * 256; kt0 = qb >= 2 ? 4 * (qb - 2) : 0; kt1 = qb * 4 + 3; kvbase = (size_t)b * SEQ * 1024 + head0 * 128; kvpitch = 1024; }
        else { b = unit >> 7; const int kvh = (unit >> 6) & 1; kx = 128u * kvh; q0 = (unit & 63) * 32; head0 = 8 * kvh + wave; kt0 = (q0 >= 127 ? q0 - 127 : 0) >> 6; kt1 = (q0 + 31) >> 6; kvbase = (size_t)b * SEQ * 128; kvpitch = 128; }
        const int tq = MODE == 0 ? q0 + 16 * (r & 15) + 2 * wave + (r >> 4) : q0 + r;
        const size_t qrow = (size_t)b * SEQ + tq;
        bf16x8v qf[NH][NKS];
#pragma unroll
        for (int hd = 0; hd < NH; ++hd)
#pragma unroll
            for (int s = 0; s < NKS; ++s) qf[hd][s] = *(const bf16x8v*)(Q + qrow * 1024 + (MODE == 0 ? head0 * 128 : (head0 + hd) * 64) + 16 * s + 8 * hh);
        f32x16 O[NH][NDT]; float m[NH], l[NH];
#pragma unroll
        for (int hd = 0; hd < NH; ++hd) { m[hd] = -1e30f; l[hd] = 0.f;
#pragma unroll
            for (int c = 0; c < NDT; ++c)
#pragma unroll
                for (int i = 0; i < 16; ++i) O[hd][c][i] = 0.f; }
        const int srow = tid >> 4, sch = tid & 15;
        const unsigned soff0 = offb(srow, sch), soff1 = offb(srow + 32, sch);
        u32x4 kreg[2], vreg[2];
        { const size_t g0 = kvbase + (size_t)(kt0 * 64 + srow) * kvpitch + sch * 8, g1 = g0 + (size_t)32 * kvpitch;
          kreg[0] = *(const u32x4*)(K + g0); kreg[1] = *(const u32x4*)(K + g1); vreg[0] = *(const u32x4*)(V + g0); vreg[1] = *(const u32x4*)(V + g1); }
        __syncthreads();
        *(LAS u32x4*)(lds + soff0) = kreg[0]; *(LAS u32x4*)(lds + soff1) = kreg[1];
        *(LAS u32x4*)(lds + ATT_TILE_BYTES + soff0) = vreg[0]; *(LAS u32x4*)(lds + ATT_TILE_BYTES + soff1) = vreg[1];
        __syncthreads();
        for (int kt = kt0; kt <= kt1; ++kt) {
            const int cur = (kt - kt0) & 1;
            LAS unsigned char* kb_ = lds + cur * ATT_BUF_BYTES; LAS unsigned char* vb_ = kb_ + ATT_TILE_BYTES;
            if (kt < kt1) { const size_t g0 = kvbase + (size_t)((kt + 1) * 64 + srow) * kvpitch + sch * 8, g1 = g0 + (size_t)32 * kvpitch;
                kreg[0] = *(const u32x4*)(K + g0); kreg[1] = *(const u32x4*)(K + g1); vreg[0] = *(const u32x4*)(V + g0); vreg[1] = *(const u32x4*)(V + g1); }
            {
                const int dq = tq - 64 * kt - 4 * hh;
#pragma unroll
                for (int hd = 0; hd < NH; ++hd) {
                    f32x16 S[2];
#pragma unroll
                    for (int kb = 0; kb < 2; ++kb) {
#pragma unroll
                        for (int i = 0; i < 16; ++i) S[kb][i] = 0.f;
#pragma unroll
                        for (int s = 0; s < NKS; ++s) { const bf16x8v kf = *(const LAS bf16x8v*)(kb_ + (kaddr[s] ^ kx) + kb * 8192); S[kb] = __builtin_amdgcn_mfma_f32_32x32x16_bf16(kf, qf[hd][s], S[kb], 0, 0, 0); }
                    }
                    float w[2][16]; float tmax = -INFINITY;
#pragma unroll
                    for (int kb = 0; kb < 2; ++kb)
#pragma unroll
                        for (int i = 0; i < 16; ++i) { const int d = dq - (kb * 32 + (i & 3) + 8 * (i >> 2));
                            if (MODE == 0) { const int cnt = (d <= 128 ? 1 : 0) + (((d & 3) == 0 && d <= 512) ? 1 : 0) + ((d & 15) == 0 ? 1 : 0); w[kb][i] = (d >= 0) ? (float)cnt : 0.f; }
                            else w[kb][i] = (d >= 0 && d <= 127) ? 1.f : 0.f;
                            S[kb][i] = (w[kb][i] > 0.f) ? S[kb][i] : -INFINITY; tmax = fmaxf(tmax, S[kb][i]); }
                    tmax = fmaxf(tmax, __shfl_xor(tmax, 32));
                    const float mn = fmaxf(m[hd], tmax), corr = __builtin_amdgcn_exp2f(m[hd] - mn); m[hd] = mn;
                    float ps = 0.f;
#pragma unroll
                    for (int kb = 0; kb < 2; ++kb)
#pragma unroll
                        for (int i = 0; i < 16; ++i) { const float pv = w[kb][i] * __builtin_amdgcn_exp2f(S[kb][i] - mn); S[kb][i] = pv; ps += pv; }
                    l[hd] = l[hd] * corr + ps;
#pragma unroll
                    for (int c = 0; c < NDT; ++c)
#pragma unroll
                        for (int i = 0; i < 16; ++i) O[hd][c][i] *= corr;
#pragma unroll
                    for (int kb = 0; kb < 2; ++kb)
#pragma unroll
                        for (int s2 = 0; s2 < 2; ++s2) {
                            bf16x8v pf; { const unsigned a0 = cvt_pk_bf16(S[kb][8 * s2 + 0], S[kb][8 * s2 + 1]), a1 = cvt_pk_bf16(S[kb][8 * s2 + 2], S[kb][8 * s2 + 3]),
                                                         a2 = cvt_pk_bf16(S[kb][8 * s2 + 4], S[kb][8 * s2 + 5]), a3 = cvt_pk_bf16(S[kb][8 * s2 + 6], S[kb][8 * s2 + 7]);
                                pf = __builtin_bit_cast(bf16x8v, (u32x4){a0, a1, a2, a3}); }
#pragma unroll
                            for (int c = 0; c < NDT; ++c) {
                                const s16x4 v0 = __builtin_amdgcn_ds_read_tr16_b64_v4i16((LAS s16x4*)(vb_ + (vaddr[0][c] ^ kx) + 256 * (32 * kb + 16 * s2)));
                                const s16x4 v1 = __builtin_amdgcn_ds_read_tr16_b64_v4i16((LAS s16x4*)(vb_ + (vaddr[1][c] ^ kx) + 256 * (32 * kb + 16 * s2)));
                                O[hd][c] = __builtin_amdgcn_mfma_f32_32x32x16_bf16(cat8(v0, v1), pf, O[hd][c], 0, 0, 0); }
                        }
                }
            }
            if (kt < kt1) { LAS unsigned char* nb_ = lds + (cur ^ 1) * ATT_BUF_BYTES;
                *(LAS u32x4*)(nb_ + soff0) = kreg[0]; *(LAS u32x4*)(nb_ + soff1) = kreg[1];
                *(LAS u32x4*)(nb_ + ATT_TILE_BYTES + soff0) = vreg[0]; *(LAS u32x4*)(nb_ + ATT_TILE_BYTES + soff1) = vreg[1]; }
            __syncthreads();
        }
        if (MODE == 0 && kt0 > 0) {
            LAS unsigned char* pk = lds + wave * 16384; LAS unsigned char* pv = pk + 8192;
            const int nfar = 4 * kt0;
            for (int s = 0; s * 16 < nfar; ++s) {
#pragma unroll
                for (int jh = 0; jh < 2; ++jh) { u32x4 kf[4], vf[4];
#pragma unroll
                    for (int j = 0; j < 4; ++j) { const int row = (lane >> 4) + 4 * (4 * jh + j), keypos = 2 * wave + (row >> 4) + 16 * (16 * s + (row & 15)); const size_t g0 = kvbase + (size_t)keypos * kvpitch + (lane & 15) * 8;
                        kf[j] = *(const u32x4*)(K + g0); vf[j] = *(const u32x4*)(V + g0); }
#pragma unroll
                    for (int j = 0; j < 4; ++j) { const unsigned so = offb((lane >> 4) + 4 * (4 * jh + j), lane & 15); *(LAS u32x4*)(pk + so) = kf[j]; *(LAS u32x4*)(pv + so) = vf[j]; } }
                f32x16 S;
#pragma unroll
                for (int i = 0; i < 16; ++i) S[i] = 0.f;
#pragma unroll
                for (int s8 = 0; s8 < NKS; ++s8) { const bf16x8v kfr = *(const LAS bf16x8v*)(pk + kaddr[s8]); S = __builtin_amdgcn_mfma_f32_32x32x16_bf16(kfr, qf[0][s8], S, 0, 0, 0); }
                float tmax = -INFINITY;
#pragma unroll
                for (int i = 0; i < 16; ++i) { const bool ok = (i >> 3) == (r >> 4); S[i] = ok ? S[i] : -INFINITY; tmax = fmaxf(tmax, S[i]); }
                tmax = fmaxf(tmax, __shfl_xor(tmax, 32));
                const float mn = fmaxf(m[0], tmax), corr = __builtin_amdgcn_exp2f(m[0] - mn); m[0] = mn;
                float ps = 0.f;
#pragma unroll
                for (int i = 0; i < 16; ++i) { const float pvv = __builtin_amdgcn_exp2f(S[i] - mn); S[i] = pvv; ps += pvv; }
                l[0] = l[0] * corr + ps;
#pragma unroll
                for (int c = 0; c < NDT; ++c)
#pragma unroll
                    for (int i = 0; i < 16; ++i) O[0][c][i] *= corr;
#pragma unroll
                for (int s2 = 0; s2 < 2; ++s2) {
                    bf16x8v pf; { const unsigned a0 = cvt_pk_bf16(S[8 * s2 + 0], S[8 * s2 + 1]), a1 = cvt_pk_bf16(S[8 * s2 + 2], S[8 * s2 + 3]), a2 = cvt_pk_bf16(S[8 * s2 + 4], S[8 * s2 + 5]), a3 = cvt_pk_bf16(S[8 * s2 + 6], S[8 * s2 + 7]);
                        pf = __builtin_bit_cast(bf16x8v, (u32x4){a0, a1, a2, a3}); }
#pragma unroll
                    for (int c = 0; c < NDT; ++c) {
                        const s16x4 v0 = __builtin_amdgcn_ds_read_tr16_b64_v4i16((LAS s16x4*)(pv + vaddr[0][c] + 256 * (16 * s2)));
                        const s16x4 v1 = __builtin_amdgcn_ds_read_tr16_b64_v4i16((LAS s16x4*)(pv + vaddr[1][c] + 256 * (16 * s2)));
                        O[0][c] = __builtin_amdgcn_mfma_f32_32x32x16_bf16(cat8(v0, v1), pf, O[0][c], 0, 0, 0); }
                }
            }
        }
#pragma unroll
        for (int hd = 0; hd < NH; ++hd) {
            float lt = l[hd] + __shfl_xor(l[hd], 32);
            if (MODE == 1) lt += __builtin_amdgcn_exp2f(P.in[I_OD_SINKS][o_idx * 16 + head0 + hd] * LOG2E - m[hd]);
            const float inv = 1.0f / lt;
            bf16* orow = MIX + qrow * 2048 + (MODE == 0 ? head0 * 128 : (head0 + hd) * 64);
#pragma unroll
            for (int c = 0; c < NDT; ++c)
#pragma unroll
                for (int g4 = 0; g4 < 4; ++g4) { u32x2 o; o.x = cvt_pk_bf16(O[hd][c][4 * g4 + 0] * inv, O[hd][c][4 * g4 + 1] * inv); o.y = cvt_pk_bf16(O[hd][c][4 * g4 + 2] * inv, O[hd][c][4 * g4 + 3] * inv);
                    *(u32x2*)(orow + 32 * c + 8 * g4 + 4 * hh) = o; }
        }
    }
    __syncthreads();
}
__device__ __forceinline__ void phase_s5(KP kp0, int kwave_, LAS unsigned char* lds, int o_idx) { KPREF(P, kp0); PHASE_IDS();
    const bf16* Ug = (const bf16*)(P.ws + WS_XB); bf16* Z = (bf16*)(P.ws + WS_YB);
    constexpr int UP = 1296;
    LAS unsigned char* uc = lds; LAS float* eL = (LAS float*)(lds + 64 * UP);
    const int r = lane & 31, hh = lane >> 5;
    for (int bg = bx; bg < 256; bg += G) { const int b = bg >> 6, g = bg & 63, og = o_idx * 64 + g;
        const bf16* TT = (const bf16*)(P.ws + WS_S5TT) + (size_t)og * 512 * 640; const bf16* T2 = (const bf16*)(P.ws + WS_S5T2) + (size_t)og * 128 * 512;
        __syncthreads();
        { const int row = tid >> 3, piece = tid & 7; const bf16* src = Ug + ((size_t)g * MT + (size_t)b * SEQ + 32 * row) * 16 + piece * 64;
#pragma unroll
          for (int q = 0; q < 8; ++q) *(LAS u32x4*)(uc + row * UP + (piece * 8 + q) * 16) = *(const u32x4*)(src + q * 8); }
        __syncthreads();
        {
            const int rt = wave & 1, ct = wave >> 1; f32x16 acc;
#pragma unroll
            for (int i = 0; i < 16; ++i) acc[i] = 0.f;
            const bf16* bp = T2 + (size_t)(32 * ct + r) * 512 + 8 * hh;
#pragma unroll 8
            for (int s = 0; s < 32; ++s) { const bf16x8v bf = *(const bf16x8v*)(bp + 16 * s); const bf16x8v af = *(const LAS bf16x8v*)(uc + (32 * rt + r) * UP + 32 * s + 16 * hh);
                acc = __builtin_amdgcn_mfma_f32_32x32x16_bf16(af, bf, acc, 0, 0, 0); }
#pragma unroll
            for (int i = 0; i < 16; ++i) eL[(32 * rt + (i & 3) + 8 * (i >> 2) + 4 * hh) * 128 + 32 * ct + r] = acc[i];
        }
        __syncthreads();
        if (wave == 0) { const f32x2 a32 = ((const f32x2*)(P.ws + WS_S5A32))[og * 64 + lane]; float hr = 0.f, hi = 0.f;
            for (int ch = 0; ch < 64; ++ch) { *(LAS unsigned short*)(uc + ch * UP + 1024 + lane * 2) = f2bf(hr); *(LAS unsigned short*)(uc + ch * UP + 1152 + lane * 2) = f2bf(hi);
                const float er = eL[ch * 128 + lane], ei = eL[ch * 128 + 64 + lane]; const float nr = a32[0] * hr - a32[1] * hi + er, ni = a32[0] * hi + a32[1] * hr + ei; hr = nr; hi = ni; } }
        __syncthreads();
        const float dsk = P.in[I_OD_D][o_idx * 1024 + g * 16 + (r & 15)];
#pragma unroll
        for (int cti = 0; cti < 2; ++cti) { const int ct = wave + 8 * cti; f32x16 acc0, acc1;
#pragma unroll
            for (int i = 0; i < 16; ++i) { acc0[i] = 0.f; acc1[i] = 0.f; }
            const bf16* bp = TT + (size_t)(32 * ct + r) * 640 + 8 * hh;
#pragma unroll 8
            for (int s = 0; s < 40; ++s) { const bf16x8v bf = *(const bf16x8v*)(bp + 16 * s);
                const bf16x8v a0 = *(const LAS bf16x8v*)(uc + r * UP + 32 * s + 16 * hh), a1 = *(const LAS bf16x8v*)(uc + (32 + r) * UP + 32 * s + 16 * hh);
                acc0 = __builtin_amdgcn_mfma_f32_32x32x16_bf16(a0, bf, acc0, 0, 0, 0); acc1 = __builtin_amdgcn_mfma_f32_32x32x16_bf16(a1, bf, acc1, 0, 0, 0); }
            const int n = 32 * ct + r, j = n >> 4, cp = n & 15;
#pragma unroll
            for (int rt = 0; rt < 2; ++rt)
#pragma unroll
                for (int i = 0; i < 16; ++i) { const int ch = 32 * rt + (i & 3) + 8 * (i >> 2) + 4 * hh; const float y = (rt ? acc1[i] : acc0[i]) + dsk * bf2f(*(const LAS unsigned short*)(uc + ch * UP + n * 2));
                    Z[((size_t)b * SEQ + 32 * ch + j) * 1024 + g * 16 + cp] = f2bf(gelu_tanh(y)); }
        }
    }
}

__device__ __forceinline__ void phase_lru(KP kp0, int kwave_, LAS unsigned char* lds, int e) { KPREF(P, kp0); PHASE_IDS();
    const bf16* XB = (const bf16*)(P.ws + WS_XB); const bf16* YB = (const bf16*)(P.ws + WS_YB); bf16* MIX = (bf16*)(P.ws + WS_MIX);
    LAS unsigned char* xcL = lds;
    LAS float* aL = (LAS float*)(lds + 69632); LAS float* bL = (LAS float*)(lds + 86016);
    LAS float* sA = (LAS float*)(lds + 102400); LAS float* sB = (LAS float*)(lds + 104448);
    LAS float* carry = (LAS float*)(lds + 106496);
    const int c16 = lane & 15, kq = lane >> 4, cg = tid & 15, rg = tid >> 4;
    for (int item = bx; item < 256; item += G) { const int b = item >> 6, blk = (item >> 3) & 7, oct = item & 7, ch0 = blk * 128 + oct * 16;
        float cw[4][8], cb[8];
#pragma unroll
        for (int q = 0; q < 8; ++q) { cb[q] = P.in[I_EV_CONV_B][e * 1024 + blk * 128 + cg * 8 + q];
#pragma unroll
            for (int i = 0; i < 4; ++i) cw[i][q] = P.in[I_EV_CONV_W][(size_t)(e * 4 + i) * 1024 + blk * 128 + cg * 8 + q]; }
        bf16x8v bfr[4], bfi[4];
        { const bf16* wg = (const bf16*)(P.ws + WS_WGATE) + ((size_t)(e * 8 + blk) * 256 + oct * 16 + c16) * 128 + 8 * kq;
#pragma unroll
          for (int s = 0; s < 4; ++s) { bfr[s] = *(const bf16x8v*)(wg + 32 * s); bfi[s] = *(const bf16x8v*)(wg + 128 * 128 + 32 * s); } }
        const float gab = P.in[I_EV_GA_B][e * 1024 + ch0 + c16], gxb = P.in[I_EV_GX_B][e * 1024 + ch0 + c16];
        const float sp8 = -8.0f * log1pf(expf(-P.in[I_EV_LAMBDA][e * 1024 + ch0 + c16]));
        if (tid < 16) carry[tid] = 0.f;
        for (int tc = 0; tc < 8; ++tc) { const int t0 = tc * 256;
            __syncthreads();
            {
                u32x4 xin[11];
#pragma unroll
                for (int i = 0; i < 11; ++i) { const int tt = t0 + 8 * rg - 3 + i;
                    xin[i] = (tt >= 0) ? *(const u32x4*)(XB + (size_t)(b * SEQ + tt) * 1024 + blk * 128 + cg * 8) : (u32x4){0u, 0u, 0u, 0u}; }
#pragma unroll
                for (int j = 0; j < 8; ++j) { float o[8];
#pragma unroll
                    for (int q = 0; q < 8; ++q) o[q] = cb[q];
#pragma unroll
                    for (int i = 0; i < 4; ++i) { const u32x4 x = xin[j + i];
                        o[0] += cw[i][0] * bf_lo(x.x); o[1] += cw[i][1] * bf_hi(x.x); o[2] += cw[i][2] * bf_lo(x.y); o[3] += cw[i][3] * bf_hi(x.y);
                        o[4] += cw[i][4] * bf_lo(x.z); o[5] += cw[i][5] * bf_hi(x.z); o[6] += cw[i][6] * bf_lo(x.w); o[7] += cw[i][7] * bf_hi(x.w); }
                    u32x4 w; w.x = cvt_pk_bf16(o[0], o[1]); w.y = cvt_pk_bf16(o[2], o[3]); w.z = cvt_pk_bf16(o[4], o[5]); w.w = cvt_pk_bf16(o[6], o[7]);
                    *(LAS u32x4*)(xcL + (8 * rg + j) * 272 + cg * 16) = w; }
            }
            __syncthreads();
#pragma unroll
            for (int rb = 0; rb < 2; ++rb) { const int row0 = 32 * wave + 16 * rb;
                f32x4 accr = {0.f, 0.f, 0.f, 0.f}, acci = {0.f, 0.f, 0.f, 0.f};
#pragma unroll
                for (int s = 0; s < 4; ++s) { const bf16x8v af = *(const LAS bf16x8v*)(xcL + (row0 + c16) * 272 + 64 * s + 16 * kq);
                    accr = __builtin_amdgcn_mfma_f32_16x16x32_bf16(af, bfr[s], accr, 0, 0, 0); acci = __builtin_amdgcn_mfma_f32_16x16x32_bf16(af, bfi[s], acci, 0, 0, 0); }
#pragma unroll
                for (int i = 0; i < 4; ++i) { const int row = row0 + 4 * kq + i;
                    const float rr = 1.0f / (1.0f + __expf(-(accr[i] + gab))), ig = 1.0f / (1.0f + __expf(-(acci[i] + gxb)));
                    const float a = __expf(sp8 * rr), mult = sqrtf(fmaxf(1.0f - a * a, 0.f));
                    const float xv = bf2f(*(const LAS unsigned short*)(xcL + row * 272 + (oct * 16 + c16) * 2));
                    aL[row * 16 + c16] = a; bL[row * 16 + c16] = mult * ig * xv; }
            }
            __syncthreads();
            float av[8], bv[8], A = 1.f, B = 0.f;
#pragma unroll
            for (int i = 0; i < 8; ++i) { av[i] = aL[(8 * rg + i) * 16 + cg]; bv[i] = bL[(8 * rg + i) * 16 + cg]; B = av[i] * B + bv[i]; A *= av[i]; }
            sA[rg * 16 + cg] = A; sB[rg * 16 + cg] = B;
            __syncthreads();
            float h = carry[cg];
            for (int j = 0; j < rg; ++j) h = sA[j * 16 + cg] * h + sB[j * 16 + cg];
#pragma unroll
            for (int i = 0; i < 8; ++i) { h = av[i] * h + bv[i]; const size_t row = (size_t)(b * SEQ + t0 + 8 * rg + i);
                MIX[row * 2048 + 1024 + ch0 + cg] = f2bf(h * bf2f(YB[row * 1024 + ch0 + cg])); }
            __syncthreads();
            if (rg == 31) carry[cg] = h;
        }
    }
}

constexpr int N_PHASES = 2 + 11 * NLAYER + 1;
#ifndef NREP_G
#define NREP_G 1
#endif
#ifndef NREP_M
#define NREP_M 1
#endif
#ifndef NREP_MB
#define NREP_MB 1
#endif
#ifndef NREP_BAR
#define NREP_BAR 1
#endif
#ifndef NREP_E
#define NREP_E 1
#endif
#ifndef NREP_P
#define NREP_P 1
#endif
#ifndef TAIL_INPROJ
#define TAIL_INPROJ 1
#endif
#ifndef MK_ONE_LAUNCH
#define MK_ONE_LAUNCH 1
#endif
__global__ void __launch_bounds__(512, 2) fwd(Params P) {
    extern __shared__ __attribute__((aligned(16))) unsigned char lds_raw[];
    LAS unsigned char* lds = (LAS unsigned char*)lds_raw;
    const int kwave = __builtin_amdgcn_readfirstlane((int)threadIdx.x >> 6);
    for (int u = threadIdx.x; u < (LDS_BYTES - LDSCTL_OFF) / 4; u += 512) ((LAS unsigned*)(lds + LDSCTL_OFF))[u] = 0u;
    __syncthreads();
    const KP kp = (KP)__builtin_amdgcn_kernarg_segment_ptr();
    const int ph_lo = kp->lo, ph_hi = kp->hi;
    unsigned* barw = (unsigned*)(kp->ws + WS_CTL) + CW_BAR + kp->li * XCD_BAR_WORDS;
    XcdBarrier bar; bar.bar = barw; bar.x = 0; bar.w0 = 0u; bar.st = nullptr;
    if (ph_hi - ph_lo > 1) bar = xcd_barrier_post(barw, (volatile LAS unsigned*)(lds + LDSCTL_OFF + 64));
    bar.w0 = (kwave == 0) ? 1u : 0u;
    const bool tails = gridDim.x == 256;
#define RUN(p) (ph_lo <= (p) && (p) < ph_hi)
#define SEAM(p) do { if (RUN(p) && RUN((p) + 1)) for (int rb_ = 0; rb_ < NREP_BAR; ++rb_) xcd_barrier(bar); } while (0)

    if (RUN(0)) for (int rep = 0; rep < NREP_P; ++rep) phase_ada(kp, kwave, lds);
    SEAM(0);
    if (RUN(1)) for (int rep = 0; rep < NREP_P; ++rep) phase_prep(kp, kwave, lds, tails);
    SEAM(1);
    for (int l = 0; l < NLAYER; ++l) {
        const int pb = 2 + 11 * l, e = l >> 1; const bool odd = (l & 1) != 0;
        if (RUN(pb + 0) && l == 0) for (int rep = 0; rep < NREP_E; ++rep) phase_norm0(kp, kwave);
        if (l == 0) SEAM(pb + 0);
        if (RUN(pb + 1)) for (int rep = 0; rep < NREP_G; ++rep) { KPREF(P, kp); const int kwave_ = kwave; PHASE_IDS(); const bf16* H = (const bf16*)(P.ws + WS_H); bf16* Qb = (bf16*)(P.ws + WS_Q);
            if (!odd) { pg8::Gemm g{H, (const bf16*)(P.ws + WS_W_EVIN) + (size_t)e * EVEN_IN * DM, MT, EVEN_IN, DM}; pg8::StaticOrder S; S.init(MT, EVEN_IN, G, bx);
                pg8::EpiEvenIn E{Qb, (const float*)(P.ws + WS_COSA), (const float*)(P.ws + WS_SINA), QSCALE_A, (const float*)(P.ws + WS_SS) + (size_t)(2 * l) * MT * 32, (const float*)(P.ws + WS_CVEC) + CV_EVIN + (size_t)e * 4 * EVEN_IN, (LAS float*)(lds + RING_BYTES + 6144)};
                pg8::gemm_phase<pg8::EpiEvenIn, pg8::StaticOrder, true, true>(lds, g, S, E, tid);
                { FRESH_IDS();
                if (tails && rep + 1 == NREP_G && fbx >= 128) {
                    if (l == 0) { if (TAIL_INPROJ) conv_range(kp, lds, 1, 3776, 6848, fbx - 128, 128, fwave, flane); }
                    else if (fbx < 192) s5_pre(kp, lds, 64 + fbx - 128, ftid);
                    else if (TAIL_INPROJ) conv_range(kp, lds, 3, 5312, 6848, fbx - 192, 64, fwave, flane); } } }
            else { pg8::Gemm g{H, (const bf16*)(P.ws + WS_W_ODIN) + (size_t)e * ODD_IN * DM, MT, ODD_IN, DM}; pg8::StaticOrder S; S.init(MT, ODD_IN, G, bx);
                pg8::EpiOddIn E{Qb, (bf16*)(P.ws + WS_K), (bf16*)(P.ws + WS_V), (bf16*)(P.ws + WS_XB), (const float*)(P.ws + WS_COSC), (const float*)(P.ws + WS_SINC), QSCALE_C, (const float*)(P.ws + WS_SS) + (size_t)(2 * l) * MT * 32, (const float*)(P.ws + WS_CVEC) + CV_ODIN + (size_t)e * 4 * ODD_IN, (LAS float*)(lds + RING_BYTES + 6144)};
                pg8::gemm_phase<pg8::EpiOddIn, pg8::StaticOrder, true, true>(lds, g, S, E, tid);
                { FRESH_IDS(); if (TAIL_INPROJ && tails && rep + 1 == NREP_G && l == 1 && fbx >= 32) conv_range(kp, lds, 2, 1408, 6784, fbx - 32, 224, fwave, flane); } }
        }
        SEAM(pb + 1);
        if (RUN(pb + 2)) for (int rep = 0; rep < NREP_M; ++rep) { if (!odd) phase_attn<0>(kp, kwave, lds, 0); else phase_attn<1>(kp, kwave, lds, e); }
        if (RUN(pb + 3)) for (int rep = 0; rep < (odd ? NREP_MB : 1); ++rep) { if (!odd) phase_lru(kp, kwave, lds, e); else phase_s5(kp, kwave, lds, e); }
        SEAM(pb + 3);
        if (RUN(pb + 4)) {
            if (odd) for (int rep = 0; rep < NREP_G; ++rep) { KPREF(P, kp); const int kwave_ = kwave; PHASE_IDS(); const bf16* YBb = (const bf16*)(P.ws + WS_YB); bf16* MIX = (bf16*)(P.ws + WS_MIX); pg8::Gemm g{YBb, (const bf16*)(P.ws + WS_W_GLU) + (size_t)e * 1024 * 1024, MT, 1024, 1024}; pg8::StaticOrder S; S.init(MT, 1024, G, bx);
                pg8::EpiGlu E{YBb, MIX, P.in[I_OD_GLU_B] + e * 1024};
                pg8::gemm_phase<pg8::EpiGlu, pg8::StaticOrder, true, true>(lds, g, S, E, tid);
                { FRESH_IDS(); if (TAIL_INPROJ && tails && rep + 1 == NREP_G && l == 1 && fbx >= 128) conv_range(kp, lds, 2, 6784, 8064, fbx - 128, 128, fwave, flane); } }
        }
        if (odd) SEAM(pb + 4);
        if (RUN(pb + 6)) for (int rep = 0; rep < NREP_G; ++rep) { KPREF(P, kp); const int kwave_ = kwave; PHASE_IDS(); const bf16* MIX = (const bf16*)(P.ws + WS_MIX); const float* mod = (const float*)(P.ws + WS_MOD);
            const bf16* W = odd ? (const bf16*)(P.ws + WS_W_ODOUT) + (size_t)e * DM * DM : (const bf16*)(P.ws + WS_W_EVOUT) + (size_t)e * DM * DM;
            pg8::Gemm g{MIX, W, MT, DM, DM}; pg8::StaticOrder S; S.init(MT, DM, G, bx);
            pg8::EpiResid E{l == 0 ? P.in[I_X] : P.out, rep + 1 < NREP_G ? (float*)(P.ws + 710 * MiB) : P.out, mod + (size_t)l * 4 * 12288 + 2 * DM, rep + 1 < NREP_G ? nullptr : (bf16*)(P.ws + WS_H), P.in[I_NORM_FFN] + l * DM, mod + (size_t)l * 4 * 12288 + 4 * DM, (float*)(P.ws + WS_SS) + (size_t)(2 * l + 1) * MT * 32};
            pg8::gemm_phase<pg8::EpiResid, pg8::StaticOrder, true, true>(lds, g, S, E, tid);
        }
        SEAM(pb + 6);
        if (RUN(pb + 8)) for (int rep = 0; rep < NREP_G; ++rep) { KPREF(P, kp); const int kwave_ = kwave; PHASE_IDS(); const bf16* H = (const bf16*)(P.ws + WS_H);
            pg8::Gemm g{H, (const bf16*)(P.ws + WS_W_FFIN) + (size_t)l * DFF2 * DM, MT, DFF2, DM}; pg8::StaticOrder S; S.init(MT, DFF2, G, bx);
            pg8::EpiFfnIn E{(bf16*)(P.ws + WS_ACT), (float*)(P.ws + WS_HALO_F), (float*)(P.ws + WS_HALO_L), P.in[I_FFN_CONV_W] + (size_t)l * 3 * DFF2, P.in[I_FFN_CONV_B] + (size_t)l * DFF2, (LAS float*)(lds + RING_BYTES), (const float*)(P.ws + WS_SS) + (size_t)(2 * l + 1) * MT * 32, (const float*)(P.ws + WS_CVEC) + CV_FFIN + (size_t)l * 4 * DFF2};
            pg8::gemm_phase<pg8::EpiFfnIn, pg8::StaticOrder, true, true>(lds, g, S, E, tid);
            { FRESH_IDS(); if (tails && rep + 1 == NREP_G && l + 1 < NLAYER && fbx >= 96) conv_range(kp, lds, l + 1, l == 1 ? 8064 : 6848, conv_total(l + 1), fbx - 96, 160, fwave, flane); }
        }
        SEAM(pb + 8);
        if (RUN(pb + 10)) for (int rep = 0; rep < NREP_G; ++rep) { KPREF(P, kp); const int kwave_ = kwave; PHASE_IDS(); const bf16* ACT = (const bf16*)(P.ws + WS_ACT); const float* mod = (const float*)(P.ws + WS_MOD);
            pg8::Gemm g{ACT, (const bf16*)(P.ws + WS_W_FFOUT) + (size_t)l * DM * DFF, MT, DM, DFF}; pg8::StaticOrder S; S.init(MT, DM, G, bx);
            if (l + 1 < NLAYER && rep == 0) cvec_reduce(kp, l + 1, bx, G, tid);
            { pg8::Unit fu; int lastpm = -1; for (int i = 0; S.next(i, fu); ++i) if (fu.pm != lastpm) { lastpm = fu.pm;
                ffn_fix_panel((const float*)(P.ws + WS_HALO_F), (const float*)(P.ws + WS_HALO_L), (bf16*)(P.ws + WS_ACT), P.in[I_FFN_CONV_W] + (size_t)l * 3 * DFF2, P.in[I_FFN_CONV_B] + (size_t)l * DFF2, fu.pm, tid); }
              asm volatile("s_waitcnt vmcnt(0)" ::: "memory"); __syncthreads(); }
            pg8::EpiResid E{P.out, rep + 1 < NREP_G ? (float*)(P.ws + 710 * MiB) : P.out, mod + (size_t)l * 4 * 12288 + 5 * DM, (rep + 1 < NREP_G || l == NLAYER - 1) ? nullptr : (bf16*)(P.ws + WS_H), P.in[I_NORM_MIX] + (l + 1 < NLAYER ? l + 1 : l) * DM, mod + (size_t)(l + 1 < NLAYER ? l + 1 : l) * 4 * 12288 + DM, (float*)(P.ws + WS_SS) + (size_t)(2 * l + 2) * MT * 32};
            pg8::gemm_phase<pg8::EpiResid, pg8::StaticOrder, true, true>(lds, g, S, E, tid);
        }
        SEAM(pb + 10);
    }
    if (RUN(N_PHASES - 1)) phase_final(kp, kwave);
#undef RUN
#undef SEAM
}

extern "C" void kernel_launch(void* const* d_in, const int* in_sizes, int n_in, void* d_out, int out_size, void* d_ws, size_t ws_size, hipStream_t stream) {
    static int grid = 0;
    if (grid == 0) {
        if (n_in != N_INPUTS || out_size != MT * DM || ws_size < WS_END) { fprintf(stderr, "kernel_launch: unexpected shapes: n_in %d out %d ws %zu (need %zu)\n", n_in, out_size, ws_size, (size_t)WS_END); grid = -1; return; }
        int dev = 0, cus = 0, per_cu = 0;
        if (hipGetDevice(&dev) != hipSuccess || hipDeviceGetAttribute(&cus, hipDeviceAttributeMultiprocessorCount, dev) != hipSuccess) { grid = -1; return; }
        if (hipFuncSetAttribute((const void*)fwd, hipFuncAttributeMaxDynamicSharedMemorySize, LDS_BYTES) != hipSuccess) { fprintf(stderr, "kernel_launch: hipFuncSetAttribute failed\n"); grid = -1; return; }
        if (hipOccupancyMaxActiveBlocksPerMultiprocessor(&per_cu, (const void*)fwd, 512, LDS_BYTES) != hipSuccess || per_cu < 1) fprintf(stderr, "kernel_launch: occupancy query says %d\n", per_cu);
        (void)hipGetLastError();
        grid = cus;
    }
    if (grid < 0) return;
    if (hipMemsetAsync((char*)d_ws + WS_CTL, 0, CTL_ZERO_BYTES, stream) != hipSuccess) return;
    Params p{};
    for (int i = 0; i < N_INPUTS; ++i) p.in[i] = (const float*)d_in[i];
    p.out = (float*)d_out; p.ws = (unsigned char*)d_ws; p.pad = 0;
#if MK_ONE_LAUNCH
    p.lo = 0; p.hi = N_PHASES; p.li = 0;
    hipLaunchKernelGGL(fwd, dim3(grid), dim3(512), LDS_BYTES, stream, p);
#else
    for (int ph = 0; ph < N_PHASES; ++ph) { p.lo = ph; p.hi = ph + 1; p.li = 0; hipLaunchKernelGGL(fwd, dim3(grid), dim3(512), LDS_BYTES, stream, p); }
#endif
    const hipError_t le = hipPeekAtLastError();
    if (le != hipSuccess) fprintf(stderr, "kernel_launch: launch failed: %s\n", hipGetErrorName(le));
}
```

```cpp
#include <hip/hip_runtime.h>
#include <cstdio>
#include <cstdint>
namespace pg8 {
#define PG8_LAS __attribute__((address_space(3)))
typedef unsigned short bf16_t;
typedef short bf16x8 __attribute__((ext_vector_type(8)));
typedef float f32x4 __attribute__((ext_vector_type(4)));
typedef unsigned u32x4 __attribute__((ext_vector_type(4)));
typedef unsigned u32x2 __attribute__((ext_vector_type(2)));
constexpr int BM = 256, BK = 64, HALF = 128, HTB = HALF * BK * 2  , STAGE_BYTES = 8 * HTB, NXCD = 8, WGM = 8;

__host__ __device__ __forceinline__ int lds_byte(int r, int c) { const int st = (r >> 4) * 2 + (c >> 5), rr = r & 15, cc = c & 31, ob = rr * 64 + cc * 2; return st * 1024 + (ob ^ (((ob >> 9) & 1) << 5)); }
__host__ __device__ __forceinline__ void stage_rc(int b, int& R, int& C) { const int st = b / 1024, sb = b % 1024, swz = sb ^ (((sb >> 9) & 1) << 5); R = (st >> 1) * 16 + swz / 64; C = (st & 1) * 32 + (swz % 64) / 2; }
__host__ __device__ __forceinline__ int perm32(int rho) { const int n = rho >> 4, i = rho & 15; return 8 * (i >> 2) + 4 * n + (i & 3); }

struct Unit { int pm, pn; };
struct Gemm { const bf16_t* A; const bf16_t* Bt; int M, N, K; };

struct StaticOrder {
    int nM, nN, nwg, G, c;
    __host__ __device__ __forceinline__ void init(int M, int N, int G_, int c_) { nM = M / BM; nN = N / BM; nwg = nM * nN; G = G_; c = c_; }
    __host__ __device__ __forceinline__ bool next(int i, Unit& u) const {
        const long L = (long)i * G + c; if (L >= nwg) return false;
        int wgid = (int)L; { const int q = nwg / NXCD, r = nwg % NXCD, xcd = wgid % NXCD, off = wgid / NXCD; wgid = (xcd < r ? xcd * (q + 1) : r * (q + 1) + (xcd - r) * q) + off; }
        const int nig = WGM * nN, gid = wgid / nig, fm = gid * WGM, gsz = (nM - fm) < WGM ? (nM - fm) : WGM;
        u.pm = fm + ((wgid % nig) % gsz); u.pn = (wgid % nig) / gsz; return true;
    }
    __device__ __forceinline__ void a_ready(const Unit&) const {}
    __device__ __forceinline__ void done(const Unit&) const {}
};

__device__ __forceinline__ unsigned cvt_pk_bf16(float lo, float hi) { unsigned r; asm volatile("v_cvt_pk_bf16_f32 %0, %1, %2" : "=v"(r) : "v"(lo), "v"(hi)); return r; }
__device__ __forceinline__ u32x4 pack8(const f32x4 a, const f32x4 b) { u32x4 w; w.x = cvt_pk_bf16(a[0], a[1]); w.y = cvt_pk_bf16(a[2], a[3]); w.z = cvt_pk_bf16(b[0], b[1]); w.w = cvt_pk_bf16(b[2], b[3]); return w; }
__device__ __forceinline__ float bf_lo(unsigned w) { return __uint_as_float(w << 16); }
__device__ __forceinline__ float bf_hi(unsigned w) { return __uint_as_float(w & 0xffff0000u); }
__device__ __forceinline__ float gelu_tanh(float x) {
    const float u = x * (0.7978845608f + 0.0356774081f * x * x);
    const float e = __builtin_amdgcn_exp2f(-2.885390082f * u);
    return x * __builtin_amdgcn_rcpf(1.0f + e);
}
__device__ __forceinline__ f32x4 gelu4(const f32x4 v) { return (f32x4){gelu_tanh(v[0]), gelu_tanh(v[1]), gelu_tanh(v[2]), gelu_tanh(v[3])}; }
__device__ __forceinline__ float sigmoidf_fast(float x) { return __builtin_amdgcn_rcpf(1.0f + __builtin_amdgcn_exp2f(-1.4426950409f * x)); }

__device__ __forceinline__ void build_rtab(const float* ssp, int row_base, PG8_LAS float* rtab, int wr, int wc, int fr, int fq) {
    const int t = (wr * 4 + wc) * 64 + fq * 16 + fr, row = t >> 1, hf = t & 1; const float* p = ssp + (size_t)(row_base + row) * 32 + 16 * hf;
    const f32x4 p0 = *(const f32x4*)p, p1 = *(const f32x4*)(p + 4), p2 = *(const f32x4*)(p + 8), p3 = *(const f32x4*)(p + 12);
    float s = (((p0[0] + p0[1]) + (p0[2] + p0[3])) + ((p1[0] + p1[1]) + (p1[2] + p1[3]))) + (((p2[0] + p2[1]) + (p2[2] + p2[3])) + ((p3[0] + p3[1]) + (p3[2] + p3[3])));
    s += __shfl_xor(s, 1);
    if (hf == 0) rtab[row] = rsqrtf(s * (1.0f / 2048.0f) + 1e-6f);
    asm volatile("s_waitcnt lgkmcnt(0)" ::: "memory"); __builtin_amdgcn_s_barrier(); asm volatile("" ::: "memory");
}

struct EpiStore {
    static constexpr bool PERM = true, AFTER_DRAIN = false;
    bf16_t* O; int ldc;
    __device__ __forceinline__ void operator()(const f32x4 (&acc)[2][2][4][2], const Unit& u, int wr, int wc, int fr, int fq) const {
        const int row0 = u.pm * BM + wr * 64 + fr, col0 = u.pn * BM + wc * 32 + 8 * fq;
#pragma unroll
        for (int ai = 0; ai < 2; ++ai)
#pragma unroll
            for (int m = 0; m < 4; ++m) { bf16_t* rowp = O + (size_t)(row0 + ai * HALF + m * 16) * ldc + col0;
#pragma unroll
                for (int bj = 0; bj < 2; ++bj) *(u32x4*)(rowp + bj * HALF) = pack8(acc[ai][bj][m][0], acc[ai][bj][m][1]); }
    }
};

struct EpiEvenIn {
    static constexpr bool PERM = true, AFTER_DRAIN = false;
    bf16_t *Q; const float *cosT, *sinT; float qscale; const float *ss, *cv; PG8_LAS float* rtab;
    __device__ __forceinline__ void operator()(const f32x4 (&acc)[2][2][4][2], const Unit& u, int wr, int wc, int fr, int fq) const {
        const int row0 = u.pm * BM + wr * 64 + fr;
        build_rtab(ss, u.pm * BM, rtab, wr, wc, fr, fq);
        f32x4 cv4[2][2];
#pragma unroll
        for (int bj = 0; bj < 2; ++bj)
#pragma unroll
            for (int n = 0; n < 2; ++n) cv4[bj][n] = *(const f32x4*)(cv + (size_t)(u.pm >> 3) * 5120 + u.pn * BM + bj * HALF + wc * 32 + 8 * fq + 4 * n);
        if (u.pn < 8) {
            bf16_t* dst = Q + (size_t)(u.pn >> 2) * (8u << 20); const float sc = (u.pn < 4) ? qscale : 1.0f;
            const int head = (u.pn & 3) * 2 + (wc >> 1), i0 = (wc & 1) * 32 + 8 * fq;
#pragma unroll
            for (int ai = 0; ai < 2; ++ai) {
#pragma unroll
              for (int mh = 0; mh < 2; ++mh) {
                f32x4 cs[2][4];
#pragma unroll
                for (int m2 = 0; m2 < 2; ++m2) { const int m = m2; const size_t tr = (size_t)(row0 + ai * HALF + (2 * mh + m2) * 16) * 64 + i0;
                    cs[m][0] = *(const f32x4*)(cosT + tr); cs[m][1] = *(const f32x4*)(cosT + tr + 4); cs[m][2] = *(const f32x4*)(sinT + tr); cs[m][3] = *(const f32x4*)(sinT + tr + 4); }
#pragma unroll
                for (int m2 = 0; m2 < 2; ++m2) { const int m = 2 * mh + m2; const int row = row0 + ai * HALF + m * 16; const float rrm = rtab[wr * 64 + ai * HALF + m * 16 + fr];
                    const f32x4 c0 = cs[m2][0], c1 = cs[m2][1], s0 = cs[m2][2], s1 = cs[m2][3];
                    const f32x4 a0 = acc[ai][0][m][0] * rrm + cv4[0][0], a1 = acc[ai][0][m][1] * rrm + cv4[0][1], b0 = acc[ai][1][m][0] * rrm + cv4[1][0], b1 = acc[ai][1][m][1] * rrm + cv4[1][1];
                    const f32x4 o10 = (a0 * c0 - b0 * s0) * sc, o11 = (a1 * c1 - b1 * s1) * sc, o20 = (b0 * c0 + a0 * s0) * sc, o21 = (b1 * c1 + a1 * s1) * sc;
                    bf16_t* rp = dst + (size_t)row * 1024 + head * 128 + i0;
                    *(u32x4*)(rp) = pack8(o10, o11); *(u32x4*)(rp + 64) = pack8(o20, o21); } } }
        } else {
            const int sel = (u.pn - 8) >> 2; bf16_t* dst = Q + (size_t)(u.pn >> 2) * (8u << 20); const int col0 = (u.pn & 3) * 256 + wc * 32 + 8 * fq;
#pragma unroll
            for (int ai = 0; ai < 2; ++ai)
#pragma unroll
                for (int m = 0; m < 4; ++m) { bf16_t* rowp = dst + (size_t)(row0 + ai * HALF + m * 16) * 1024 + col0; const float rrm = rtab[wr * 64 + ai * HALF + m * 16 + fr];
#pragma unroll
                    for (int bj = 0; bj < 2; ++bj) { f32x4 v0 = acc[ai][bj][m][0] * rrm + cv4[bj][0], v1 = acc[ai][bj][m][1] * rrm + cv4[bj][1];
                        if (sel == 2) { v0 = gelu4(v0); v1 = gelu4(v1); }
                        *(u32x4*)(rowp + bj * HALF) = pack8(v0, v1); } }
        }
    }
};

struct EpiOddIn {
    static constexpr bool PERM = true, AFTER_DRAIN = false;
    bf16_t *Q, *K, *V, *U; const float *cosT, *sinT; float qscale; const float *ss, *cv; PG8_LAS float* rtab;
    __device__ __forceinline__ void operator()(const f32x4 (&acc)[2][2][4][2], const Unit& u, int wr, int wc, int fr, int fq) const {
        const int row0 = u.pm * BM + wr * 64 + fr;
        build_rtab(ss, u.pm * BM, rtab, wr, wc, fr, fq);
        f32x4 cv4[2][2];
#pragma unroll
        for (int bj = 0; bj < 2; ++bj)
#pragma unroll
            for (int n = 0; n < 2; ++n) cv4[bj][n] = *(const f32x4*)(cv + (size_t)(u.pm >> 3) * 2304 + u.pn * BM + bj * HALF + wc * 32 + 8 * fq + 4 * n);
        if (u.pn < 4 || (u.pn == 4 && wc < 2)) {
            const bool isq = u.pn < 4; const float sc = isq ? qscale : 1.0f;
            bf16_t* dst = isq ? Q + (u.pn * 4 + wc) * 64 : K + wc * 64; const int pitch = isq ? 1024 : 128;
#pragma unroll
            for (int ai = 0; ai < 2; ++ai) {
#pragma unroll
              for (int mh = 0; mh < 2; ++mh) {
                f32x4 cs[2][4];
#pragma unroll
                for (int m2 = 0; m2 < 2; ++m2) { const int m = m2; const size_t tr = (size_t)(row0 + ai * HALF + (2 * mh + m2) * 16) * 32 + 8 * fq;
                    cs[m][0] = *(const f32x4*)(cosT + tr); cs[m][1] = *(const f32x4*)(cosT + tr + 4); cs[m][2] = *(const f32x4*)(sinT + tr); cs[m][3] = *(const f32x4*)(sinT + tr + 4); }
#pragma unroll
                for (int m2 = 0; m2 < 2; ++m2) { const int m = 2 * mh + m2; const int row = row0 + ai * HALF + m * 16; const float rrm = rtab[wr * 64 + ai * HALF + m * 16 + fr];
                    const f32x4 c0 = cs[m2][0], c1 = cs[m2][1], s0 = cs[m2][2], s1 = cs[m2][3];
                    const f32x4 a0 = acc[ai][0][m][0] * rrm + cv4[0][0], a1 = acc[ai][0][m][1] * rrm + cv4[0][1], b0 = acc[ai][1][m][0] * rrm + cv4[1][0], b1 = acc[ai][1][m][1] * rrm + cv4[1][1];
                    const f32x4 o10 = (a0 * c0 - b0 * s0) * sc, o11 = (a1 * c1 - b1 * s1) * sc, o20 = (b0 * c0 + a0 * s0) * sc, o21 = (b1 * c1 + a1 * s1) * sc;
                    bf16_t* rp = dst + (size_t)row * pitch + 8 * fq;
                    *(u32x4*)(rp) = pack8(o10, o11); *(u32x4*)(rp + 32) = pack8(o20, o21); } } }
        } else if (u.pn == 4) {
#pragma unroll
            for (int ai = 0; ai < 2; ++ai)
#pragma unroll
                for (int m = 0; m < 4; ++m) { bf16_t* rowp = V + (size_t)(row0 + ai * HALF + m * 16) * 128 + (wc - 2) * 32 + 8 * fq; const float rrm = rtab[wr * 64 + ai * HALF + m * 16 + fr];
#pragma unroll
                    for (int bj = 0; bj < 2; ++bj) *(u32x4*)(rowp + bj * 64) = pack8(acc[ai][bj][m][0] * rrm + cv4[bj][0], acc[ai][bj][m][1] * rrm + cv4[bj][1]); }
        } else {
            const int col0 = (u.pn - 5) * 256 + wc * 32 + 8 * fq;
#pragma unroll
            for (int ai = 0; ai < 2; ++ai)
#pragma unroll
                for (int m = 0; m < 4; ++m) { bf16_t* rowp = U + ((size_t)(col0 >> 4) * 8192 + (size_t)(row0 + ai * HALF + m * 16)) * 16 + (col0 & 8); const float rrm = rtab[wr * 64 + ai * HALF + m * 16 + fr];
#pragma unroll
                    for (int bj = 0; bj < 2; ++bj) *(u32x4*)(rowp + (size_t)bj * 8 * 8192 * 16) = pack8(acc[ai][bj][m][0] * rrm + cv4[bj][0], acc[ai][bj][m][1] * rrm + cv4[bj][1]); }
        }
    }
};

struct EpiResid {
    static constexpr bool PERM = true, AFTER_DRAIN = false;
    const float* base32; const bf16_t* baseb; bf16_t* outb; float* out32; const float* gate; bf16_t* Hn; const float* gn; const float* scn; float* ssn;
    __device__ __forceinline__ void operator()(const f32x4 (&acc)[2][2][4][2], const Unit& u, int wr, int wc, int fr, int fq) const {
        const int row0 = u.pm * BM + wr * 64 + fr, col0 = u.pn * BM + wc * 32 + 8 * fq; const float* gp = gate + (size_t)(u.pm >> 3) * 12288 + col0;
        f32x4 gv[2][2], an[2][2];
#pragma unroll
        for (int bj = 0; bj < 2; ++bj)
#pragma unroll
            for (int n = 0; n < 2; ++n) { gv[bj][n] = *(const f32x4*)(gp + bj * HALF + n * 4);
                an[bj][n] = Hn ? *(const f32x4*)(gn + col0 + bj * HALF + n * 4) * (1.0f + *(const f32x4*)(scn + (size_t)(u.pm >> 3) * 12288 + col0 + bj * HALF + n * 4)) : (f32x4){0.f, 0.f, 0.f, 0.f}; }
#pragma unroll
        for (int ai = 0; ai < 2; ++ai) {
#pragma unroll
          for (int mh = 0; mh < 2; ++mh) {
            f32x4 bs[2][2][2];
#pragma unroll
            for (int m2 = 0; m2 < 2; ++m2) { const size_t off = (size_t)(row0 + ai * HALF + (2 * mh + m2) * 16) * 2048 + col0;
#pragma unroll
                for (int bj = 0; bj < 2; ++bj) {
                    if (base32) { bs[m2][bj][0] = *(const f32x4*)(base32 + off + bj * HALF); bs[m2][bj][1] = *(const f32x4*)(base32 + off + bj * HALF + 4); }
                    else { const u32x4 w = *(const u32x4*)(baseb + off + bj * HALF); bs[m2][bj][0] = (f32x4){bf_lo(w.x), bf_hi(w.x), bf_lo(w.y), bf_hi(w.y)}; bs[m2][bj][1] = (f32x4){bf_lo(w.z), bf_hi(w.z), bf_lo(w.w), bf_hi(w.w)}; } } }
#pragma unroll
            for (int m2 = 0; m2 < 2; ++m2) { const int m = 2 * mh + m2; const int row = row0 + ai * HALF + m * 16; const size_t off = (size_t)row * 2048 + col0; float s2 = 0.f;
#pragma unroll
                for (int bj = 0; bj < 2; ++bj) {
                    const f32x4 o0 = bs[m2][bj][0] + gv[bj][0] * acc[ai][bj][m][0], o1 = bs[m2][bj][1] + gv[bj][1] * acc[ai][bj][m][1];
                    if (out32) { *(f32x4*)(out32 + off + bj * HALF) = o0; *(f32x4*)(out32 + off + bj * HALF + 4) = o1; }
                    else *(u32x4*)(outb + off + bj * HALF) = pack8(o0, o1);
                    if (Hn) { s2 += ((o0[0] * o0[0] + o0[1] * o0[1]) + (o0[2] * o0[2] + o0[3] * o0[3])) + ((o1[0] * o1[0] + o1[1] * o1[1]) + (o1[2] * o1[2] + o1[3] * o1[3]));
                        *(u32x4*)(Hn + off + bj * HALF) = pack8(o0 * an[bj][0], o1 * an[bj][1]); } }
                if (Hn) { s2 += __shfl_xor(s2, 16); s2 += __shfl_xor(s2, 32); if (fq == 0) ssn[(size_t)row * 32 + u.pn * 4 + wc] = s2; }
            }
          }
        }
    }
};

struct EpiGlu {
    static constexpr bool PERM = true, AFTER_DRAIN = false;
    const bf16_t* Z; bf16_t* MIX; const float* gb;
    __device__ __forceinline__ void operator()(const f32x4 (&acc)[2][2][4][2], const Unit& u, int wr, int wc, int fr, int fq) const {
        const int row0 = u.pm * BM + wr * 64 + fr, col0 = u.pn * BM + wc * 32 + 8 * fq;
        f32x4 bv[2][2];
#pragma unroll
        for (int bj = 0; bj < 2; ++bj)
#pragma unroll
            for (int n = 0; n < 2; ++n) bv[bj][n] = *(const f32x4*)(gb + col0 + bj * HALF + 4 * n);
#pragma unroll
        for (int ai = 0; ai < 2; ++ai) {
#pragma unroll
          for (int mh = 0; mh < 2; ++mh) {
            u32x4 zq[2][2];
#pragma unroll
            for (int m2 = 0; m2 < 2; ++m2)
#pragma unroll
                for (int bj = 0; bj < 2; ++bj) zq[m2][bj] = *(const u32x4*)(Z + (size_t)(row0 + ai * HALF + (2 * mh + m2) * 16) * 1024 + col0 + bj * HALF);
#pragma unroll
            for (int m2 = 0; m2 < 2; ++m2) { const int m = 2 * mh + m2; const size_t row = (size_t)(row0 + ai * HALF + m * 16);
#pragma unroll
                for (int bj = 0; bj < 2; ++bj) { const u32x4 zr = zq[m2][bj];
                    const f32x4 v0 = acc[ai][bj][m][0] + bv[bj][0], v1 = acc[ai][bj][m][1] + bv[bj][1];
                    const f32x4 z0 = (f32x4){bf_lo(zr.x), bf_hi(zr.x), bf_lo(zr.y), bf_hi(zr.y)}, z1 = (f32x4){bf_lo(zr.z), bf_hi(zr.z), bf_lo(zr.w), bf_hi(zr.w)};
                    const f32x4 o0 = (f32x4){z0[0] * sigmoidf_fast(v0[0]), z0[1] * sigmoidf_fast(v0[1]), z0[2] * sigmoidf_fast(v0[2]), z0[3] * sigmoidf_fast(v0[3])};
                    const f32x4 o1 = (f32x4){z1[0] * sigmoidf_fast(v1[0]), z1[1] * sigmoidf_fast(v1[1]), z1[2] * sigmoidf_fast(v1[2]), z1[3] * sigmoidf_fast(v1[3])};
                    *(u32x4*)(MIX + row * 2048 + 1024 + col0 + bj * HALF) = pack8(o0, o1); } } } }
    }
};

__device__ __forceinline__ float dpp_ror1(float v) { return __builtin_bit_cast(float, __builtin_amdgcn_update_dpp(0, __builtin_bit_cast(int, v), 0x121, 0xf, 0xf, false)); }
__device__ __forceinline__ float dpp_ror2(float v) { return __builtin_bit_cast(float, __builtin_amdgcn_update_dpp(0, __builtin_bit_cast(int, v), 0x122, 0xf, 0xf, false)); }
__device__ __forceinline__ float dpp_shr1(float old, float v) { return __builtin_bit_cast(float, __builtin_amdgcn_update_dpp(__builtin_bit_cast(int, old), __builtin_bit_cast(int, v), 0x111, 0xf, 0xf, false)); }
__device__ __forceinline__ float dpp_shr2(float old, float v) { return __builtin_bit_cast(float, __builtin_amdgcn_update_dpp(__builtin_bit_cast(int, old), __builtin_bit_cast(int, v), 0x112, 0xf, 0xf, false)); }
struct EpiFfnIn {
    static constexpr bool PERM = true, AFTER_DRAIN = false;
    bf16_t* ACT; float* halo_first; float* halo_last; const float* cw; const float* cb; PG8_LAS float* exch; const float *ss, *cv;
    __device__ __forceinline__ void operator()(f32x4 (&acc)[2][2][4][2], const Unit& u, int wr, int wc, int fr, int fq) const {
        asm volatile("" : "+v"(fr), "+v"(fq));
        const int jj0 = wc * 32 + 8 * fq, jcol = u.pn * 128 + jj0;
        build_rtab(ss, u.pm * BM, exch + 1536, wr, wc, fr, fq);
        {
            f32x4 cv4[2][2];
#pragma unroll
            for (int bj = 0; bj < 2; ++bj)
#pragma unroll
                for (int n = 0; n < 2; ++n) cv4[bj][n] = *(const f32x4*)(cv + (size_t)(u.pm >> 3) * 11008 + u.pn * BM + bj * HALF + jj0 + 4 * n);
#pragma unroll
            for (int ai = 0; ai < 2; ++ai)
#pragma unroll
                for (int m = 0; m < 4; ++m) { const float r = exch[1536 + ai * HALF + wr * 64 + m * 16 + fr];
#pragma unroll
                    for (int bj = 0; bj < 2; ++bj)
#pragma unroll
                        for (int n = 0; n < 2; ++n) acc[ai][bj][m][n] = acc[ai][bj][m][n] * r + cv4[bj][n]; }
        }
        if (fr >= 14) { const int r2 = fr - 14;
#pragma unroll
            for (int bj = 0; bj < 2; ++bj)
#pragma unroll
                for (int n = 0; n < 2; ++n) {
                    *(PG8_LAS f32x4*)(exch + ((wr * 2 + r2) * 2 + bj) * 128 + jj0 + 4 * n) = acc[0][bj][3][n];
                    if (wr == 0) *(PG8_LAS f32x4*)(exch + ((2 * 2 + r2) * 2 + bj) * 128 + jj0 + 4 * n) = acc[1][bj][3][n];
                    else *(f32x4*)(halo_last + ((size_t)(u.pm * 2 + r2) * 2 + bj) * 5504 + jcol + 4 * n) = acc[1][bj][3][n];
                } }
        if (wr == 0 && fr < 2) {
#pragma unroll
            for (int bj = 0; bj < 2; ++bj)
#pragma unroll
                for (int n = 0; n < 2; ++n) *(f32x4*)(halo_first + ((size_t)(u.pm * 2 + fr) * 2 + bj) * 5504 + jcol + 4 * n) = acc[0][bj][0][n]; }
        asm volatile("s_waitcnt lgkmcnt(0)" ::: "memory"); __builtin_amdgcn_s_barrier(); asm volatile("" ::: "memory");
        const bool seq_start = (u.pm & 7) == 0;
#pragma unroll
        for (int n = 0; n < 2; ++n) {
            f32x4 w0[2], w1[2], w2[2], bb[2];
#pragma unroll
            for (int bj = 0; bj < 2; ++bj) { const int col = bj * 5504 + jcol + 4 * n;
                w0[bj] = *(const f32x4*)(cw + col); w1[bj] = *(const f32x4*)(cw + 11008 + col); w2[bj] = *(const f32x4*)(cw + 22016 + col); bb[bj] = *(const f32x4*)(cb + col); }
#pragma unroll
            for (int ai = 0; ai < 2; ++ai) {
                f32x4 prev[2];
                const int slot = 2 * ai + wr - 1;
#pragma unroll
                for (int bj = 0; bj < 2; ++bj) prev[bj] = (slot >= 0) ? *(const PG8_LAS f32x4*)(exch + ((slot * 2 + (fr & 1)) * 2 + bj) * 128 + jj0 + 4 * n) : (f32x4){0.f, 0.f, 0.f, 0.f};
#pragma unroll
                for (int m = 0; m < 4; ++m) {
                    f32x4 cv[2];
#pragma unroll
                    for (int bj = 0; bj < 2; ++bj) { const f32x4 cur = acc[ai][bj][m][n]; f32x4 o;
#pragma unroll
                        for (int q = 0; q < 4; ++q) { const float um1 = dpp_shr1(dpp_ror1(prev[bj][q]), cur[q]), um2 = dpp_shr2(dpp_ror2(prev[bj][q]), cur[q]);
                            o[q] = bb[bj][q] + w0[bj][q] * um2 + w1[bj][q] * um1 + w2[bj][q] * cur[q]; }
                        cv[bj] = o; prev[bj] = cur; }
                    const f32x4 o0 = gelu4(cv[0]) * cv[1];
                    const bool skip = (ai == 0 && m == 0) && wr == 0 && fr < 2 && !seq_start;
                    if (!skip) { u32x2 w; w.x = cvt_pk_bf16(o0[0], o0[1]); w.y = cvt_pk_bf16(o0[2], o0[3]); *(u32x2*)(ACT + (size_t)(u.pm * BM + ai * HALF + wr * 64 + m * 16 + fr) * 5504 + jcol + 4 * n) = w; }
                }
            }
        }
    }
};
template <class Epi, class Sched, bool ALIGN_EPI = false, bool SP2 = false>
__device__ __forceinline__ void gemm_phase(PG8_LAS unsigned char* lds, const Gemm g, const Sched& S, const Epi& E, int tid_in) {
    int tid = tid_in; asm volatile("" : "+v"(tid));
    const int wid = __builtin_amdgcn_readfirstlane(tid >> 6), lane = tid & 63, wr = wid >> 2, wc = wid & 3, fr = lane & 15, fq = lane >> 4;
    const int K = g.K, nt = K / BK;
    unsigned voffA[2], voffB[2];
#pragma unroll
    for (int i = 0; i < 2; ++i) { int R, C; stage_rc(tid * 16 + i * 8192, R, C); const int Rb = Epi::PERM ? ((R & ~31) + perm32(R & 31)) : R;
        voffA[i] = (unsigned)(R * K + C) * 2u; voffB[i] = (unsigned)(Rb * K + C) * 2u; }
    const size_t kstep = (size_t)(BK * 2);
    const size_t hstep = (size_t)HALF * K * 2;
    const size_t tstep = 2 * hstep;
    const unsigned ldsw = (unsigned)wid * 1024u;
    const int aoff = lds_byte(wr * 64 + fr, fq * 8), boff = lds_byte(wc * 32 + fr, fq * 8);
#define PG8_SA(b, h) (((b) * 2 + (h)) * HTB)
#define PG8_SB(b, h) ((4 + (b) * 2 + (h)) * HTB)
#define PG8_STAGE(bufoff, gbase, voff) do { _Pragma("unroll") for (int _i = 0; _i < 2; ++_i) \
        __builtin_amdgcn_global_load_lds((const unsigned*)((const char*)(gbase) + (voff)[_i]), (PG8_LAS unsigned*)(lds + (bufoff) + ldsw + _i * 8192), 16, 0, 0); } while (0)
#define PG8_LDA(dst, b, h) do { _Pragma("unroll") for (int m = 0; m < 4; ++m) _Pragma("unroll") for (int k = 0; k < 2; ++k) dst[m][k] = *(const PG8_LAS bf16x8*)(lds + PG8_SA(b, h) + aoff + m * 2048 + k * 1024); } while (0)
#define PG8_LDB(dst, b, h) do { _Pragma("unroll") for (int n = 0; n < 2; ++n) _Pragma("unroll") for (int k = 0; k < 2; ++k) dst[n][k] = *(const PG8_LAS bf16x8*)(lds + PG8_SB(b, h) + boff + n * 2048 + k * 1024); } while (0)
#define PG8_MMA(ai, bj, At, Bt) do { __builtin_amdgcn_s_setprio(1); _Pragma("unroll") for (int m = 0; m < 4; ++m) _Pragma("unroll") for (int n = 0; n < 2; ++n) _Pragma("unroll") for (int k = 0; k < 2; ++k) \
        acc[ai][bj][m][n] = __builtin_amdgcn_mfma_f32_16x16x32_bf16(Bt[n][k], At[m][k], acc[ai][bj][m][n], 0, 0, 0); __builtin_amdgcn_s_setprio(0); } while (0)
#define PG8_WAIT_V(n) asm volatile("s_waitcnt vmcnt(" #n ")" ::: "memory")
#define PG8_WAIT_L(n) asm volatile("s_waitcnt lgkmcnt(" #n ")" ::: "memory")
#define PG8_BAR __builtin_amdgcn_s_barrier()
#define PG8_SCHED __builtin_amdgcn_sched_barrier(0)
    Unit cur, nxt; int ui = 0;
    if (!S.next(0, cur)) return;
    f32x4 acc[2][2][4][2];
#pragma unroll
    for (int a = 0; a < 2; ++a)
#pragma unroll
        for (int b = 0; b < 2; ++b)
#pragma unroll
            for (int m = 0; m < 4; ++m)
#pragma unroll
                for (int n = 0; n < 2; ++n) acc[a][b][m][n] = (f32x4){0.f, 0.f, 0.f, 0.f};
    bf16x8 At[4][2], B0[2][2], B1[2][2];
    const char* cA = (const char*)g.A + (size_t)cur.pm * tstep; const char* cB = (const char*)g.Bt + (size_t)cur.pn * tstep;
    S.a_ready(cur);
    if constexpr (SP2) {
        PG8_STAGE(PG8_SB(0, 0), cB, voffB); PG8_STAGE(PG8_SB(0, 1), cB + hstep, voffB); PG8_STAGE(PG8_SA(0, 0), cA, voffA); PG8_STAGE(PG8_SA(0, 1), cA + hstep, voffA);
        if (wr == 1) PG8_BAR;
        PG8_WAIT_V(2); PG8_BAR;
        PG8_STAGE(PG8_SB(1, 0), cB + kstep, voffB); PG8_STAGE(PG8_SA(1, 0), cA + kstep, voffA); PG8_STAGE(PG8_SB(1, 1), cB + hstep + kstep, voffB);
        PG8_WAIT_V(6); PG8_BAR;
    } else {
        PG8_STAGE(PG8_SB(0, 0), cB, voffB); PG8_STAGE(PG8_SA(0, 0), cA, voffA); PG8_STAGE(PG8_SB(0, 1), cB + hstep, voffB); PG8_STAGE(PG8_SA(0, 1), cA + hstep, voffA);
        if (wr == 1) PG8_BAR;
        PG8_WAIT_V(4); PG8_BAR;
        PG8_STAGE(PG8_SB(1, 0), cB + kstep, voffB); PG8_STAGE(PG8_SA(1, 0), cA + kstep, voffA); PG8_STAGE(PG8_SB(1, 1), cB + hstep + kstep, voffB);
        PG8_WAIT_V(6); PG8_BAR;
    }
    for (;;) {
        const bool has_next = S.next(ui + 1, nxt);
        const char* nA = has_next ? (const char*)g.A + (size_t)nxt.pm * tstep : cA; const char* nB = has_next ? (const char*)g.Bt + (size_t)nxt.pn * tstep : cB;
        for (int t = 0; t < nt; t += 2) {
            const bool last = (t == nt - 2);
            const char* a1 = cA + (size_t)(t + 1) * kstep;
            const char* a2 = last ? nA : cA + (size_t)(t + 2) * kstep; const char* b2 = last ? nB : cB + (size_t)(t + 2) * kstep;
            const char* a3 = a2 + kstep; const char* b3 = b2 + kstep;
            if (last && has_next) S.a_ready(nxt);
            if constexpr (SP2) {
            PG8_LDB(B0, 0, 0); PG8_LDB(B1, 0, 1); PG8_SCHED; PG8_LDA(At, 0, 0); PG8_STAGE(PG8_SA(1, 1), a1 + hstep, voffA);
            PG8_WAIT_V(8); PG8_WAIT_L(0); PG8_BAR; PG8_MMA(0, 0, At, B0); PG8_MMA(0, 1, At, B1); PG8_BAR; PG8_SCHED;
            PG8_LDA(At, 0, 1); PG8_STAGE(PG8_SB(0, 0), b2, voffB); PG8_STAGE(PG8_SB(0, 1), b2 + hstep, voffB); PG8_STAGE(PG8_SA(0, 0), a2, voffA);
            PG8_WAIT_V(8); PG8_WAIT_L(0); PG8_BAR; PG8_MMA(1, 0, At, B0); PG8_MMA(1, 1, At, B1); PG8_BAR; PG8_SCHED;
            PG8_LDB(B0, 1, 0); PG8_LDB(B1, 1, 1); PG8_SCHED; PG8_LDA(At, 1, 0); PG8_STAGE(PG8_SA(0, 1), a2 + hstep, voffA);
            PG8_WAIT_V(8); PG8_WAIT_L(0); PG8_BAR; PG8_MMA(0, 0, At, B0); PG8_MMA(0, 1, At, B1); PG8_BAR; PG8_SCHED;
            PG8_LDA(At, 1, 1); PG8_STAGE(PG8_SB(1, 0), b3, voffB); PG8_STAGE(PG8_SB(1, 1), b3 + hstep, voffB); PG8_STAGE(PG8_SA(1, 0), a3, voffA);
            PG8_WAIT_V(8); PG8_WAIT_L(0); PG8_BAR; PG8_MMA(1, 0, At, B0); PG8_MMA(1, 1, At, B1); PG8_BAR; PG8_SCHED;
            } else {
            PG8_LDB(B0, 0, 0); PG8_SCHED; PG8_LDA(At, 0, 0); PG8_STAGE(PG8_SA(1, 1), a1 + hstep, voffA);
            PG8_WAIT_L(8); PG8_BAR; PG8_WAIT_L(0); PG8_MMA(0, 0, At, B0); PG8_BAR; PG8_SCHED;
            PG8_LDB(B1, 0, 1); PG8_STAGE(PG8_SB(0, 0), b2, voffB);
            PG8_BAR; PG8_WAIT_L(0); PG8_MMA(0, 1, At, B1); PG8_BAR;
            PG8_LDA(At, 0, 1); PG8_STAGE(PG8_SA(0, 0), a2, voffA);
            PG8_BAR; PG8_WAIT_L(0); PG8_MMA(1, 0, At, B0); PG8_BAR; PG8_SCHED;
            PG8_STAGE(PG8_SB(0, 1), b2 + hstep, voffB);
            PG8_WAIT_V(6); PG8_BAR; PG8_MMA(1, 1, At, B1); PG8_BAR;
            PG8_LDB(B0, 1, 0); PG8_SCHED; PG8_LDA(At, 1, 0); PG8_STAGE(PG8_SA(0, 1), a2 + hstep, voffA);
            PG8_WAIT_L(8); PG8_BAR; PG8_WAIT_L(0); PG8_MMA(0, 0, At, B0); PG8_BAR; PG8_SCHED;
            PG8_LDB(B1, 1, 1); PG8_STAGE(PG8_SB(1, 0), b3, voffB);
            PG8_BAR; PG8_WAIT_L(0); PG8_MMA(0, 1, At, B1); PG8_BAR;
            PG8_LDA(At, 1, 1); PG8_STAGE(PG8_SA(1, 0), a3, voffA);
            PG8_BAR; PG8_WAIT_L(0); PG8_MMA(1, 0, At, B0); PG8_BAR; PG8_SCHED;
            PG8_STAGE(PG8_SB(1, 1), b3 + hstep, voffB);
            PG8_WAIT_V(6); PG8_BAR; PG8_MMA(1, 1, At, B1); PG8_BAR;
            }
        }
        if constexpr (ALIGN_EPI) { if (wr == 0) PG8_BAR; }
        if constexpr (!Epi::AFTER_DRAIN) { E(acc, cur, wr, wc, fr, fq); S.done(cur); }
        if (!has_next) break;
#pragma unroll
        for (int a = 0; a < 2; ++a)
#pragma unroll
            for (int b = 0; b < 2; ++b)
#pragma unroll
                for (int m = 0; m < 4; ++m)
#pragma unroll
                    for (int n = 0; n < 2; ++n) acc[a][b][m][n] = (f32x4){0.f, 0.f, 0.f, 0.f};
        cur = nxt; cA = nA; cB = nB; ++ui;
        if constexpr (ALIGN_EPI) { if (wr == 1) PG8_BAR; }
    }
    PG8_WAIT_V(0);
    if constexpr (!ALIGN_EPI) { if (wr == 0) PG8_BAR; }
    PG8_BAR;
    if constexpr (Epi::AFTER_DRAIN) { E.fused(acc, cur, wr, wc, fr, fq, lds, wid, lane); S.done(cur); }
#undef PG8_SA
#undef PG8_SB
#undef PG8_STAGE
#undef PG8_LDA
#undef PG8_LDB
#undef PG8_MMA
#undef PG8_WAIT_V
#undef PG8_WAIT_L
#undef PG8_BAR
#undef PG8_SCHED
}
}

constexpr int DM = 2048, NB = 4, SEQ = 2048, MT = NB * SEQ, NLAYER = 4;
constexpr int EVEN_IN = 5120, ODD_IN = 2304, DFF = 5504, DFF2 = 11008;
constexpr float LOG2E = 1.4426950408889634f;
constexpr float QSCALE_A = 0.08838834764831845f * LOG2E;
constexpr float QSCALE_C = 0.125f * LOG2E;
enum { I_X = 0, I_C, I_POS, I_ADA_W, I_ADA_B, I_NORM_MIX, I_NORM_FFN, I_NORM_FINAL,
       I_EV_W_IN, I_EV_CONV_W, I_EV_CONV_B, I_EV_GA_W, I_EV_GA_B, I_EV_GX_W, I_EV_GX_B, I_EV_LAMBDA, I_EV_W_OUT,
       I_OD_W_IN, I_OD_SINKS, I_OD_A_RE, I_OD_A_IM, I_OD_B_RE, I_OD_B_IM, I_OD_C_RE, I_OD_C_IM, I_OD_D, I_OD_LOG_DT, I_OD_GLU_W, I_OD_GLU_B, I_OD_W_OUT,
       I_FFN_W_IN, I_FFN_CONV_W, I_FFN_CONV_B, I_FFN_W_OUT, N_INPUTS };
constexpr size_t MiB = 1u << 20;
constexpr size_t WS_CTL = 0, CTL_ZERO_BYTES = 2 * MiB;
constexpr size_t WS_SS = 516 * MiB;
constexpr size_t WS_CVEC = 524288;
constexpr int CV_EVIN = 0, CV_ODIN = 2 * 4 * 5120, CV_FFIN = CV_ODIN + 2 * 4 * 2304;
constexpr int CV_TOTAL = CV_FFIN + 4 * 4 * 11008;
constexpr size_t WS_CVPART = 526 * MiB;
constexpr size_t WS_MOD = 11 * MiB;
constexpr size_t WS_COSA = 2 * MiB, WS_SINA = 4 * MiB, WS_COSC = 6 * MiB, WS_SINC = 7 * MiB;
constexpr size_t WS_S5T = 8 * MiB;
constexpr size_t WS_WGATE = 10 * MiB;
constexpr size_t WS_W_EVIN = 12 * MiB, WS_W_EVOUT = 52 * MiB, WS_W_ODIN = 68 * MiB, WS_W_ODOUT = 86 * MiB, WS_W_GLU = 102 * MiB, WS_W_FFIN = 106 * MiB, WS_W_FFOUT = 278 * MiB;
constexpr size_t WS_H = 364 * MiB, WS_MIX = 396 * MiB, WS_Q = 428 * MiB, WS_K = 444 * MiB, WS_V = 460 * MiB, WS_XB = 476 * MiB, WS_YB = 492 * MiB;
constexpr size_t WS_XC = 508 * MiB, WS_LA = 540 * MiB, WS_LB = 572 * MiB, WS_UFF = 604 * MiB, WS_ACT = 776 * MiB, WS_END = 862 * MiB;
constexpr size_t WS_HALO_F = 508 * MiB, WS_HALO_L = 512 * MiB;
constexpr size_t WS_XRES = 712 * MiB;
constexpr int CW_BAR = 4096;
constexpr int RING_BYTES = 131072, LDSCTL_OFF = 143360, LDS_BYTES = 147456;

#define GAS __attribute__((address_space(1)))
#define LAS __attribute__((address_space(3)))
typedef unsigned short bf16;
typedef float f32x4 __attribute__((ext_vector_type(4)));
typedef float f32x2 __attribute__((ext_vector_type(2)));
typedef unsigned u32x4 __attribute__((ext_vector_type(4)));
typedef unsigned u32x2 __attribute__((ext_vector_type(2)));
#define LDS_WAIT() asm volatile("s_waitcnt lgkmcnt(0)" ::: "memory")
using pg8::cvt_pk_bf16; using pg8::bf_lo; using pg8::bf_hi; using pg8::gelu_tanh;
__device__ __forceinline__ float wave_sum(float v) {
#pragma unroll
    for (int o = 1; o < 64; o <<= 1) v += __shfl_xor(v, o);
    return v;
}
__device__ __forceinline__ unsigned short f2bf(float f) { return (unsigned short)(cvt_pk_bf16(f, 0.f) & 0xffffu); }
__device__ __forceinline__ float bf2f(unsigned short b) { return __uint_as_float(((unsigned)b) << 16); }

struct Params { const float* in[N_INPUTS]; float* out; unsigned char* ws; int lo, hi, li, pad; };
typedef const __attribute__((address_space(4))) Params* KP;
#define KPREF(P, kp0) KP kp_ = (kp0); asm volatile("" : "+s"(kp_)); const __attribute__((address_space(4))) Params& P = *kp_
#define PHASE_IDS() int tid; asm volatile("v_mbcnt_lo_u32_b32 %0, -1, 0\n\tv_mbcnt_hi_u32_b32 %0, -1, %0" : "=v"(tid)); tid += kwave_ * 64;     const int lane = tid & 63, wave = __builtin_amdgcn_readfirstlane(tid >> 6); int bx = blockIdx.x; asm volatile("" : "+s"(bx)); const int G = gridDim.x; (void)lane; (void)wave; (void)G
#define FRESH_IDS() int ftid; asm volatile("v_mbcnt_lo_u32_b32 %0, -1, 0\n\tv_mbcnt_hi_u32_b32 %0, -1, %0" : "=v"(ftid)); const int flane = ftid, fwave = kwave; ftid += kwave * 64; int fbx = blockIdx.x; asm volatile("" : "+s"(fbx)); (void)flane; (void)fwave
#ifndef TAIL_INPROJ
#define TAIL_INPROJ 1
#endif
#define XB_TMO      128
#define XB_XCNT(j)  (256  + 64 * (j))
#define XB_XSUB(j)  (1280 + 64 * (j))
#define XB_XGEN(j)  (2304 + 64 * (j))
#define XB_TOP      3328
#define XB_TOPGEN   3392
#define XCD_BAR_WORDS 3456
#define XB_SPIN_CAP (1u << 18)
#define LAS __attribute__((address_space(3)))

__device__ __forceinline__ unsigned xb_ld(unsigned* p)              { return __hip_atomic_load(p, __ATOMIC_RELAXED, __HIP_MEMORY_SCOPE_AGENT); }
__device__ __forceinline__ unsigned xb_add(unsigned* p, unsigned v) { return __hip_atomic_fetch_add(p, v, __ATOMIC_RELAXED, __HIP_MEMORY_SCOPE_AGENT); }
__device__ __forceinline__ unsigned xb_xcc_id() { return (unsigned)__builtin_amdgcn_s_getreg((3 << 11) | 20) & 0xFu; }
#define XB_SPIN(cond, bar) do { unsigned _sp = 0; while (cond) { __builtin_amdgcn_s_sleep(1); \
    if ((++_sp & 255u) == 0u) { if (xb_ld(&(bar)[XB_TMO])) break; if (_sp > XB_SPIN_CAP) { atomicAdd(&(bar)[XB_TMO], 1u); break; } } } } while (0)

struct XcdBarrier {
    unsigned* bar; unsigned x; unsigned w0;
    volatile LAS unsigned* st;
};

__device__ __forceinline__ XcdBarrier xcd_barrier_post(unsigned* bar, volatile LAS unsigned* st) {
    XcdBarrier b; b.bar = bar; b.x = xb_xcc_id(); b.st = st;
    if (threadIdx.x == 0) (void)xb_add(&bar[XB_XCNT(b.x)], 1u);
    b.w0 = 0u;
    return b;
}
__device__ __forceinline__ void xcd_barrier_complete(unsigned* bar, unsigned x, unsigned& nloc, unsigned& nx) {
    const unsigned G = gridDim.x * gridDim.y * gridDim.z;
    unsigned sum, cnt, mine, sp = 0u;
    for (;;) {
        sum = 0u; cnt = 0u; mine = 0u;
#pragma unroll
        for (unsigned j = 0; j < 16; ++j) { const unsigned c = xb_ld(&bar[XB_XCNT(j)]); sum += c; cnt += (c > 0u) ? 1u : 0u; mine = (j == x) ? c : mine; }
        if (sum == G) break;
        __builtin_amdgcn_s_sleep(1);
        if ((++sp & 255u) == 0u) { if (xb_ld(&bar[XB_TMO])) break; if (sp > XB_SPIN_CAP) { atomicAdd(&bar[XB_TMO], 1u); break; } }
    }
    nloc = mine > 0u ? mine : 1u; nx = cnt > 0u ? cnt : 1u;
}

__device__ __forceinline__ void xcd_barrier(const XcdBarrier& b) {
    asm volatile("s_waitcnt vmcnt(0)" ::: "memory");
    __syncthreads();
    if (b.w0 != 0u && __builtin_amdgcn_mbcnt_hi(~0u, __builtin_amdgcn_mbcnt_lo(~0u, 0u)) == 0u) {
        unsigned* bar = b.bar;
        __builtin_amdgcn_s_waitcnt(0);
        unsigned nloc = b.st[0], nx = b.st[1];
        if (nloc == 0u) { xcd_barrier_complete(bar, b.x, nloc, nx); b.st[0] = nloc; b.st[1] = nx; }
        const unsigned old = xb_add(&bar[XB_XSUB(b.x)], 1u);
        const unsigned gen = old / nloc;
        if (old + 1u == (gen + 1u) * nloc) {
            __builtin_amdgcn_fence(__ATOMIC_RELEASE, "agent");
            asm volatile("s_waitcnt vmcnt(0)" ::: "memory");
            const unsigned og = xb_add(&bar[XB_TOP], 1u);
            const unsigned tg = og / nx;
            if (og + 1u == (tg + 1u) * nx) xb_add(&bar[XB_TOPGEN], 1u);
            else XB_SPIN(xb_ld(&bar[XB_TOPGEN]) == tg, bar);
            __builtin_amdgcn_fence(__ATOMIC_ACQUIRE, "agent");
            xb_add(&bar[XB_XGEN(b.x)], 1u);
            asm volatile("s_waitcnt vmcnt(0)" ::: "memory");
        } else {
            XB_SPIN(xb_ld(&bar[XB_XGEN(b.x)]) == gen, bar);
            __builtin_amdgcn_fence(__ATOMIC_ACQUIRE, "agent");
            asm volatile("s_waitcnt vmcnt(0)" ::: "memory");
        }
    }
    __syncthreads();
}
__device__ __forceinline__ void sincos_rev(double ang, float& s, float& c) {
    double rev = ang * 0.15915494309189535; rev -= floor(rev); const float fr = (float)rev;
    s = __builtin_amdgcn_sinf(fr); c = __builtin_amdgcn_cosf(fr);
}

constexpr size_t WS_S5TT = 604 * MiB, WS_S5T2 = 690 * MiB, WS_S5A32 = 707 * MiB;
__device__ __forceinline__ void s5_pre(KP kp0, LAS unsigned char* lds, int og, int tid) { KPREF(P, kp0);
    LAS float* apr = (LAS float*)lds; LAS float* api = apr + 33 * 64;
    LAS float* bbr = api + 33 * 64; LAS float* bbi = bbr + 1024;
    LAS float* cre = bbi + 1024; LAS float* cim = cre + 1024;
    LAS float* kern = cim + 1024;
    const int o = og >> 6, g = og & 63;
    const float dt = expf(P.in[I_OD_LOG_DT][og]);
    __syncthreads();
    for (int idx = tid; idx < 33 * 64; idx += 512) { const int k = idx >> 6, p = idx & 63; const float are = P.in[I_OD_A_RE][og * 64 + p], aim = P.in[I_OD_A_IM][og * 64 + p];
        const float er = expf((float)k * are * dt); float s, c; sincos_rev((double)k * (double)aim * (double)dt, s, c); apr[idx] = er * c; api[idx] = er * s; }
    for (int idx = tid; idx < 1024; idx += 512) { cre[idx] = P.in[I_OD_C_RE][(size_t)og * 1024 + idx]; cim[idx] = P.in[I_OD_C_IM][(size_t)og * 1024 + idx]; }
    __syncthreads();
    for (int idx = tid; idx < 1024; idx += 512) { const int p = idx >> 4; const float are = P.in[I_OD_A_RE][og * 64 + p], aim = P.in[I_OD_A_IM][og * 64 + p];
        const float xr = apr[64 + p] - 1.0f, xi = api[64 + p], den = 1.0f / (are * are + aim * aim), cr = (xr * are + xi * aim) * den, ci = (xi * are - xr * aim) * den;
        const float br = P.in[I_OD_B_RE][(size_t)og * 1024 + idx], bi = P.in[I_OD_B_IM][(size_t)og * 1024 + idx];
        bbr[idx] = cr * br - ci * bi; bbi[idx] = cr * bi + ci * br; }
    if (tid < 64) ((f32x2*)(P.ws + WS_S5A32))[og * 64 + tid] = (f32x2){apr[32 * 64 + tid], api[32 * 64 + tid]};
    __syncthreads();
    {
        const int pair = tid & 255, cp = pair >> 4, c = pair & 15, kh = tid >> 8; float acc[16];
#pragma unroll
        for (int kk = 0; kk < 16; ++kk) acc[kk] = 0.f;
        for (int p = 0; p < 64; ++p) { const float gr = cre[cp * 64 + p] * bbr[p * 16 + c] - cim[cp * 64 + p] * bbi[p * 16 + c], gi = cre[cp * 64 + p] * bbi[p * 16 + c] + cim[cp * 64 + p] * bbr[p * 16 + c];
#pragma unroll
            for (int kk = 0; kk < 16; ++kk) acc[kk] += gr * apr[(16 * kh + kk) * 64 + p] - gi * api[(16 * kh + kk) * 64 + p]; }
#pragma unroll
        for (int kk = 0; kk < 16; ++kk) kern[(16 * kh + kk) * 256 + pair] = acc[kk];
    }
    __syncthreads();
    bf16* TT = (bf16*)(P.ws + WS_S5TT) + (size_t)og * 512 * 640; bf16* T2 = (bf16*)(P.ws + WS_S5T2) + (size_t)og * 128 * 512;
    for (int idx = tid; idx < 512 * 64; idx += 512) { const int n = idx >> 6, ic = idx & 63, i = ic >> 1, ch = ic & 1, j = n >> 4, cp = n & 15; float v[8];
#pragma unroll
        for (int cc = 0; cc < 8; ++cc) v[cc] = (j >= i) ? kern[(j - i) * 256 + cp * 16 + 8 * ch + cc] : 0.f;
        u32x4 w; w.x = cvt_pk_bf16(v[0], v[1]); w.y = cvt_pk_bf16(v[2], v[3]); w.z = cvt_pk_bf16(v[4], v[5]); w.w = cvt_pk_bf16(v[6], v[7]);
        *(u32x4*)(TT + (size_t)n * 640 + i * 16 + 8 * ch) = w; }
    for (int idx = tid; idx < 512 * 16; idx += 512) { const int n = idx >> 4, q = idx & 15, j = n >> 4, cp = n & 15, im = q >> 3, p0 = (q & 7) * 8; float v[8];
#pragma unroll
        for (int cc = 0; cc < 8; ++cc) { const int p = p0 + cc; const float ar = apr[(j + 1) * 64 + p], ai = api[(j + 1) * 64 + p], cr = cre[cp * 64 + p], ci = cim[cp * 64 + p];
            v[cc] = im ? -(cr * ai + ci * ar) : (cr * ar - ci * ai); }
        u32x4 w; w.x = cvt_pk_bf16(v[0], v[1]); w.y = cvt_pk_bf16(v[2], v[3]); w.z = cvt_pk_bf16(v[4], v[5]); w.w = cvt_pk_bf16(v[6], v[7]);
        *(u32x4*)(TT + (size_t)n * 640 + 512 + 64 * im + p0) = w; }
    for (int idx = tid; idx < 128 * 64; idx += 512) { const int comp = idx >> 6, ic = idx & 63, i = ic >> 1, ch = ic & 1, p = comp & 63, im = comp >> 6; float v[8];
        const float ar = apr[(31 - i) * 64 + p], ai = api[(31 - i) * 64 + p];
#pragma unroll
        for (int cc = 0; cc < 8; ++cc) { const float br = bbr[p * 16 + 8 * ch + cc], bi = bbi[p * 16 + 8 * ch + cc]; v[cc] = im ? (ar * bi + ai * br) : (ar * br - ai * bi); }
        u32x4 w; w.x = cvt_pk_bf16(v[0], v[1]); w.y = cvt_pk_bf16(v[2], v[3]); w.z = cvt_pk_bf16(v[4], v[5]); w.w = cvt_pk_bf16(v[6], v[7]);
        *(u32x4*)(T2 + (size_t)comp * 512 + i * 16 + 8 * ch) = w; }
}


__device__ __forceinline__ void phase_ada(KP kp0, int kwave_, LAS unsigned char* lds) { KPREF(P, kp0); PHASE_IDS();
    LAS float* cond = (LAS float*)lds;
    LAS float* part = (LAS float*)(lds + 32768);
    const float* c = P.in[I_C];
    for (int i = tid; i < NB * DM; i += 512) { const float v = c[i]; cond[i] = v / (1.0f + __expf(-v)); }
    __syncthreads();
    float* mod = (float*)(P.ws + WS_MOD);
    for (int item = bx; item < 192; item += G) {
        const int l = item / 48, ng = item % 48;
        const float* W = P.in[I_ADA_W] + (size_t)l * DM * 12288 + (size_t)(wave * 256) * 12288 + ng * 256 + lane * 4;
        f32x4 a0 = {0.f, 0.f, 0.f, 0.f}, a1 = a0, a2 = a0, a3 = a0;
#pragma unroll 8
        for (int k = 0; k < 256; ++k) {
            const f32x4 w = *(const f32x4*)(W + (size_t)k * 12288); const int kk = wave * 256 + k;
            a0 += cond[kk] * w; a1 += cond[2048 + kk] * w; a2 += cond[4096 + kk] * w; a3 += cond[6144 + kk] * w;
        }
        LAS float* pp = part + wave * 1024 + lane * 4;
        *(LAS f32x4*)(pp) = a0; *(LAS f32x4*)(pp + 256) = a1; *(LAS f32x4*)(pp + 512) = a2; *(LAS f32x4*)(pp + 768) = a3;
        __syncthreads();
        for (int o = tid; o < 1024; o += 512) {
            float s = 0.f;
#pragma unroll
            for (int w = 0; w < 8; ++w) s += part[w * 1024 + o];
            const int b = o >> 8, cc = o & 255;
            mod[(size_t)(l * 4 + b) * 12288 + ng * 256 + cc] = s + P.in[I_ADA_B][l * 12288 + ng * 256 + cc];
        }
        __syncthreads();
    }
    if (bx >= 192 || G < 256) for (int og = (G < 256 ? bx : bx - 192); og < (G == 256 ? 64 : 128); og += (G < 256 ? G : 64)) s5_pre(kp0, lds, og, tid);
}

__device__ __forceinline__ int cmap(int type, int n) {
    if (type == 1) { if (n >= 2048) return n; const int tile = n >> 8, j = n & 255, bj = j >> 7, jj = j & 127; return tile * 256 + (jj >> 6) * 128 + bj * 64 + (jj & 63); }
    if (type == 2) {
        if (n >= 1280) return n;
        if (n < 1024) { const int tile = n >> 8, j = n & 255, bj = j >> 7, jj = j & 127; return tile * 256 + (jj >> 5) * 64 + bj * 32 + (jj & 31); }
        const int j = n - 1024, bj = j >> 7, jj = j & 127; if (jj < 64) return 1024 + (jj >> 5) * 64 + bj * 32 + (jj & 31); return 1152 + bj * 64 + (jj - 64);
    }
    if (type == 3) { const int tile = n >> 8, j = n & 255; return (j >> 7) * 5504 + tile * 128 + (j & 127); }
    return n;
}
__device__ __forceinline__ void tr_item(const float* W, int K, int N, bf16* WT, int k0, int c0a, int c0b, int dstr0, LAS float* scr, int lane, float* cv, const float* sh) {
    const int csrc = ((lane & 8) ? c0b : c0a) + (lane & 7) * 4, cl = (lane & 15) * 4;
#pragma unroll
    for (int i = 0; i < 16; ++i) { const int kk = 4 * i + (lane >> 4); const f32x4 v = __builtin_nontemporal_load((const f32x4*)(W + (size_t)(k0 + kk) * N + csrc));
        LAS float* d = scr + kk * 65 + cl; d[0] = v[0]; d[1] = v[1]; d[2] = v[2]; d[3] = v[3]; }
    LDS_WAIT(); asm volatile("" ::: "memory");
    const int c = lane & 7;
#pragma unroll
    for (int j = 0; j < 8; ++j) { const int n = (lane >> 3) + 8 * j; const LAS float* s = scr + (8 * c) * 65 + n;
        u32x4 o; o.x = cvt_pk_bf16(s[0 * 65], s[1 * 65]); o.y = cvt_pk_bf16(s[2 * 65], s[3 * 65]); o.z = cvt_pk_bf16(s[4 * 65], s[5 * 65]); o.w = cvt_pk_bf16(s[6 * 65], s[7 * 65]);
        __builtin_nontemporal_store(o, (u32x4*)(WT + (size_t)(dstr0 + n) * K + k0 + 8 * c)); }
    if (cv) { float a0 = 0.f, a1 = 0.f, a2 = 0.f, a3 = 0.f;
#pragma unroll 16
        for (int k = 0; k < 64; ++k) { const float w = scr[k * 65 + lane]; a0 += sh[k0 + k] * w; a1 += sh[12288 + k0 + k] * w; a2 += sh[2 * 12288 + k0 + k] * w; a3 += sh[3 * 12288 + k0 + k] * w; }
        cv[dstr0 + lane] = a0; cv[N + dstr0 + lane] = a1; cv[2 * N + dstr0 + lane] = a2; cv[3 * N + dstr0 + lane] = a3; }
    LDS_WAIT(); asm volatile("" ::: "memory");
}
constexpr int CONV_EVEN = 11872, CONV_ODD = 10688;
__device__ __forceinline__ int conv_total(int L) { return (L & 1) ? CONV_ODD : CONV_EVEN; }
__device__ __forceinline__ void conv_item(KP kp0, int L, int idx, LAS float* scr, int lane) { KPREF(P, kp0);
    const float* mod = (const float*)(P.ws + WS_MOD) + (size_t)L * 4 * 12288; float* cvpart = (float*)(P.ws + WS_CVPART);
    const int e = L >> 1; const bool odd = (L & 1) != 0;
    int r = idx, in_idx, K, N, ctype = 0, cvo = -1; size_t wsoff; const float* sh = mod; size_t li_off;
    const int n_in = odd ? 1152 : 2560, n_aux = odd ? 256 : 32;
    if (r < n_in) { in_idx = odd ? I_OD_W_IN : I_EV_W_IN; K = 2048; N = odd ? ODD_IN : EVEN_IN; ctype = odd ? 2 : 1; wsoff = odd ? WS_W_ODIN : WS_W_EVIN; cvo = odd ? CV_ODIN + e * 4 * ODD_IN : CV_EVIN + e * 4 * EVEN_IN; li_off = (size_t)e * K * N; }
    else if ((r -= n_in) < n_aux) {
        if (!odd) { const int mat = r >> 1, kb = r & 1, gate = mat & 1, eb = e * 8 + (mat >> 1);
#pragma unroll
            for (int nb = 0; nb < 2; ++nb)
                tr_item(P.in[gate ? I_EV_GX_W : I_EV_GA_W] + (size_t)eb * 16384, 128, 128, (bf16*)(P.ws + WS_WGATE) + ((size_t)eb * 256 + gate * 128) * 128, 64 * kb, 64 * nb, 64 * nb + 32, 64 * nb, scr, lane, nullptr, nullptr);
            return; }
        in_idx = I_OD_GLU_W; K = 1024; N = 1024; wsoff = WS_W_GLU; li_off = (size_t)e * K * N; }
    else if ((r -= n_aux) < 1024) { in_idx = odd ? I_OD_W_OUT : I_EV_W_OUT; K = 2048; N = 2048; wsoff = odd ? WS_W_ODOUT : WS_W_EVOUT; li_off = (size_t)e * K * N; }
    else if ((r -= 1024) < 5504) { in_idx = I_FFN_W_IN; K = 2048; N = DFF2; ctype = 3; wsoff = WS_W_FFIN; cvo = CV_FFIN + L * 4 * DFF2; sh = mod + 3 * DM; li_off = (size_t)L * K * N; }
    else { r -= 5504; in_idx = I_FFN_W_OUT; K = DFF; N = 2048; wsoff = WS_W_FFOUT; li_off = (size_t)L * K * N; }
    const int nblk = N / 64, kb = r / nblk, nb = r % nblk;
    tr_item(P.in[in_idx] + li_off, K, N, (bf16*)(P.ws + wsoff) + li_off, 64 * kb, cmap(ctype, 64 * nb), cmap(ctype, 64 * nb + 32), 64 * nb, scr, lane,
            cvo >= 0 ? cvpart + ((size_t)kb * CV_TOTAL + cvo) : nullptr, sh);
}
__device__ __forceinline__ void conv_range(KP kp0, LAS unsigned char* lds, int L, int first, int last, int rank, int nranks, int wave, int lane) {
    LAS float* scr = (LAS float*)(lds + wave * 16640);
    for (int it = first + rank * 8 + wave; it < last; it += nranks * 8) conv_item(kp0, L, it, scr, lane);
}
__device__ __forceinline__ void cvec_reduce(KP kp0, int L, int bx, int G, int tid) { KPREF(P, kp0);
    const float* cvpart = (const float*)(P.ws + WS_CVPART); float* cvec = (float*)(P.ws + WS_CVEC);
    const int e = L >> 1, n_in = (L & 1) ? 4 * ODD_IN : 4 * EVEN_IN, o_in = (L & 1) ? CV_ODIN + e * 4 * ODD_IN : CV_EVIN + e * 4 * EVEN_IN, o_ff = CV_FFIN + L * 4 * DFF2;
    for (int i = bx * 512 + tid; i < n_in + 4 * DFF2; i += G * 512) { const int off = i < n_in ? o_in + i : o_ff + (i - n_in); float v[32];
#pragma unroll
        for (int kb = 0; kb < 32; ++kb) v[kb] = cvpart[(size_t)kb * CV_TOTAL + off];
        float s = 0.f;
#pragma unroll
        for (int kb = 0; kb < 32; ++kb) s += v[kb];
        cvec[off] = s; }
}
__device__ __forceinline__ int conv_up(int L, bool tails) { return !tails ? conv_total(L) : (L == 0 ? CONV_EVEN : (TAIL_INPROJ ? (L == 1 ? 3776 : (L == 2 ? 1408 : 5312)) : (L == 2 ? 8064 : 6848))); }
__device__ __forceinline__ void phase_prep(KP kp0, int kwave_, LAS unsigned char* lds, bool tails) { KPREF(P, kp0); PHASE_IDS();
    {
        LAS float* scr = (LAS float*)(lds + wave * 16640);
        const int t0 = conv_up(0, tails), t1 = t0 + conv_up(1, tails), t2 = t1 + conv_up(2, tails), t3 = t2 + conv_up(3, tails);
        for (int it = bx * 8 + wave; it < t3; it += G * 8) { const int L = it < t0 ? 0 : (it < t1 ? 1 : (it < t2 ? 2 : 3)); conv_item(kp0, L, it - (L == 0 ? 0 : (L == 1 ? t0 : (L == 2 ? t1 : t2))), scr, lane); }
    }
    const int gw = bx * 8 + wave, NGW = G * 8; (void)gw; (void)NGW;
    const int gt = bx * 512 + tid, NT = G * 512;
    const int* pos = (const int*)P.in[I_POS];
    float* cosA = (float*)(P.ws + WS_COSA); float* sinA = (float*)(P.ws + WS_SINA); float* cosC = (float*)(P.ws + WS_COSC); float* sinC = (float*)(P.ws + WS_SINC);
    for (int idx = gt; idx < MT * 64; idx += NT) { const int row = idx >> 6, i = idx & 63;
        const double inv = exp2(-(double)i * (13.287712379549449 / 64.0)); float s, c; sincos_rev((double)pos[row] * inv, s, c); cosA[idx] = c; sinA[idx] = s; }
    for (int idx = gt; idx < MT * 32; idx += NT) { const int row = idx >> 5, i = idx & 31;
        const double inv = exp2(-(double)i * (13.287712379549449 / 32.0)); float s, c; sincos_rev((double)pos[row] * inv, s, c); cosC[idx] = c; sinC[idx] = s; }
}

__device__ __forceinline__ void phase_norm0(KP kp0, int kwave_) { KPREF(P, kp0); PHASE_IDS();
    const float* x = P.in[I_X]; const float* gwt = P.in[I_NORM_MIX];
    const float* modl = (const float*)(P.ws + WS_MOD);
    bf16* H = (bf16*)(P.ws + WS_H); float* ss = (float*)(P.ws + WS_SS);
    const int gw = bx * 8 + wave, NGW = G * 8;
    for (int row = gw; row < MT; row += NGW) {
        const f32x4* xr = (const f32x4*)(x + (size_t)row * DM) + lane;
        f32x4 v[8]; float s2 = 0.f;
#pragma unroll
        for (int j = 0; j < 8; ++j) { v[j] = xr[64 * j]; s2 += (v[j][0] * v[j][0] + v[j][1] * v[j][1]) + (v[j][2] * v[j][2] + v[j][3] * v[j][3]); }
        s2 = wave_sum(s2); if (lane < 32) ss[(size_t)row * 32 + lane] = lane == 0 ? s2 : 0.f;
        const float* sc = modl + (size_t)(row >> 11) * 12288 + DM;
        u32x2* o8 = (u32x2*)(H + (size_t)row * DM) + lane;
#pragma unroll
        for (int j = 0; j < 8; ++j) { const int col = (lane + 64 * j) * 4;
            const f32x4 y = v[j] * *(const f32x4*)(gwt + col) * (1.0f + *(const f32x4*)(sc + col));
            u32x2 w; w.x = cvt_pk_bf16(y[0], y[1]); w.y = cvt_pk_bf16(y[2], y[3]); o8[64 * j] = w; }
    }
    cvec_reduce(kp0, 0, bx, G, tid);
}
__device__ __forceinline__ void phase_final(KP kp0, int kwave_) { KPREF(P, kp0); PHASE_IDS();
    const float* gwt = P.in[I_NORM_FINAL];
    const int gw = bx * 8 + wave, NGW = G * 8;
    for (int row = gw; row < MT; row += NGW) {
        f32x4* xr = (f32x4*)(P.out + (size_t)row * DM) + lane;
        f32x4 v[8]; float ss = 0.f;
#pragma unroll
        for (int j = 0; j < 8; ++j) { v[j] = xr[64 * j]; ss += (v[j][0] * v[j][0] + v[j][1] * v[j][1]) + (v[j][2] * v[j][2] + v[j][3] * v[j][3]); }
        const float rstd = rsqrtf(wave_sum(ss) * (1.0f / DM) + 1e-6f);
#pragma unroll
        for (int j = 0; j < 8; ++j) { const int col = (lane + 64 * j) * 4; xr[64 * j] = v[j] * rstd * *(const f32x4*)(gwt + col); }
    }
}

__device__ __forceinline__ void ffn_fix_panel(const float* hf, const float* hl, bf16* ACT, const float* cw, const float* cb, int pm, int tid) {
    if ((pm & 7) == 0) return;
    for (int idx = tid; idx < 2 * DFF; idx += 512) { const int j = idx % DFF, rr = idx / DFF;
        float o[2];
#pragma unroll
        for (int bj = 0; bj < 2; ++bj) { const int col = bj * DFF + j;
            const float l0 = hl[((size_t)((pm - 1) * 2 + 0) * 2 + bj) * DFF + j], l1 = hl[((size_t)((pm - 1) * 2 + 1) * 2 + bj) * DFF + j];
            const float f0 = hf[((size_t)(pm * 2 + 0) * 2 + bj) * DFF + j], f1 = hf[((size_t)(pm * 2 + 1) * 2 + bj) * DFF + j];
            const float um2 = rr == 0 ? l0 : l1, um1 = rr == 0 ? l1 : f0, u0 = rr == 0 ? f0 : f1;
            o[bj] = cb[col] + cw[col] * um2 + cw[DFF2 + col] * um1 + cw[2 * DFF2 + col] * u0; }
        ACT[(size_t)(pm * 256 + rr) * DFF + j] = f2bf(gelu_tanh(o[0]) * o[1]); }
}

typedef short s16x4 __attribute__((ext_vector_type(4)));
typedef short bf16x8v __attribute__((ext_vector_type(8)));
typedef float f32x16 __attribute__((ext_vector_type(16)));
__device__ __forceinline__ unsigned offb(unsigned row, unsigned ch) { return 256u * row + 16u * (ch ^ (((row & 3u) << 2) | ((row >> 2) & 3u))); }
constexpr int ATT_TILE_BYTES = 64 * 256, ATT_BUF_BYTES = 2 * ATT_TILE_BYTES;
__device__ __forceinline__ bf16x8v cat8(const s16x4 a, const s16x4 b) { return (bf16x8v){a[0], a[1], a[2], a[3], b[0], b[1], b[2], b[3]}; }

template <int MODE>
__device__ __forceinline__ void phase_attn(KP kp0, int kwave_, LAS unsigned char* lds, int o_idx) { KPREF(P, kp0); PHASE_IDS();
    constexpr int NKS = MODE == 0 ? 8 : 4;
    constexpr int NDT = MODE == 0 ? 4 : 2;
    constexpr int NH = 1;
    const bf16* Q = (const bf16*)(P.ws + WS_Q); const bf16* K = (const bf16*)(P.ws + WS_K); const bf16* V = (const bf16*)(P.ws + WS_V); bf16* MIX = (bf16*)(P.ws + WS_MIX);
    const int r = lane & 31, hh = lane >> 5, q4 = (lane & 15) >> 2, p4 = lane & 3, blk = (lane >> 4) & 1;
    unsigned kaddr[NKS], vaddr[2][NDT];
    { const unsigned x = ((r & 3u) << 2) | ((r >> 2) & 3u);
#pragma unroll
      for (int s = 0; s < NKS; ++s) kaddr[s] = 256u * r + 16u * (((unsigned)(2 * s + hh)) ^ x);
#pragma unroll
      for (int t = 0; t < 2; ++t)
#pragma unroll
        for (int c = 0; c < NDT; ++c) { const unsigned row = 8u * t + 4u * hh + q4, ch = 4u * c + 2u * blk + (p4 >> 1);
            vaddr[t][c] = 256u * row + 16u * (ch ^ (((row & 3u) << 2) | ((row >> 2) & 3u))) + 8u * (p4 & 1); } }
    const int nunits = MODE == 0 ? 256 : 512;
    for (int unit = bx; unit < nunits; unit += G) {
        int b, head0, q0, kt0, kt1; size_t kvbase; int kvpitch; unsigned kx = 0u;
        if (MODE == 0) { const int qb = 7 - (unit >> 5), bh = unit & 31; b = bh >> 3; head0 = bh & 7; q0 = qb * 256; kt0 = qb >= 2 ? 4 * (qb - 2) : 0; kt1 = qb * 4 + 3; kvbase = (size_t)b * SEQ * 1024 + head0 * 128; kvpitch = 1024; }
        else { b = unit >> 7; const int kvh = (unit >> 6) & 1; kx = 128u * kvh; q0 = (unit & 63) * 32; head0 = 8 * kvh + wave; kt0 = (q0 >= 127 ? q0 - 127 : 0) >> 6; kt1 = (q0 + 31) >> 6; kvbase = (size_t)b * SEQ * 128; kvpitch = 128; }
        const int tq = MODE == 0 ? q0 + 16 * (r & 15) + 2 * wave + (r >> 4) : q0 + r;
        const size_t qrow = (size_t)b * SEQ + tq;
        bf16x8v qf[NH][NKS];
#pragma unroll
        for (int hd = 0; hd < NH; ++hd)
#pragma unroll
            for (int s = 0; s < NKS; ++s) qf[hd][s] = *(const bf16x8v*)(Q + qrow * 1024 + (MODE == 0 ? head0 * 128 : (head0 + hd) * 64) + 16 * s + 8 * hh);
        f32x16 O[NH][NDT]; float m[NH], l[NH];
#pragma unroll
        for (int hd = 0; hd < NH; ++hd) { m[hd] = -1e30f; l[hd] = 0.f;
#pragma unroll
            for (int c = 0; c < NDT; ++c)
#pragma unroll
                for (int i = 0; i < 16; ++i) O[hd][c][i] = 0.f; }
        const int srow = tid >> 4, sch = tid & 15;
        const unsigned soff0 = offb(srow, sch), soff1 = offb(srow + 32, sch);
        u32x4 kreg[2], vreg[2];
        { const size_t g0 = kvbase + (size_t)(kt0 * 64 + srow) * kvpitch + sch * 8, g1 = g0 + (size_t)32 * kvpitch;
          kreg[0] = *(const u32x4*)(K + g0); kreg[1] = *(const u32x4*)(K + g1); vreg[0] = *(const u32x4*)(V + g0); vreg[1] = *(const u32x4*)(V + g1); }
        __syncthreads();
        *(LAS u32x4*)(lds + soff0) = kreg[0]; *(LAS u32x4*)(lds + soff1) = kreg[1];
        *(LAS u32x4*)(lds + ATT_TILE_BYTES + soff0) = vreg[0]; *(LAS u32x4*)(lds + ATT_TILE_BYTES + soff1) = vreg[1];
        __syncthreads();
        for (int kt = kt0; kt <= kt1; ++kt) {
            const int cur = (kt - kt0) & 1;
            LAS unsigned char* kb_ = lds + cur * ATT_BUF_BYTES; LAS unsigned char* vb_ = kb_ + ATT_TILE_BYTES;
            if (kt < kt1) { const size_t g0 = kvbase + (size_t)((kt + 1) * 64 + srow) * kvpitch + sch * 8, g1 = g0 + (size_t)32 * kvpitch;
                kreg[0] = *(const u32x4*)(K + g0); kreg[1] = *(const u32x4*)(K + g1); vreg[0] = *(const u32x4*)(V + g0); vreg[1] = *(const u32x4*)(V + g1); }
            {
                const int dq = tq - 64 * kt - 4 * hh;
#pragma unroll
                for (int hd = 0; hd < NH; ++hd) {
                    f32x16 S[2];
#pragma unroll
                    for (int kb = 0; kb < 2; ++kb) {
#pragma unroll
                        for (int i = 0; i < 16; ++i) S[kb][i] = 0.f;
#pragma unroll
                        for (int s = 0; s < NKS; ++s) { const bf16x8v kf = *(const LAS bf16x8v*)(kb_ + (kaddr[s] ^ kx) + kb * 8192); S[kb] = __builtin_amdgcn_mfma_f32_32x32x16_bf16(kf, qf[hd][s], S[kb], 0, 0, 0); }
                    }
                    float w[2][16]; float tmax = -INFINITY;
#pragma unroll
                    for (int kb = 0; kb < 2; ++kb)
#pragma unroll
                        for (int i = 0; i < 16; ++i) { const int d = dq - (kb * 32 + (i & 3) + 8 * (i >> 2));
                            if (MODE == 0) { const int cnt = (d <= 128 ? 1 : 0) + (((d & 3) == 0 && d <= 512) ? 1 : 0) + ((d & 15) == 0 ? 1 : 0); w[kb][i] = (d >= 0) ? (float)cnt : 0.f; }
                            else w[kb][i] = (d >= 0 && d <= 127) ? 1.f : 0.f;
                            S[kb][i] = (w[kb][i] > 0.f) ? S[kb][i] : -INFINITY; tmax = fmaxf(tmax, S[kb][i]); }
                    tmax = fmaxf(tmax, __shfl_xor(tmax, 32));
                    const float mn = fmaxf(m[hd], tmax), corr = __builtin_amdgcn_exp2f(m[hd] - mn); m[hd] = mn;
                    float ps = 0.f;
#pragma unroll
                    for (int kb = 0; kb < 2; ++kb)
#pragma unroll
                        for (int i = 0; i < 16; ++i) { const float pv = w[kb][i] * __builtin_amdgcn_exp2f(S[kb][i] - mn); S[kb][i] = pv; ps += pv; }
                    l[hd] = l[hd] * corr + ps;
#pragma unroll
                    for (int c = 0; c < NDT; ++c)
#pragma unroll
                        for (int i = 0; i < 16; ++i) O[hd][c][i] *= corr;
#pragma unroll
                    for (int kb = 0; kb < 2; ++kb)
#pragma unroll
                        for (int s2 = 0; s2 < 2; ++s2) {
                            bf16x8v pf; { const unsigned a0 = cvt_pk_bf16(S[kb][8 * s2 + 0], S[kb][8 * s2 + 1]), a1 = cvt_pk_bf16(S[kb][8 * s2 + 2], S[kb][8 * s2 + 3]),
                                                         a2 = cvt_pk_bf16(S[kb][8 * s2 + 4], S[kb][8 * s2 + 5]), a3 = cvt_pk_bf16(S[kb][8 * s2 + 6], S[kb][8 * s2 + 7]);
                                pf = __builtin_bit_cast(bf16x8v, (u32x4){a0, a1, a2, a3}); }
#pragma unroll
                            for (int c = 0; c < NDT; ++c) {
                                const s16x4 v0 = __builtin_amdgcn_ds_read_tr16_b64_v4i16((LAS s16x4*)(vb_ + (vaddr[0][c] ^ kx) + 256 * (32 * kb + 16 * s2)));
                                const s16x4 v1 = __builtin_amdgcn_ds_read_tr16_b64_v4i16((LAS s16x4*)(vb_ + (vaddr[1][c] ^ kx) + 256 * (32 * kb + 16 * s2)));
                                O[hd][c] = __builtin_amdgcn_mfma_f32_32x32x16_bf16(cat8(v0, v1), pf, O[hd][c], 0, 0, 0); }
                        }
                }
            }
            if (kt < kt1) { LAS unsigned char* nb_ = lds + (cur ^ 1) * ATT_BUF_BYTES;
                *(LAS u32x4*)(nb_ + soff0) = kreg[0]; *(LAS u32x4*)(nb_ + soff1) = kreg[1];
                *(LAS u32x4*)(nb_ + ATT_TILE_BYTES + soff0) = vreg[0]; *(LAS u32x4*)(nb_ + ATT_TILE_BYTES + soff1) = vreg[1]; }
            __syncthreads();
        }
        if (MODE == 0 && kt0 > 0) {
            LAS unsigned char* pk = lds + wave * 16384; LAS unsigned char* pv = pk + 8192;
            const int nfar = 4 * kt0;
            for (int s = 0; s * 16 < nfar; ++s) {
#pragma unroll
                for (int jh = 0; jh < 2; ++jh) { u32x4 kf[4], vf[4];
#pragma unroll
                    for (int j = 0; j < 4; ++j) { const int row = (lane >> 4) + 4 * (4 * jh + j), keypos = 2 * wave + (row >> 4) + 16 * (16 * s + (row & 15)); const size_t g0 = kvbase + (size_t)keypos * kvpitch + (lane & 15) * 8;
                        kf[j] = *(const u32x4*)(K + g0); vf[j] = *(const u32x4*)(V + g0); }
#pragma unroll
                    for (int j = 0; j < 4; ++j) { const unsigned so = offb((lane >> 4) + 4 * (4 * jh + j), lane & 15); *(LAS u32x4*)(pk + so) = kf[j]; *(LAS u32x4*)(pv + so) = vf[j]; } }
                f32x16 S;
#pragma unroll
                for (int i = 0; i < 16; ++i) S[i] = 0.f;
#pragma unroll
                for (int s8 = 0; s8 < NKS; ++s8) { const bf16x8v kfr = *(const LAS bf16x8v*)(pk + kaddr[s8]); S = __builtin_amdgcn_mfma_f32_32x32x16_bf16(kfr, qf[0][s8], S, 0, 0, 0); }
                float tmax = -INFINITY;
#pragma unroll
                for (int i = 0; i < 16; ++i) { const bool ok = (i >> 3) == (r >> 4); S[i] = ok ? S[i] : -INFINITY; tmax = fmaxf(tmax, S[i]); }
                tmax = fmaxf(tmax, __shfl_xor(tmax, 32));
                const float mn = fmaxf(m[0], tmax), corr = __builtin_amdgcn_exp2f(m[0] - mn); m[0] = mn;
                float ps = 0.f;
#pragma unroll
                for (int i = 0; i < 16; ++i) { const float pvv = __builtin_amdgcn_exp2f(S[i] - mn); S[i] = pvv; ps += pvv; }
                l[0] = l[0] * corr + ps;
#pragma unroll
                for (int c = 0; c < NDT; ++c)
#pragma unroll
                    for (int i = 0; i < 16; ++i) O[0][c][i] *= corr;
#pragma unroll
                for (int s2 = 0; s2 < 2; ++s2) {
                    bf16x8v pf; { const unsigned a0 = cvt_pk_bf16(S[8 * s2 + 0], S[8 * s2 + 1]), a1 = cvt_pk_bf16(S[8 * s2 + 2], S[8 * s2 + 3]), a2 = cvt_pk_bf16(S[8 * s2 + 4], S[8 * s2 + 5]), a3 = cvt_pk_bf16(S[8 * s2 + 6], S[8 * s2 + 7]);
                        pf = __builtin_bit_cast(bf16x8v, (u32x4){a0, a1, a2, a3}); }
#pragma unroll
                    for (int c = 0; c < NDT; ++c) {
                        const s16x4 v0 = __builtin_amdgcn_ds_read_tr16_b64_v4i16((LAS s16x4*)(pv + vaddr[0][c] + 256 * (16 * s2)));
                        const s16x4 v1 = __builtin_amdgcn_ds_read_tr16_b64_v4i16((LAS s16x4*)(pv + vaddr[1][c] + 256 * (16 * s2)));
                        O[0][c] = __builtin_amdgcn_mfma_f32_32x32x16_bf16(cat8(v0, v1), pf, O[0][c], 0, 0, 0); }
                }
            }
        }
#pragma unroll
        for (int hd = 0; hd < NH; ++hd) {
            float lt = l[hd] + __shfl_xor(l[hd], 32);
            if (MODE == 1) lt += __builtin_amdgcn_exp2f(P.in[I_OD_SINKS][o_idx * 16 + head0 + hd] * LOG2E - m[hd]);
            const float inv = 1.0f / lt;
            bf16* orow = MIX + qrow * 2048 + (MODE == 0 ? head0 * 128 : (head0 + hd) * 64);
#pragma unroll
            for (int c = 0; c < NDT; ++c)
#pragma unroll
                for (int g4 = 0; g4 < 4; ++g4) { u32x2 o; o.x = cvt_pk_bf16(O[hd][c][4 * g4 + 0] * inv, O[hd][c][4 * g4 + 1] * inv); o.y = cvt_pk_bf16(O[hd][c][4 * g4 + 2] * inv, O[hd][c][4 * g4 + 3] * inv);
                    *(u32x2*)(orow + 32 * c + 8 * g4 + 4 * hh) = o; }
        }
    }
    __syncthreads();
}
__device__ __forceinline__ void phase_s5(KP kp0, int kwave_, LAS unsigned char* lds, int o_idx) { KPREF(P, kp0); PHASE_IDS();
    const bf16* Ug = (const bf16*)(P.ws + WS_XB); bf16* Z = (bf16*)(P.ws + WS_YB);
    constexpr int UP = 1296;
    LAS unsigned char* uc = lds; LAS float* eL = (LAS float*)(lds + 64 * UP);
    const int r = lane & 31, hh = lane >> 5;
    for (int bg = bx; bg < 256; bg += G) { const int b = bg >> 6, g = bg & 63, og = o_idx * 64 + g;
        const bf16* TT = (const bf16*)(P.ws + WS_S5TT) + (size_t)og * 512 * 640; const bf16* T2 = (const bf16*)(P.ws + WS_S5T2) + (size_t)og * 128 * 512;
        __syncthreads();
        { const int row = tid >> 3, piece = tid & 7; const bf16* src = Ug + ((size_t)g * MT + (size_t)b * SEQ + 32 * row) * 16 + piece * 64;
#pragma unroll
          for (int q = 0; q < 8; ++q) *(LAS u32x4*)(uc + row * UP + (piece * 8 + q) * 16) = *(const u32x4*)(src + q * 8); }
        __syncthreads();
        {
            const int rt = wave & 1, ct = wave >> 1; f32x16 acc;
#pragma unroll
            for (int i = 0; i < 16; ++i) acc[i] = 0.f;
            const bf16* bp = T2 + (size_t)(32 * ct + r) * 512 + 8 * hh;
            bf16x8v bq[32];
#pragma unroll
            for (int s = 0; s < 32; ++s) bq[s] = *(const bf16x8v*)(bp + 16 * s);
            asm volatile("" ::: "memory");
#pragma unroll
            for (int s = 0; s < 32; ++s) { const bf16x8v af = *(const LAS bf16x8v*)(uc + (32 * rt + r) * UP + 32 * s + 16 * hh);
                acc = __builtin_amdgcn_mfma_f32_32x32x16_bf16(af, bq[s], acc, 0, 0, 0); }
#pragma unroll
            for (int i = 0; i < 16; ++i) eL[(32 * rt + (i & 3) + 8 * (i >> 2) + 4 * hh) * 128 + 32 * ct + r] = acc[i];
        }
        __syncthreads();
        if (wave == 0) { const f32x2 a32 = ((const f32x2*)(P.ws + WS_S5A32))[og * 64 + lane]; float hr = 0.f, hi = 0.f;
            for (int ch = 0; ch < 64; ++ch) { *(LAS unsigned short*)(uc + ch * UP + 1024 + lane * 2) = f2bf(hr); *(LAS unsigned short*)(uc + ch * UP + 1152 + lane * 2) = f2bf(hi);
                const float er = eL[ch * 128 + lane], ei = eL[ch * 128 + 64 + lane]; const float nr = a32[0] * hr - a32[1] * hi + er, ni = a32[0] * hi + a32[1] * hr + ei; hr = nr; hi = ni; } }
        __syncthreads();
        const float dsk = P.in[I_OD_D][o_idx * 1024 + g * 16 + (r & 15)];
        {
            f32x16 acc[2][2];
#pragma unroll
            for (int a = 0; a < 2; ++a)
#pragma unroll
                for (int c = 0; c < 2; ++c)
#pragma unroll
                    for (int i = 0; i < 16; ++i) acc[a][c][i] = 0.f;
            const bf16* bp0 = TT + (size_t)(32 * wave + r) * 640 + 8 * hh; const bf16* bp1 = bp0 + (size_t)256 * 640;
            bf16x8v bq[2][5][2];
#pragma unroll
            for (int s = 0; s < 5; ++s) { bq[0][s][0] = *(const bf16x8v*)(bp0 + 16 * s); bq[0][s][1] = *(const bf16x8v*)(bp1 + 16 * s); }
#pragma unroll
            for (int bt = 0; bt < 8; ++bt) {
                if (bt < 7) {
#pragma unroll
                    for (int s = 0; s < 5; ++s) { bq[(bt + 1) & 1][s][0] = *(const bf16x8v*)(bp0 + 16 * (5 * (bt + 1) + s)); bq[(bt + 1) & 1][s][1] = *(const bf16x8v*)(bp1 + 16 * (5 * (bt + 1) + s)); } }
                asm volatile("" ::: "memory");
#pragma unroll
                for (int s8 = 0; s8 < 5; ++s8) { const int s = 5 * bt + s8; const bf16x8v b0 = bq[bt & 1][s8][0], b1 = bq[bt & 1][s8][1];
                    const bf16x8v a0 = *(const LAS bf16x8v*)(uc + r * UP + 32 * s + 16 * hh), a1 = *(const LAS bf16x8v*)(uc + (32 + r) * UP + 32 * s + 16 * hh);
                    acc[0][0] = __builtin_amdgcn_mfma_f32_32x32x16_bf16(a0, b0, acc[0][0], 0, 0, 0); acc[1][0] = __builtin_amdgcn_mfma_f32_32x32x16_bf16(a1, b0, acc[1][0], 0, 0, 0);
                    acc[0][1] = __builtin_amdgcn_mfma_f32_32x32x16_bf16(a0, b1, acc[0][1], 0, 0, 0); acc[1][1] = __builtin_amdgcn_mfma_f32_32x32x16_bf16(a1, b1, acc[1][1], 0, 0, 0); }
            }
            __syncthreads();
#pragma unroll
            for (int cti = 0; cti < 2; ++cti) { const int n = 32 * (wave + 8 * cti) + r;
#pragma unroll
                for (int rt = 0; rt < 2; ++rt)
#pragma unroll
                    for (int i = 0; i < 16; ++i) { const int ch = 32 * rt + (i & 3) + 8 * (i >> 2) + 4 * hh; LAS unsigned short* up = (LAS unsigned short*)(uc + ch * UP + n * 2);
                        *up = f2bf(gelu_tanh(acc[rt][cti][i] + dsk * bf2f(*up))); } }
            __syncthreads();
#pragma unroll
            for (int q = 0; q < 8; ++q) { const int p = tid + 512 * q, t = p >> 1, hf = p & 1;
                *(u32x4*)(Z + ((size_t)b * SEQ + t) * 1024 + g * 16 + hf * 8) = *(const LAS u32x4*)(uc + (t >> 5) * UP + ((t & 31) * 16 + hf * 8) * 2); }
        }
    }
}

__device__ __forceinline__ void phase_lru(KP kp0, int kwave_, LAS unsigned char* lds, int e) { KPREF(P, kp0); PHASE_IDS();
    const bf16* XB = (const bf16*)(P.ws + WS_XB); const bf16* YB = (const bf16*)(P.ws + WS_YB); bf16* MIX = (bf16*)(P.ws + WS_MIX);
    LAS unsigned char* xcL = lds;
    LAS float* aL = (LAS float*)(lds + 69632); LAS float* bL = (LAS float*)(lds + 86016);
    LAS float* sA = (LAS float*)(lds + 102400); LAS float* sB = (LAS float*)(lds + 104448);
    LAS float* carry = (LAS float*)(lds + 106496);
    const int c16 = lane & 15, kq = lane >> 4, cg = tid & 15, rg = tid >> 4;
    for (int item = bx; item < 256; item += G) { const int b = item >> 6, blk = (item >> 3) & 7, oct = item & 7, ch0 = blk * 128 + oct * 16;
        float cw[4][8], cb[8];
#pragma unroll
        for (int q = 0; q < 8; ++q) { cb[q] = P.in[I_EV_CONV_B][e * 1024 + blk * 128 + cg * 8 + q];
#pragma unroll
            for (int i = 0; i < 4; ++i) cw[i][q] = P.in[I_EV_CONV_W][(size_t)(e * 4 + i) * 1024 + blk * 128 + cg * 8 + q]; }
        bf16x8v bfr[4], bfi[4];
        { const bf16* wg = (const bf16*)(P.ws + WS_WGATE) + ((size_t)(e * 8 + blk) * 256 + oct * 16 + c16) * 128 + 8 * kq;
#pragma unroll
          for (int s = 0; s < 4; ++s) { bfr[s] = *(const bf16x8v*)(wg + 32 * s); bfi[s] = *(const bf16x8v*)(wg + 128 * 128 + 32 * s); } }
        const float gab = P.in[I_EV_GA_B][e * 1024 + ch0 + c16], gxb = P.in[I_EV_GX_B][e * 1024 + ch0 + c16];
        const float sp8 = -8.0f * log1pf(expf(-P.in[I_EV_LAMBDA][e * 1024 + ch0 + c16]));
        if (tid < 16) carry[tid] = 0.f;
        u32x4 xin[11];
#pragma unroll
        for (int i = 0; i < 11; ++i) { const int tt = 8 * rg - 3 + i; xin[i] = (tt >= 0) ? *(const u32x4*)(XB + (size_t)(b * SEQ + tt) * 1024 + blk * 128 + cg * 8) : (u32x4){0u, 0u, 0u, 0u}; }
        __syncthreads();
        for (int tc = 0; tc < 8; ++tc) { const int t0 = tc * 256;
#pragma unroll
            for (int j = 0; j < 8; ++j) { float o[8];
#pragma unroll
                for (int q = 0; q < 8; ++q) o[q] = cb[q];
#pragma unroll
                for (int i = 0; i < 4; ++i) { const u32x4 x = xin[j + i];
                    o[0] += cw[i][0] * bf_lo(x.x); o[1] += cw[i][1] * bf_hi(x.x); o[2] += cw[i][2] * bf_lo(x.y); o[3] += cw[i][3] * bf_hi(x.y);
                    o[4] += cw[i][4] * bf_lo(x.z); o[5] += cw[i][5] * bf_hi(x.z); o[6] += cw[i][6] * bf_lo(x.w); o[7] += cw[i][7] * bf_hi(x.w); }
                u32x4 w; w.x = cvt_pk_bf16(o[0], o[1]); w.y = cvt_pk_bf16(o[2], o[3]); w.z = cvt_pk_bf16(o[4], o[5]); w.w = cvt_pk_bf16(o[6], o[7]);
                *(LAS u32x4*)(xcL + (8 * rg + j) * 272 + cg * 16) = w; }
            if (tc < 7) {
#pragma unroll
                for (int i = 0; i < 11; ++i) xin[i] = *(const u32x4*)(XB + (size_t)(b * SEQ + t0 + 256 + 8 * rg - 3 + i) * 1024 + blk * 128 + cg * 8); }
            float ybv[8];
#pragma unroll
            for (int i = 0; i < 8; ++i) ybv[i] = bf2f(YB[(size_t)(b * SEQ + t0 + 8 * rg + i) * 1024 + ch0 + cg]);
            __syncthreads();
#pragma unroll
            for (int rb = 0; rb < 2; ++rb) { const int row0 = 32 * wave + 16 * rb;
                f32x4 accr = {0.f, 0.f, 0.f, 0.f}, acci = {0.f, 0.f, 0.f, 0.f};
#pragma unroll
                for (int s2 = 0; s2 < 4; ++s2) { const bf16x8v af = *(const LAS bf16x8v*)(xcL + (row0 + c16) * 272 + 64 * s2 + 16 * kq);
                    accr = __builtin_amdgcn_mfma_f32_16x16x32_bf16(af, bfr[s2], accr, 0, 0, 0); acci = __builtin_amdgcn_mfma_f32_16x16x32_bf16(af, bfi[s2], acci, 0, 0, 0); }
#pragma unroll
                for (int i = 0; i < 4; ++i) { const int row = row0 + 4 * kq + i;
                    const float rr = 1.0f / (1.0f + __expf(-(accr[i] + gab))), ig = 1.0f / (1.0f + __expf(-(acci[i] + gxb)));
                    const float a = __expf(sp8 * rr), mult = sqrtf(fmaxf(1.0f - a * a, 0.f));
                    const float xv = bf2f(*(const LAS unsigned short*)(xcL + row * 272 + (oct * 16 + c16) * 2));
                    aL[row * 16 + c16] = a; bL[row * 16 + c16] = mult * ig * xv; }
            }
            __syncthreads();
            float av[8], bv[8], A = 1.f, B = 0.f;
#pragma unroll
            for (int i = 0; i < 8; ++i) { av[i] = aL[(8 * rg + i) * 16 + cg]; bv[i] = bL[(8 * rg + i) * 16 + cg]; B = av[i] * B + bv[i]; A *= av[i]; }
            { const float a1 = __shfl_up(A, 16), b1 = __shfl_up(B, 16); if (lane >= 16) { B = A * b1 + B; A = A * a1; }
              const float a2 = __shfl_up(A, 32), b2 = __shfl_up(B, 32); if (lane >= 32) { B = A * b2 + B; A = A * a2; } }
            if (lane >= 48) { sA[wave * 16 + cg] = A; sB[wave * 16 + cg] = B; }
            const float ape = __shfl_up(A, 16), bpe = __shfl_up(B, 16);
            __syncthreads();
            float h = carry[(tc & 1) * 16 + cg];
            for (int w = 0; w < wave; ++w) h = sA[w * 16 + cg] * h + sB[w * 16 + cg];
            if (lane >= 16) h = ape * h + bpe;
#pragma unroll
            for (int i = 0; i < 8; ++i) { h = av[i] * h + bv[i];
                MIX[(size_t)(b * SEQ + t0 + 8 * rg + i) * 2048 + 1024 + ch0 + cg] = f2bf(h * ybv[i]); }
            if (rg == 31 && tc < 7) carry[((tc + 1) & 1) * 16 + cg] = h;
        }
    }
}

constexpr int N_PHASES = 2 + 11 * NLAYER + 1;
#ifndef NREP_G
#define NREP_G 1
#endif
#ifndef NREP_M
#define NREP_M 1
#endif
#ifndef NREP_MB
#define NREP_MB 1
#endif
#ifndef NREP_BAR
#define NREP_BAR 1
#endif
#ifndef NREP_GO
#define NREP_GO 1
#endif
#ifndef NREP_E
#define NREP_E 1
#endif
#ifndef NREP_P
#define NREP_P 1
#endif
#ifndef TAIL_INPROJ
#define TAIL_INPROJ 1
#endif
#ifndef MK_ONE_LAUNCH
#define MK_ONE_LAUNCH 1
#endif
__global__ void __launch_bounds__(512, 2) fwd(Params P) {
    extern __shared__ __attribute__((aligned(16))) unsigned char lds_raw[];
    LAS unsigned char* lds = (LAS unsigned char*)lds_raw;
    const int kwave = __builtin_amdgcn_readfirstlane((int)threadIdx.x >> 6);
    for (int u = threadIdx.x; u < (LDS_BYTES - LDSCTL_OFF) / 4; u += 512) ((LAS unsigned*)(lds + LDSCTL_OFF))[u] = 0u;
    __syncthreads();
    const KP kp = (KP)__builtin_amdgcn_kernarg_segment_ptr();
    const int ph_lo = kp->lo, ph_hi = kp->hi;
    unsigned* barw = (unsigned*)(kp->ws + WS_CTL) + CW_BAR + kp->li * XCD_BAR_WORDS;
    XcdBarrier bar; bar.bar = barw; bar.x = 0; bar.w0 = 0u; bar.st = nullptr;
    if (ph_hi - ph_lo > 1) bar = xcd_barrier_post(barw, (volatile LAS unsigned*)(lds + LDSCTL_OFF + 64));
    bar.w0 = (kwave == 0) ? 1u : 0u;
    const bool tails = gridDim.x == 256;
#define RUN(p) (ph_lo <= (p) && (p) < ph_hi)
#define SEAM(p) do { if (RUN(p) && RUN((p) + 1)) for (int rb_ = 0; rb_ < NREP_BAR; ++rb_) xcd_barrier(bar); } while (0)

    if (RUN(0)) for (int rep = 0; rep < NREP_P; ++rep) phase_ada(kp, kwave, lds);
    SEAM(0);
    if (RUN(1)) for (int rep = 0; rep < NREP_P; ++rep) phase_prep(kp, kwave, lds, tails);
    SEAM(1);
    for (int l = 0; l < NLAYER; ++l) {
        const int pb = 2 + 11 * l, e = l >> 1; const bool odd = (l & 1) != 0;
        if (RUN(pb + 0) && l == 0) for (int rep = 0; rep < NREP_E; ++rep) phase_norm0(kp, kwave);
        if (l == 0) SEAM(pb + 0);
        if (RUN(pb + 1)) for (int rep = 0; rep < NREP_G; ++rep) { KPREF(P, kp); const int kwave_ = kwave; PHASE_IDS(); const bf16* H = (const bf16*)(P.ws + WS_H); bf16* Qb = (bf16*)(P.ws + WS_Q);
            if (!odd) { pg8::Gemm g{H, (const bf16*)(P.ws + WS_W_EVIN) + (size_t)e * EVEN_IN * DM, MT, EVEN_IN, DM}; pg8::StaticOrder S; S.init(MT, EVEN_IN, G, bx);
                pg8::EpiEvenIn E{Qb, (const float*)(P.ws + WS_COSA), (const float*)(P.ws + WS_SINA), QSCALE_A, (const float*)(P.ws + WS_SS) + (size_t)(2 * l) * MT * 32, (const float*)(P.ws + WS_CVEC) + CV_EVIN + (size_t)e * 4 * EVEN_IN, (LAS float*)(lds + RING_BYTES + 6144)};
                pg8::gemm_phase<pg8::EpiEvenIn, pg8::StaticOrder, true, true>(lds, g, S, E, tid);
                { FRESH_IDS();
                if (tails && rep + 1 == NREP_G && fbx >= 128) {
                    if (l == 0) { if (TAIL_INPROJ) conv_range(kp, lds, 1, 3776, 6848, fbx - 128, 128, fwave, flane); }
                    else if (fbx < 192) s5_pre(kp, lds, 64 + fbx - 128, ftid);
                    else if (TAIL_INPROJ) conv_range(kp, lds, 3, 5312, 6848, fbx - 192, 64, fwave, flane); } } }
            else { pg8::Gemm g{H, (const bf16*)(P.ws + WS_W_ODIN) + (size_t)e * ODD_IN * DM, MT, ODD_IN, DM}; pg8::StaticOrder S; S.init(MT, ODD_IN, G, bx);
                pg8::EpiOddIn E{Qb, (bf16*)(P.ws + WS_K), (bf16*)(P.ws + WS_V), (bf16*)(P.ws + WS_XB), (const float*)(P.ws + WS_COSC), (const float*)(P.ws + WS_SINC), QSCALE_C, (const float*)(P.ws + WS_SS) + (size_t)(2 * l) * MT * 32, (const float*)(P.ws + WS_CVEC) + CV_ODIN + (size_t)e * 4 * ODD_IN, (LAS float*)(lds + RING_BYTES + 6144)};
                pg8::gemm_phase<pg8::EpiOddIn, pg8::StaticOrder, true, true>(lds, g, S, E, tid);
                { FRESH_IDS(); if (TAIL_INPROJ && tails && rep + 1 == NREP_G && l == 1 && fbx >= 32) conv_range(kp, lds, 2, 1408, 6784, fbx - 32, 224, fwave, flane); } }
        }
        SEAM(pb + 1);
        if (RUN(pb + 2)) for (int rep = 0; rep < NREP_M; ++rep) { if (!odd) phase_attn<0>(kp, kwave, lds, 0); else phase_attn<1>(kp, kwave, lds, e); }
        if (RUN(pb + 3)) for (int rep = 0; rep < (odd ? NREP_MB : 1); ++rep) { if (!odd) phase_lru(kp, kwave, lds, e); else phase_s5(kp, kwave, lds, e); }
        SEAM(pb + 3);
        if (RUN(pb + 4)) {
            if (odd) for (int rep = 0; rep < NREP_G; ++rep) { KPREF(P, kp); const int kwave_ = kwave; PHASE_IDS(); const bf16* YBb = (const bf16*)(P.ws + WS_YB); bf16* MIX = (bf16*)(P.ws + WS_MIX); pg8::Gemm g{YBb, (const bf16*)(P.ws + WS_W_GLU) + (size_t)e * 1024 * 1024, MT, 1024, 1024}; pg8::StaticOrder S; S.init(MT, 1024, G, bx);
                pg8::EpiGlu E{YBb, MIX, P.in[I_OD_GLU_B] + e * 1024};
                pg8::gemm_phase<pg8::EpiGlu, pg8::StaticOrder, true, true>(lds, g, S, E, tid);
                { FRESH_IDS(); if (TAIL_INPROJ && tails && rep + 1 == NREP_G && l == 1 && fbx >= 128) conv_range(kp, lds, 2, 6784, 8064, fbx - 128, 128, fwave, flane); } }
        }
        if (odd) SEAM(pb + 4);
        if (RUN(pb + 6)) for (int rep = 0; rep < NREP_G * NREP_GO; ++rep) { KPREF(P, kp); const int kwave_ = kwave; PHASE_IDS(); const bf16* MIX = (const bf16*)(P.ws + WS_MIX); const float* mod = (const float*)(P.ws + WS_MOD);
            const bf16* W = odd ? (const bf16*)(P.ws + WS_W_ODOUT) + (size_t)e * DM * DM : (const bf16*)(P.ws + WS_W_EVOUT) + (size_t)e * DM * DM;
            pg8::Gemm g{MIX, W, MT, DM, DM}; pg8::StaticOrder S; S.init(MT, DM, G, bx);
            const bool dry = rep + 1 < NREP_G * NREP_GO;
            pg8::EpiResid E{l == 0 ? P.in[I_X] : nullptr, (const bf16*)(P.ws + WS_XRES), dry ? (bf16*)(P.ws + 710 * MiB) : (bf16*)(P.ws + WS_XRES), nullptr, mod + (size_t)l * 4 * 12288 + 2 * DM, dry ? nullptr : (bf16*)(P.ws + WS_H), P.in[I_NORM_FFN] + l * DM, mod + (size_t)l * 4 * 12288 + 4 * DM, (float*)(P.ws + WS_SS) + (size_t)(2 * l + 1) * MT * 32};
            pg8::gemm_phase<pg8::EpiResid, pg8::StaticOrder, true, true>(lds, g, S, E, tid);
        }
        SEAM(pb + 6);
        if (RUN(pb + 8)) for (int rep = 0; rep < NREP_G; ++rep) { KPREF(P, kp); const int kwave_ = kwave; PHASE_IDS(); const bf16* H = (const bf16*)(P.ws + WS_H);
            pg8::Gemm g{H, (const bf16*)(P.ws + WS_W_FFIN) + (size_t)l * DFF2 * DM, MT, DFF2, DM}; pg8::StaticOrder S; S.init(MT, DFF2, G, bx);
            pg8::EpiFfnIn E{(bf16*)(P.ws + WS_ACT), (float*)(P.ws + WS_HALO_F), (float*)(P.ws + WS_HALO_L), P.in[I_FFN_CONV_W] + (size_t)l * 3 * DFF2, P.in[I_FFN_CONV_B] + (size_t)l * DFF2, (LAS float*)(lds + RING_BYTES), (const float*)(P.ws + WS_SS) + (size_t)(2 * l + 1) * MT * 32, (const float*)(P.ws + WS_CVEC) + CV_FFIN + (size_t)l * 4 * DFF2};
            pg8::gemm_phase<pg8::EpiFfnIn, pg8::StaticOrder, true, true>(lds, g, S, E, tid);
            { FRESH_IDS(); if (tails && rep + 1 == NREP_G && l + 1 < NLAYER && fbx >= 96) conv_range(kp, lds, l + 1, l == 1 ? 8064 : 6848, conv_total(l + 1), fbx - 96, 160, fwave, flane); }
        }
        SEAM(pb + 8);
        if (RUN(pb + 10)) for (int rep = 0; rep < NREP_G; ++rep) { KPREF(P, kp); const int kwave_ = kwave; PHASE_IDS(); const bf16* ACT = (const bf16*)(P.ws + WS_ACT); const float* mod = (const float*)(P.ws + WS_MOD);
            pg8::Gemm g{ACT, (const bf16*)(P.ws + WS_W_FFOUT) + (size_t)l * DM * DFF, MT, DM, DFF}; pg8::StaticOrder S; S.init(MT, DM, G, bx);
            if (l + 1 < NLAYER && rep == 0) cvec_reduce(kp, l + 1, bx, G, tid);
            { pg8::Unit fu; int lastpm = -1; for (int i = 0; S.next(i, fu); ++i) if (fu.pm != lastpm) { lastpm = fu.pm;
                ffn_fix_panel((const float*)(P.ws + WS_HALO_F), (const float*)(P.ws + WS_HALO_L), (bf16*)(P.ws + WS_ACT), P.in[I_FFN_CONV_W] + (size_t)l * 3 * DFF2, P.in[I_FFN_CONV_B] + (size_t)l * DFF2, fu.pm, tid); }
              asm volatile("s_waitcnt vmcnt(0)" ::: "memory"); __syncthreads(); }
            const bool dry = rep + 1 < NREP_G, last = l == NLAYER - 1;
            pg8::EpiResid E{nullptr, (const bf16*)(P.ws + WS_XRES), dry ? (bf16*)(P.ws + 710 * MiB) : (bf16*)(P.ws + WS_XRES), (last && !dry) ? P.out : nullptr, mod + (size_t)l * 4 * 12288 + 5 * DM, (dry || last) ? nullptr : (bf16*)(P.ws + WS_H), P.in[I_NORM_MIX] + (last ? l : l + 1) * DM, mod + (size_t)(last ? l : l + 1) * 4 * 12288 + DM, (float*)(P.ws + WS_SS) + (size_t)(2 * l + 2) * MT * 32};
            pg8::gemm_phase<pg8::EpiResid, pg8::StaticOrder, true, true>(lds, g, S, E, tid);
        }
        SEAM(pb + 10);
    }
    if (RUN(N_PHASES - 1)) phase_final(kp, kwave);
#undef RUN
#undef SEAM
}

extern "C" void kernel_launch(void* const* d_in, const int* in_sizes, int n_in, void* d_out, int out_size, void* d_ws, size_t ws_size, hipStream_t stream) {
    static int grid = 0;
    if (grid == 0) {
        if (n_in != N_INPUTS || out_size != MT * DM || ws_size < WS_END) { fprintf(stderr, "kernel_launch: unexpected shapes: n_in %d out %d ws %zu (need %zu)\n", n_in, out_size, ws_size, (size_t)WS_END); grid = -1; return; }
        int dev = 0, cus = 0, per_cu = 0;
        if (hipGetDevice(&dev) != hipSuccess || hipDeviceGetAttribute(&cus, hipDeviceAttributeMultiprocessorCount, dev) != hipSuccess) { grid = -1; return; }
        if (hipFuncSetAttribute((const void*)fwd, hipFuncAttributeMaxDynamicSharedMemorySize, LDS_BYTES) != hipSuccess) { fprintf(stderr, "kernel_launch: hipFuncSetAttribute failed\n"); grid = -1; return; }
        if (hipOccupancyMaxActiveBlocksPerMultiprocessor(&per_cu, (const void*)fwd, 512, LDS_BYTES) != hipSuccess || per_cu < 1) fprintf(stderr, "kernel_launch: occupancy query says %d\n", per_cu);
        (void)hipGetLastError();
        grid = cus;
    }
    if (grid < 0) return;
    if (hipMemsetAsync((char*)d_ws + WS_CTL, 0, CTL_ZERO_BYTES, stream) != hipSuccess) return;
    Params p{};
    for (int i = 0; i < N_INPUTS; ++i) p.in[i] = (const float*)d_in[i];
    p.out = (float*)d_out; p.ws = (unsigned char*)d_ws; p.pad = 0;
#if MK_ONE_LAUNCH
    p.lo = 0; p.hi = N_PHASES; p.li = 0;
    hipLaunchKernelGGL(fwd, dim3(grid), dim3(512), LDS_BYTES, stream, p);
#else
    for (int ph = 0; ph < N_PHASES; ++ph) { p.lo = ph; p.hi = ph + 1; p.li = 0; hipLaunchKernelGGL(fwd, dim3(grid), dim3(512), LDS_BYTES, stream, p); }
#endif
    const hipError_t le = hipPeekAtLastError();
    if (le != hipSuccess) fprintf(stderr, "kernel_launch: launch failed: %s\n", hipGetErrorName(le));
}
```

```cpp
#include <hip/hip_runtime.h>
#include <cstdio>
#include <cstdint>
namespace pg8 {
#define PG8_LAS __attribute__((address_space(3)))
typedef unsigned short bf16_t;
typedef short bf16x8 __attribute__((ext_vector_type(8)));
typedef float f32x4 __attribute__((ext_vector_type(4)));
typedef unsigned u32x4 __attribute__((ext_vector_type(4)));
typedef unsigned u32x2 __attribute__((ext_vector_type(2)));
constexpr int BM = 256, BK = 64, HALF = 128, HTB = HALF * BK * 2  , STAGE_BYTES = 8 * HTB, NXCD = 8, WGM = 8;

__host__ __device__ __forceinline__ int lds_byte(int r, int c) { const int st = (r >> 4) * 2 + (c >> 5), rr = r & 15, cc = c & 31, ob = rr * 64 + cc * 2; return st * 1024 + (ob ^ (((ob >> 9) & 1) << 5)); }
__host__ __device__ __forceinline__ void stage_rc(int b, int& R, int& C) { const int st = b / 1024, sb = b % 1024, swz = sb ^ (((sb >> 9) & 1) << 5); R = (st >> 1) * 16 + swz / 64; C = (st & 1) * 32 + (swz % 64) / 2; }
__host__ __device__ __forceinline__ int perm32(int rho) { const int n = rho >> 4, i = rho & 15; return 8 * (i >> 2) + 4 * n + (i & 3); }

struct Unit { int pm, pn; };
struct Gemm { const bf16_t* A; const bf16_t* Bt; int M, N, K; };

struct StaticOrder {
    int nM, nN, nwg, G, c;
    __host__ __device__ __forceinline__ void init(int M, int N, int G_, int c_) { nM = M / BM; nN = N / BM; nwg = nM * nN; G = G_; c = c_; }
    __host__ __device__ __forceinline__ bool next(int i, Unit& u) const {
        const long L = (long)i * G + c; if (L >= nwg) return false;
        int wgid = (int)L; { const int q = nwg / NXCD, r = nwg % NXCD, xcd = wgid % NXCD, off = wgid / NXCD; wgid = (xcd < r ? xcd * (q + 1) : r * (q + 1) + (xcd - r) * q) + off; }
        const int nig = WGM * nN, gid = wgid / nig, fm = gid * WGM, gsz = (nM - fm) < WGM ? (nM - fm) : WGM;
        u.pm = fm + ((wgid % nig) % gsz); u.pn = (wgid % nig) / gsz; return true;
    }
    __device__ __forceinline__ void a_ready(const Unit&) const {}
    __device__ __forceinline__ void done(const Unit&) const {}
};

__device__ __forceinline__ unsigned cvt_pk_bf16(float lo, float hi) { unsigned r; asm volatile("v_cvt_pk_bf16_f32 %0, %1, %2" : "=v"(r) : "v"(lo), "v"(hi)); return r; }
__device__ __forceinline__ u32x4 pack8(const f32x4 a, const f32x4 b) { u32x4 w; w.x = cvt_pk_bf16(a[0], a[1]); w.y = cvt_pk_bf16(a[2], a[3]); w.z = cvt_pk_bf16(b[0], b[1]); w.w = cvt_pk_bf16(b[2], b[3]); return w; }
__device__ __forceinline__ float bf_lo(unsigned w) { return __uint_as_float(w << 16); }
__device__ __forceinline__ float bf_hi(unsigned w) { return __uint_as_float(w & 0xffff0000u); }
__device__ __forceinline__ float gelu_tanh(float x) {
    const float u = x * (0.7978845608f + 0.0356774081f * x * x);
    const float e = __builtin_amdgcn_exp2f(-2.885390082f * u);
    return x * __builtin_amdgcn_rcpf(1.0f + e);
}
__device__ __forceinline__ f32x4 gelu4(const f32x4 v) { return (f32x4){gelu_tanh(v[0]), gelu_tanh(v[1]), gelu_tanh(v[2]), gelu_tanh(v[3])}; }
__device__ __forceinline__ float sigmoidf_fast(float x) { return __builtin_amdgcn_rcpf(1.0f + __builtin_amdgcn_exp2f(-1.4426950409f * x)); }

struct PrefetchOrder : StaticOrder {
    const float* ssp; PG8_LAS unsigned char* buf; int wave; mutable int ui;
    __device__ __forceinline__ void fetch(const Unit& u) const {
        int lane; asm volatile("v_mbcnt_lo_u32_b32 %0, -1, 0\n\tv_mbcnt_hi_u32_b32 %0, -1, %0" : "=v"(lane)); const int t = wave * 64 + lane;
        __builtin_amdgcn_global_load_lds((const unsigned*)(ssp + ((size_t)u.pm * BM + (t >> 1)) * 8 + (t & 1) * 4), (PG8_LAS unsigned*)(buf + wave * 1024), 16, 0, 0);
    }
    __device__ __forceinline__ void a_ready(const Unit& u) const { if (ui == 0) { ui = 1; fetch(u); } }
    __device__ __forceinline__ void done(const Unit&) const { Unit n; if (next(ui, n)) fetch(n); ++ui; }
};
__device__ __forceinline__ void build_rtab(PG8_LAS const unsigned char* buf, PG8_LAS float* rtab, int wr, int wc, int fr, int fq) {
    const int t = (wr * 4 + wc) * 64 + fq * 16 + fr;
    const f32x4 p = *(PG8_LAS const f32x4*)(buf + t * 16);
    float s = (p[0] + p[1]) + (p[2] + p[3]);
    s += __shfl_xor(s, 1);
    if ((t & 1) == 0) rtab[t >> 1] = rsqrtf(s * (1.0f / 2048.0f) + 1e-6f);
    asm volatile("s_waitcnt lgkmcnt(0)" ::: "memory"); __builtin_amdgcn_s_barrier(); asm volatile("" ::: "memory");
}

struct EpiStore {
    static constexpr bool PERM = true, AFTER_DRAIN = false;
    bf16_t* O; int ldc;
    __device__ __forceinline__ void operator()(const f32x4 (&acc)[2][2][4][2], const Unit& u, int wr, int wc, int fr, int fq) const {
        const int row0 = u.pm * BM + wr * 64 + fr, col0 = u.pn * BM + wc * 32 + 8 * fq;
#pragma unroll
        for (int ai = 0; ai < 2; ++ai)
#pragma unroll
            for (int m = 0; m < 4; ++m) { bf16_t* rowp = O + (size_t)(row0 + ai * HALF + m * 16) * ldc + col0;
#pragma unroll
                for (int bj = 0; bj < 2; ++bj) *(u32x4*)(rowp + bj * HALF) = pack8(acc[ai][bj][m][0], acc[ai][bj][m][1]); }
    }
};

struct EpiEvenIn {
    static constexpr bool PERM = true, AFTER_DRAIN = false;
    bf16_t *Q; const float *cosT, *sinT; float qscale; PG8_LAS const unsigned char* ssb; const float* cv; PG8_LAS float* rtab;
    __device__ __forceinline__ void operator()(const f32x4 (&acc)[2][2][4][2], const Unit& u, int wr, int wc, int fr, int fq) const {
        const int row0 = u.pm * BM + wr * 64 + fr;
        build_rtab(ssb, rtab, wr, wc, fr, fq);
        f32x4 cv4[2][2];
#pragma unroll
        for (int bj = 0; bj < 2; ++bj)
#pragma unroll
            for (int n = 0; n < 2; ++n) cv4[bj][n] = *(const f32x4*)(cv + (size_t)(u.pm >> 3) * 5120 + u.pn * BM + bj * HALF + wc * 32 + 8 * fq + 4 * n);
        if (u.pn < 8) {
            bf16_t* dst = Q + (size_t)(u.pn >> 2) * (8u << 20); const float sc = (u.pn < 4) ? qscale : 1.0f;
            const int head = (u.pn & 3) * 2 + (wc >> 1), i0 = (wc & 1) * 32 + 8 * fq;
#pragma unroll
            for (int ai = 0; ai < 2; ++ai) {
#pragma unroll
              for (int mh = 0; mh < 2; ++mh) {
                f32x4 cs[2][4];
#pragma unroll
                for (int m2 = 0; m2 < 2; ++m2) { const int m = m2; const size_t tr = (size_t)(row0 + ai * HALF + (2 * mh + m2) * 16) * 64 + i0;
                    cs[m][0] = *(const f32x4*)(cosT + tr); cs[m][1] = *(const f32x4*)(cosT + tr + 4); cs[m][2] = *(const f32x4*)(sinT + tr); cs[m][3] = *(const f32x4*)(sinT + tr + 4); }
#pragma unroll
                for (int m2 = 0; m2 < 2; ++m2) { const int m = 2 * mh + m2; const int row = row0 + ai * HALF + m * 16; const float rrm = rtab[wr * 64 + ai * HALF + m * 16 + fr];
                    const f32x4 c0 = cs[m2][0], c1 = cs[m2][1], s0 = cs[m2][2], s1 = cs[m2][3];
                    const f32x4 a0 = acc[ai][0][m][0] * rrm + cv4[0][0], a1 = acc[ai][0][m][1] * rrm + cv4[0][1], b0 = acc[ai][1][m][0] * rrm + cv4[1][0], b1 = acc[ai][1][m][1] * rrm + cv4[1][1];
                    const f32x4 o10 = (a0 * c0 - b0 * s0) * sc, o11 = (a1 * c1 - b1 * s1) * sc, o20 = (b0 * c0 + a0 * s0) * sc, o21 = (b1 * c1 + a1 * s1) * sc;
                    bf16_t* rp = dst + (size_t)row * 1024 + head * 128 + i0;
                    *(u32x4*)(rp) = pack8(o10, o11); *(u32x4*)(rp + 64) = pack8(o20, o21); } } }
        } else {
            const int sel = (u.pn - 8) >> 2; bf16_t* dst = Q + (size_t)(u.pn >> 2) * (8u << 20); const int col0 = (u.pn & 3) * 256 + wc * 32 + 8 * fq;
#pragma unroll
            for (int ai = 0; ai < 2; ++ai)
#pragma unroll
                for (int m = 0; m < 4; ++m) { bf16_t* rowp = dst + (size_t)(row0 + ai * HALF + m * 16) * 1024 + col0; const float rrm = rtab[wr * 64 + ai * HALF + m * 16 + fr];
#pragma unroll
                    for (int bj = 0; bj < 2; ++bj) { f32x4 v0 = acc[ai][bj][m][0] * rrm + cv4[bj][0], v1 = acc[ai][bj][m][1] * rrm + cv4[bj][1];
                        if (sel == 2) { v0 = gelu4(v0); v1 = gelu4(v1); }
                        *(u32x4*)(rowp + bj * HALF) = pack8(v0, v1); } }
        }
    }
};

struct EpiOddIn {
    static constexpr bool PERM = true, AFTER_DRAIN = false;
    bf16_t *Q, *K, *V, *U; const float *cosT, *sinT; float qscale; PG8_LAS const unsigned char* ssb; const float* cv; PG8_LAS float* rtab;
    __device__ __forceinline__ void operator()(const f32x4 (&acc)[2][2][4][2], const Unit& u, int wr, int wc, int fr, int fq) const {
        const int row0 = u.pm * BM + wr * 64 + fr;
        build_rtab(ssb, rtab, wr, wc, fr, fq);
        f32x4 cv4[2][2];
#pragma unroll
        for (int bj = 0; bj < 2; ++bj)
#pragma unroll
            for (int n = 0; n < 2; ++n) cv4[bj][n] = *(const f32x4*)(cv + (size_t)(u.pm >> 3) * 2304 + u.pn * BM + bj * HALF + wc * 32 + 8 * fq + 4 * n);
        if (u.pn < 4 || (u.pn == 4 && wc < 2)) {
            const bool isq = u.pn < 4; const float sc = isq ? qscale : 1.0f;
            bf16_t* dst = isq ? Q + (u.pn * 4 + wc) * 64 : K + wc * 64; const int pitch = isq ? 1024 : 128;
#pragma unroll
            for (int ai = 0; ai < 2; ++ai) {
#pragma unroll
              for (int mh = 0; mh < 2; ++mh) {
                f32x4 cs[2][4];
#pragma unroll
                for (int m2 = 0; m2 < 2; ++m2) { const int m = m2; const size_t tr = (size_t)(row0 + ai * HALF + (2 * mh + m2) * 16) * 32 + 8 * fq;
                    cs[m][0] = *(const f32x4*)(cosT + tr); cs[m][1] = *(const f32x4*)(cosT + tr + 4); cs[m][2] = *(const f32x4*)(sinT + tr); cs[m][3] = *(const f32x4*)(sinT + tr + 4); }
#pragma unroll
                for (int m2 = 0; m2 < 2; ++m2) { const int m = 2 * mh + m2; const int row = row0 + ai * HALF + m * 16; const float rrm = rtab[wr * 64 + ai * HALF + m * 16 + fr];
                    const f32x4 c0 = cs[m2][0], c1 = cs[m2][1], s0 = cs[m2][2], s1 = cs[m2][3];
                    const f32x4 a0 = acc[ai][0][m][0] * rrm + cv4[0][0], a1 = acc[ai][0][m][1] * rrm + cv4[0][1], b0 = acc[ai][1][m][0] * rrm + cv4[1][0], b1 = acc[ai][1][m][1] * rrm + cv4[1][1];
                    const f32x4 o10 = (a0 * c0 - b0 * s0) * sc, o11 = (a1 * c1 - b1 * s1) * sc, o20 = (b0 * c0 + a0 * s0) * sc, o21 = (b1 * c1 + a1 * s1) * sc;
                    bf16_t* rp = dst + (size_t)row * pitch + 8 * fq;
                    *(u32x4*)(rp) = pack8(o10, o11); *(u32x4*)(rp + 32) = pack8(o20, o21); } } }
        } else if (u.pn == 4) {
#pragma unroll
            for (int ai = 0; ai < 2; ++ai)
#pragma unroll
                for (int m = 0; m < 4; ++m) { bf16_t* rowp = V + (size_t)(row0 + ai * HALF + m * 16) * 128 + (wc - 2) * 32 + 8 * fq; const float rrm = rtab[wr * 64 + ai * HALF + m * 16 + fr];
#pragma unroll
                    for (int bj = 0; bj < 2; ++bj) *(u32x4*)(rowp + bj * 64) = pack8(acc[ai][bj][m][0] * rrm + cv4[bj][0], acc[ai][bj][m][1] * rrm + cv4[bj][1]); }
        } else {
            const int col0 = (u.pn - 5) * 256 + wc * 32 + 8 * fq;
#pragma unroll
            for (int ai = 0; ai < 2; ++ai)
#pragma unroll
                for (int m = 0; m < 4; ++m) { bf16_t* rowp = U + ((size_t)(col0 >> 4) * 8192 + (size_t)(row0 + ai * HALF + m * 16)) * 16 + (col0 & 8); const float rrm = rtab[wr * 64 + ai * HALF + m * 16 + fr];
#pragma unroll
                    for (int bj = 0; bj < 2; ++bj) *(u32x4*)(rowp + (size_t)bj * 8 * 8192 * 16) = pack8(acc[ai][bj][m][0] * rrm + cv4[bj][0], acc[ai][bj][m][1] * rrm + cv4[bj][1]); }
        }
    }
};

struct EpiResid {
    static constexpr bool PERM = true, AFTER_DRAIN = false;
    const float* base32; const bf16_t* baseb; bf16_t* outb; float* out32; const float* gate; bf16_t* Hn; const float* gn; const float* scn; float* ssn; PG8_LAS float* xs;
    __device__ __forceinline__ void operator()(const f32x4 (&acc)[2][2][4][2], const Unit& u, int wr, int wc, int fr, int fq) const {
        const int row0 = u.pm * BM + wr * 64 + fr, col0 = u.pn * BM + wc * 32 + 8 * fq; const float* gp = gate + (size_t)(u.pm >> 3) * 12288 + col0;
        f32x4 gv[2][2], an[2][2];
#pragma unroll
        for (int bj = 0; bj < 2; ++bj)
#pragma unroll
            for (int n = 0; n < 2; ++n) { gv[bj][n] = *(const f32x4*)(gp + bj * HALF + n * 4);
                an[bj][n] = Hn ? *(const f32x4*)(gn + col0 + bj * HALF + n * 4) * (1.0f + *(const f32x4*)(scn + (size_t)(u.pm >> 3) * 12288 + col0 + bj * HALF + n * 4)) : (f32x4){0.f, 0.f, 0.f, 0.f}; }
#pragma unroll
        for (int ai = 0; ai < 2; ++ai) {
#pragma unroll
          for (int mh = 0; mh < 2; ++mh) {
            f32x4 bs[2][2][2];
#pragma unroll
            for (int m2 = 0; m2 < 2; ++m2) { const size_t off = (size_t)(row0 + ai * HALF + (2 * mh + m2) * 16) * 2048 + col0;
#pragma unroll
                for (int bj = 0; bj < 2; ++bj) {
                    if (base32) { bs[m2][bj][0] = *(const f32x4*)(base32 + off + bj * HALF); bs[m2][bj][1] = *(const f32x4*)(base32 + off + bj * HALF + 4); }
                    else { const u32x4 w = *(const u32x4*)(baseb + off + bj * HALF); bs[m2][bj][0] = (f32x4){bf_lo(w.x), bf_hi(w.x), bf_lo(w.y), bf_hi(w.y)}; bs[m2][bj][1] = (f32x4){bf_lo(w.z), bf_hi(w.z), bf_lo(w.w), bf_hi(w.w)}; } } }
#pragma unroll
            for (int m2 = 0; m2 < 2; ++m2) { const int m = 2 * mh + m2; const int row = row0 + ai * HALF + m * 16; const size_t off = (size_t)row * 2048 + col0; float s2 = 0.f;
#pragma unroll
                for (int bj = 0; bj < 2; ++bj) {
                    const f32x4 o0 = bs[m2][bj][0] + gv[bj][0] * acc[ai][bj][m][0], o1 = bs[m2][bj][1] + gv[bj][1] * acc[ai][bj][m][1];
                    if (out32) { *(f32x4*)(out32 + off + bj * HALF) = o0; *(f32x4*)(out32 + off + bj * HALF + 4) = o1; }
                    else *(u32x4*)(outb + off + bj * HALF) = pack8(o0, o1);
                    if (Hn) { s2 += ((o0[0] * o0[0] + o0[1] * o0[1]) + (o0[2] * o0[2] + o0[3] * o0[3])) + ((o1[0] * o1[0] + o1[1] * o1[1]) + (o1[2] * o1[2] + o1[3] * o1[3]));
                        *(u32x4*)(Hn + off + bj * HALF) = pack8(o0 * an[bj][0], o1 * an[bj][1]); } }
                if (Hn) { s2 += __shfl_xor(s2, 16); s2 += __shfl_xor(s2, 32); if (fq == 0) xs[wc * 256 + row - u.pm * BM] = s2; }
            }
          }
        }
        if (Hn) {
            asm volatile("s_waitcnt lgkmcnt(0)" ::: "memory"); __builtin_amdgcn_s_barrier(); asm volatile("" ::: "memory");
            const int t = (wr * 4 + wc) * 64 + fq * 16 + fr;
            if (t < 256) ssn[((size_t)u.pm * BM + t) * 8 + u.pn] = (xs[t] + xs[256 + t]) + (xs[512 + t] + xs[768 + t]);
        }
    }
};

struct EpiGlu {
    static constexpr bool PERM = true, AFTER_DRAIN = false;
    const bf16_t* Z; bf16_t* MIX; const float* gb;
    __device__ __forceinline__ void operator()(const f32x4 (&acc)[2][2][4][2], const Unit& u, int wr, int wc, int fr, int fq) const {
        const int row0 = u.pm * BM + wr * 64 + fr, col0 = u.pn * BM + wc * 32 + 8 * fq;
        f32x4 bv[2][2];
#pragma unroll
        for (int bj = 0; bj < 2; ++bj)
#pragma unroll
            for (int n = 0; n < 2; ++n) bv[bj][n] = *(const f32x4*)(gb + col0 + bj * HALF + 4 * n);
#pragma unroll
        for (int ai = 0; ai < 2; ++ai) {
#pragma unroll
          for (int mh = 0; mh < 2; ++mh) {
            u32x4 zq[2][2];
#pragma unroll
            for (int m2 = 0; m2 < 2; ++m2)
#pragma unroll
                for (int bj = 0; bj < 2; ++bj) zq[m2][bj] = *(const u32x4*)(Z + (size_t)(row0 + ai * HALF + (2 * mh + m2) * 16) * 1024 + col0 + bj * HALF);
#pragma unroll
            for (int m2 = 0; m2 < 2; ++m2) { const int m = 2 * mh + m2; const size_t row = (size_t)(row0 + ai * HALF + m * 16);
#pragma unroll
                for (int bj = 0; bj < 2; ++bj) { const u32x4 zr = zq[m2][bj];
                    const f32x4 v0 = acc[ai][bj][m][0] + bv[bj][0], v1 = acc[ai][bj][m][1] + bv[bj][1];
                    const f32x4 z0 = (f32x4){bf_lo(zr.x), bf_hi(zr.x), bf_lo(zr.y), bf_hi(zr.y)}, z1 = (f32x4){bf_lo(zr.z), bf_hi(zr.z), bf_lo(zr.w), bf_hi(zr.w)};
                    const f32x4 o0 = (f32x4){z0[0] * sigmoidf_fast(v0[0]), z0[1] * sigmoidf_fast(v0[1]), z0[2] * sigmoidf_fast(v0[2]), z0[3] * sigmoidf_fast(v0[3])};
                    const f32x4 o1 = (f32x4){z1[0] * sigmoidf_fast(v1[0]), z1[1] * sigmoidf_fast(v1[1]), z1[2] * sigmoidf_fast(v1[2]), z1[3] * sigmoidf_fast(v1[3])};
                    *(u32x4*)(MIX + row * 2048 + 1024 + col0 + bj * HALF) = pack8(o0, o1); } } } }
    }
};

__device__ __forceinline__ float dpp_ror1(float v) { return __builtin_bit_cast(float, __builtin_amdgcn_update_dpp(0, __builtin_bit_cast(int, v), 0x121, 0xf, 0xf, false)); }
__device__ __forceinline__ float dpp_ror2(float v) { return __builtin_bit_cast(float, __builtin_amdgcn_update_dpp(0, __builtin_bit_cast(int, v), 0x122, 0xf, 0xf, false)); }
__device__ __forceinline__ float dpp_shr1(float old, float v) { return __builtin_bit_cast(float, __builtin_amdgcn_update_dpp(__builtin_bit_cast(int, old), __builtin_bit_cast(int, v), 0x111, 0xf, 0xf, false)); }
__device__ __forceinline__ float dpp_shr2(float old, float v) { return __builtin_bit_cast(float, __builtin_amdgcn_update_dpp(__builtin_bit_cast(int, old), __builtin_bit_cast(int, v), 0x112, 0xf, 0xf, false)); }
struct EpiFfnIn {
    static constexpr bool PERM = true, AFTER_DRAIN = false;
    bf16_t* ACT; float* halo_first; float* halo_last; const float* cw; const float* cb; PG8_LAS float* exch; PG8_LAS const unsigned char* ssb; const float* cv;
    __device__ __forceinline__ void operator()(f32x4 (&acc)[2][2][4][2], const Unit& u, int wr, int wc, int fr, int fq) const {
        asm volatile("" : "+v"(fr), "+v"(fq));
        const int jj0 = wc * 32 + 8 * fq, jcol = u.pn * 128 + jj0;
        build_rtab(ssb, exch + 1536, wr, wc, fr, fq);
        {
            f32x4 cv4[2][2];
#pragma unroll
            for (int bj = 0; bj < 2; ++bj)
#pragma unroll
                for (int n = 0; n < 2; ++n) cv4[bj][n] = *(const f32x4*)(cv + (size_t)(u.pm >> 3) * 11008 + u.pn * BM + bj * HALF + jj0 + 4 * n);
#pragma unroll
            for (int ai = 0; ai < 2; ++ai)
#pragma unroll
                for (int m = 0; m < 4; ++m) { const float r = exch[1536 + ai * HALF + wr * 64 + m * 16 + fr];
#pragma unroll
                    for (int bj = 0; bj < 2; ++bj)
#pragma unroll
                        for (int n = 0; n < 2; ++n) acc[ai][bj][m][n] = acc[ai][bj][m][n] * r + cv4[bj][n]; }
        }
        if (fr >= 14) { const int r2 = fr - 14;
#pragma unroll
            for (int bj = 0; bj < 2; ++bj)
#pragma unroll
                for (int n = 0; n < 2; ++n) {
                    *(PG8_LAS f32x4*)(exch + ((wr * 2 + r2) * 2 + bj) * 128 + jj0 + 4 * n) = acc[0][bj][3][n];
                    if (wr == 0) *(PG8_LAS f32x4*)(exch + ((2 * 2 + r2) * 2 + bj) * 128 + jj0 + 4 * n) = acc[1][bj][3][n];
                    else *(f32x4*)(halo_last + ((size_t)(u.pm * 2 + r2) * 2 + bj) * 5504 + jcol + 4 * n) = acc[1][bj][3][n];
                } }
        if (wr == 0 && fr < 2) {
#pragma unroll
            for (int bj = 0; bj < 2; ++bj)
#pragma unroll
                for (int n = 0; n < 2; ++n) *(f32x4*)(halo_first + ((size_t)(u.pm * 2 + fr) * 2 + bj) * 5504 + jcol + 4 * n) = acc[0][bj][0][n]; }
        asm volatile("s_waitcnt lgkmcnt(0)" ::: "memory"); __builtin_amdgcn_s_barrier(); asm volatile("" ::: "memory");
        const bool seq_start = (u.pm & 7) == 0;
#pragma unroll
        for (int n = 0; n < 2; ++n) {
            f32x4 w0[2], w1[2], w2[2], bb[2];
#pragma unroll
            for (int bj = 0; bj < 2; ++bj) { const int col = bj * 5504 + jcol + 4 * n;
                w0[bj] = *(const f32x4*)(cw + col); w1[bj] = *(const f32x4*)(cw + 11008 + col); w2[bj] = *(const f32x4*)(cw + 22016 + col); bb[bj] = *(const f32x4*)(cb + col); }
#pragma unroll
            for (int ai = 0; ai < 2; ++ai) {
                f32x4 prev[2];
                const int slot = 2 * ai + wr - 1;
#pragma unroll
                for (int bj = 0; bj < 2; ++bj) prev[bj] = (slot >= 0) ? *(const PG8_LAS f32x4*)(exch + ((slot * 2 + (fr & 1)) * 2 + bj) * 128 + jj0 + 4 * n) : (f32x4){0.f, 0.f, 0.f, 0.f};
#pragma unroll
                for (int m = 0; m < 4; ++m) {
                    f32x4 cv[2];
#pragma unroll
                    for (int bj = 0; bj < 2; ++bj) { const f32x4 cur = acc[ai][bj][m][n]; f32x4 o;
#pragma unroll
                        for (int q = 0; q < 4; ++q) { const float um1 = dpp_shr1(dpp_ror1(prev[bj][q]), cur[q]), um2 = dpp_shr2(dpp_ror2(prev[bj][q]), cur[q]);
                            o[q] = bb[bj][q] + w0[bj][q] * um2 + w1[bj][q] * um1 + w2[bj][q] * cur[q]; }
                        cv[bj] = o; prev[bj] = cur; }
                    const f32x4 o0 = gelu4(cv[0]) * cv[1];
                    const bool skip = (ai == 0 && m == 0) && wr == 0 && fr < 2 && !seq_start;
                    if (!skip) { u32x2 w; w.x = cvt_pk_bf16(o0[0], o0[1]); w.y = cvt_pk_bf16(o0[2], o0[3]); *(u32x2*)(ACT + (size_t)(u.pm * BM + ai * HALF + wr * 64 + m * 16 + fr) * 5504 + jcol + 4 * n) = w; }
                }
            }
        }
    }
};
template <class Epi, class Sched, bool ALIGN_EPI = false, bool SP2 = false>
__device__ __forceinline__ void gemm_phase(PG8_LAS unsigned char* lds, const Gemm g, const Sched& S, const Epi& E, int tid_in) {
    int tid = tid_in; asm volatile("" : "+v"(tid));
    const int wid = __builtin_amdgcn_readfirstlane(tid >> 6), lane = tid & 63, wr = wid >> 2, wc = wid & 3, fr = lane & 15, fq = lane >> 4;
    const int K = g.K, nt = K / BK;
    unsigned voffA[2], voffB[2];
#pragma unroll
    for (int i = 0; i < 2; ++i) { int R, C; stage_rc(tid * 16 + i * 8192, R, C); const int Rb = Epi::PERM ? ((R & ~31) + perm32(R & 31)) : R;
        voffA[i] = (unsigned)(R * K + C) * 2u; voffB[i] = (unsigned)(Rb * K + C) * 2u; }
    const size_t kstep = (size_t)(BK * 2);
    const size_t hstep = (size_t)HALF * K * 2;
    const size_t tstep = 2 * hstep;
    const unsigned ldsw = (unsigned)wid * 1024u;
    const int aoff = lds_byte(wr * 64 + fr, fq * 8), boff = lds_byte(wc * 32 + fr, fq * 8);
#define PG8_SA(b, h) (((b) * 2 + (h)) * HTB)
#define PG8_SB(b, h) ((4 + (b) * 2 + (h)) * HTB)
#define PG8_STAGE(bufoff, gbase, voff) do { _Pragma("unroll") for (int _i = 0; _i < 2; ++_i) \
        __builtin_amdgcn_global_load_lds((const unsigned*)((const char*)(gbase) + (voff)[_i]), (PG8_LAS unsigned*)(lds + (bufoff) + ldsw + _i * 8192), 16, 0, 0); } while (0)
#define PG8_LDA(dst, b, h) do { _Pragma("unroll") for (int m = 0; m < 4; ++m) _Pragma("unroll") for (int k = 0; k < 2; ++k) dst[m][k] = *(const PG8_LAS bf16x8*)(lds + PG8_SA(b, h) + aoff + m * 2048 + k * 1024); } while (0)
#define PG8_LDB(dst, b, h) do { _Pragma("unroll") for (int n = 0; n < 2; ++n) _Pragma("unroll") for (int k = 0; k < 2; ++k) dst[n][k] = *(const PG8_LAS bf16x8*)(lds + PG8_SB(b, h) + boff + n * 2048 + k * 1024); } while (0)
#define PG8_MMA(ai, bj, At, Bt) do { __builtin_amdgcn_s_setprio(1); _Pragma("unroll") for (int m = 0; m < 4; ++m) _Pragma("unroll") for (int n = 0; n < 2; ++n) _Pragma("unroll") for (int k = 0; k < 2; ++k) \
        acc[ai][bj][m][n] = __builtin_amdgcn_mfma_f32_16x16x32_bf16(Bt[n][k], At[m][k], acc[ai][bj][m][n], 0, 0, 0); __builtin_amdgcn_s_setprio(0); } while (0)
#define PG8_WAIT_V(n) asm volatile("s_waitcnt vmcnt(" #n ")" ::: "memory")
#define PG8_WAIT_L(n) asm volatile("s_waitcnt lgkmcnt(" #n ")" ::: "memory")
#define PG8_BAR __builtin_amdgcn_s_barrier()
#define PG8_SCHED __builtin_amdgcn_sched_barrier(0)
    Unit cur, nxt; int ui = 0;
    if (!S.next(0, cur)) return;
    f32x4 acc[2][2][4][2];
#pragma unroll
    for (int a = 0; a < 2; ++a)
#pragma unroll
        for (int b = 0; b < 2; ++b)
#pragma unroll
            for (int m = 0; m < 4; ++m)
#pragma unroll
                for (int n = 0; n < 2; ++n) acc[a][b][m][n] = (f32x4){0.f, 0.f, 0.f, 0.f};
    bf16x8 At[4][2], B0[2][2], B1[2][2];
    const char* cA = (const char*)g.A + (size_t)cur.pm * tstep; const char* cB = (const char*)g.Bt + (size_t)cur.pn * tstep;
    S.a_ready(cur);
    if constexpr (SP2) {
        PG8_STAGE(PG8_SB(0, 0), cB, voffB); PG8_STAGE(PG8_SB(0, 1), cB + hstep, voffB); PG8_STAGE(PG8_SA(0, 0), cA, voffA); PG8_STAGE(PG8_SA(0, 1), cA + hstep, voffA);
        if (wr == 1) PG8_BAR;
        PG8_WAIT_V(2); PG8_BAR;
        PG8_STAGE(PG8_SB(1, 0), cB + kstep, voffB); PG8_STAGE(PG8_SA(1, 0), cA + kstep, voffA); PG8_STAGE(PG8_SB(1, 1), cB + hstep + kstep, voffB);
        PG8_WAIT_V(6); PG8_BAR;
    } else {
        PG8_STAGE(PG8_SB(0, 0), cB, voffB); PG8_STAGE(PG8_SA(0, 0), cA, voffA); PG8_STAGE(PG8_SB(0, 1), cB + hstep, voffB); PG8_STAGE(PG8_SA(0, 1), cA + hstep, voffA);
        if (wr == 1) PG8_BAR;
        PG8_WAIT_V(4); PG8_BAR;
        PG8_STAGE(PG8_SB(1, 0), cB + kstep, voffB); PG8_STAGE(PG8_SA(1, 0), cA + kstep, voffA); PG8_STAGE(PG8_SB(1, 1), cB + hstep + kstep, voffB);
        PG8_WAIT_V(6); PG8_BAR;
    }
    for (;;) {
        const bool has_next = S.next(ui + 1, nxt);
        const char* nA = has_next ? (const char*)g.A + (size_t)nxt.pm * tstep : cA; const char* nB = has_next ? (const char*)g.Bt + (size_t)nxt.pn * tstep : cB;
        for (int t = 0; t < nt; t += 2) {
            const bool last = (t == nt - 2);
            const char* a1 = cA + (size_t)(t + 1) * kstep;
            const char* a2 = last ? nA : cA + (size_t)(t + 2) * kstep; const char* b2 = last ? nB : cB + (size_t)(t + 2) * kstep;
            const char* a3 = a2 + kstep; const char* b3 = b2 + kstep;
            if (last && has_next) S.a_ready(nxt);
            if constexpr (SP2) {
            PG8_LDB(B0, 0, 0); PG8_LDB(B1, 0, 1); PG8_SCHED; PG8_LDA(At, 0, 0); PG8_STAGE(PG8_SA(1, 1), a1 + hstep, voffA);
            PG8_WAIT_V(8); PG8_WAIT_L(0); PG8_BAR; PG8_MMA(0, 0, At, B0); PG8_MMA(0, 1, At, B1); PG8_BAR; PG8_SCHED;
            PG8_LDA(At, 0, 1); PG8_STAGE(PG8_SB(0, 0), b2, voffB); PG8_STAGE(PG8_SB(0, 1), b2 + hstep, voffB); PG8_STAGE(PG8_SA(0, 0), a2, voffA);
            PG8_WAIT_V(8); PG8_WAIT_L(0); PG8_BAR; PG8_MMA(1, 0, At, B0); PG8_MMA(1, 1, At, B1); PG8_BAR; PG8_SCHED;
            PG8_LDB(B0, 1, 0); PG8_LDB(B1, 1, 1); PG8_SCHED; PG8_LDA(At, 1, 0); PG8_STAGE(PG8_SA(0, 1), a2 + hstep, voffA);
            PG8_WAIT_V(8); PG8_WAIT_L(0); PG8_BAR; PG8_MMA(0, 0, At, B0); PG8_MMA(0, 1, At, B1); PG8_BAR; PG8_SCHED;
            PG8_LDA(At, 1, 1); PG8_STAGE(PG8_SB(1, 0), b3, voffB); PG8_STAGE(PG8_SB(1, 1), b3 + hstep, voffB); PG8_STAGE(PG8_SA(1, 0), a3, voffA);
            PG8_WAIT_V(8); PG8_WAIT_L(0); PG8_BAR; PG8_MMA(1, 0, At, B0); PG8_MMA(1, 1, At, B1); PG8_BAR; PG8_SCHED;
            } else {
            PG8_LDB(B0, 0, 0); PG8_SCHED; PG8_LDA(At, 0, 0); PG8_STAGE(PG8_SA(1, 1), a1 + hstep, voffA);
            PG8_WAIT_L(8); PG8_BAR; PG8_WAIT_L(0); PG8_MMA(0, 0, At, B0); PG8_BAR; PG8_SCHED;
            PG8_LDB(B1, 0, 1); PG8_STAGE(PG8_SB(0, 0), b2, voffB);
            PG8_BAR; PG8_WAIT_L(0); PG8_MMA(0, 1, At, B1); PG8_BAR;
            PG8_LDA(At, 0, 1); PG8_STAGE(PG8_SA(0, 0), a2, voffA);
            PG8_BAR; PG8_WAIT_L(0); PG8_MMA(1, 0, At, B0); PG8_BAR; PG8_SCHED;
            PG8_STAGE(PG8_SB(0, 1), b2 + hstep, voffB);
            PG8_WAIT_V(6); PG8_BAR; PG8_MMA(1, 1, At, B1); PG8_BAR;
            PG8_LDB(B0, 1, 0); PG8_SCHED; PG8_LDA(At, 1, 0); PG8_STAGE(PG8_SA(0, 1), a2 + hstep, voffA);
            PG8_WAIT_L(8); PG8_BAR; PG8_WAIT_L(0); PG8_MMA(0, 0, At, B0); PG8_BAR; PG8_SCHED;
            PG8_LDB(B1, 1, 1); PG8_STAGE(PG8_SB(1, 0), b3, voffB);
            PG8_BAR; PG8_WAIT_L(0); PG8_MMA(0, 1, At, B1); PG8_BAR;
            PG8_LDA(At, 1, 1); PG8_STAGE(PG8_SA(1, 0), a3, voffA);
            PG8_BAR; PG8_WAIT_L(0); PG8_MMA(1, 0, At, B0); PG8_BAR; PG8_SCHED;
            PG8_STAGE(PG8_SB(1, 1), b3 + hstep, voffB);
            PG8_WAIT_V(6); PG8_BAR; PG8_MMA(1, 1, At, B1); PG8_BAR;
            }
        }
        if constexpr (ALIGN_EPI) { if (wr == 0) PG8_BAR; }
        if constexpr (!Epi::AFTER_DRAIN) { E(acc, cur, wr, wc, fr, fq); S.done(cur); }
        if (!has_next) break;
#pragma unroll
        for (int a = 0; a < 2; ++a)
#pragma unroll
            for (int b = 0; b < 2; ++b)
#pragma unroll
                for (int m = 0; m < 4; ++m)
#pragma unroll
                    for (int n = 0; n < 2; ++n) acc[a][b][m][n] = (f32x4){0.f, 0.f, 0.f, 0.f};
        cur = nxt; cA = nA; cB = nB; ++ui;
        if constexpr (ALIGN_EPI) { if (wr == 1) PG8_BAR; }
    }
    PG8_WAIT_V(0);
    if constexpr (!ALIGN_EPI) { if (wr == 0) PG8_BAR; }
    PG8_BAR;
    if constexpr (Epi::AFTER_DRAIN) { E.fused(acc, cur, wr, wc, fr, fq, lds, wid, lane); S.done(cur); }
#undef PG8_SA
#undef PG8_SB
#undef PG8_STAGE
#undef PG8_LDA
#undef PG8_LDB
#undef PG8_MMA
#undef PG8_WAIT_V
#undef PG8_WAIT_L
#undef PG8_BAR
#undef PG8_SCHED
}
}

constexpr int DM = 2048, NB = 4, SEQ = 2048, MT = NB * SEQ, NLAYER = 4;
constexpr int EVEN_IN = 5120, ODD_IN = 2304, DFF = 5504, DFF2 = 11008;
constexpr float LOG2E = 1.4426950408889634f;
constexpr float QSCALE_A = 0.08838834764831845f * LOG2E;
constexpr float QSCALE_C = 0.125f * LOG2E;
enum { I_X = 0, I_C, I_POS, I_ADA_W, I_ADA_B, I_NORM_MIX, I_NORM_FFN, I_NORM_FINAL,
       I_EV_W_IN, I_EV_CONV_W, I_EV_CONV_B, I_EV_GA_W, I_EV_GA_B, I_EV_GX_W, I_EV_GX_B, I_EV_LAMBDA, I_EV_W_OUT,
       I_OD_W_IN, I_OD_SINKS, I_OD_A_RE, I_OD_A_IM, I_OD_B_RE, I_OD_B_IM, I_OD_C_RE, I_OD_C_IM, I_OD_D, I_OD_LOG_DT, I_OD_GLU_W, I_OD_GLU_B, I_OD_W_OUT,
       I_FFN_W_IN, I_FFN_CONV_W, I_FFN_CONV_B, I_FFN_W_OUT, N_INPUTS };
constexpr size_t MiB = 1u << 20;
constexpr size_t WS_CTL = 0, CTL_ZERO_BYTES = 2 * MiB;
constexpr size_t WS_SS = 516 * MiB;
constexpr size_t WS_CVEC = 524288;
constexpr int CV_EVIN = 0, CV_ODIN = 2 * 4 * 5120, CV_FFIN = CV_ODIN + 2 * 4 * 2304;
constexpr int CV_TOTAL = CV_FFIN + 4 * 4 * 11008;
constexpr size_t WS_CVPART = 526 * MiB;
constexpr size_t WS_MOD = 11 * MiB;
constexpr size_t WS_COSA = 2 * MiB, WS_SINA = 4 * MiB, WS_COSC = 6 * MiB, WS_SINC = 7 * MiB;
constexpr size_t WS_S5T = 8 * MiB;
constexpr size_t WS_WGATE = 10 * MiB;
constexpr size_t WS_W_EVIN = 12 * MiB, WS_W_EVOUT = 52 * MiB, WS_W_ODIN = 68 * MiB, WS_W_ODOUT = 86 * MiB, WS_W_GLU = 102 * MiB, WS_W_FFIN = 106 * MiB, WS_W_FFOUT = 278 * MiB;
constexpr size_t WS_H = 364 * MiB, WS_MIX = 396 * MiB, WS_Q = 428 * MiB, WS_K = 444 * MiB, WS_V = 460 * MiB, WS_XB = 476 * MiB, WS_YB = 492 * MiB;
constexpr size_t WS_XC = 508 * MiB, WS_LA = 540 * MiB, WS_LB = 572 * MiB, WS_UFF = 604 * MiB, WS_ACT = 776 * MiB, WS_END = 862 * MiB;
constexpr size_t WS_HALO_F = 508 * MiB, WS_HALO_L = 512 * MiB;
constexpr size_t WS_XRES = 712 * MiB;
constexpr int CW_BAR = 4096;
constexpr int RING_BYTES = 131072, LDSCTL_OFF = 163584, LDS_BYTES = 163840;

#define GAS __attribute__((address_space(1)))
#define LAS __attribute__((address_space(3)))
typedef unsigned short bf16;
typedef float f32x4 __attribute__((ext_vector_type(4)));
typedef float f32x2 __attribute__((ext_vector_type(2)));
typedef unsigned u32x4 __attribute__((ext_vector_type(4)));
typedef unsigned u32x2 __attribute__((ext_vector_type(2)));
#define LDS_WAIT() asm volatile("s_waitcnt lgkmcnt(0)" ::: "memory")
using pg8::cvt_pk_bf16; using pg8::bf_lo; using pg8::bf_hi; using pg8::gelu_tanh;
__device__ __forceinline__ float wave_sum(float v) {
#pragma unroll
    for (int o = 1; o < 64; o <<= 1) v += __shfl_xor(v, o);
    return v;
}
__device__ __forceinline__ unsigned short f2bf(float f) { return (unsigned short)(cvt_pk_bf16(f, 0.f) & 0xffffu); }
__device__ __forceinline__ float bf2f(unsigned short b) { return __uint_as_float(((unsigned)b) << 16); }

struct Params { const float* in[N_INPUTS]; float* out; unsigned char* ws; int lo, hi, li, pad; };
typedef const __attribute__((address_space(4))) Params* KP;
#define KPREF(P, kp0) KP kp_ = (kp0); asm volatile("" : "+s"(kp_)); const __attribute__((address_space(4))) Params& P = *kp_
#define PHASE_IDS() int tid; asm volatile("v_mbcnt_lo_u32_b32 %0, -1, 0\n\tv_mbcnt_hi_u32_b32 %0, -1, %0" : "=v"(tid)); tid += kwave_ * 64;     const int lane = tid & 63, wave = __builtin_amdgcn_readfirstlane(tid >> 6); int bx = blockIdx.x; asm volatile("" : "+s"(bx)); const int G = gridDim.x; (void)lane; (void)wave; (void)G
#define FRESH_IDS() int ftid; asm volatile("v_mbcnt_lo_u32_b32 %0, -1, 0\n\tv_mbcnt_hi_u32_b32 %0, -1, %0" : "=v"(ftid)); const int flane = ftid, fwave = kwave; ftid += kwave * 64; int fbx = blockIdx.x; asm volatile("" : "+s"(fbx)); (void)flane; (void)fwave
#ifndef TAIL_INPROJ
#define TAIL_INPROJ 1
#endif
#define XB_TMO      128
#define XB_XCNT(j)  (256  + 64 * (j))
#define XB_XSUB(j)  (1280 + 64 * (j))
#define XB_XGEN(j)  (2304 + 64 * (j))
#define XB_TOP      3328
#define XB_TOPGEN   3392
#define XCD_BAR_WORDS 3456
#define XB_SPIN_CAP (1u << 18)
#define LAS __attribute__((address_space(3)))

__device__ __forceinline__ unsigned xb_ld(unsigned* p)              { return __hip_atomic_load(p, __ATOMIC_RELAXED, __HIP_MEMORY_SCOPE_AGENT); }
__device__ __forceinline__ unsigned xb_add(unsigned* p, unsigned v) { return __hip_atomic_fetch_add(p, v, __ATOMIC_RELAXED, __HIP_MEMORY_SCOPE_AGENT); }
__device__ __forceinline__ unsigned xb_xcc_id() { return (unsigned)__builtin_amdgcn_s_getreg((3 << 11) | 20) & 0xFu; }
#define XB_SPIN(cond, bar) do { unsigned _sp = 0; while (cond) { __builtin_amdgcn_s_sleep(1); \
    if ((++_sp & 255u) == 0u) { if (xb_ld(&(bar)[XB_TMO])) break; if (_sp > XB_SPIN_CAP) { atomicAdd(&(bar)[XB_TMO], 1u); break; } } } } while (0)

struct XcdBarrier {
    unsigned* bar; unsigned x; unsigned w0;
    volatile LAS unsigned* st;
};

__device__ __forceinline__ XcdBarrier xcd_barrier_post(unsigned* bar, volatile LAS unsigned* st) {
    XcdBarrier b; b.bar = bar; b.x = xb_xcc_id(); b.st = st;
    if (threadIdx.x == 0) (void)xb_add(&bar[XB_XCNT(b.x)], 1u);
    b.w0 = 0u;
    return b;
}
__device__ __forceinline__ void xcd_barrier_complete(unsigned* bar, unsigned x, unsigned& nloc, unsigned& nx) {
    const unsigned G = gridDim.x * gridDim.y * gridDim.z;
    unsigned sum, cnt, mine, sp = 0u;
    for (;;) {
        sum = 0u; cnt = 0u; mine = 0u;
#pragma unroll
        for (unsigned j = 0; j < 16; ++j) { const unsigned c = xb_ld(&bar[XB_XCNT(j)]); sum += c; cnt += (c > 0u) ? 1u : 0u; mine = (j == x) ? c : mine; }
        if (sum == G) break;
        __builtin_amdgcn_s_sleep(1);
        if ((++sp & 255u) == 0u) { if (xb_ld(&bar[XB_TMO])) break; if (sp > XB_SPIN_CAP) { atomicAdd(&bar[XB_TMO], 1u); break; } }
    }
    nloc = mine > 0u ? mine : 1u; nx = cnt > 0u ? cnt : 1u;
}

__device__ __forceinline__ void xcd_barrier(const XcdBarrier& b) {
    asm volatile("s_waitcnt vmcnt(0)" ::: "memory");
    __syncthreads();
    if (b.w0 != 0u && __builtin_amdgcn_mbcnt_hi(~0u, __builtin_amdgcn_mbcnt_lo(~0u, 0u)) == 0u) {
        unsigned* bar = b.bar;
        __builtin_amdgcn_s_waitcnt(0);
        unsigned nloc = b.st[0], nx = b.st[1];
        if (nloc == 0u) { xcd_barrier_complete(bar, b.x, nloc, nx); b.st[0] = nloc; b.st[1] = nx; }
        const unsigned old = xb_add(&bar[XB_XSUB(b.x)], 1u);
        const unsigned gen = old / nloc;
        if (old + 1u == (gen + 1u) * nloc) {
            __builtin_amdgcn_fence(__ATOMIC_RELEASE, "agent");
            asm volatile("s_waitcnt vmcnt(0)" ::: "memory");
            const unsigned og = xb_add(&bar[XB_TOP], 1u);
            const unsigned tg = og / nx;
            if (og + 1u == (tg + 1u) * nx) xb_add(&bar[XB_TOPGEN], 1u);
            else XB_SPIN(xb_ld(&bar[XB_TOPGEN]) == tg, bar);
            __builtin_amdgcn_fence(__ATOMIC_ACQUIRE, "agent");
            xb_add(&bar[XB_XGEN(b.x)], 1u);
            asm volatile("s_waitcnt vmcnt(0)" ::: "memory");
        } else {
            XB_SPIN(xb_ld(&bar[XB_XGEN(b.x)]) == gen, bar);
            __builtin_amdgcn_fence(__ATOMIC_ACQUIRE, "agent");
            asm volatile("s_waitcnt vmcnt(0)" ::: "memory");
        }
    }
    __syncthreads();
}
__device__ __forceinline__ void sincos_rev(double ang, float& s, float& c) {
    double rev = ang * 0.15915494309189535; rev -= floor(rev); const float fr = (float)rev;
    s = __builtin_amdgcn_sinf(fr); c = __builtin_amdgcn_cosf(fr);
}

constexpr size_t WS_S5TT = 604 * MiB, WS_S5T2 = 690 * MiB, WS_S5A32 = 707 * MiB;
__device__ __forceinline__ void s5_pre(KP kp0, LAS unsigned char* lds, int og, int tid) { KPREF(P, kp0);
    LAS float* apr = (LAS float*)lds; LAS float* api = apr + 33 * 64;
    LAS float* bbr = api + 33 * 64; LAS float* bbi = bbr + 1024;
    LAS float* cre = bbi + 1024; LAS float* cim = cre + 1024;
    LAS float* kern = cim + 1024;
    const int o = og >> 6, g = og & 63;
    const float dt = expf(P.in[I_OD_LOG_DT][og]);
    __syncthreads();
    for (int idx = tid; idx < 33 * 64; idx += 512) { const int k = idx >> 6, p = idx & 63; const float are = P.in[I_OD_A_RE][og * 64 + p], aim = P.in[I_OD_A_IM][og * 64 + p];
        const float er = expf((float)k * are * dt); float s, c; sincos_rev((double)k * (double)aim * (double)dt, s, c); apr[idx] = er * c; api[idx] = er * s; }
    for (int idx = tid; idx < 1024; idx += 512) { cre[idx] = P.in[I_OD_C_RE][(size_t)og * 1024 + idx]; cim[idx] = P.in[I_OD_C_IM][(size_t)og * 1024 + idx]; }
    __syncthreads();
    for (int idx = tid; idx < 1024; idx += 512) { const int p = idx >> 4; const float are = P.in[I_OD_A_RE][og * 64 + p], aim = P.in[I_OD_A_IM][og * 64 + p];
        const float xr = apr[64 + p] - 1.0f, xi = api[64 + p], den = 1.0f / (are * are + aim * aim), cr = (xr * are + xi * aim) * den, ci = (xi * are - xr * aim) * den;
        const float br = P.in[I_OD_B_RE][(size_t)og * 1024 + idx], bi = P.in[I_OD_B_IM][(size_t)og * 1024 + idx];
        bbr[idx] = cr * br - ci * bi; bbi[idx] = cr * bi + ci * br; }
    if (tid < 64) ((f32x2*)(P.ws + WS_S5A32))[og * 64 + tid] = (f32x2){apr[32 * 64 + tid], api[32 * 64 + tid]};
    __syncthreads();
    {
        const int pair = tid & 255, cp = pair >> 4, c = pair & 15, kh = tid >> 8; float acc[16];
#pragma unroll
        for (int kk = 0; kk < 16; ++kk) acc[kk] = 0.f;
        for (int p = 0; p < 64; ++p) { const float gr = cre[cp * 64 + p] * bbr[p * 16 + c] - cim[cp * 64 + p] * bbi[p * 16 + c], gi = cre[cp * 64 + p] * bbi[p * 16 + c] + cim[cp * 64 + p] * bbr[p * 16 + c];
#pragma unroll
            for (int kk = 0; kk < 16; ++kk) acc[kk] += gr * apr[(16 * kh + kk) * 64 + p] - gi * api[(16 * kh + kk) * 64 + p]; }
#pragma unroll
        for (int kk = 0; kk < 16; ++kk) kern[(16 * kh + kk) * 256 + pair] = acc[kk];
    }
    __syncthreads();
    bf16* TT = (bf16*)(P.ws + WS_S5TT) + (size_t)og * 512 * 640; bf16* T2 = (bf16*)(P.ws + WS_S5T2) + (size_t)og * 128 * 512;
    for (int idx = tid; idx < 512 * 64; idx += 512) { const int n = idx >> 6, ic = idx & 63, i = ic >> 1, ch = ic & 1, j = n >> 4, cp = n & 15; float v[8];
#pragma unroll
        for (int cc = 0; cc < 8; ++cc) v[cc] = (j >= i) ? kern[(j - i) * 256 + cp * 16 + 8 * ch + cc] : 0.f;
        u32x4 w; w.x = cvt_pk_bf16(v[0], v[1]); w.y = cvt_pk_bf16(v[2], v[3]); w.z = cvt_pk_bf16(v[4], v[5]); w.w = cvt_pk_bf16(v[6], v[7]);
        *(u32x4*)(TT + (size_t)n * 640 + i * 16 + 8 * ch) = w; }
    for (int idx = tid; idx < 512 * 16; idx += 512) { const int n = idx >> 4, q = idx & 15, j = n >> 4, cp = n & 15, im = q >> 3, p0 = (q & 7) * 8; float v[8];
#pragma unroll
        for (int cc = 0; cc < 8; ++cc) { const int p = p0 + cc; const float ar = apr[(j + 1) * 64 + p], ai = api[(j + 1) * 64 + p], cr = cre[cp * 64 + p], ci = cim[cp * 64 + p];
            v[cc] = im ? -(cr * ai + ci * ar) : (cr * ar - ci * ai); }
        u32x4 w; w.x = cvt_pk_bf16(v[0], v[1]); w.y = cvt_pk_bf16(v[2], v[3]); w.z = cvt_pk_bf16(v[4], v[5]); w.w = cvt_pk_bf16(v[6], v[7]);
        *(u32x4*)(TT + (size_t)n * 640 + 512 + 64 * im + p0) = w; }
    for (int idx = tid; idx < 128 * 64; idx += 512) { const int comp = idx >> 6, ic = idx & 63, i = ic >> 1, ch = ic & 1, p = comp & 63, im = comp >> 6; float v[8];
        const float ar = apr[(31 - i) * 64 + p], ai = api[(31 - i) * 64 + p];
#pragma unroll
        for (int cc = 0; cc < 8; ++cc) { const float br = bbr[p * 16 + 8 * ch + cc], bi = bbi[p * 16 + 8 * ch + cc]; v[cc] = im ? (ar * bi + ai * br) : (ar * br - ai * bi); }
        u32x4 w; w.x = cvt_pk_bf16(v[0], v[1]); w.y = cvt_pk_bf16(v[2], v[3]); w.z = cvt_pk_bf16(v[4], v[5]); w.w = cvt_pk_bf16(v[6], v[7]);
        *(u32x4*)(T2 + (size_t)comp * 512 + i * 16 + 8 * ch) = w; }
}


__device__ __forceinline__ void phase_ada(KP kp0, int kwave_, LAS unsigned char* lds) { KPREF(P, kp0); PHASE_IDS();
    LAS float* cond = (LAS float*)lds;
    LAS float* part = (LAS float*)(lds + 32768);
    const float* c = P.in[I_C];
    for (int i = tid; i < NB * DM; i += 512) { const float v = c[i]; cond[i] = v / (1.0f + __expf(-v)); }
    __syncthreads();
    float* mod = (float*)(P.ws + WS_MOD);
    for (int item = bx; item < 192; item += G) {
        const int l = item / 48, ng = item % 48;
        const float* W = P.in[I_ADA_W] + (size_t)l * DM * 12288 + (size_t)(wave * 256) * 12288 + ng * 256 + lane * 4;
        f32x4 a0 = {0.f, 0.f, 0.f, 0.f}, a1 = a0, a2 = a0, a3 = a0;
#pragma unroll 8
        for (int k = 0; k < 256; ++k) {
            const f32x4 w = *(const f32x4*)(W + (size_t)k * 12288); const int kk = wave * 256 + k;
            a0 += cond[kk] * w; a1 += cond[2048 + kk] * w; a2 += cond[4096 + kk] * w; a3 += cond[6144 + kk] * w;
        }
        LAS float* pp = part + wave * 1024 + lane * 4;
        *(LAS f32x4*)(pp) = a0; *(LAS f32x4*)(pp + 256) = a1; *(LAS f32x4*)(pp + 512) = a2; *(LAS f32x4*)(pp + 768) = a3;
        __syncthreads();
        for (int o = tid; o < 1024; o += 512) {
            float s = 0.f;
#pragma unroll
            for (int w = 0; w < 8; ++w) s += part[w * 1024 + o];
            const int b = o >> 8, cc = o & 255;
            mod[(size_t)(l * 4 + b) * 12288 + ng * 256 + cc] = s + P.in[I_ADA_B][l * 12288 + ng * 256 + cc];
        }
        __syncthreads();
    }
    if (bx >= 192 || G < 256) for (int og = (G < 256 ? bx : bx - 192); og < (G == 256 ? 64 : 128); og += (G < 256 ? G : 64)) s5_pre(kp0, lds, og, tid);
}

__device__ __forceinline__ int cmap(int type, int n) {
    if (type == 1) { if (n >= 2048) return n; const int tile = n >> 8, j = n & 255, bj = j >> 7, jj = j & 127; return tile * 256 + (jj >> 6) * 128 + bj * 64 + (jj & 63); }
    if (type == 2) {
        if (n >= 1280) return n;
        if (n < 1024) { const int tile = n >> 8, j = n & 255, bj = j >> 7, jj = j & 127; return tile * 256 + (jj >> 5) * 64 + bj * 32 + (jj & 31); }
        const int j = n - 1024, bj = j >> 7, jj = j & 127; if (jj < 64) return 1024 + (jj >> 5) * 64 + bj * 32 + (jj & 31); return 1152 + bj * 64 + (jj - 64);
    }
    if (type == 3) { const int tile = n >> 8, j = n & 255; return (j >> 7) * 5504 + tile * 128 + (j & 127); }
    return n;
}
__device__ __forceinline__ void tr_item(const float* W, int K, int N, bf16* WT, int k0, int c0a, int c0b, int dstr0, LAS float* scr, int lane, float* cv, const float* sh) {
    const int csrc = ((lane & 8) ? c0b : c0a) + (lane & 7) * 4, cl = (lane & 15) * 4;
#pragma unroll
    for (int i = 0; i < 16; ++i) { const int kk = 4 * i + (lane >> 4); const f32x4 v = __builtin_nontemporal_load((const f32x4*)(W + (size_t)(k0 + kk) * N + csrc));
        LAS float* d = scr + kk * 65 + cl; d[0] = v[0]; d[1] = v[1]; d[2] = v[2]; d[3] = v[3]; }
    LDS_WAIT(); asm volatile("" ::: "memory");
    const int c = lane & 7;
#pragma unroll
    for (int j = 0; j < 8; ++j) { const int n = (lane >> 3) + 8 * j; const LAS float* s = scr + (8 * c) * 65 + n;
        u32x4 o; o.x = cvt_pk_bf16(s[0 * 65], s[1 * 65]); o.y = cvt_pk_bf16(s[2 * 65], s[3 * 65]); o.z = cvt_pk_bf16(s[4 * 65], s[5 * 65]); o.w = cvt_pk_bf16(s[6 * 65], s[7 * 65]);
        __builtin_nontemporal_store(o, (u32x4*)(WT + (size_t)(dstr0 + n) * K + k0 + 8 * c)); }
    if (cv) { float a0 = 0.f, a1 = 0.f, a2 = 0.f, a3 = 0.f;
#pragma unroll 16
        for (int k = 0; k < 64; ++k) { const float w = scr[k * 65 + lane]; a0 += sh[k0 + k] * w; a1 += sh[12288 + k0 + k] * w; a2 += sh[2 * 12288 + k0 + k] * w; a3 += sh[3 * 12288 + k0 + k] * w; }
        cv[dstr0 + lane] = a0; cv[N + dstr0 + lane] = a1; cv[2 * N + dstr0 + lane] = a2; cv[3 * N + dstr0 + lane] = a3; }
    LDS_WAIT(); asm volatile("" ::: "memory");
}
constexpr int CONV_EVEN = 11872, CONV_ODD = 10688;
__device__ __forceinline__ int conv_total(int L) { return (L & 1) ? CONV_ODD : CONV_EVEN; }
__device__ __forceinline__ void conv_item(KP kp0, int L, int idx, LAS float* scr, int lane) { KPREF(P, kp0);
    const float* mod = (const float*)(P.ws + WS_MOD) + (size_t)L * 4 * 12288; float* cvpart = (float*)(P.ws + WS_CVPART);
    const int e = L >> 1; const bool odd = (L & 1) != 0;
    int r = idx, in_idx, K, N, ctype = 0, cvo = -1; size_t wsoff; const float* sh = mod; size_t li_off;
    const int n_in = odd ? 1152 : 2560, n_aux = odd ? 256 : 32;
    if (r < n_in) { in_idx = odd ? I_OD_W_IN : I_EV_W_IN; K = 2048; N = odd ? ODD_IN : EVEN_IN; ctype = odd ? 2 : 1; wsoff = odd ? WS_W_ODIN : WS_W_EVIN; cvo = odd ? CV_ODIN + e * 4 * ODD_IN : CV_EVIN + e * 4 * EVEN_IN; li_off = (size_t)e * K * N; }
    else if ((r -= n_in) < n_aux) {
        if (!odd) { const int mat = r >> 1, kb = r & 1, gate = mat & 1, eb = e * 8 + (mat >> 1);
#pragma unroll
            for (int nb = 0; nb < 2; ++nb)
                tr_item(P.in[gate ? I_EV_GX_W : I_EV_GA_W] + (size_t)eb * 16384, 128, 128, (bf16*)(P.ws + WS_WGATE) + ((size_t)eb * 256 + gate * 128) * 128, 64 * kb, 64 * nb, 64 * nb + 32, 64 * nb, scr, lane, nullptr, nullptr);
            return; }
        in_idx = I_OD_GLU_W; K = 1024; N = 1024; wsoff = WS_W_GLU; li_off = (size_t)e * K * N; }
    else if ((r -= n_aux) < 1024) { in_idx = odd ? I_OD_W_OUT : I_EV_W_OUT; K = 2048; N = 2048; wsoff = odd ? WS_W_ODOUT : WS_W_EVOUT; li_off = (size_t)e * K * N; }
    else if ((r -= 1024) < 5504) { in_idx = I_FFN_W_IN; K = 2048; N = DFF2; ctype = 3; wsoff = WS_W_FFIN; cvo = CV_FFIN + L * 4 * DFF2; sh = mod + 3 * DM; li_off = (size_t)L * K * N; }
    else { r -= 5504; in_idx = I_FFN_W_OUT; K = DFF; N = 2048; wsoff = WS_W_FFOUT; li_off = (size_t)L * K * N; }
    const int nblk = N / 64, kb = r / nblk, nb = r % nblk;
    tr_item(P.in[in_idx] + li_off, K, N, (bf16*)(P.ws + wsoff) + li_off, 64 * kb, cmap(ctype, 64 * nb), cmap(ctype, 64 * nb + 32), 64 * nb, scr, lane,
            cvo >= 0 ? cvpart + ((size_t)kb * CV_TOTAL + cvo) : nullptr, sh);
}
__device__ __forceinline__ void conv_range(KP kp0, LAS unsigned char* lds, int L, int first, int last, int rank, int nranks, int wave, int lane) {
    LAS float* scr = (LAS float*)(lds + wave * 16640);
    for (int it = first + rank * 8 + wave; it < last; it += nranks * 8) conv_item(kp0, L, it, scr, lane);
}
__device__ __forceinline__ void cvec_reduce(KP kp0, int L, int bx, int G, int tid) { KPREF(P, kp0);
    const float* cvpart = (const float*)(P.ws + WS_CVPART); float* cvec = (float*)(P.ws + WS_CVEC);
    const int e = L >> 1, n_in = (L & 1) ? 4 * ODD_IN : 4 * EVEN_IN, o_in = (L & 1) ? CV_ODIN + e * 4 * ODD_IN : CV_EVIN + e * 4 * EVEN_IN, o_ff = CV_FFIN + L * 4 * DFF2;
    for (int i = bx * 512 + tid; i < n_in + 4 * DFF2; i += G * 512) { const int off = i < n_in ? o_in + i : o_ff + (i - n_in); float v[32];
#pragma unroll
        for (int kb = 0; kb < 32; ++kb) v[kb] = cvpart[(size_t)kb * CV_TOTAL + off];
        float s = 0.f;
#pragma unroll
        for (int kb = 0; kb < 32; ++kb) s += v[kb];
        cvec[off] = s; }
}
__device__ __forceinline__ void cvec_reduce_l0(KP kp0, const pg8::StaticOrder& S, int bx, int G, int tid) { KPREF(P, kp0);
    const float* cvpart = (const float*)(P.ws + WS_CVPART); float* cvec = (float*)(P.ws + WS_CVEC);
    pg8::Unit u;
    for (int i = 0; S.next(i, u); ++i) if (tid < 256) { const int off = CV_EVIN + (u.pm >> 3) * EVEN_IN + u.pn * 256 + tid; float v[32];
#pragma unroll
        for (int kb = 0; kb < 32; ++kb) v[kb] = cvpart[(size_t)kb * CV_TOTAL + off];
        float s = 0.f;
#pragma unroll
        for (int kb = 0; kb < 32; ++kb) s += v[kb];
        cvec[off] = s; }
    for (int i = bx * 512 + tid; i < 4 * DFF2; i += G * 512) { const int off = CV_FFIN + i; float v[32];
#pragma unroll
        for (int kb = 0; kb < 32; ++kb) v[kb] = cvpart[(size_t)kb * CV_TOTAL + off];
        float s = 0.f;
#pragma unroll
        for (int kb = 0; kb < 32; ++kb) s += v[kb];
        cvec[off] = s; }
    asm volatile("s_waitcnt vmcnt(0)" ::: "memory"); __syncthreads();
}
__device__ __forceinline__ void norm0_rows(KP kp0, int bx, int G, int wave, int lane);
__device__ __forceinline__ int conv_up(int L, bool tails) { return !tails ? conv_total(L) : (L == 0 ? CONV_EVEN : (TAIL_INPROJ ? (L == 1 ? 3776 : (L == 2 ? 1408 : 5312)) : (L == 2 ? 8064 : 6848))); }
__device__ __forceinline__ void phase_prep(KP kp0, int kwave_, LAS unsigned char* lds, bool tails) { KPREF(P, kp0); PHASE_IDS();
    {
        LAS float* scr = (LAS float*)(lds + wave * 16640);
        const int t0 = conv_up(0, tails), t1 = t0 + conv_up(1, tails), t2 = t1 + conv_up(2, tails), t3 = t2 + conv_up(3, tails);
        for (int it = bx * 8 + wave; it < t3; it += G * 8) { const int L = it < t0 ? 0 : (it < t1 ? 1 : (it < t2 ? 2 : 3)); conv_item(kp0, L, it - (L == 0 ? 0 : (L == 1 ? t0 : (L == 2 ? t1 : t2))), scr, lane); }
    }
    norm0_rows(kp0, bx, G, wave, lane);
    const int gw = bx * 8 + wave, NGW = G * 8; (void)gw; (void)NGW;
    const int gt = bx * 512 + tid, NT = G * 512;
    const int* pos = (const int*)P.in[I_POS];
    float* cosA = (float*)(P.ws + WS_COSA); float* sinA = (float*)(P.ws + WS_SINA); float* cosC = (float*)(P.ws + WS_COSC); float* sinC = (float*)(P.ws + WS_SINC);
    for (int idx = gt; idx < MT * 64; idx += NT) { const int row = idx >> 6, i = idx & 63;
        const double inv = exp2(-(double)i * (13.287712379549449 / 64.0)); float s, c; sincos_rev((double)pos[row] * inv, s, c); cosA[idx] = c; sinA[idx] = s; }
    for (int idx = gt; idx < MT * 32; idx += NT) { const int row = idx >> 5, i = idx & 31;
        const double inv = exp2(-(double)i * (13.287712379549449 / 32.0)); float s, c; sincos_rev((double)pos[row] * inv, s, c); cosC[idx] = c; sinC[idx] = s; }
}

__device__ __forceinline__ void norm0_rows(KP kp0, int bx, int G, int wave, int lane) { KPREF(P, kp0);
    const float* x = P.in[I_X]; const float* gwt = P.in[I_NORM_MIX];
    const float* modl = (const float*)(P.ws + WS_MOD);
    bf16* H = (bf16*)(P.ws + WS_H); float* ss = (float*)(P.ws + WS_SS);
    const int gw = bx * 8 + wave, NGW = G * 8;
    for (int row = gw; row < MT; row += NGW) {
        const f32x4* xr = (const f32x4*)(x + (size_t)row * DM) + lane;
        f32x4 v[8]; float s2 = 0.f;
#pragma unroll
        for (int j = 0; j < 8; ++j) { v[j] = xr[64 * j]; s2 += (v[j][0] * v[j][0] + v[j][1] * v[j][1]) + (v[j][2] * v[j][2] + v[j][3] * v[j][3]); }
        s2 = wave_sum(s2); if (lane < 8) ss[(size_t)row * 8 + lane] = lane == 0 ? s2 : 0.f;
        const float* sc = modl + (size_t)(row >> 11) * 12288 + DM;
        u32x2* o8 = (u32x2*)(H + (size_t)row * DM) + lane;
#pragma unroll
        for (int j = 0; j < 8; ++j) { const int col = (lane + 64 * j) * 4;
            const f32x4 y = v[j] * *(const f32x4*)(gwt + col) * (1.0f + *(const f32x4*)(sc + col));
            u32x2 w; w.x = cvt_pk_bf16(y[0], y[1]); w.y = cvt_pk_bf16(y[2], y[3]); o8[64 * j] = w; }
    }
}
__device__ __forceinline__ void phase_final(KP kp0, int kwave_) { KPREF(P, kp0); PHASE_IDS();
    const float* gwt = P.in[I_NORM_FINAL];
    const int gw = bx * 8 + wave, NGW = G * 8;
    for (int row = gw; row < MT; row += NGW) {
        f32x4* xr = (f32x4*)(P.out + (size_t)row * DM) + lane;
        f32x4 v[8]; float ss = 0.f;
#pragma unroll
        for (int j = 0; j < 8; ++j) { v[j] = xr[64 * j]; ss += (v[j][0] * v[j][0] + v[j][1] * v[j][1]) + (v[j][2] * v[j][2] + v[j][3] * v[j][3]); }
        const float rstd = rsqrtf(wave_sum(ss) * (1.0f / DM) + 1e-6f);
#pragma unroll
        for (int j = 0; j < 8; ++j) { const int col = (lane + 64 * j) * 4; xr[64 * j] = v[j] * rstd * *(const f32x4*)(gwt + col); }
    }
}

__device__ __forceinline__ void ffn_fix_panel(const float* hf, const float* hl, bf16* ACT, const float* cw, const float* cb, int pm, int tid) {
    if ((pm & 7) == 0) return;
    for (int idx = tid; idx < 2 * DFF; idx += 512) { const int j = idx % DFF, rr = idx / DFF;
        float o[2];
#pragma unroll
        for (int bj = 0; bj < 2; ++bj) { const int col = bj * DFF + j;
            const float l0 = hl[((size_t)((pm - 1) * 2 + 0) * 2 + bj) * DFF + j], l1 = hl[((size_t)((pm - 1) * 2 + 1) * 2 + bj) * DFF + j];
            const float f0 = hf[((size_t)(pm * 2 + 0) * 2 + bj) * DFF + j], f1 = hf[((size_t)(pm * 2 + 1) * 2 + bj) * DFF + j];
            const float um2 = rr == 0 ? l0 : l1, um1 = rr == 0 ? l1 : f0, u0 = rr == 0 ? f0 : f1;
            o[bj] = cb[col] + cw[col] * um2 + cw[DFF2 + col] * um1 + cw[2 * DFF2 + col] * u0; }
        ACT[(size_t)(pm * 256 + rr) * DFF + j] = f2bf(gelu_tanh(o[0]) * o[1]); }
}

typedef short s16x4 __attribute__((ext_vector_type(4)));
typedef short bf16x8v __attribute__((ext_vector_type(8)));
typedef float f32x16 __attribute__((ext_vector_type(16)));
__device__ __forceinline__ unsigned offb(unsigned row, unsigned ch) { return 256u * row + 16u * (ch ^ (((row & 3u) << 2) | ((row >> 2) & 3u))); }
constexpr int ATT_TILE_BYTES = 64 * 256, ATT_BUF_BYTES = 2 * ATT_TILE_BYTES;
__device__ __forceinline__ bf16x8v cat8(const s16x4 a, const s16x4 b) { return (bf16x8v){a[0], a[1], a[2], a[3], b[0], b[1], b[2], b[3]}; }

template <int MODE>
__device__ __forceinline__ void phase_attn(KP kp0, int kwave_, LAS unsigned char* lds, int o_idx) { KPREF(P, kp0); PHASE_IDS();
    constexpr int NKS = MODE == 0 ? 8 : 4;
    constexpr int NDT = MODE == 0 ? 4 : 2;
    constexpr int NH = 1;
    const bf16* Q = (const bf16*)(P.ws + WS_Q); const bf16* K = (const bf16*)(P.ws + WS_K); const bf16* V = (const bf16*)(P.ws + WS_V); bf16* MIX = (bf16*)(P.ws + WS_MIX);
    const int r = lane & 31, hh = lane >> 5, q4 = (lane & 15) >> 2, p4 = lane & 3, blk = (lane >> 4) & 1;
    unsigned kaddr[NKS], vaddr[2][NDT];
    { const unsigned x = ((r & 3u) << 2) | ((r >> 2) & 3u);
#pragma unroll
      for (int s = 0; s < NKS; ++s) kaddr[s] = 256u * r + 16u * (((unsigned)(2 * s + hh)) ^ x);
#pragma unroll
      for (int t = 0; t < 2; ++t)
#pragma unroll
        for (int c = 0; c < NDT; ++c) { const unsigned row = 8u * t + 4u * hh + q4, ch = 4u * c + 2u * blk + (p4 >> 1);
            vaddr[t][c] = 256u * row + 16u * (ch ^ (((row & 3u) << 2) | ((row >> 2) & 3u))) + 8u * (p4 & 1); } }
    const int nunits = MODE == 0 ? 256 : 512;
    for (int unit = bx; unit < nunits; unit += G) {
        int b, head0, q0, kt0, kt1; size_t kvbase; int kvpitch; unsigned kx = 0u;
        if (MODE == 0) { const int qb = 7 - (unit >> 5), bh = unit & 31; b = bh >> 3; head0 = bh & 7; q0 = qb * 256; kt0 = qb >= 2 ? 4 * (qb - 2) : 0; kt1 = qb * 4 + 3; kvbase = (size_t)b * SEQ * 1024 + head0 * 128; kvpitch = 1024; }
        else { b = unit >> 7; const int kvh = (unit >> 6) & 1; kx = 128u * kvh; q0 = (unit & 63) * 32; head0 = 8 * kvh + wave; kt0 = (q0 >= 127 ? q0 - 127 : 0) >> 6; kt1 = (q0 + 31) >> 6; kvbase = (size_t)b * SEQ * 128; kvpitch = 128; }
        const int tq = MODE == 0 ? q0 + 16 * (r & 15) + 2 * wave + (r >> 4) : q0 + r;
        const size_t qrow = (size_t)b * SEQ + tq;
        bf16x8v qf[NH][NKS];
#pragma unroll
        for (int hd = 0; hd < NH; ++hd)
#pragma unroll
            for (int s = 0; s < NKS; ++s) qf[hd][s] = *(const bf16x8v*)(Q + qrow * 1024 + (MODE == 0 ? head0 * 128 : (head0 + hd) * 64) + 16 * s + 8 * hh);
        f32x16 O[NH][NDT]; float m[NH], l[NH];
#pragma unroll
        for (int hd = 0; hd < NH; ++hd) { m[hd] = -1e30f; l[hd] = 0.f;
#pragma unroll
            for (int c = 0; c < NDT; ++c)
#pragma unroll
                for (int i = 0; i < 16; ++i) O[hd][c][i] = 0.f; }
        const int srow = tid >> 4, sch = tid & 15;
        const unsigned soff0 = offb(srow, sch), soff1 = offb(srow + 32, sch);
        u32x4 kreg[2], vreg[2];
        { const size_t g0 = kvbase + (size_t)(kt0 * 64 + srow) * kvpitch + sch * 8, g1 = g0 + (size_t)32 * kvpitch;
          kreg[0] = *(const u32x4*)(K + g0); kreg[1] = *(const u32x4*)(K + g1); vreg[0] = *(const u32x4*)(V + g0); vreg[1] = *(const u32x4*)(V + g1); }
        __syncthreads();
        *(LAS u32x4*)(lds + soff0) = kreg[0]; *(LAS u32x4*)(lds + soff1) = kreg[1];
        *(LAS u32x4*)(lds + ATT_TILE_BYTES + soff0) = vreg[0]; *(LAS u32x4*)(lds + ATT_TILE_BYTES + soff1) = vreg[1];
        __syncthreads();
        for (int kt = kt0; kt <= kt1; ++kt) {
            const int cur = (kt - kt0) & 1;
            LAS unsigned char* kb_ = lds + cur * ATT_BUF_BYTES; LAS unsigned char* vb_ = kb_ + ATT_TILE_BYTES;
            if (kt < kt1) { const size_t g0 = kvbase + (size_t)((kt + 1) * 64 + srow) * kvpitch + sch * 8, g1 = g0 + (size_t)32 * kvpitch;
                kreg[0] = *(const u32x4*)(K + g0); kreg[1] = *(const u32x4*)(K + g1); vreg[0] = *(const u32x4*)(V + g0); vreg[1] = *(const u32x4*)(V + g1); }
            {
                const int dq = tq - 64 * kt - 4 * hh;
#pragma unroll
                for (int hd = 0; hd < NH; ++hd) {
                    f32x16 S[2];
#pragma unroll
                    for (int kb = 0; kb < 2; ++kb) {
#pragma unroll
                        for (int i = 0; i < 16; ++i) S[kb][i] = 0.f;
#pragma unroll
                        for (int s = 0; s < NKS; ++s) { const bf16x8v kf = *(const LAS bf16x8v*)(kb_ + (kaddr[s] ^ kx) + kb * 8192); S[kb] = __builtin_amdgcn_mfma_f32_32x32x16_bf16(kf, qf[hd][s], S[kb], 0, 0, 0); }
                    }
                    float w[2][16]; float tmax = -INFINITY;
#pragma unroll
                    for (int kb = 0; kb < 2; ++kb)
#pragma unroll
                        for (int i = 0; i < 16; ++i) { const int d = dq - (kb * 32 + (i & 3) + 8 * (i >> 2));
                            if (MODE == 0) { const int cnt = (d <= 128 ? 1 : 0) + (((d & 3) == 0 && d <= 512) ? 1 : 0) + ((d & 15) == 0 ? 1 : 0); w[kb][i] = (d >= 0) ? (float)cnt : 0.f; }
                            else w[kb][i] = (d >= 0 && d <= 127) ? 1.f : 0.f;
                            S[kb][i] = (w[kb][i] > 0.f) ? S[kb][i] : -INFINITY; tmax = fmaxf(tmax, S[kb][i]); }
                    tmax = fmaxf(tmax, __shfl_xor(tmax, 32));
                    const float mn = fmaxf(m[hd], tmax), corr = __builtin_amdgcn_exp2f(m[hd] - mn); m[hd] = mn;
                    float ps = 0.f;
#pragma unroll
                    for (int kb = 0; kb < 2; ++kb)
#pragma unroll
                        for (int i = 0; i < 16; ++i) { const float pv = w[kb][i] * __builtin_amdgcn_exp2f(S[kb][i] - mn); S[kb][i] = pv; ps += pv; }
                    l[hd] = l[hd] * corr + ps;
#pragma unroll
                    for (int c = 0; c < NDT; ++c)
#pragma unroll
                        for (int i = 0; i < 16; ++i) O[hd][c][i] *= corr;
#pragma unroll
                    for (int kb = 0; kb < 2; ++kb)
#pragma unroll
                        for (int s2 = 0; s2 < 2; ++s2) {
                            bf16x8v pf; { const unsigned a0 = cvt_pk_bf16(S[kb][8 * s2 + 0], S[kb][8 * s2 + 1]), a1 = cvt_pk_bf16(S[kb][8 * s2 + 2], S[kb][8 * s2 + 3]),
                                                         a2 = cvt_pk_bf16(S[kb][8 * s2 + 4], S[kb][8 * s2 + 5]), a3 = cvt_pk_bf16(S[kb][8 * s2 + 6], S[kb][8 * s2 + 7]);
                                pf = __builtin_bit_cast(bf16x8v, (u32x4){a0, a1, a2, a3}); }
#pragma unroll
                            for (int c = 0; c < NDT; ++c) {
                                const s16x4 v0 = __builtin_amdgcn_ds_read_tr16_b64_v4i16((LAS s16x4*)(vb_ + (vaddr[0][c] ^ kx) + 256 * (32 * kb + 16 * s2)));
                                const s16x4 v1 = __builtin_amdgcn_ds_read_tr16_b64_v4i16((LAS s16x4*)(vb_ + (vaddr[1][c] ^ kx) + 256 * (32 * kb + 16 * s2)));
                                O[hd][c] = __builtin_amdgcn_mfma_f32_32x32x16_bf16(cat8(v0, v1), pf, O[hd][c], 0, 0, 0); }
                        }
                }
            }
            if (kt < kt1) { LAS unsigned char* nb_ = lds + (cur ^ 1) * ATT_BUF_BYTES;
                *(LAS u32x4*)(nb_ + soff0) = kreg[0]; *(LAS u32x4*)(nb_ + soff1) = kreg[1];
                *(LAS u32x4*)(nb_ + ATT_TILE_BYTES + soff0) = vreg[0]; *(LAS u32x4*)(nb_ + ATT_TILE_BYTES + soff1) = vreg[1]; }
            __syncthreads();
        }
        if (MODE == 0 && kt0 > 0) {
            LAS unsigned char* pk = lds + wave * 16384; LAS unsigned char* pv = pk + 8192;
            const int nfar = 4 * kt0;
            for (int s = 0; s * 16 < nfar; ++s) {
#pragma unroll
                for (int jh = 0; jh < 2; ++jh) { u32x4 kf[4], vf[4];
#pragma unroll
                    for (int j = 0; j < 4; ++j) { const int row = (lane >> 4) + 4 * (4 * jh + j), keypos = 2 * wave + (row >> 4) + 16 * (16 * s + (row & 15)); const size_t g0 = kvbase + (size_t)keypos * kvpitch + (lane & 15) * 8;
                        kf[j] = *(const u32x4*)(K + g0); vf[j] = *(const u32x4*)(V + g0); }
#pragma unroll
                    for (int j = 0; j < 4; ++j) { const unsigned so = offb((lane >> 4) + 4 * (4 * jh + j), lane & 15); *(LAS u32x4*)(pk + so) = kf[j]; *(LAS u32x4*)(pv + so) = vf[j]; } }
                f32x16 S;
#pragma unroll
                for (int i = 0; i < 16; ++i) S[i] = 0.f;
#pragma unroll
                for (int s8 = 0; s8 < NKS; ++s8) { const bf16x8v kfr = *(const LAS bf16x8v*)(pk + kaddr[s8]); S = __builtin_amdgcn_mfma_f32_32x32x16_bf16(kfr, qf[0][s8], S, 0, 0, 0); }
                float tmax = -INFINITY;
#pragma unroll
                for (int i = 0; i < 16; ++i) { const bool ok = (i >> 3) == (r >> 4); S[i] = ok ? S[i] : -INFINITY; tmax = fmaxf(tmax, S[i]); }
                tmax = fmaxf(tmax, __shfl_xor(tmax, 32));
                const float mn = fmaxf(m[0], tmax), corr = __builtin_amdgcn_exp2f(m[0] - mn); m[0] = mn;
                float ps = 0.f;
#pragma unroll
                for (int i = 0; i < 16; ++i) { const float pvv = __builtin_amdgcn_exp2f(S[i] - mn); S[i] = pvv; ps += pvv; }
                l[0] = l[0] * corr + ps;
#pragma unroll
                for (int c = 0; c < NDT; ++c)
#pragma unroll
                    for (int i = 0; i < 16; ++i) O[0][c][i] *= corr;
#pragma unroll
                for (int s2 = 0; s2 < 2; ++s2) {
                    bf16x8v pf; { const unsigned a0 = cvt_pk_bf16(S[8 * s2 + 0], S[8 * s2 + 1]), a1 = cvt_pk_bf16(S[8 * s2 + 2], S[8 * s2 + 3]), a2 = cvt_pk_bf16(S[8 * s2 + 4], S[8 * s2 + 5]), a3 = cvt_pk_bf16(S[8 * s2 + 6], S[8 * s2 + 7]);
                        pf = __builtin_bit_cast(bf16x8v, (u32x4){a0, a1, a2, a3}); }
#pragma unroll
                    for (int c = 0; c < NDT; ++c) {
                        const s16x4 v0 = __builtin_amdgcn_ds_read_tr16_b64_v4i16((LAS s16x4*)(pv + vaddr[0][c] + 256 * (16 * s2)));
                        const s16x4 v1 = __builtin_amdgcn_ds_read_tr16_b64_v4i16((LAS s16x4*)(pv + vaddr[1][c] + 256 * (16 * s2)));
                        O[0][c] = __builtin_amdgcn_mfma_f32_32x32x16_bf16(cat8(v0, v1), pf, O[0][c], 0, 0, 0); }
                }
            }
        }
#pragma unroll
        for (int hd = 0; hd < NH; ++hd) {
            float lt = l[hd] + __shfl_xor(l[hd], 32);
            if (MODE == 1) lt += __builtin_amdgcn_exp2f(P.in[I_OD_SINKS][o_idx * 16 + head0 + hd] * LOG2E - m[hd]);
            const float inv = 1.0f / lt;
            bf16* orow = MIX + qrow * 2048 + (MODE == 0 ? head0 * 128 : (head0 + hd) * 64);
#pragma unroll
            for (int c = 0; c < NDT; ++c)
#pragma unroll
                for (int g4 = 0; g4 < 4; ++g4) { u32x2 o; o.x = cvt_pk_bf16(O[hd][c][4 * g4 + 0] * inv, O[hd][c][4 * g4 + 1] * inv); o.y = cvt_pk_bf16(O[hd][c][4 * g4 + 2] * inv, O[hd][c][4 * g4 + 3] * inv);
                    *(u32x2*)(orow + 32 * c + 8 * g4 + 4 * hh) = o; }
        }
    }
    __syncthreads();
}
__device__ __forceinline__ void phase_s5(KP kp0, int kwave_, LAS unsigned char* lds, int o_idx) { KPREF(P, kp0); PHASE_IDS();
    const bf16* Ug = (const bf16*)(P.ws + WS_XB); bf16* Z = (bf16*)(P.ws + WS_YB);
    constexpr int UP = 1296;
    LAS unsigned char* uc = lds; LAS float* eL = (LAS float*)(lds + 64 * UP);
    const int r = lane & 31, hh = lane >> 5;
    for (int bg = bx; bg < 256; bg += G) { const int b = bg >> 6, g = bg & 63, og = o_idx * 64 + g;
        const bf16* TT = (const bf16*)(P.ws + WS_S5TT) + (size_t)og * 512 * 640; const bf16* T2 = (const bf16*)(P.ws + WS_S5T2) + (size_t)og * 128 * 512;
        __syncthreads();
        { const int row = tid >> 3, piece = tid & 7; const bf16* src = Ug + ((size_t)g * MT + (size_t)b * SEQ + 32 * row) * 16 + piece * 64;
#pragma unroll
          for (int q = 0; q < 8; ++q) *(LAS u32x4*)(uc + row * UP + (piece * 8 + q) * 16) = *(const u32x4*)(src + q * 8); }
        __syncthreads();
        {
            const int rt = wave & 1, ct = wave >> 1; f32x16 acc;
#pragma unroll
            for (int i = 0; i < 16; ++i) acc[i] = 0.f;
            const bf16* bp = T2 + (size_t)(32 * ct + r) * 512 + 8 * hh;
            bf16x8v bq[32];
#pragma unroll
            for (int s = 0; s < 32; ++s) bq[s] = *(const bf16x8v*)(bp + 16 * s);
            asm volatile("" ::: "memory");
#pragma unroll
            for (int s = 0; s < 32; ++s) { const bf16x8v af = *(const LAS bf16x8v*)(uc + (32 * rt + r) * UP + 32 * s + 16 * hh);
                acc = __builtin_amdgcn_mfma_f32_32x32x16_bf16(af, bq[s], acc, 0, 0, 0); }
#pragma unroll
            for (int i = 0; i < 16; ++i) eL[(32 * rt + (i & 3) + 8 * (i >> 2) + 4 * hh) * 128 + 32 * ct + r] = acc[i];
        }
        __syncthreads();
        if (wave == 0) { const f32x2 a32 = ((const f32x2*)(P.ws + WS_S5A32))[og * 64 + lane]; float hr = 0.f, hi = 0.f;
            for (int ch = 0; ch < 64; ++ch) { *(LAS unsigned short*)(uc + ch * UP + 1024 + lane * 2) = f2bf(hr); *(LAS unsigned short*)(uc + ch * UP + 1152 + lane * 2) = f2bf(hi);
                const float er = eL[ch * 128 + lane], ei = eL[ch * 128 + 64 + lane]; const float nr = a32[0] * hr - a32[1] * hi + er, ni = a32[0] * hi + a32[1] * hr + ei; hr = nr; hi = ni; } }
        __syncthreads();
        const float dsk = P.in[I_OD_D][o_idx * 1024 + g * 16 + (r & 15)];
        {
            f32x16 acc[2][2];
#pragma unroll
            for (int a = 0; a < 2; ++a)
#pragma unroll
                for (int c = 0; c < 2; ++c)
#pragma unroll
                    for (int i = 0; i < 16; ++i) acc[a][c][i] = 0.f;
            const bf16* bp0 = TT + (size_t)(32 * wave + r) * 640 + 8 * hh; const bf16* bp1 = bp0 + (size_t)256 * 640;
            bf16x8v bq[2][5][2];
#pragma unroll
            for (int s = 0; s < 5; ++s) { bq[0][s][0] = *(const bf16x8v*)(bp0 + 16 * s); bq[0][s][1] = *(const bf16x8v*)(bp1 + 16 * s); }
#pragma unroll
            for (int bt = 0; bt < 8; ++bt) {
                if (bt < 7) {
#pragma unroll
                    for (int s = 0; s < 5; ++s) { bq[(bt + 1) & 1][s][0] = *(const bf16x8v*)(bp0 + 16 * (5 * (bt + 1) + s)); bq[(bt + 1) & 1][s][1] = *(const bf16x8v*)(bp1 + 16 * (5 * (bt + 1) + s)); } }
                asm volatile("" ::: "memory");
#pragma unroll
                for (int s8 = 0; s8 < 5; ++s8) { const int s = 5 * bt + s8; const bf16x8v b0 = bq[bt & 1][s8][0], b1 = bq[bt & 1][s8][1];
                    const bf16x8v a0 = *(const LAS bf16x8v*)(uc + r * UP + 32 * s + 16 * hh), a1 = *(const LAS bf16x8v*)(uc + (32 + r) * UP + 32 * s + 16 * hh);
                    acc[0][0] = __builtin_amdgcn_mfma_f32_32x32x16_bf16(a0, b0, acc[0][0], 0, 0, 0); acc[1][0] = __builtin_amdgcn_mfma_f32_32x32x16_bf16(a1, b0, acc[1][0], 0, 0, 0);
                    acc[0][1] = __builtin_amdgcn_mfma_f32_32x32x16_bf16(a0, b1, acc[0][1], 0, 0, 0); acc[1][1] = __builtin_amdgcn_mfma_f32_32x32x16_bf16(a1, b1, acc[1][1], 0, 0, 0); }
            }
            __syncthreads();
#pragma unroll
            for (int cti = 0; cti < 2; ++cti) { const int n = 32 * (wave + 8 * cti) + r;
#pragma unroll
                for (int rt = 0; rt < 2; ++rt)
#pragma unroll
                    for (int i = 0; i < 16; ++i) { const int ch = 32 * rt + (i & 3) + 8 * (i >> 2) + 4 * hh; LAS unsigned short* up = (LAS unsigned short*)(uc + ch * UP + n * 2);
                        *up = f2bf(gelu_tanh(acc[rt][cti][i] + dsk * bf2f(*up))); } }
            __syncthreads();
#pragma unroll
            for (int q = 0; q < 8; ++q) { const int p = tid + 512 * q, t = p >> 1, hf = p & 1;
                *(u32x4*)(Z + ((size_t)b * SEQ + t) * 1024 + g * 16 + hf * 8) = *(const LAS u32x4*)(uc + (t >> 5) * UP + ((t & 31) * 16 + hf * 8) * 2); }
        }
    }
}

__device__ __forceinline__ void phase_lru(KP kp0, int kwave_, LAS unsigned char* lds, int e) { KPREF(P, kp0); PHASE_IDS();
    const bf16* XB = (const bf16*)(P.ws + WS_XB); const bf16* YB = (const bf16*)(P.ws + WS_YB); bf16* MIX = (bf16*)(P.ws + WS_MIX);
    LAS unsigned char* xcL = lds;
    LAS float* aL = (LAS float*)(lds + 69632); LAS float* bL = (LAS float*)(lds + 86016);
    LAS float* sA = (LAS float*)(lds + 102400); LAS float* sB = (LAS float*)(lds + 104448);
    LAS float* carry = (LAS float*)(lds + 106496);
    const int c16 = lane & 15, kq = lane >> 4, cg = tid & 15, rg = tid >> 4;
    for (int item = bx; item < 256; item += G) { const int b = item >> 6, blk = (item >> 3) & 7, oct = item & 7, ch0 = blk * 128 + oct * 16;
        float cw[4][8], cb[8];
#pragma unroll
        for (int q = 0; q < 8; ++q) { cb[q] = P.in[I_EV_CONV_B][e * 1024 + blk * 128 + cg * 8 + q];
#pragma unroll
            for (int i = 0; i < 4; ++i) cw[i][q] = P.in[I_EV_CONV_W][(size_t)(e * 4 + i) * 1024 + blk * 128 + cg * 8 + q]; }
        bf16x8v bfr[4], bfi[4];
        { const bf16* wg = (const bf16*)(P.ws + WS_WGATE) + ((size_t)(e * 8 + blk) * 256 + oct * 16 + c16) * 128 + 8 * kq;
#pragma unroll
          for (int s = 0; s < 4; ++s) { bfr[s] = *(const bf16x8v*)(wg + 32 * s); bfi[s] = *(const bf16x8v*)(wg + 128 * 128 + 32 * s); } }
        const float gab = P.in[I_EV_GA_B][e * 1024 + ch0 + c16], gxb = P.in[I_EV_GX_B][e * 1024 + ch0 + c16];
        const float sp8 = -8.0f * log1pf(expf(-P.in[I_EV_LAMBDA][e * 1024 + ch0 + c16]));
        if (tid < 16) carry[tid] = 0.f;
        u32x4 xin[11];
#pragma unroll
        for (int i = 0; i < 11; ++i) { const int tt = 8 * rg - 3 + i; xin[i] = (tt >= 0) ? *(const u32x4*)(XB + (size_t)(b * SEQ + tt) * 1024 + blk * 128 + cg * 8) : (u32x4){0u, 0u, 0u, 0u}; }
        __syncthreads();
        for (int tc = 0; tc < 8; ++tc) { const int t0 = tc * 256;
#pragma unroll
            for (int j = 0; j < 8; ++j) { float o[8];
#pragma unroll
                for (int q = 0; q < 8; ++q) o[q] = cb[q];
#pragma unroll
                for (int i = 0; i < 4; ++i) { const u32x4 x = xin[j + i];
                    o[0] += cw[i][0] * bf_lo(x.x); o[1] += cw[i][1] * bf_hi(x.x); o[2] += cw[i][2] * bf_lo(x.y); o[3] += cw[i][3] * bf_hi(x.y);
                    o[4] += cw[i][4] * bf_lo(x.z); o[5] += cw[i][5] * bf_hi(x.z); o[6] += cw[i][6] * bf_lo(x.w); o[7] += cw[i][7] * bf_hi(x.w); }
                u32x4 w; w.x = cvt_pk_bf16(o[0], o[1]); w.y = cvt_pk_bf16(o[2], o[3]); w.z = cvt_pk_bf16(o[4], o[5]); w.w = cvt_pk_bf16(o[6], o[7]);
                *(LAS u32x4*)(xcL + (8 * rg + j) * 272 + cg * 16) = w; }
            if (tc < 7) {
#pragma unroll
                for (int i = 0; i < 11; ++i) xin[i] = *(const u32x4*)(XB + (size_t)(b * SEQ + t0 + 256 + 8 * rg - 3 + i) * 1024 + blk * 128 + cg * 8); }
            float ybv[8];
#pragma unroll
            for (int i = 0; i < 8; ++i) ybv[i] = bf2f(YB[(size_t)(b * SEQ + t0 + 8 * rg + i) * 1024 + ch0 + cg]);
            __syncthreads();
#pragma unroll
            for (int rb = 0; rb < 2; ++rb) { const int row0 = 32 * wave + 16 * rb;
                f32x4 accr = {0.f, 0.f, 0.f, 0.f}, acci = {0.f, 0.f, 0.f, 0.f};
#pragma unroll
                for (int s2 = 0; s2 < 4; ++s2) { const bf16x8v af = *(const LAS bf16x8v*)(xcL + (row0 + c16) * 272 + 64 * s2 + 16 * kq);
                    accr = __builtin_amdgcn_mfma_f32_16x16x32_bf16(af, bfr[s2], accr, 0, 0, 0); acci = __builtin_amdgcn_mfma_f32_16x16x32_bf16(af, bfi[s2], acci, 0, 0, 0); }
#pragma unroll
                for (int i = 0; i < 4; ++i) { const int row = row0 + 4 * kq + i;
                    const float rr = 1.0f / (1.0f + __expf(-(accr[i] + gab))), ig = 1.0f / (1.0f + __expf(-(acci[i] + gxb)));
                    const float a = __expf(sp8 * rr), mult = sqrtf(fmaxf(1.0f - a * a, 0.f));
                    const float xv = bf2f(*(const LAS unsigned short*)(xcL + row * 272 + (oct * 16 + c16) * 2));
                    aL[row * 16 + c16] = a; bL[row * 16 + c16] = mult * ig * xv; }
            }
            __syncthreads();
            float av[8], bv[8], A = 1.f, B = 0.f;
#pragma unroll
            for (int i = 0; i < 8; ++i) { av[i] = aL[(8 * rg + i) * 16 + cg]; bv[i] = bL[(8 * rg + i) * 16 + cg]; B = av[i] * B + bv[i]; A *= av[i]; }
            { const float a1 = __shfl_up(A, 16), b1 = __shfl_up(B, 16); if (lane >= 16) { B = A * b1 + B; A = A * a1; }
              const float a2 = __shfl_up(A, 32), b2 = __shfl_up(B, 32); if (lane >= 32) { B = A * b2 + B; A = A * a2; } }
            if (lane >= 48) { sA[wave * 16 + cg] = A; sB[wave * 16 + cg] = B; }
            const float ape = __shfl_up(A, 16), bpe = __shfl_up(B, 16);
            __syncthreads();
            float h = carry[(tc & 1) * 16 + cg];
            for (int w = 0; w < wave; ++w) h = sA[w * 16 + cg] * h + sB[w * 16 + cg];
            if (lane >= 16) h = ape * h + bpe;
#pragma unroll
            for (int i = 0; i < 8; ++i) { h = av[i] * h + bv[i];
                MIX[(size_t)(b * SEQ + t0 + 8 * rg + i) * 2048 + 1024 + ch0 + cg] = f2bf(h * ybv[i]); }
            if (rg == 31 && tc < 7) carry[((tc + 1) & 1) * 16 + cg] = h;
        }
    }
}

constexpr int N_PHASES = 2 + 11 * NLAYER + 1;
#ifndef NREP_G
#define NREP_G 1
#endif
#ifndef NREP_M
#define NREP_M 1
#endif
#ifndef NREP_MB
#define NREP_MB 1
#endif
#ifndef NREP_BAR
#define NREP_BAR 1
#endif
#ifndef NREP_GO
#define NREP_GO 1
#endif
#ifndef NREP_E
#define NREP_E 1
#endif
#ifndef NREP_P
#define NREP_P 1
#endif
#ifndef TAIL_INPROJ
#define TAIL_INPROJ 1
#endif
#ifndef MK_ONE_LAUNCH
#define MK_ONE_LAUNCH 1
#endif
__global__ void __launch_bounds__(512, 2) fwd(Params P) {
    extern __shared__ __attribute__((aligned(16))) unsigned char lds_raw[];
    LAS unsigned char* lds = (LAS unsigned char*)lds_raw;
    const int kwave = __builtin_amdgcn_readfirstlane((int)threadIdx.x >> 6);
    for (int u = threadIdx.x; u < (LDS_BYTES - LDSCTL_OFF) / 4; u += 512) ((LAS unsigned*)(lds + LDSCTL_OFF))[u] = 0u;
    __syncthreads();
    const KP kp = (KP)__builtin_amdgcn_kernarg_segment_ptr();
    const int ph_lo = kp->lo, ph_hi = kp->hi;
    unsigned* barw = (unsigned*)(kp->ws + WS_CTL) + CW_BAR + kp->li * XCD_BAR_WORDS;
    XcdBarrier bar; bar.bar = barw; bar.x = 0; bar.w0 = 0u; bar.st = nullptr;
    if (ph_hi - ph_lo > 1) bar = xcd_barrier_post(barw, (volatile LAS unsigned*)(lds + LDSCTL_OFF + 64));
    bar.w0 = (kwave == 0) ? 1u : 0u;
    const bool tails = gridDim.x == 256;
#define RUN(p) (ph_lo <= (p) && (p) < ph_hi)
#define SEAM(p) do { if (RUN(p) && RUN((p) + 1)) for (int rb_ = 0; rb_ < NREP_BAR; ++rb_) xcd_barrier(bar); } while (0)

    if (RUN(0)) for (int rep = 0; rep < NREP_P; ++rep) phase_ada(kp, kwave, lds);
    SEAM(0);
    if (RUN(1)) for (int rep = 0; rep < NREP_P; ++rep) phase_prep(kp, kwave, lds, tails);
    SEAM(1);
    for (int l = 0; l < NLAYER; ++l) {
        const int pb = 2 + 11 * l, e = l >> 1; const bool odd = (l & 1) != 0;
        if (RUN(pb + 1)) for (int rep = 0; rep < NREP_G; ++rep) { KPREF(P, kp); const int kwave_ = kwave; PHASE_IDS(); const bf16* H = (const bf16*)(P.ws + WS_H); bf16* Qb = (bf16*)(P.ws + WS_Q);
            if (!odd) { pg8::Gemm g{H, (const bf16*)(P.ws + WS_W_EVIN) + (size_t)e * EVEN_IN * DM, MT, EVEN_IN, DM}; pg8::PrefetchOrder S; S.init(MT, EVEN_IN, G, bx); S.ssp = (const float*)(P.ws + WS_SS) + (size_t)(2 * l) * MT * 8; S.buf = lds + RING_BYTES + 8192; S.wave = wave; S.ui = 0;
                if (l == 0 && rep == 0) cvec_reduce_l0(kp, S, bx, G, tid);
                pg8::EpiEvenIn E{Qb, (const float*)(P.ws + WS_COSA), (const float*)(P.ws + WS_SINA), QSCALE_A, lds + RING_BYTES + 8192, (const float*)(P.ws + WS_CVEC) + CV_EVIN + (size_t)e * 4 * EVEN_IN, (LAS float*)(lds + RING_BYTES + 6144)};
                pg8::gemm_phase<pg8::EpiEvenIn, pg8::PrefetchOrder, true, true>(lds, g, S, E, tid);
                { FRESH_IDS();
                if (tails && rep + 1 == NREP_G && fbx >= 128) {
                    if (l == 0) { if (TAIL_INPROJ) conv_range(kp, lds, 1, 3776, 6848, fbx - 128, 128, fwave, flane); }
                    else if (fbx < 192) s5_pre(kp, lds, 64 + fbx - 128, ftid);
                    else if (TAIL_INPROJ) conv_range(kp, lds, 3, 5312, 6848, fbx - 192, 64, fwave, flane); } } }
            else { pg8::Gemm g{H, (const bf16*)(P.ws + WS_W_ODIN) + (size_t)e * ODD_IN * DM, MT, ODD_IN, DM}; pg8::PrefetchOrder S; S.init(MT, ODD_IN, G, bx); S.ssp = (const float*)(P.ws + WS_SS) + (size_t)(2 * l) * MT * 8; S.buf = lds + RING_BYTES + 8192; S.wave = wave; S.ui = 0;
                pg8::EpiOddIn E{Qb, (bf16*)(P.ws + WS_K), (bf16*)(P.ws + WS_V), (bf16*)(P.ws + WS_XB), (const float*)(P.ws + WS_COSC), (const float*)(P.ws + WS_SINC), QSCALE_C, lds + RING_BYTES + 8192, (const float*)(P.ws + WS_CVEC) + CV_ODIN + (size_t)e * 4 * ODD_IN, (LAS float*)(lds + RING_BYTES + 6144)};
                pg8::gemm_phase<pg8::EpiOddIn, pg8::PrefetchOrder, true, true>(lds, g, S, E, tid);
                { FRESH_IDS(); if (TAIL_INPROJ && tails && rep + 1 == NREP_G && l == 1 && fbx >= 32) conv_range(kp, lds, 2, 1408, 6784, fbx - 32, 224, fwave, flane); } }
        }
        SEAM(pb + 1);
        if (RUN(pb + 2)) for (int rep = 0; rep < (odd ? 1 : NREP_M); ++rep) { if (!odd) phase_attn<0>(kp, kwave, lds, 0); else phase_attn<1>(kp, kwave, lds, e); }
        if (RUN(pb + 3)) for (int rep = 0; rep < (odd ? NREP_MB : 1); ++rep) { if (!odd) phase_lru(kp, kwave, lds, e); else phase_s5(kp, kwave, lds, e); }
        SEAM(pb + 3);
        if (RUN(pb + 4)) {
            if (odd) for (int rep = 0; rep < NREP_G; ++rep) { KPREF(P, kp); const int kwave_ = kwave; PHASE_IDS(); const bf16* YBb = (const bf16*)(P.ws + WS_YB); bf16* MIX = (bf16*)(P.ws + WS_MIX); pg8::Gemm g{YBb, (const bf16*)(P.ws + WS_W_GLU) + (size_t)e * 1024 * 1024, MT, 1024, 1024}; pg8::StaticOrder S; S.init(MT, 1024, G, bx);
                pg8::EpiGlu E{YBb, MIX, P.in[I_OD_GLU_B] + e * 1024};
                pg8::gemm_phase<pg8::EpiGlu, pg8::StaticOrder, true, true>(lds, g, S, E, tid);
                { FRESH_IDS(); if (TAIL_INPROJ && tails && rep + 1 == NREP_G && l == 1 && fbx >= 128) conv_range(kp, lds, 2, 6784, 8064, fbx - 128, 128, fwave, flane); } }
        }
        if (odd) SEAM(pb + 4);
        if (RUN(pb + 6)) for (int rep = 0; rep < NREP_G * NREP_GO; ++rep) { KPREF(P, kp); const int kwave_ = kwave; PHASE_IDS(); const bf16* MIX = (const bf16*)(P.ws + WS_MIX); const float* mod = (const float*)(P.ws + WS_MOD);
            const bf16* W = odd ? (const bf16*)(P.ws + WS_W_ODOUT) + (size_t)e * DM * DM : (const bf16*)(P.ws + WS_W_EVOUT) + (size_t)e * DM * DM;
            pg8::Gemm g{MIX, W, MT, DM, DM}; pg8::StaticOrder S; S.init(MT, DM, G, bx);
            const bool dry = rep + 1 < NREP_G * NREP_GO;
            pg8::EpiResid E{l == 0 ? P.in[I_X] : nullptr, (const bf16*)(P.ws + WS_XRES), dry ? (bf16*)(P.ws + 710 * MiB) : (bf16*)(P.ws + WS_XRES), nullptr, mod + (size_t)l * 4 * 12288 + 2 * DM, dry ? nullptr : (bf16*)(P.ws + WS_H), P.in[I_NORM_FFN] + l * DM, mod + (size_t)l * 4 * 12288 + 4 * DM, (float*)(P.ws + WS_SS) + (size_t)(2 * l + 1) * MT * 8, (LAS float*)(lds + RING_BYTES)};
            pg8::gemm_phase<pg8::EpiResid, pg8::StaticOrder, true, true>(lds, g, S, E, tid);
        }
        SEAM(pb + 6);
        if (RUN(pb + 8)) for (int rep = 0; rep < NREP_G; ++rep) { KPREF(P, kp); const int kwave_ = kwave; PHASE_IDS(); const bf16* H = (const bf16*)(P.ws + WS_H);
            pg8::Gemm g{H, (const bf16*)(P.ws + WS_W_FFIN) + (size_t)l * DFF2 * DM, MT, DFF2, DM}; pg8::PrefetchOrder S; S.init(MT, DFF2, G, bx); S.ssp = (const float*)(P.ws + WS_SS) + (size_t)(2 * l + 1) * MT * 8; S.buf = lds + RING_BYTES + 8192; S.wave = wave; S.ui = 0;
            pg8::EpiFfnIn E{(bf16*)(P.ws + WS_ACT), (float*)(P.ws + WS_HALO_F), (float*)(P.ws + WS_HALO_L), P.in[I_FFN_CONV_W] + (size_t)l * 3 * DFF2, P.in[I_FFN_CONV_B] + (size_t)l * DFF2, (LAS float*)(lds + RING_BYTES), lds + RING_BYTES + 8192, (const float*)(P.ws + WS_CVEC) + CV_FFIN + (size_t)l * 4 * DFF2};
            pg8::gemm_phase<pg8::EpiFfnIn, pg8::PrefetchOrder, true, true>(lds, g, S, E, tid);
            { FRESH_IDS(); if (tails && rep + 1 == NREP_G && l + 1 < NLAYER && fbx >= 96) conv_range(kp, lds, l + 1, l == 1 ? 8064 : 6848, conv_total(l + 1), fbx - 96, 160, fwave, flane); }
        }
        SEAM(pb + 8);
        if (RUN(pb + 10)) for (int rep = 0; rep < NREP_G; ++rep) { KPREF(P, kp); const int kwave_ = kwave; PHASE_IDS(); const bf16* ACT = (const bf16*)(P.ws + WS_ACT); const float* mod = (const float*)(P.ws + WS_MOD);
            pg8::Gemm g{ACT, (const bf16*)(P.ws + WS_W_FFOUT) + (size_t)l * DM * DFF, MT, DM, DFF}; pg8::StaticOrder S; S.init(MT, DM, G, bx);
            if (l + 1 < NLAYER && rep == 0) cvec_reduce(kp, l + 1, bx, G, tid);
            { pg8::Unit fu; int lastpm = -1; for (int i = 0; S.next(i, fu); ++i) if (fu.pm != lastpm) { lastpm = fu.pm;
                ffn_fix_panel((const float*)(P.ws + WS_HALO_F), (const float*)(P.ws + WS_HALO_L), (bf16*)(P.ws + WS_ACT), P.in[I_FFN_CONV_W] + (size_t)l * 3 * DFF2, P.in[I_FFN_CONV_B] + (size_t)l * DFF2, fu.pm, tid); }
              asm volatile("s_waitcnt vmcnt(0)" ::: "memory"); __syncthreads(); }
            const bool dry = rep + 1 < NREP_G, last = l == NLAYER - 1;
            pg8::EpiResid E{nullptr, (const bf16*)(P.ws + WS_XRES), dry ? (bf16*)(P.ws + 710 * MiB) : (bf16*)(P.ws + WS_XRES), (last && !dry) ? P.out : nullptr, mod + (size_t)l * 4 * 12288 + 5 * DM, (dry || last) ? nullptr : (bf16*)(P.ws + WS_H), P.in[I_NORM_MIX] + (last ? l : l + 1) * DM, mod + (size_t)(last ? l : l + 1) * 4 * 12288 + DM, (float*)(P.ws + WS_SS) + (size_t)(2 * l + 2) * MT * 8, (LAS float*)(lds + RING_BYTES)};
            pg8::gemm_phase<pg8::EpiResid, pg8::StaticOrder, true, true>(lds, g, S, E, tid);
        }
        SEAM(pb + 10);
    }
    if (RUN(N_PHASES - 1)) phase_final(kp, kwave);
#undef RUN
#undef SEAM
}

extern "C" void kernel_launch(void* const* d_in, const int* in_sizes, int n_in, void* d_out, int out_size, void* d_ws, size_t ws_size, hipStream_t stream) {
    static int grid = 0;
    if (grid == 0) {
        if (n_in != N_INPUTS || out_size != MT * DM || ws_size < WS_END) { fprintf(stderr, "kernel_launch: unexpected shapes: n_in %d out %d ws %zu (need %zu)\n", n_in, out_size, ws_size, (size_t)WS_END); grid = -1; return; }
        int dev = 0, cus = 0, per_cu = 0;
        if (hipGetDevice(&dev) != hipSuccess || hipDeviceGetAttribute(&cus, hipDeviceAttributeMultiprocessorCount, dev) != hipSuccess) { grid = -1; return; }
        if (hipFuncSetAttribute((const void*)fwd, hipFuncAttributeMaxDynamicSharedMemorySize, LDS_BYTES) != hipSuccess) { fprintf(stderr, "kernel_launch: hipFuncSetAttribute failed\n"); grid = -1; return; }
        if (hipOccupancyMaxActiveBlocksPerMultiprocessor(&per_cu, (const void*)fwd, 512, LDS_BYTES) != hipSuccess || per_cu < 1) fprintf(stderr, "kernel_launch: occupancy query says %d\n", per_cu);
        (void)hipGetLastError();
        grid = cus;
    }
    if (grid < 0) return;
    if (hipMemsetAsync((char*)d_ws + WS_CTL, 0, CTL_ZERO_BYTES, stream) != hipSuccess) return;
    Params p{};
    for (int i = 0; i < N_INPUTS; ++i) p.in[i] = (const float*)d_in[i];
    p.out = (float*)d_out; p.ws = (unsigned char*)d_ws; p.pad = 0;
#if MK_ONE_LAUNCH
    p.lo = 0; p.hi = N_PHASES; p.li = 0;
    hipLaunchKernelGGL(fwd, dim3(grid), dim3(512), LDS_BYTES, stream, p);
#else
    for (int ph = 0; ph < N_PHASES; ++ph) { p.lo = ph; p.hi = ph + 1; p.li = 0; hipLaunchKernelGGL(fwd, dim3(grid), dim3(512), LDS_BYTES, stream, p); }
#endif
    const hipError_t le = hipPeekAtLastError();
    if (le != hipSuccess) fprintf(stderr, "kernel_launch: launch failed: %s\n", hipGetErrorName(le));
}
```

```cpp
#include <hip/hip_runtime.h>
#include <cstdio>
#include <cstdint>
namespace pg8 {
#define PG8_LAS __attribute__((address_space(3)))
typedef unsigned short bf16_t;
typedef short bf16x8 __attribute__((ext_vector_type(8)));
typedef float f32x4 __attribute__((ext_vector_type(4)));
typedef unsigned u32x4 __attribute__((ext_vector_type(4)));
typedef unsigned u32x2 __attribute__((ext_vector_type(2)));
constexpr int BM = 256, BK = 64, HALF = 128, HTB = HALF * BK * 2  , STAGE_BYTES = 8 * HTB, NXCD = 8, WGM = 8;

__host__ __device__ __forceinline__ int lds_byte(int r, int c) { const int st = (r >> 4) * 2 + (c >> 5), rr = r & 15, cc = c & 31, ob = rr * 64 + cc * 2; return st * 1024 + (ob ^ (((ob >> 9) & 1) << 5)); }
__host__ __device__ __forceinline__ void stage_rc(int b, int& R, int& C) { const int st = b / 1024, sb = b % 1024, swz = sb ^ (((sb >> 9) & 1) << 5); R = (st >> 1) * 16 + swz / 64; C = (st & 1) * 32 + (swz % 64) / 2; }
__host__ __device__ __forceinline__ int perm32(int rho) { const int n = rho >> 4, i = rho & 15; return 8 * (i >> 2) + 4 * n + (i & 3); }

struct Unit { int pm, pn, ro, nar; };
struct Gemm { const bf16_t* A; const bf16_t* Bt; int M, N, K; };

struct StaticOrder {
    int nM, nN, nwg, G, c, nsplit;
    __host__ __device__ __forceinline__ void init(int M, int N, int G_, int c_, int nsplit_ = 0) { nM = M / BM; nN = N / BM; nwg = nM * nN; G = G_; c = c_; nsplit = nsplit_; }
    __host__ __device__ __forceinline__ bool next(int i, Unit& u) const {
        const long L = (long)i * G + c; if (L >= nwg + nsplit) return false;
        int wgid = (int)L; u.ro = 0; u.nar = 0;
        if (wgid >= nwg - nsplit) { u.nar = 1; if (wgid >= nwg) { wgid -= nsplit; u.ro = HALF; } }
        { const int q = nwg / NXCD, r = nwg % NXCD, xcd = wgid % NXCD, off = wgid / NXCD; wgid = (xcd < r ? xcd * (q + 1) : r * (q + 1) + (xcd - r) * q) + off; }
        const int nig = WGM * nN, gid = wgid / nig, fm = gid * WGM, gsz = (nM - fm) < WGM ? (nM - fm) : WGM;
        u.pm = fm + ((wgid % nig) % gsz); u.pn = (wgid % nig) / gsz; return true;
    }
    __device__ __forceinline__ void a_ready(const Unit&) const {}
    __device__ __forceinline__ void done(const Unit&) const {}
};

__device__ __forceinline__ unsigned cvt_pk_bf16(float lo, float hi) { unsigned r; asm("v_cvt_pk_bf16_f32 %0, %1, %2" : "=v"(r) : "v"(lo), "v"(hi)); return r; }
__device__ __forceinline__ u32x4 pack8(const f32x4 a, const f32x4 b) { u32x4 w; w.x = cvt_pk_bf16(a[0], a[1]); w.y = cvt_pk_bf16(a[2], a[3]); w.z = cvt_pk_bf16(b[0], b[1]); w.w = cvt_pk_bf16(b[2], b[3]); return w; }
__device__ __forceinline__ float bf_lo(unsigned w) { return __uint_as_float(w << 16); }
__device__ __forceinline__ float bf_hi(unsigned w) { return __uint_as_float(w & 0xffff0000u); }
__device__ __forceinline__ float gelu_tanh(float x) {
    const float u = x * (0.7978845608f + 0.0356774081f * x * x);
    const float e = __builtin_amdgcn_exp2f(-2.885390082f * u);
    return x * __builtin_amdgcn_rcpf(1.0f + e);
}
__device__ __forceinline__ f32x4 gelu4(const f32x4 v) { return (f32x4){gelu_tanh(v[0]), gelu_tanh(v[1]), gelu_tanh(v[2]), gelu_tanh(v[3])}; }
__device__ __forceinline__ float sigmoidf_fast(float x) { return __builtin_amdgcn_rcpf(1.0f + __builtin_amdgcn_exp2f(-1.4426950409f * x)); }

struct PrefetchOrder : StaticOrder {
    const float* ssp; PG8_LAS unsigned char* buf; int wave; mutable int ui;
    __device__ __forceinline__ void fetch(const Unit& u) const {
        int lane; asm volatile("v_mbcnt_lo_u32_b32 %0, -1, 0\n\tv_mbcnt_hi_u32_b32 %0, -1, %0" : "=v"(lane)); const int t = wave * 64 + lane;
        __builtin_amdgcn_global_load_lds((const unsigned*)(ssp + ((size_t)u.pm * BM + (t >> 1)) * 8 + (t & 1) * 4), (PG8_LAS unsigned*)(buf + wave * 1024), 16, 0, 0);
    }
    __device__ __forceinline__ void a_ready(const Unit& u) const { if (ui == 0) { ui = 1; fetch(u); } }
    __device__ __forceinline__ void done(const Unit&) const { Unit n; if (next(ui, n)) fetch(n); ++ui; }
};
__device__ __forceinline__ void build_rtab(PG8_LAS const unsigned char* buf, PG8_LAS float* rtab, int wr, int wc, int fr, int fq) {
    const int t = (wr * 4 + wc) * 64 + fq * 16 + fr;
    const f32x4 p = *(PG8_LAS const f32x4*)(buf + t * 16);
    float s = (p[0] + p[1]) + (p[2] + p[3]);
    s += __shfl_xor(s, 1);
    if ((t & 1) == 0) rtab[t >> 1] = rsqrtf(s * (1.0f / 2048.0f) + 1e-6f);
    asm volatile("s_waitcnt lgkmcnt(0)" ::: "memory"); __builtin_amdgcn_s_barrier(); asm volatile("" ::: "memory");
}

struct EpiStore {
    static constexpr bool PERM = true, AFTER_DRAIN = false;
    bf16_t* O; int ldc;
    __device__ __forceinline__ void operator()(const f32x4 (&acc)[2][2][4][2], const Unit& u, int wr, int wc, int fr, int fq) const {
        const int row0 = u.pm * BM + u.ro + wr * 64 + fr, col0 = u.pn * BM + wc * 32 + 8 * fq;
#pragma unroll
        for (int ai = 0; ai < 2; ++ai)
#pragma unroll
            for (int m = 0; m < 4; ++m) { if (ai == 1 && u.nar) break; bf16_t* rowp = O + (size_t)(row0 + ai * HALF + m * 16) * ldc + col0;
#pragma unroll
                for (int bj = 0; bj < 2; ++bj) *(u32x4*)(rowp + bj * HALF) = pack8(acc[ai][bj][m][0], acc[ai][bj][m][1]); }
    }
};

struct EpiEvenIn {
    static constexpr bool PERM = true, AFTER_DRAIN = false;
    bf16_t *Q; const float *cosT, *sinT; float qscale; PG8_LAS const unsigned char* ssb; const float* cv; PG8_LAS float* rtab;
    __device__ __forceinline__ void operator()(const f32x4 (&acc)[2][2][4][2], const Unit& u, int wr, int wc, int fr, int fq) const {
        const int row0 = u.pm * BM + u.ro + wr * 64 + fr;
        f32x4 cv4[2][2];
#pragma unroll
        for (int bj = 0; bj < 2; ++bj)
#pragma unroll
            for (int n = 0; n < 2; ++n) cv4[bj][n] = *(const f32x4*)(cv + (size_t)(u.pm >> 3) * 5120 + u.pn * BM + bj * HALF + wc * 32 + 8 * fq + 4 * n);
        build_rtab(ssb, rtab, wr, wc, fr, fq);
        float rr8[2][4];
#pragma unroll
        for (int ai = 0; ai < 2; ++ai)
#pragma unroll
            for (int m = 0; m < 4; ++m) rr8[ai][m] = rtab[u.ro + wr * 64 + ai * HALF + m * 16 + fr];
        if (u.pn < 8) {
            bf16_t* dst = Q + (size_t)(u.pn >> 2) * (8u << 20); const float sc = (u.pn < 4) ? qscale : 1.0f;
            const int head = (u.pn & 3) * 2 + (wc >> 1), i0 = (wc & 1) * 32 + 8 * fq;
#pragma unroll
            for (int ai = 0; ai < 2; ++ai) { if (ai == 1 && u.nar) break;
#pragma unroll
              for (int mh = 0; mh < 2; ++mh) {
                f32x4 cs[2][4];
#pragma unroll
                for (int m2 = 0; m2 < 2; ++m2) { const int m = m2; const size_t tr = (size_t)(row0 + ai * HALF + (2 * mh + m2) * 16) * 64 + i0;
                    cs[m][0] = *(const f32x4*)(cosT + tr); cs[m][1] = *(const f32x4*)(cosT + tr + 4); cs[m][2] = *(const f32x4*)(sinT + tr); cs[m][3] = *(const f32x4*)(sinT + tr + 4); }
#pragma unroll
                for (int m2 = 0; m2 < 2; ++m2) { const int m = 2 * mh + m2; const int row = row0 + ai * HALF + m * 16; const float rrm = rr8[ai][m];
                    const f32x4 c0 = cs[m2][0], c1 = cs[m2][1], s0 = cs[m2][2], s1 = cs[m2][3];
                    const f32x4 a0 = acc[ai][0][m][0] * rrm + cv4[0][0], a1 = acc[ai][0][m][1] * rrm + cv4[0][1], b0 = acc[ai][1][m][0] * rrm + cv4[1][0], b1 = acc[ai][1][m][1] * rrm + cv4[1][1];
                    const f32x4 o10 = (a0 * c0 - b0 * s0) * sc, o11 = (a1 * c1 - b1 * s1) * sc, o20 = (b0 * c0 + a0 * s0) * sc, o21 = (b1 * c1 + a1 * s1) * sc;
                    bf16_t* rp = dst + (size_t)row * 1024 + head * 128 + i0;
                    *(u32x4*)(rp) = pack8(o10, o11); *(u32x4*)(rp + 64) = pack8(o20, o21); } } }
        } else {
            const int sel = (u.pn - 8) >> 2; bf16_t* dst = Q + (size_t)(u.pn >> 2) * (8u << 20); const int col0 = (u.pn & 3) * 256 + wc * 32 + 8 * fq;
#pragma unroll
            for (int ai = 0; ai < 2; ++ai)
#pragma unroll
                for (int m = 0; m < 4; ++m) { if (ai == 1 && u.nar) break; bf16_t* rowp = dst + (size_t)(row0 + ai * HALF + m * 16) * 1024 + col0; const float rrm = rr8[ai][m];
#pragma unroll
                    for (int bj = 0; bj < 2; ++bj) { f32x4 v0 = acc[ai][bj][m][0] * rrm + cv4[bj][0], v1 = acc[ai][bj][m][1] * rrm + cv4[bj][1];
                        if (sel == 2) { v0 = gelu4(v0); v1 = gelu4(v1); }
                        *(u32x4*)(rowp + bj * HALF) = pack8(v0, v1); } }
        }
    }
};

struct EpiOddIn {
    static constexpr bool PERM = true, AFTER_DRAIN = false;
    bf16_t *Q, *K, *V, *U; const float *cosT, *sinT; float qscale; PG8_LAS const unsigned char* ssb; const float* cv; PG8_LAS float* rtab;
    __device__ __forceinline__ void operator()(const f32x4 (&acc)[2][2][4][2], const Unit& u, int wr, int wc, int fr, int fq) const {
        const int row0 = u.pm * BM + u.ro + wr * 64 + fr;
        f32x4 cv4[2][2];
#pragma unroll
        for (int bj = 0; bj < 2; ++bj)
#pragma unroll
            for (int n = 0; n < 2; ++n) cv4[bj][n] = *(const f32x4*)(cv + (size_t)(u.pm >> 3) * 2304 + u.pn * BM + bj * HALF + wc * 32 + 8 * fq + 4 * n);
        build_rtab(ssb, rtab, wr, wc, fr, fq);
        float rr8[2][4];
#pragma unroll
        for (int ai = 0; ai < 2; ++ai)
#pragma unroll
            for (int m = 0; m < 4; ++m) rr8[ai][m] = rtab[u.ro + wr * 64 + ai * HALF + m * 16 + fr];
        if (u.pn < 4 || (u.pn == 4 && wc < 2)) {
            const bool isq = u.pn < 4; const float sc = isq ? qscale : 1.0f;
            bf16_t* dst = isq ? Q + (u.pn * 4 + wc) * 64 : K + wc * 64; const int pitch = isq ? 1024 : 128;
#pragma unroll
            for (int ai = 0; ai < 2; ++ai) { if (ai == 1 && u.nar) break;
#pragma unroll
              for (int mh = 0; mh < 2; ++mh) {
                f32x4 cs[2][4];
#pragma unroll
                for (int m2 = 0; m2 < 2; ++m2) { const int m = m2; const size_t tr = (size_t)(row0 + ai * HALF + (2 * mh + m2) * 16) * 32 + 8 * fq;
                    cs[m][0] = *(const f32x4*)(cosT + tr); cs[m][1] = *(const f32x4*)(cosT + tr + 4); cs[m][2] = *(const f32x4*)(sinT + tr); cs[m][3] = *(const f32x4*)(sinT + tr + 4); }
#pragma unroll
                for (int m2 = 0; m2 < 2; ++m2) { const int m = 2 * mh + m2; const int row = row0 + ai * HALF + m * 16; const float rrm = rr8[ai][m];
                    const f32x4 c0 = cs[m2][0], c1 = cs[m2][1], s0 = cs[m2][2], s1 = cs[m2][3];
                    const f32x4 a0 = acc[ai][0][m][0] * rrm + cv4[0][0], a1 = acc[ai][0][m][1] * rrm + cv4[0][1], b0 = acc[ai][1][m][0] * rrm + cv4[1][0], b1 = acc[ai][1][m][1] * rrm + cv4[1][1];
                    const f32x4 o10 = (a0 * c0 - b0 * s0) * sc, o11 = (a1 * c1 - b1 * s1) * sc, o20 = (b0 * c0 + a0 * s0) * sc, o21 = (b1 * c1 + a1 * s1) * sc;
                    bf16_t* rp = dst + (size_t)row * pitch + 8 * fq;
                    *(u32x4*)(rp) = pack8(o10, o11); *(u32x4*)(rp + 32) = pack8(o20, o21); } } }
        } else if (u.pn == 4) {
#pragma unroll
            for (int ai = 0; ai < 2; ++ai)
#pragma unroll
                for (int m = 0; m < 4; ++m) { if (ai == 1 && u.nar) break; bf16_t* rowp = V + (size_t)(row0 + ai * HALF + m * 16) * 128 + (wc - 2) * 32 + 8 * fq; const float rrm = rr8[ai][m];
#pragma unroll
                    for (int bj = 0; bj < 2; ++bj) *(u32x4*)(rowp + bj * 64) = pack8(acc[ai][bj][m][0] * rrm + cv4[bj][0], acc[ai][bj][m][1] * rrm + cv4[bj][1]); }
        } else {
            const int col0 = (u.pn - 5) * 256 + wc * 32 + 8 * fq;
#pragma unroll
            for (int ai = 0; ai < 2; ++ai)
#pragma unroll
                for (int m = 0; m < 4; ++m) { if (ai == 1 && u.nar) break; bf16_t* rowp = U + ((size_t)(col0 >> 4) * 8192 + (size_t)(row0 + ai * HALF + m * 16)) * 16 + (col0 & 8); const float rrm = rr8[ai][m];
#pragma unroll
                    for (int bj = 0; bj < 2; ++bj) *(u32x4*)(rowp + (size_t)bj * 8 * 8192 * 16) = pack8(acc[ai][bj][m][0] * rrm + cv4[bj][0], acc[ai][bj][m][1] * rrm + cv4[bj][1]); }
        }
    }
};

struct EpiResid {
    static constexpr bool PERM = true, AFTER_DRAIN = false;
    const float* base32; const bf16_t* baseb; bf16_t* outb; float* out32; const float* gate; bf16_t* Hn; const float* gn; const float* scn; float* ssn; PG8_LAS float* xs;
    template <bool F32BASE, int MB>
    __device__ __forceinline__ void rows(const f32x4 (&acc)[2][2][4][2], const Unit& u, int ai, int wc, int fq, int row0, int col0, const f32x4 (&gv)[2][2], const f32x4 (&an)[2][2]) const {
#pragma unroll
        for (int mb = 0; mb < 4 / MB; ++mb) {
            f32x4 b32[F32BASE ? MB : 1][2][2]; u32x4 b16[F32BASE ? 1 : MB][2];
#pragma unroll
            for (int m2 = 0; m2 < MB; ++m2) { const size_t off = (size_t)(row0 + ai * HALF + (MB * mb + m2) * 16) * 2048 + col0;
#pragma unroll
                for (int bj = 0; bj < 2; ++bj) {
                    if constexpr (F32BASE) { b32[m2][bj][0] = *(const f32x4*)(base32 + off + bj * HALF); b32[m2][bj][1] = *(const f32x4*)(base32 + off + bj * HALF + 4); }
                    else b16[m2][bj] = *(const u32x4*)(baseb + off + bj * HALF); } }
            float s2v[MB];
#pragma unroll
            for (int m2 = 0; m2 < MB; ++m2) { const int m = MB * mb + m2; const int row = row0 + ai * HALF + m * 16; const size_t off = (size_t)row * 2048 + col0; float s2 = 0.f;
#pragma unroll
                for (int bj = 0; bj < 2; ++bj) {
                    f32x4 x0, x1;
                    if constexpr (F32BASE) { x0 = b32[m2][bj][0]; x1 = b32[m2][bj][1]; }
                    else { const u32x4 w = b16[m2][bj]; x0 = (f32x4){bf_lo(w.x), bf_hi(w.x), bf_lo(w.y), bf_hi(w.y)}; x1 = (f32x4){bf_lo(w.z), bf_hi(w.z), bf_lo(w.w), bf_hi(w.w)}; }
                    const f32x4 o0 = x0 + gv[bj][0] * acc[ai][bj][m][0], o1 = x1 + gv[bj][1] * acc[ai][bj][m][1];
                    if (out32) { *(f32x4*)(out32 + off + bj * HALF) = o0; *(f32x4*)(out32 + off + bj * HALF + 4) = o1; }
                    else *(u32x4*)(outb + off + bj * HALF) = pack8(o0, o1);
                    if (Hn) { s2 += ((o0[0] * o0[0] + o0[1] * o0[1]) + (o0[2] * o0[2] + o0[3] * o0[3])) + ((o1[0] * o1[0] + o1[1] * o1[1]) + (o1[2] * o1[2] + o1[3] * o1[3]));
                        *(u32x4*)(Hn + off + bj * HALF) = pack8(o0 * an[bj][0], o1 * an[bj][1]); } }
                s2v[m2] = s2;
            }
            if (Hn) {
#pragma unroll
                for (int m2 = 0; m2 < MB; ++m2) { const int row = row0 + ai * HALF + (MB * mb + m2) * 16;
                    auto p16 = __builtin_amdgcn_permlane16_swap(__float_as_uint(s2v[m2]), __float_as_uint(s2v[m2]), false, false); const float q = __uint_as_float(p16[0]) + __uint_as_float(p16[1]);
                    auto p32 = __builtin_amdgcn_permlane32_swap(__float_as_uint(q), __float_as_uint(q), false, false);
                    if (fq == 0) xs[wc * 256 + row - u.pm * BM] = __uint_as_float(p32[0]) + __uint_as_float(p32[1]); }
            }
        }
    }
    __device__ __forceinline__ void operator()(const f32x4 (&acc)[2][2][4][2], const Unit& u, int wr, int wc, int fr, int fq) const {
        const int row0 = u.pm * BM + wr * 64 + fr, col0 = u.pn * BM + wc * 32 + 8 * fq; const float* gp = gate + (size_t)(u.pm >> 3) * 12288 + col0;
        f32x4 gv[2][2], an[2][2];
#pragma unroll
        for (int bj = 0; bj < 2; ++bj)
#pragma unroll
            for (int n = 0; n < 2; ++n) { gv[bj][n] = *(const f32x4*)(gp + bj * HALF + n * 4);
                an[bj][n] = Hn ? *(const f32x4*)(gn + col0 + bj * HALF + n * 4) * (1.0f + *(const f32x4*)(scn + (size_t)(u.pm >> 3) * 12288 + col0 + bj * HALF + n * 4)) : (f32x4){0.f, 0.f, 0.f, 0.f}; }
#pragma unroll
        for (int ai = 0; ai < 2; ++ai) { if (base32) rows<true, 2>(acc, u, ai, wc, fq, row0, col0, gv, an); else rows<false, 4>(acc, u, ai, wc, fq, row0, col0, gv, an); }
        if (Hn) {
            asm volatile("s_waitcnt lgkmcnt(0)" ::: "memory"); __builtin_amdgcn_s_barrier(); asm volatile("" ::: "memory");
            const int t = (wr * 4 + wc) * 64 + fq * 16 + fr;
            if (t < 256) ssn[((size_t)u.pm * BM + t) * 8 + u.pn] = (xs[t] + xs[256 + t]) + (xs[512 + t] + xs[768 + t]);
        }
    }
};

struct EpiGlu {
    static constexpr bool PERM = true, AFTER_DRAIN = false;
    const bf16_t* Z; bf16_t* MIX; const float* gb;
    __device__ __forceinline__ void operator()(const f32x4 (&acc)[2][2][4][2], const Unit& u, int wr, int wc, int fr, int fq) const {
        const int row0 = u.pm * BM + wr * 64 + fr, col0 = u.pn * BM + wc * 32 + 8 * fq;
        f32x4 bv[2][2];
#pragma unroll
        for (int bj = 0; bj < 2; ++bj)
#pragma unroll
            for (int n = 0; n < 2; ++n) bv[bj][n] = *(const f32x4*)(gb + col0 + bj * HALF + 4 * n);
#pragma unroll
        for (int ai = 0; ai < 2; ++ai) {
#pragma unroll
          for (int mh = 0; mh < 1; ++mh) {
            u32x4 zq[4][2];
#pragma unroll
            for (int m2 = 0; m2 < 4; ++m2)
#pragma unroll
                for (int bj = 0; bj < 2; ++bj) zq[m2][bj] = *(const u32x4*)(Z + (size_t)(row0 + ai * HALF + m2 * 16) * 1024 + col0 + bj * HALF);
#pragma unroll
            for (int m2 = 0; m2 < 4; ++m2) { const int m = m2; const size_t row = (size_t)(row0 + ai * HALF + m * 16);
#pragma unroll
                for (int bj = 0; bj < 2; ++bj) { const u32x4 zr = zq[m2][bj];
                    const f32x4 v0 = acc[ai][bj][m][0] + bv[bj][0], v1 = acc[ai][bj][m][1] + bv[bj][1];
                    const f32x4 z0 = (f32x4){bf_lo(zr.x), bf_hi(zr.x), bf_lo(zr.y), bf_hi(zr.y)}, z1 = (f32x4){bf_lo(zr.z), bf_hi(zr.z), bf_lo(zr.w), bf_hi(zr.w)};
                    const f32x4 o0 = (f32x4){z0[0] * sigmoidf_fast(v0[0]), z0[1] * sigmoidf_fast(v0[1]), z0[2] * sigmoidf_fast(v0[2]), z0[3] * sigmoidf_fast(v0[3])};
                    const f32x4 o1 = (f32x4){z1[0] * sigmoidf_fast(v1[0]), z1[1] * sigmoidf_fast(v1[1]), z1[2] * sigmoidf_fast(v1[2]), z1[3] * sigmoidf_fast(v1[3])};
                    *(u32x4*)(MIX + row * 2048 + 1024 + col0 + bj * HALF) = pack8(o0, o1); } } } }
    }
};

__device__ __forceinline__ float dpp_ror1(float v) { return __builtin_bit_cast(float, __builtin_amdgcn_update_dpp(0, __builtin_bit_cast(int, v), 0x121, 0xf, 0xf, false)); }
__device__ __forceinline__ float dpp_ror2(float v) { return __builtin_bit_cast(float, __builtin_amdgcn_update_dpp(0, __builtin_bit_cast(int, v), 0x122, 0xf, 0xf, false)); }
__device__ __forceinline__ float dpp_shr1(float old, float v) { return __builtin_bit_cast(float, __builtin_amdgcn_update_dpp(__builtin_bit_cast(int, old), __builtin_bit_cast(int, v), 0x111, 0xf, 0xf, false)); }
__device__ __forceinline__ float dpp_shr2(float old, float v) { return __builtin_bit_cast(float, __builtin_amdgcn_update_dpp(__builtin_bit_cast(int, old), __builtin_bit_cast(int, v), 0x112, 0xf, 0xf, false)); }
struct EpiFfnIn {
    static constexpr bool PERM = true, AFTER_DRAIN = false;
    bf16_t* ACT; float* halo_first; float* halo_last; size_t hmid; const float* cw; const float* cb; PG8_LAS float* exch; PG8_LAS const unsigned char* ssb; const float* cv;
    __device__ __forceinline__ void operator()(f32x4 (&acc)[2][2][4][2], const Unit& u, int wr, int wc, int fr, int fq) const {
        asm volatile("" : "+v"(fr), "+v"(fq));
        const int jj0 = wc * 32 + 8 * fq, jcol = u.pn * 128 + jj0; const bool nar = u.nar != 0;
        f32x4 cv4[2][2];
#pragma unroll
        for (int bj = 0; bj < 2; ++bj)
#pragma unroll
            for (int n = 0; n < 2; ++n) cv4[bj][n] = *(const f32x4*)(cv + (size_t)(u.pm >> 3) * 11008 + u.pn * BM + bj * HALF + jj0 + 4 * n);
        f32x4 wq[4][2];
#pragma unroll
        for (int bj = 0; bj < 2; ++bj) { const int col = bj * 5504 + jcol;
            wq[0][bj] = *(const f32x4*)(cw + col); wq[1][bj] = *(const f32x4*)(cw + 11008 + col); wq[2][bj] = *(const f32x4*)(cw + 22016 + col); wq[3][bj] = *(const f32x4*)(cb + col); }
        build_rtab(ssb, exch + 1536, wr, wc, fr, fq);
        {
#pragma unroll
            for (int ai = 0; ai < 2; ++ai)
#pragma unroll
                for (int m = 0; m < 4; ++m) { if (ai == 1 && nar) break; const float r = exch[1536 + u.ro + ai * HALF + wr * 64 + m * 16 + fr];
#pragma unroll
                    for (int bj = 0; bj < 2; ++bj)
#pragma unroll
                        for (int n = 0; n < 2; ++n) acc[ai][bj][m][n] = acc[ai][bj][m][n] * r + cv4[bj][n]; }
        }
        float* hlast = halo_last + ((nar && u.ro == 0) ? hmid : (size_t)0); float* hfirst = halo_first + (u.ro ? hmid : (size_t)0);
        if (fr >= 14) { const int r2 = fr - 14;
#pragma unroll
            for (int bj = 0; bj < 2; ++bj)
#pragma unroll
                for (int n = 0; n < 2; ++n) {
                    *(PG8_LAS f32x4*)(exch + ((wr * 2 + r2) * 2 + bj) * 128 + jj0 + 4 * n) = acc[0][bj][3][n];
                    if (!nar) {
                        if (wr == 0) *(PG8_LAS f32x4*)(exch + ((2 * 2 + r2) * 2 + bj) * 128 + jj0 + 4 * n) = acc[1][bj][3][n];
                        else *(f32x4*)(hlast + ((size_t)(u.pm * 2 + r2) * 2 + bj) * 5504 + jcol + 4 * n) = acc[1][bj][3][n];
                    } else if (wr == 1) *(f32x4*)(hlast + ((size_t)(u.pm * 2 + r2) * 2 + bj) * 5504 + jcol + 4 * n) = acc[0][bj][3][n];
                } }
        if (wr == 0 && fr < 2) {
#pragma unroll
            for (int bj = 0; bj < 2; ++bj)
#pragma unroll
                for (int n = 0; n < 2; ++n) *(f32x4*)(hfirst + ((size_t)(u.pm * 2 + fr) * 2 + bj) * 5504 + jcol + 4 * n) = acc[0][bj][0][n]; }
        asm volatile("s_waitcnt lgkmcnt(0)" ::: "memory"); __builtin_amdgcn_s_barrier(); asm volatile("" ::: "memory");
        const bool seq_start = (u.pm & 7) == 0 && u.ro == 0;
        u32x2 held[2][4];
#pragma unroll
        for (int n = 0; n < 2; ++n) {
            f32x4 w0[2], w1[2], w2[2], bb[2];
#pragma unroll
            for (int bj = 0; bj < 2; ++bj) { const int col = bj * 5504 + jcol + 4 * n;
                if (n == 0) { w0[bj] = wq[0][bj]; w1[bj] = wq[1][bj]; w2[bj] = wq[2][bj]; bb[bj] = wq[3][bj]; }
                else { w0[bj] = *(const f32x4*)(cw + col); w1[bj] = *(const f32x4*)(cw + 11008 + col); w2[bj] = *(const f32x4*)(cw + 22016 + col); bb[bj] = *(const f32x4*)(cb + col); } }
#pragma unroll
            for (int ai = 0; ai < 2; ++ai) { if (ai == 1 && nar) break;
                f32x4 prev[2];
                const int slot = 2 * ai + wr - 1;
#pragma unroll
                for (int bj = 0; bj < 2; ++bj) prev[bj] = (slot >= 0) ? *(const PG8_LAS f32x4*)(exch + ((slot * 2 + (fr & 1)) * 2 + bj) * 128 + jj0 + 4 * n) : (f32x4){0.f, 0.f, 0.f, 0.f};
#pragma unroll
                for (int m = 0; m < 4; ++m) {
                    f32x4 cv[2];
#pragma unroll
                    for (int bj = 0; bj < 2; ++bj) { const f32x4 cur = acc[ai][bj][m][n]; f32x4 o;
#pragma unroll
                        for (int q = 0; q < 4; ++q) { const float um1 = dpp_shr1(dpp_ror1(prev[bj][q]), cur[q]), um2 = dpp_shr2(dpp_ror2(prev[bj][q]), cur[q]);
                            o[q] = bb[bj][q] + w0[bj][q] * um2 + w1[bj][q] * um1 + w2[bj][q] * cur[q]; }
                        cv[bj] = o; prev[bj] = cur; }
                    const f32x4 o0 = gelu4(cv[0]) * cv[1];
                    u32x2 w; w.x = cvt_pk_bf16(o0[0], o0[1]); w.y = cvt_pk_bf16(o0[2], o0[3]);
                    if (n == 0) held[ai][m] = w;
                    else { const bool skip = (ai == 0 && m == 0) && wr == 0 && fr < 2 && !seq_start;
                        if (!skip) *(u32x4*)(ACT + (size_t)(u.pm * BM + u.ro + ai * HALF + wr * 64 + m * 16 + fr) * 5504 + jcol) = (u32x4){held[ai][m].x, held[ai][m].y, w.x, w.y}; }
                }
            }
        }
    }
};
template <class Epi, class Sched, bool ALIGN_EPI = false, bool SP2 = false, bool SPLIT = false>
__device__ __forceinline__ void gemm_phase(PG8_LAS unsigned char* lds, const Gemm g, const Sched& S, const Epi& E, int tid_in) {
    int tid = tid_in; asm volatile("" : "+v"(tid));
    const int wid = __builtin_amdgcn_readfirstlane(tid >> 6), lane = tid & 63, wr = wid >> 2, wc = wid & 3, fr = lane & 15, fq = lane >> 4;
    const int K = g.K, nt = K / BK;
    unsigned voffA[2], voffB[2];
#pragma unroll
    for (int i = 0; i < 2; ++i) { int R, C; stage_rc(tid * 16 + i * 8192, R, C); const int Rb = Epi::PERM ? ((R & ~31) + perm32(R & 31)) : R;
        voffA[i] = (unsigned)(R * K + C) * 2u; voffB[i] = (unsigned)(Rb * K + C) * 2u; }
    const size_t kstep = (size_t)(BK * 2);
    const size_t hstep = (size_t)HALF * K * 2;
    const size_t tstep = 2 * hstep;
    const unsigned ldsw = (unsigned)wid * 1024u;
    const int aoff = lds_byte(wr * 64 + fr, fq * 8), boff = lds_byte(wc * 32 + fr, fq * 8);
#define PG8_SA(b, h) (((b) * 2 + (h)) * HTB)
#define PG8_SB(b, h) ((4 + (b) * 2 + (h)) * HTB)
#define PG8_STAGE(bufoff, gbase, voff) do { _Pragma("unroll") for (int _i = 0; _i < 2; ++_i) \
        __builtin_amdgcn_global_load_lds((const unsigned*)((const char*)(gbase) + (voff)[_i]), (PG8_LAS unsigned*)(lds + (bufoff) + ldsw + _i * 8192), 16, 0, 0); } while (0)
#define PG8_LDA(dst, b, h) do { _Pragma("unroll") for (int m = 0; m < 4; ++m) _Pragma("unroll") for (int k = 0; k < 2; ++k) dst[m][k] = *(const PG8_LAS bf16x8*)(lds + PG8_SA(b, h) + aoff + m * 2048 + k * 1024); } while (0)
#define PG8_LDB(dst, b, h) do { _Pragma("unroll") for (int n = 0; n < 2; ++n) _Pragma("unroll") for (int k = 0; k < 2; ++k) dst[n][k] = *(const PG8_LAS bf16x8*)(lds + PG8_SB(b, h) + boff + n * 2048 + k * 1024); } while (0)
#define PG8_MMA(ai, bj, At, Bt) do { __builtin_amdgcn_s_setprio(1); _Pragma("unroll") for (int m = 0; m < 4; ++m) _Pragma("unroll") for (int n = 0; n < 2; ++n) _Pragma("unroll") for (int k = 0; k < 2; ++k) \
        acc[ai][bj][m][n] = __builtin_amdgcn_mfma_f32_16x16x32_bf16(Bt[n][k], At[m][k], acc[ai][bj][m][n], 0, 0, 0); __builtin_amdgcn_s_setprio(0); } while (0)
#define PG8_WAIT_V(n) asm volatile("s_waitcnt vmcnt(" #n ")" ::: "memory")
#define PG8_WAIT_L(n) asm volatile("s_waitcnt lgkmcnt(" #n ")" ::: "memory")
#define PG8_BAR __builtin_amdgcn_s_barrier()
#define PG8_SCHED __builtin_amdgcn_sched_barrier(0)
#define PG8_KLOOP_SP2(NARV)         for (int t = 0; t < nt; t += 2) { \
            const bool last = (t == nt - 2); \
            const char* a1 = cA + (size_t)(t + 1) * kstep; \
            const char* a2 = last ? nA : cA + (size_t)(t + 2) * kstep; const char* b2 = last ? nB : cB + (size_t)(t + 2) * kstep; \
            const char* a3 = a2 + kstep; const char* b3 = b2 + kstep; \
            if (last && has_next) S.a_ready(nxt); \
            PG8_LDB(B0, 0, 0); PG8_LDB(B1, 0, 1); PG8_SCHED; PG8_LDA(At, 0, 0); PG8_STAGE(PG8_SA(1, 1), a1 + hstep, voffA); \
            PG8_WAIT_V(8); PG8_WAIT_L(0); PG8_BAR; PG8_MMA(0, 0, At, B0); PG8_MMA(0, 1, At, B1); PG8_BAR; PG8_SCHED; \
            if (!(NARV)) PG8_LDA(At, 0, 1); PG8_STAGE(PG8_SB(0, 0), b2, voffB); PG8_STAGE(PG8_SB(0, 1), b2 + hstep, voffB); PG8_STAGE(PG8_SA(0, 0), a2, voffA); \
            PG8_WAIT_V(8); PG8_WAIT_L(0); PG8_BAR; if (!(NARV)) { PG8_MMA(1, 0, At, B0); PG8_MMA(1, 1, At, B1); } PG8_BAR; PG8_SCHED; \
            PG8_LDB(B0, 1, 0); PG8_LDB(B1, 1, 1); PG8_SCHED; PG8_LDA(At, 1, 0); PG8_STAGE(PG8_SA(0, 1), a2 + hstep, voffA); \
            PG8_WAIT_V(8); PG8_WAIT_L(0); PG8_BAR; PG8_MMA(0, 0, At, B0); PG8_MMA(0, 1, At, B1); PG8_BAR; PG8_SCHED; \
            if (!(NARV)) PG8_LDA(At, 1, 1); PG8_STAGE(PG8_SB(1, 0), b3, voffB); PG8_STAGE(PG8_SB(1, 1), b3 + hstep, voffB); PG8_STAGE(PG8_SA(1, 0), a3, voffA); \
            PG8_WAIT_V(8); PG8_WAIT_L(0); PG8_BAR; if (!(NARV)) { PG8_MMA(1, 0, At, B0); PG8_MMA(1, 1, At, B1); } PG8_BAR; PG8_SCHED; \
        }
    Unit cur, nxt; int ui = 0;
    if (!S.next(0, cur)) return;
    if constexpr (!SPLIT) { cur.ro = 0; cur.nar = 0; }
    f32x4 acc[2][2][4][2];
#pragma unroll
    for (int a = 0; a < 2; ++a)
#pragma unroll
        for (int b = 0; b < 2; ++b)
#pragma unroll
            for (int m = 0; m < 4; ++m)
#pragma unroll
                for (int n = 0; n < 2; ++n) acc[a][b][m][n] = (f32x4){0.f, 0.f, 0.f, 0.f};
    bf16x8 At[4][2], B0[2][2], B1[2][2];
    const char* cA = (const char*)g.A + (size_t)cur.pm * tstep + (cur.ro ? hstep : (size_t)0); const char* cB = (const char*)g.Bt + (size_t)cur.pn * tstep;
    S.a_ready(cur);
    if constexpr (SP2) {
        PG8_STAGE(PG8_SB(0, 0), cB, voffB); PG8_STAGE(PG8_SB(0, 1), cB + hstep, voffB); PG8_STAGE(PG8_SA(0, 0), cA, voffA); PG8_STAGE(PG8_SA(0, 1), cA + hstep, voffA);
        PG8_STAGE(PG8_SB(1, 0), cB + kstep, voffB); PG8_STAGE(PG8_SA(1, 0), cA + kstep, voffA); PG8_STAGE(PG8_SB(1, 1), cB + hstep + kstep, voffB);
        if (wr == 1) PG8_BAR;
        PG8_WAIT_V(8); PG8_BAR;
        PG8_WAIT_V(6); PG8_BAR;
    } else {
        PG8_STAGE(PG8_SB(0, 0), cB, voffB); PG8_STAGE(PG8_SA(0, 0), cA, voffA); PG8_STAGE(PG8_SB(0, 1), cB + hstep, voffB); PG8_STAGE(PG8_SA(0, 1), cA + hstep, voffA);
        if (wr == 1) PG8_BAR;
        PG8_WAIT_V(4); PG8_BAR;
        PG8_STAGE(PG8_SB(1, 0), cB + kstep, voffB); PG8_STAGE(PG8_SA(1, 0), cA + kstep, voffA); PG8_STAGE(PG8_SB(1, 1), cB + hstep + kstep, voffB);
        PG8_WAIT_V(6); PG8_BAR;
    }
    for (;;) {
        const bool has_next = S.next(ui + 1, nxt);
        if constexpr (!SPLIT) { nxt.ro = 0; nxt.nar = 0; }
        const char* nA = has_next ? (const char*)g.A + (size_t)nxt.pm * tstep + (nxt.ro ? hstep : (size_t)0) : cA; const char* nB = has_next ? (const char*)g.Bt + (size_t)nxt.pn * tstep : cB;
        const bool nar = SPLIT && cur.nar != 0;
        if constexpr (SP2) {
            if (nar) { PG8_KLOOP_SP2(true) } else { PG8_KLOOP_SP2(false) }
        } else {
        for (int t = 0; t < nt; t += 2) {
            const bool last = (t == nt - 2);
            const char* a1 = cA + (size_t)(t + 1) * kstep;
            const char* a2 = last ? nA : cA + (size_t)(t + 2) * kstep; const char* b2 = last ? nB : cB + (size_t)(t + 2) * kstep;
            const char* a3 = a2 + kstep; const char* b3 = b2 + kstep;
            if (last && has_next) S.a_ready(nxt);
            PG8_LDB(B0, 0, 0); PG8_SCHED; PG8_LDA(At, 0, 0); PG8_STAGE(PG8_SA(1, 1), a1 + hstep, voffA);
            PG8_WAIT_L(8); PG8_BAR; PG8_WAIT_L(0); PG8_MMA(0, 0, At, B0); PG8_BAR; PG8_SCHED;
            PG8_LDB(B1, 0, 1); PG8_STAGE(PG8_SB(0, 0), b2, voffB);
            PG8_BAR; PG8_WAIT_L(0); PG8_MMA(0, 1, At, B1); PG8_BAR;
            PG8_LDA(At, 0, 1); PG8_STAGE(PG8_SA(0, 0), a2, voffA);
            PG8_BAR; PG8_WAIT_L(0); PG8_MMA(1, 0, At, B0); PG8_BAR; PG8_SCHED;
            PG8_STAGE(PG8_SB(0, 1), b2 + hstep, voffB);
            PG8_WAIT_V(6); PG8_BAR; PG8_MMA(1, 1, At, B1); PG8_BAR;
            PG8_LDB(B0, 1, 0); PG8_SCHED; PG8_LDA(At, 1, 0); PG8_STAGE(PG8_SA(0, 1), a2 + hstep, voffA);
            PG8_WAIT_L(8); PG8_BAR; PG8_WAIT_L(0); PG8_MMA(0, 0, At, B0); PG8_BAR; PG8_SCHED;
            PG8_LDB(B1, 1, 1); PG8_STAGE(PG8_SB(1, 0), b3, voffB);
            PG8_BAR; PG8_WAIT_L(0); PG8_MMA(0, 1, At, B1); PG8_BAR;
            PG8_LDA(At, 1, 1); PG8_STAGE(PG8_SA(1, 0), a3, voffA);
            PG8_BAR; PG8_WAIT_L(0); PG8_MMA(1, 0, At, B0); PG8_BAR; PG8_SCHED;
            PG8_STAGE(PG8_SB(1, 1), b3 + hstep, voffB);
            PG8_WAIT_V(6); PG8_BAR; PG8_MMA(1, 1, At, B1); PG8_BAR;
        }
        }
        if constexpr (ALIGN_EPI) { if (wr == 0) PG8_BAR; }
        if constexpr (!Epi::AFTER_DRAIN) { E(acc, cur, wr, wc, fr, fq); S.done(cur); }
        if (!has_next) break;
#pragma unroll
        for (int a = 0; a < 2; ++a)
#pragma unroll
            for (int b = 0; b < 2; ++b)
#pragma unroll
                for (int m = 0; m < 4; ++m)
#pragma unroll
                    for (int n = 0; n < 2; ++n) acc[a][b][m][n] = (f32x4){0.f, 0.f, 0.f, 0.f};
        cur = nxt; cA = nA; cB = nB; ++ui;
        if constexpr (ALIGN_EPI) { if (wr == 1) PG8_BAR; }
    }
    PG8_WAIT_V(0);
    if constexpr (!ALIGN_EPI) { if (wr == 0) PG8_BAR; }
    PG8_BAR;
    if constexpr (Epi::AFTER_DRAIN) { E.fused(acc, cur, wr, wc, fr, fq, lds, wid, lane); S.done(cur); }
#undef PG8_KLOOP_SP2
#undef PG8_SA
#undef PG8_SB
#undef PG8_STAGE
#undef PG8_LDA
#undef PG8_LDB
#undef PG8_MMA
#undef PG8_WAIT_V
#undef PG8_WAIT_L
#undef PG8_BAR
#undef PG8_SCHED
}
}

constexpr int DM = 2048, NB = 4, SEQ = 2048, MT = NB * SEQ, NLAYER = 4;
constexpr int EVEN_IN = 5120, ODD_IN = 2304, DFF = 5504, DFF2 = 11008;
constexpr float LOG2E = 1.4426950408889634f;
constexpr float QSCALE_A = 0.08838834764831845f * LOG2E;
constexpr float QSCALE_C = 0.125f * LOG2E;
enum { I_X = 0, I_C, I_POS, I_ADA_W, I_ADA_B, I_NORM_MIX, I_NORM_FFN, I_NORM_FINAL,
       I_EV_W_IN, I_EV_CONV_W, I_EV_CONV_B, I_EV_GA_W, I_EV_GA_B, I_EV_GX_W, I_EV_GX_B, I_EV_LAMBDA, I_EV_W_OUT,
       I_OD_W_IN, I_OD_SINKS, I_OD_A_RE, I_OD_A_IM, I_OD_B_RE, I_OD_B_IM, I_OD_C_RE, I_OD_C_IM, I_OD_D, I_OD_LOG_DT, I_OD_GLU_W, I_OD_GLU_B, I_OD_W_OUT,
       I_FFN_W_IN, I_FFN_CONV_W, I_FFN_CONV_B, I_FFN_W_OUT, N_INPUTS };
constexpr size_t MiB = 1u << 20;
constexpr size_t WS_CTL = 0, CTL_ZERO_BYTES = 65536;
constexpr size_t WS_SS = 516 * MiB;
constexpr size_t WS_CVEC = 524288;
constexpr int CV_EVIN = 0, CV_ODIN = 2 * 4 * 5120, CV_FFIN = CV_ODIN + 2 * 4 * 2304;
constexpr int CV_TOTAL = CV_FFIN + 4 * 4 * 11008;
constexpr size_t WS_CVPART = 526 * MiB;
constexpr size_t WS_MOD = 11 * MiB;
constexpr size_t WS_COSA = 2 * MiB, WS_SINA = 4 * MiB, WS_COSC = 6 * MiB, WS_SINC = 7 * MiB;
constexpr size_t WS_S5T = 8 * MiB;
constexpr size_t WS_WGATE = 10 * MiB;
constexpr size_t WS_W_EVIN = 12 * MiB, WS_W_EVOUT = 52 * MiB, WS_W_ODIN = 68 * MiB, WS_W_ODOUT = 86 * MiB, WS_W_GLU = 102 * MiB, WS_W_FFIN = 106 * MiB, WS_W_FFOUT = 278 * MiB;
constexpr size_t WS_H = 364 * MiB, WS_MIX = 396 * MiB, WS_Q = 428 * MiB, WS_K = 444 * MiB, WS_V = 460 * MiB, WS_XB = 476 * MiB, WS_YB = 492 * MiB;
constexpr size_t WS_XC = 508 * MiB, WS_LA = 540 * MiB, WS_LB = 572 * MiB, WS_UFF = 604 * MiB, WS_ACT = 776 * MiB, WS_END = 862 * MiB;
constexpr size_t WS_HALO_F = 508 * MiB, WS_HALO_L = 512 * MiB;
constexpr size_t WS_HALO_MF = 560 * MiB, WS_HALO_ML = 564 * MiB;
constexpr int SPLIT_EVIN = 128, SPLIT_ODIN = 32, SPLIT_FFIN = 96;
#ifndef TAIL_HEAVY
#define TAIL_HEAVY 0
#endif
#ifndef NARROW_ALL
#define NARROW_ALL 0
#endif
#ifndef CONV_TAILS
#define CONV_TAILS 1
#endif
constexpr size_t WS_XRES = 712 * MiB;
constexpr int CW_BAR = 4096;
constexpr int RING_BYTES = 131072, LDSCTL_OFF = 163584, LDS_BYTES = 163840;

#define GAS __attribute__((address_space(1)))
#define LAS __attribute__((address_space(3)))
typedef unsigned short bf16;
typedef float f32x4 __attribute__((ext_vector_type(4)));
typedef float f32x2 __attribute__((ext_vector_type(2)));
typedef unsigned u32x4 __attribute__((ext_vector_type(4)));
typedef unsigned u32x2 __attribute__((ext_vector_type(2)));
#define LDS_WAIT() asm volatile("s_waitcnt lgkmcnt(0)" ::: "memory")
using pg8::cvt_pk_bf16; using pg8::bf_lo; using pg8::bf_hi; using pg8::gelu_tanh;
__device__ __forceinline__ float wave_sum(float v) {
#pragma unroll
    for (int o = 1; o < 64; o <<= 1) v += __shfl_xor(v, o);
    return v;
}
__device__ __forceinline__ unsigned short f2bf(float f) { return (unsigned short)(cvt_pk_bf16(f, 0.f) & 0xffffu); }
__device__ __forceinline__ float bf2f(unsigned short b) { return __uint_as_float(((unsigned)b) << 16); }

struct Params { const float* in[N_INPUTS]; float* out; unsigned char* ws; int lo, hi, li, pad; };
typedef const __attribute__((address_space(4))) Params* KP;
#define KPREF(P, kp0) KP kp_ = (kp0); asm volatile("" : "+s"(kp_)); const __attribute__((address_space(4))) Params& P = *kp_
#define PHASE_IDS() int tid; asm volatile("v_mbcnt_lo_u32_b32 %0, -1, 0\n\tv_mbcnt_hi_u32_b32 %0, -1, %0" : "=v"(tid)); tid += kwave_ * 64;     const int lane = tid & 63, wave = __builtin_amdgcn_readfirstlane(tid >> 6); int bx = blockIdx.x; asm volatile("" : "+s"(bx)); const int G = gridDim.x; (void)lane; (void)wave; (void)G
#define FRESH_IDS() int ftid; asm volatile("v_mbcnt_lo_u32_b32 %0, -1, 0\n\tv_mbcnt_hi_u32_b32 %0, -1, %0" : "=v"(ftid)); const int flane = ftid, fwave = kwave; ftid += kwave * 64; int fbx = blockIdx.x; asm volatile("" : "+s"(fbx)); (void)flane; (void)fwave
#ifndef TAIL_INPROJ
#define TAIL_INPROJ 1
#endif
#define XB_TMO      128
#define XB_XCNT(j)  (256  + 64 * (j))
#define XB_XSUB(j)  (1280 + 64 * (j))
#define XB_XGEN(j)  (2304 + 64 * (j))
#define XB_TOP      3328
#define XB_TOPGEN   3392
#define XCD_BAR_WORDS 3456
#define XB_SPIN_CAP (1u << 18)
#define LAS __attribute__((address_space(3)))

__device__ __forceinline__ unsigned xb_ld(unsigned* p)              { return __hip_atomic_load(p, __ATOMIC_RELAXED, __HIP_MEMORY_SCOPE_AGENT); }
__device__ __forceinline__ unsigned xb_add(unsigned* p, unsigned v) { return __hip_atomic_fetch_add(p, v, __ATOMIC_RELAXED, __HIP_MEMORY_SCOPE_AGENT); }
__device__ __forceinline__ unsigned xb_xcc_id() { return (unsigned)__builtin_amdgcn_s_getreg((3 << 11) | 20) & 0xFu; }
#define XB_SPIN(cond, bar) do { unsigned _sp = 0; while (cond) { __builtin_amdgcn_s_sleep(1); \
    if ((++_sp & 255u) == 0u) { if (xb_ld(&(bar)[XB_TMO])) break; if (_sp > XB_SPIN_CAP) { atomicAdd(&(bar)[XB_TMO], 1u); break; } } } } while (0)

struct XcdBarrier {
    unsigned* bar; unsigned x; unsigned w0;
    volatile LAS unsigned* st;
};

__device__ __forceinline__ XcdBarrier xcd_barrier_post(unsigned* bar, volatile LAS unsigned* st) {
    XcdBarrier b; b.bar = bar; b.x = xb_xcc_id(); b.st = st;
    if (threadIdx.x == 0) (void)xb_add(&bar[XB_XCNT(b.x)], 1u);
    b.w0 = 0u;
    return b;
}
__device__ __forceinline__ void xcd_barrier_complete(unsigned* bar, unsigned x, unsigned& nloc, unsigned& nx) {
    const unsigned G = gridDim.x * gridDim.y * gridDim.z;
    unsigned sum, cnt, mine, sp = 0u;
    for (;;) {
        sum = 0u; cnt = 0u; mine = 0u;
#pragma unroll
        for (unsigned j = 0; j < 16; ++j) { const unsigned c = xb_ld(&bar[XB_XCNT(j)]); sum += c; cnt += (c > 0u) ? 1u : 0u; mine = (j == x) ? c : mine; }
        if (sum == G) break;
        __builtin_amdgcn_s_sleep(1);
        if ((++sp & 255u) == 0u) { if (xb_ld(&bar[XB_TMO])) break; if (sp > XB_SPIN_CAP) { atomicAdd(&bar[XB_TMO], 1u); break; } }
    }
    nloc = mine > 0u ? mine : 1u; nx = cnt > 0u ? cnt : 1u;
}

__device__ __forceinline__ void xcd_barrier(const XcdBarrier& b) {
    asm volatile("s_waitcnt vmcnt(0)" ::: "memory");
    __syncthreads();
    if (b.w0 != 0u && __builtin_amdgcn_mbcnt_hi(~0u, __builtin_amdgcn_mbcnt_lo(~0u, 0u)) == 0u) {
        unsigned* bar = b.bar;
        __builtin_amdgcn_s_waitcnt(0);
        unsigned nloc = b.st[0], nx = b.st[1];
        if (nloc == 0u) { xcd_barrier_complete(bar, b.x, nloc, nx); b.st[0] = nloc; b.st[1] = nx; }
        const unsigned old = xb_add(&bar[XB_XSUB(b.x)], 1u);
        const unsigned gen = old / nloc;
        if (old + 1u == (gen + 1u) * nloc) {
            __builtin_amdgcn_fence(__ATOMIC_RELEASE, "agent");
            asm volatile("s_waitcnt vmcnt(0)" ::: "memory");
            const unsigned og = xb_add(&bar[XB_TOP], 1u);
            const unsigned tg = og / nx;
            if (og + 1u == (tg + 1u) * nx) xb_add(&bar[XB_TOPGEN], 1u);
            else XB_SPIN(xb_ld(&bar[XB_TOPGEN]) == tg, bar);
            __builtin_amdgcn_fence(__ATOMIC_ACQUIRE, "agent");
            xb_add(&bar[XB_XGEN(b.x)], 1u);
            asm volatile("s_waitcnt vmcnt(0)" ::: "memory");
        } else {
            XB_SPIN(xb_ld(&bar[XB_XGEN(b.x)]) == gen, bar);
            __builtin_amdgcn_fence(__ATOMIC_ACQUIRE, "agent");
            asm volatile("s_waitcnt vmcnt(0)" ::: "memory");
        }
    }
    __syncthreads();
}
__device__ __forceinline__ void sincos_rev(double ang, float& s, float& c) {
    double rev = ang * 0.15915494309189535; rev -= floor(rev); const float fr = (float)rev;
    s = __builtin_amdgcn_sinf(fr); c = __builtin_amdgcn_cosf(fr);
}

constexpr size_t WS_S5TT = 604 * MiB, WS_S5T2 = 690 * MiB, WS_S5A32 = 707 * MiB;
__device__ __forceinline__ void s5_pre(KP kp0, LAS unsigned char* lds, int og, int tid) { KPREF(P, kp0);
    LAS float* apr = (LAS float*)lds; LAS float* api = apr + 33 * 64;
    LAS float* bbr = api + 33 * 64; LAS float* bbi = bbr + 1024;
    LAS float* cre = bbi + 1024; LAS float* cim = cre + 1024;
    LAS float* kern = cim + 1024;
    const int o = og >> 6, g = og & 63;
    const float dt = expf(P.in[I_OD_LOG_DT][og]);
    __syncthreads();
    for (int idx = tid; idx < 33 * 64; idx += 512) { const int k = idx >> 6, p = idx & 63; const float are = P.in[I_OD_A_RE][og * 64 + p], aim = P.in[I_OD_A_IM][og * 64 + p];
        const float er = expf((float)k * are * dt); float s, c; sincos_rev((double)k * (double)aim * (double)dt, s, c); apr[idx] = er * c; api[idx] = er * s; }
    for (int idx = tid; idx < 1024; idx += 512) { cre[idx] = P.in[I_OD_C_RE][(size_t)og * 1024 + idx]; cim[idx] = P.in[I_OD_C_IM][(size_t)og * 1024 + idx]; }
    __syncthreads();
    for (int idx = tid; idx < 1024; idx += 512) { const int p = idx >> 4; const float are = P.in[I_OD_A_RE][og * 64 + p], aim = P.in[I_OD_A_IM][og * 64 + p];
        const float xr = apr[64 + p] - 1.0f, xi = api[64 + p], den = 1.0f / (are * are + aim * aim), cr = (xr * are + xi * aim) * den, ci = (xi * are - xr * aim) * den;
        const float br = P.in[I_OD_B_RE][(size_t)og * 1024 + idx], bi = P.in[I_OD_B_IM][(size_t)og * 1024 + idx];
        bbr[idx] = cr * br - ci * bi; bbi[idx] = cr * bi + ci * br; }
    if (tid < 64) ((f32x2*)(P.ws + WS_S5A32))[og * 64 + tid] = (f32x2){apr[32 * 64 + tid], api[32 * 64 + tid]};
    __syncthreads();
    {
        const int pair = tid & 255, cp = pair >> 4, c = pair & 15, kh = tid >> 8; float acc[16];
#pragma unroll
        for (int kk = 0; kk < 16; ++kk) acc[kk] = 0.f;
        for (int p = 0; p < 64; ++p) { const float gr = cre[cp * 64 + p] * bbr[p * 16 + c] - cim[cp * 64 + p] * bbi[p * 16 + c], gi = cre[cp * 64 + p] * bbi[p * 16 + c] + cim[cp * 64 + p] * bbr[p * 16 + c];
#pragma unroll
            for (int kk = 0; kk < 16; ++kk) acc[kk] += gr * apr[(16 * kh + kk) * 64 + p] - gi * api[(16 * kh + kk) * 64 + p]; }
#pragma unroll
        for (int kk = 0; kk < 16; ++kk) kern[(16 * kh + kk) * 256 + pair] = acc[kk];
    }
    __syncthreads();
    bf16* TT = (bf16*)(P.ws + WS_S5TT) + (size_t)og * 512 * 640; bf16* T2 = (bf16*)(P.ws + WS_S5T2) + (size_t)og * 128 * 512;
    for (int idx = tid; idx < 512 * 64; idx += 512) { const int n = idx >> 6, ic = idx & 63, i = ic >> 1, ch = ic & 1, j = n >> 4, cp = n & 15; float v[8];
#pragma unroll
        for (int cc = 0; cc < 8; ++cc) v[cc] = (j >= i) ? kern[(j - i) * 256 + cp * 16 + 8 * ch + cc] : 0.f;
        u32x4 w; w.x = cvt_pk_bf16(v[0], v[1]); w.y = cvt_pk_bf16(v[2], v[3]); w.z = cvt_pk_bf16(v[4], v[5]); w.w = cvt_pk_bf16(v[6], v[7]);
        *(u32x4*)(TT + (size_t)n * 640 + i * 16 + 8 * ch) = w; }
    for (int idx = tid; idx < 512 * 16; idx += 512) { const int n = idx >> 4, q = idx & 15, j = n >> 4, cp = n & 15, im = q >> 3, p0 = (q & 7) * 8; float v[8];
#pragma unroll
        for (int cc = 0; cc < 8; ++cc) { const int p = p0 + cc; const float ar = apr[(j + 1) * 64 + p], ai = api[(j + 1) * 64 + p], cr = cre[cp * 64 + p], ci = cim[cp * 64 + p];
            v[cc] = im ? -(cr * ai + ci * ar) : (cr * ar - ci * ai); }
        u32x4 w; w.x = cvt_pk_bf16(v[0], v[1]); w.y = cvt_pk_bf16(v[2], v[3]); w.z = cvt_pk_bf16(v[4], v[5]); w.w = cvt_pk_bf16(v[6], v[7]);
        *(u32x4*)(TT + (size_t)n * 640 + 512 + 64 * im + p0) = w; }
    for (int idx = tid; idx < 128 * 64; idx += 512) { const int comp = idx >> 6, ic = idx & 63, i = ic >> 1, ch = ic & 1, p = comp & 63, im = comp >> 6; float v[8];
        const float ar = apr[(31 - i) * 64 + p], ai = api[(31 - i) * 64 + p];
#pragma unroll
        for (int cc = 0; cc < 8; ++cc) { const float br = bbr[p * 16 + 8 * ch + cc], bi = bbi[p * 16 + 8 * ch + cc]; v[cc] = im ? (ar * bi + ai * br) : (ar * br - ai * bi); }
        u32x4 w; w.x = cvt_pk_bf16(v[0], v[1]); w.y = cvt_pk_bf16(v[2], v[3]); w.z = cvt_pk_bf16(v[4], v[5]); w.w = cvt_pk_bf16(v[6], v[7]);
        *(u32x4*)(T2 + (size_t)comp * 512 + i * 16 + 8 * ch) = w; }
}


__device__ __forceinline__ void phase_ada(KP kp0, int kwave_, LAS unsigned char* lds) { KPREF(P, kp0); PHASE_IDS();
    LAS float* cond = (LAS float*)lds;
    LAS float* part = (LAS float*)(lds + 32768);
    const float* c = P.in[I_C];
    for (int i = tid; i < NB * DM; i += 512) { const float v = c[i]; cond[i] = v / (1.0f + __expf(-v)); }
    __syncthreads();
    float* mod = (float*)(P.ws + WS_MOD);
    for (int item = bx; item < 192; item += G) {
        const int l = item / 48, ng = item % 48;
        const float* W = P.in[I_ADA_W] + (size_t)l * DM * 12288 + (size_t)(wave * 256) * 12288 + ng * 256 + lane * 4;
        f32x4 a0 = {0.f, 0.f, 0.f, 0.f}, a1 = a0, a2 = a0, a3 = a0;
#pragma unroll 8
        for (int k = 0; k < 256; ++k) {
            const f32x4 w = *(const f32x4*)(W + (size_t)k * 12288); const int kk = wave * 256 + k;
            a0 += cond[kk] * w; a1 += cond[2048 + kk] * w; a2 += cond[4096 + kk] * w; a3 += cond[6144 + kk] * w;
        }
        LAS float* pp = part + wave * 1024 + lane * 4;
        *(LAS f32x4*)(pp) = a0; *(LAS f32x4*)(pp + 256) = a1; *(LAS f32x4*)(pp + 512) = a2; *(LAS f32x4*)(pp + 768) = a3;
        __syncthreads();
        for (int o = tid; o < 1024; o += 512) {
            float s = 0.f;
#pragma unroll
            for (int w = 0; w < 8; ++w) s += part[w * 1024 + o];
            const int b = o >> 8, cc = o & 255;
            mod[(size_t)(l * 4 + b) * 12288 + ng * 256 + cc] = s + P.in[I_ADA_B][l * 12288 + ng * 256 + cc];
        }
        __syncthreads();
    }
    if (bx >= 192 || G < 256) for (int og = (G < 256 ? bx : bx - 192); og < (G == 256 ? 64 : 128); og += (G < 256 ? G : 64)) s5_pre(kp0, lds, og, tid);
}

__device__ __forceinline__ int cmap(int type, int n) {
    if (type == 1) { if (n >= 2048) return n; const int tile = n >> 8, j = n & 255, bj = j >> 7, jj = j & 127; return tile * 256 + (jj >> 6) * 128 + bj * 64 + (jj & 63); }
    if (type == 2) {
        if (n >= 1280) return n;
        if (n < 1024) { const int tile = n >> 8, j = n & 255, bj = j >> 7, jj = j & 127; return tile * 256 + (jj >> 5) * 64 + bj * 32 + (jj & 31); }
        const int j = n - 1024, bj = j >> 7, jj = j & 127; if (jj < 64) return 1024 + (jj >> 5) * 64 + bj * 32 + (jj & 31); return 1152 + bj * 64 + (jj - 64);
    }
    if (type == 3) { const int tile = n >> 8, j = n & 255; return (j >> 7) * 5504 + tile * 128 + (j & 127); }
    return n;
}
__device__ __forceinline__ void tr_item(const float* W, int K, int N, bf16* WT, int k0, int c0a, int c0b, int dstr0, LAS float* scr, int lane, float* cv, const float* sh) {
    const int csrc = ((lane & 8) ? c0b : c0a) + (lane & 7) * 4, cl = (lane & 15) * 4;
#pragma unroll
    for (int i = 0; i < 16; ++i) { const int kk = 4 * i + (lane >> 4); const f32x4 v = __builtin_nontemporal_load((const f32x4*)(W + (size_t)(k0 + kk) * N + csrc));
        LAS float* d = scr + kk * 65 + cl; d[0] = v[0]; d[1] = v[1]; d[2] = v[2]; d[3] = v[3]; }
    LDS_WAIT(); asm volatile("" ::: "memory");
    const int c = lane & 7;
#pragma unroll
    for (int j = 0; j < 8; ++j) { const int n = (lane >> 3) + 8 * j; const LAS float* s = scr + (8 * c) * 65 + n;
        u32x4 o; o.x = cvt_pk_bf16(s[0 * 65], s[1 * 65]); o.y = cvt_pk_bf16(s[2 * 65], s[3 * 65]); o.z = cvt_pk_bf16(s[4 * 65], s[5 * 65]); o.w = cvt_pk_bf16(s[6 * 65], s[7 * 65]);
        __builtin_nontemporal_store(o, (u32x4*)(WT + (size_t)(dstr0 + n) * K + k0 + 8 * c)); }
    if (cv) { float a0 = 0.f, a1 = 0.f, a2 = 0.f, a3 = 0.f;
        const int s0 = __float_as_int(sh[k0 + lane]), s1 = __float_as_int(sh[12288 + k0 + lane]), s2 = __float_as_int(sh[2 * 12288 + k0 + lane]), s3 = __float_as_int(sh[3 * 12288 + k0 + lane]);
#pragma unroll
        for (int k = 0; k < 64; ++k) { const float w = scr[k * 65 + lane];
            a0 += __int_as_float(__builtin_amdgcn_readlane(s0, k)) * w; a1 += __int_as_float(__builtin_amdgcn_readlane(s1, k)) * w;
            a2 += __int_as_float(__builtin_amdgcn_readlane(s2, k)) * w; a3 += __int_as_float(__builtin_amdgcn_readlane(s3, k)) * w; }
        cv[dstr0 + lane] = a0; cv[N + dstr0 + lane] = a1; cv[2 * N + dstr0 + lane] = a2; cv[3 * N + dstr0 + lane] = a3; }
    LDS_WAIT(); asm volatile("" ::: "memory");
}
constexpr int CONV_EVEN = 11872, CONV_ODD = 10688;
__device__ __forceinline__ int conv_total(int L) { return (L & 1) ? CONV_ODD : CONV_EVEN; }
__device__ __forceinline__ void conv_item(KP kp0, int L, int idx, LAS float* scr, int lane) { KPREF(P, kp0);
    const float* mod = (const float*)(P.ws + WS_MOD) + (size_t)L * 4 * 12288; float* cvpart = (float*)(P.ws + WS_CVPART);
    const int e = L >> 1; const bool odd = (L & 1) != 0;
    int r = idx, in_idx, K, N, ctype = 0, cvo = -1; size_t wsoff; const float* sh = mod; size_t li_off;
    const int n_in = odd ? 1152 : 2560, n_aux = odd ? 256 : 32;
    if (r < n_in) { in_idx = odd ? I_OD_W_IN : I_EV_W_IN; K = 2048; N = odd ? ODD_IN : EVEN_IN; ctype = odd ? 2 : 1; wsoff = odd ? WS_W_ODIN : WS_W_EVIN; cvo = odd ? CV_ODIN + e * 4 * ODD_IN : CV_EVIN + e * 4 * EVEN_IN; li_off = (size_t)e * K * N; }
    else if ((r -= n_in) < n_aux) {
        if (!odd) { const int mat = r >> 1, kb = r & 1, gate = mat & 1, eb = e * 8 + (mat >> 1);
#pragma unroll
            for (int nb = 0; nb < 2; ++nb)
                tr_item(P.in[gate ? I_EV_GX_W : I_EV_GA_W] + (size_t)eb * 16384, 128, 128, (bf16*)(P.ws + WS_WGATE) + ((size_t)eb * 256 + gate * 128) * 128, 64 * kb, 64 * nb, 64 * nb + 32, 64 * nb, scr, lane, nullptr, nullptr);
            return; }
        in_idx = I_OD_GLU_W; K = 1024; N = 1024; wsoff = WS_W_GLU; li_off = (size_t)e * K * N; }
    else if ((r -= n_aux) < 1024) { in_idx = odd ? I_OD_W_OUT : I_EV_W_OUT; K = 2048; N = 2048; wsoff = odd ? WS_W_ODOUT : WS_W_EVOUT; li_off = (size_t)e * K * N; }
    else if ((r -= 1024) < 5504) { in_idx = I_FFN_W_IN; K = 2048; N = DFF2; ctype = 3; wsoff = WS_W_FFIN; cvo = CV_FFIN + L * 4 * DFF2; sh = mod + 3 * DM; li_off = (size_t)L * K * N; }
    else { r -= 5504; in_idx = I_FFN_W_OUT; K = DFF; N = 2048; wsoff = WS_W_FFOUT; li_off = (size_t)L * K * N; }
    const int nblk = N / 64, kb = r / nblk, nb = r % nblk;
    tr_item(P.in[in_idx] + li_off, K, N, (bf16*)(P.ws + wsoff) + li_off, 64 * kb, cmap(ctype, 64 * nb), cmap(ctype, 64 * nb + 32), 64 * nb, scr, lane,
            cvo >= 0 ? cvpart + ((size_t)kb * CV_TOTAL + cvo) : nullptr, sh);
}
__device__ __forceinline__ void conv_range(KP kp0, LAS unsigned char* lds, int L, int first, int last, int rank, int nranks, int wave, int lane) {
    LAS float* scr = (LAS float*)(lds + wave * 16640);
    for (int it = first + rank * 8 + wave; it < last; it += nranks * 8) conv_item(kp0, L, it, scr, lane);
}
__device__ __forceinline__ void cvec_reduce(KP kp0, int L, int bx, int G, int tid) { KPREF(P, kp0);
    const float* cvpart = (const float*)(P.ws + WS_CVPART); float* cvec = (float*)(P.ws + WS_CVEC);
    const int e = L >> 1, n_in = (L & 1) ? 4 * ODD_IN : 4 * EVEN_IN, o_in = (L & 1) ? CV_ODIN + e * 4 * ODD_IN : CV_EVIN + e * 4 * EVEN_IN, o_ff = CV_FFIN + L * 4 * DFF2;
    for (int i = bx * 512 + tid; i < n_in + 4 * DFF2; i += G * 512) { const int off = i < n_in ? o_in + i : o_ff + (i - n_in); float v[32];
#pragma unroll
        for (int kb = 0; kb < 32; ++kb) v[kb] = cvpart[(size_t)kb * CV_TOTAL + off];
        float s = 0.f;
#pragma unroll
        for (int kb = 0; kb < 32; ++kb) s += v[kb];
        cvec[off] = s; }
}
__device__ __forceinline__ void cvec_reduce_l0(KP kp0, const pg8::StaticOrder& S, int bx, int G, int tid) { KPREF(P, kp0);
    const float* cvpart = (const float*)(P.ws + WS_CVPART); float* cvec = (float*)(P.ws + WS_CVEC);
    pg8::Unit u;
    for (int i = 0; S.next(i, u); ++i) if (tid < 256) { const int off = CV_EVIN + (u.pm >> 3) * EVEN_IN + u.pn * 256 + tid; float v[32];
#pragma unroll
        for (int kb = 0; kb < 32; ++kb) v[kb] = cvpart[(size_t)kb * CV_TOTAL + off];
        float s = 0.f;
#pragma unroll
        for (int kb = 0; kb < 32; ++kb) s += v[kb];
        cvec[off] = s; }
    for (int i = bx * 512 + tid; i < 4 * DFF2; i += G * 512) { const int off = CV_FFIN + i; float v[32];
#pragma unroll
        for (int kb = 0; kb < 32; ++kb) v[kb] = cvpart[(size_t)kb * CV_TOTAL + off];
        float s = 0.f;
#pragma unroll
        for (int kb = 0; kb < 32; ++kb) s += v[kb];
        cvec[off] = s; }
    asm volatile("s_waitcnt vmcnt(0)" ::: "memory"); __syncthreads();
}
__device__ __forceinline__ void norm0_rows(KP kp0, int bx, int G, int wave, int lane);
__device__ __forceinline__ int conv_up(int L, bool tails) { return (!tails || !CONV_TAILS) ? conv_total(L) : (L == 0 ? CONV_EVEN : (TAIL_INPROJ ? (TAIL_HEAVY ? 0 : NARROW_ALL ? (L == 1 ? 5568 : (L == 2 ? 3168 : 7104)) : L == 1 ? 3776 : (L == 2 ? 1408 : 5312)) : (L == 2 ? 8064 : 6848))); }
__device__ __forceinline__ void phase_prep(KP kp0, int kwave_, LAS unsigned char* lds, bool tails) { KPREF(P, kp0); PHASE_IDS();
    {
        LAS float* scr = (LAS float*)(lds + wave * 16640);
        const int t0 = conv_up(0, tails), t1 = t0 + conv_up(1, tails), t2 = t1 + conv_up(2, tails), t3 = t2 + conv_up(3, tails);
        for (int it = bx * 8 + wave; it < t3; it += G * 8) { const int L = it < t0 ? 0 : (it < t1 ? 1 : (it < t2 ? 2 : 3)); conv_item(kp0, L, it - (L == 0 ? 0 : (L == 1 ? t0 : (L == 2 ? t1 : t2))), scr, lane); }
    }
    norm0_rows(kp0, bx, G, wave, lane);
    const int gw = bx * 8 + wave, NGW = G * 8; (void)gw; (void)NGW;
    const int gt = bx * 512 + tid, NT = G * 512;
    const int* pos = (const int*)P.in[I_POS];
    float* cosA = (float*)(P.ws + WS_COSA); float* sinA = (float*)(P.ws + WS_SINA); float* cosC = (float*)(P.ws + WS_COSC); float* sinC = (float*)(P.ws + WS_SINC);
    for (int idx = gt; idx < MT * 64; idx += NT) { const int row = idx >> 6, i = idx & 63;
        const double inv = exp2(-(double)i * (13.287712379549449 / 64.0)); float s, c; sincos_rev((double)pos[row] * inv, s, c); cosA[idx] = c; sinA[idx] = s; }
    for (int idx = gt; idx < MT * 32; idx += NT) { const int row = idx >> 5, i = idx & 31;
        const double inv = exp2(-(double)i * (13.287712379549449 / 32.0)); float s, c; sincos_rev((double)pos[row] * inv, s, c); cosC[idx] = c; sinC[idx] = s; }
}

__device__ __forceinline__ void norm0_rows(KP kp0, int bx, int G, int wave, int lane) { KPREF(P, kp0);
    const float* x = P.in[I_X]; const float* gwt = P.in[I_NORM_MIX];
    const float* modl = (const float*)(P.ws + WS_MOD);
    bf16* H = (bf16*)(P.ws + WS_H); float* ss = (float*)(P.ws + WS_SS);
    const int gw = bx * 8 + wave, NGW = G * 8;
    for (int row0 = gw; row0 < MT; row0 += 2 * NGW) {
        f32x4 vv[2][8];
#pragma unroll
        for (int rb = 0; rb < 2; ++rb) { const int row = row0 + rb * NGW < MT ? row0 + rb * NGW : row0; const f32x4* xr = (const f32x4*)(x + (size_t)row * DM) + lane;
#pragma unroll
            for (int j = 0; j < 8; ++j) vv[rb][j] = xr[64 * j]; }
#pragma unroll
        for (int rb = 0; rb < 2; ++rb) { const int row = row0 + rb * NGW; if (row < MT) { float s2 = 0.f;
#pragma unroll
            for (int j = 0; j < 8; ++j) { const f32x4 v = vv[rb][j]; s2 += (v[0] * v[0] + v[1] * v[1]) + (v[2] * v[2] + v[3] * v[3]); }
            s2 = wave_sum(s2); if (lane < 8) ss[(size_t)row * 8 + lane] = lane == 0 ? s2 : 0.f;
            const float* sc = modl + (size_t)(row >> 11) * 12288 + DM;
            u32x2* o8 = (u32x2*)(H + (size_t)row * DM) + lane;
#pragma unroll
            for (int j = 0; j < 8; ++j) { const int col = (lane + 64 * j) * 4;
                const f32x4 y = vv[rb][j] * *(const f32x4*)(gwt + col) * (1.0f + *(const f32x4*)(sc + col));
                u32x2 w; w.x = cvt_pk_bf16(y[0], y[1]); w.y = cvt_pk_bf16(y[2], y[3]); o8[64 * j] = w; } } }
    }
}
__device__ __forceinline__ void phase_final(KP kp0, int kwave_) { KPREF(P, kp0); PHASE_IDS();
    const float* gwt = P.in[I_NORM_FINAL]; const bf16* X = (const bf16*)(P.ws + WS_XRES);
    const int gw = bx * 8 + wave, NGW = G * 8;
    constexpr int RB = 4;
    for (int row0 = gw; row0 < MT; row0 += RB * NGW) {
        u32x4 raw[RB][4];
#pragma unroll
        for (int rb = 0; rb < RB; ++rb) { const int row = row0 + rb * NGW < MT ? row0 + rb * NGW : row0; const u32x4* xr = (const u32x4*)(X + (size_t)row * DM) + lane;
#pragma unroll
            for (int j = 0; j < 4; ++j) raw[rb][j] = xr[64 * j]; }
#pragma unroll
        for (int rb = 0; rb < RB; ++rb) { const int row = row0 + rb * NGW; if (row < MT) {
            f32x4 v[4][2]; float ss = 0.f;
#pragma unroll
            for (int j = 0; j < 4; ++j) { const u32x4 w = raw[rb][j]; v[j][0] = (f32x4){bf_lo(w.x), bf_hi(w.x), bf_lo(w.y), bf_hi(w.y)}; v[j][1] = (f32x4){bf_lo(w.z), bf_hi(w.z), bf_lo(w.w), bf_hi(w.w)};
                ss += ((v[j][0][0] * v[j][0][0] + v[j][0][1] * v[j][0][1]) + (v[j][0][2] * v[j][0][2] + v[j][0][3] * v[j][0][3])) + ((v[j][1][0] * v[j][1][0] + v[j][1][1] * v[j][1][1]) + (v[j][1][2] * v[j][1][2] + v[j][1][3] * v[j][1][3])); }
            const float rstd = rsqrtf(wave_sum(ss) * (1.0f / DM) + 1e-6f);
#pragma unroll
            for (int j = 0; j < 4; ++j) { const int col = (lane + 64 * j) * 8; float* o = P.out + (size_t)row * DM + col;
                *(f32x4*)(o) = v[j][0] * rstd * *(const f32x4*)(gwt + col); *(f32x4*)(o + 4) = v[j][1] * rstd * *(const f32x4*)(gwt + col + 4); } } }
    }
}

__device__ __forceinline__ void ffn_fix_panel(const float* hf, const float* hl, bf16* ACT, const float* cw, const float* cb, int pm, int tid) {
    if ((pm & 7) == 0) return;
#pragma unroll
    for (int it = 0; it < 3; ++it) { const int gq0 = tid + 512 * it, gq = gq0 < DFF / 4 ? gq0 : DFF / 4 - 1; { const int j = 4 * gq;
        f32x4 o[2][2];
#pragma unroll
        for (int bj = 0; bj < 2; ++bj) { const int col = bj * DFF + j;
            const f32x4 l0 = *(const f32x4*)(hl + ((size_t)((pm - 1) * 2 + 0) * 2 + bj) * DFF + j), l1 = *(const f32x4*)(hl + ((size_t)((pm - 1) * 2 + 1) * 2 + bj) * DFF + j);
            const f32x4 f0 = *(const f32x4*)(hf + ((size_t)(pm * 2 + 0) * 2 + bj) * DFF + j), f1 = *(const f32x4*)(hf + ((size_t)(pm * 2 + 1) * 2 + bj) * DFF + j);
            const f32x4 w0 = *(const f32x4*)(cw + col), w1 = *(const f32x4*)(cw + DFF2 + col), w2 = *(const f32x4*)(cw + 2 * DFF2 + col), bb = *(const f32x4*)(cb + col);
            o[0][bj] = bb + w0 * l0 + w1 * l1 + w2 * f0;
            o[1][bj] = bb + w0 * l1 + w1 * f0 + w2 * f1; }
#pragma unroll
        for (int rr = 0; rr < 2; ++rr) { const f32x4 r = pg8::gelu4(o[rr][0]) * o[rr][1]; u32x2 w; w.x = cvt_pk_bf16(r[0], r[1]); w.y = cvt_pk_bf16(r[2], r[3]);
            if (gq0 < DFF / 4) *(u32x2*)(ACT + (size_t)(pm * 256 + rr) * DFF + j) = w; } } }
}
__device__ __forceinline__ bool tile_is_split(const pg8::StaticOrder& T, int pm, int pn) {
    const int nig = pg8::WGM * T.nN, gid = pm / pg8::WGM, fm = gid * pg8::WGM, gsz = (T.nM - fm) < pg8::WGM ? (T.nM - fm) : pg8::WGM;
    const int w2 = gid * nig + pn * gsz + (pm - fm), q = T.nwg / pg8::NXCD, r = T.nwg % pg8::NXCD;
    int xcd, off; if (w2 < r * (q + 1)) { xcd = w2 / (q + 1); off = w2 % (q + 1); } else { const int w = w2 - r * (q + 1); xcd = r + w / q; off = w % q; }
    return off * pg8::NXCD + xcd >= T.nwg - T.nsplit;
}
__device__ __forceinline__ void ffn_fix_mid(const float* hmf, const float* hml, bf16* ACT, const float* cw, const float* cb, const pg8::StaticOrder& T, int pm, int tid) {
    int my_pn = -1, cnt = 0;
    for (int pn = 0; pn < DFF / 128; ++pn) if (tile_is_split(T, pm, pn)) { if ((tid >> 5) == cnt) my_pn = pn; ++cnt; }
    if (my_pn < 0) return;
    const int j = my_pn * 128 + (tid & 31) * 4;
    f32x4 o[2][2];
#pragma unroll
    for (int bj = 0; bj < 2; ++bj) { const int col = bj * DFF + j;
        const f32x4 l0 = *(const f32x4*)(hml + ((size_t)(pm * 2 + 0) * 2 + bj) * DFF + j), l1 = *(const f32x4*)(hml + ((size_t)(pm * 2 + 1) * 2 + bj) * DFF + j);
        const f32x4 f0 = *(const f32x4*)(hmf + ((size_t)(pm * 2 + 0) * 2 + bj) * DFF + j), f1 = *(const f32x4*)(hmf + ((size_t)(pm * 2 + 1) * 2 + bj) * DFF + j);
        const f32x4 w0 = *(const f32x4*)(cw + col), w1 = *(const f32x4*)(cw + DFF2 + col), w2 = *(const f32x4*)(cw + 2 * DFF2 + col), bb = *(const f32x4*)(cb + col);
        o[0][bj] = bb + w0 * l0 + w1 * l1 + w2 * f0;
        o[1][bj] = bb + w0 * l1 + w1 * f0 + w2 * f1; }
#pragma unroll
    for (int rr = 0; rr < 2; ++rr) { const f32x4 r = pg8::gelu4(o[rr][0]) * o[rr][1]; u32x2 w; w.x = cvt_pk_bf16(r[0], r[1]); w.y = cvt_pk_bf16(r[2], r[3]);
        *(u32x2*)(ACT + (size_t)(pm * 256 + 128 + rr) * DFF + j) = w; }
}

#define ATT_FENCE() do { asm volatile("" ::: "memory"); __builtin_amdgcn_sched_barrier(0); } while (0)
__device__ __forceinline__ float xhalf_max(float x) { auto rr = __builtin_amdgcn_permlane32_swap(__float_as_uint(x), __float_as_uint(x), false, false); return fmaxf(__uint_as_float(rr[0]), __uint_as_float(rr[1])); }
__device__ __forceinline__ float xhalf_sum(float x) { auto rr = __builtin_amdgcn_permlane32_swap(__float_as_uint(x), __float_as_uint(x), false, false); return __uint_as_float(rr[0]) + __uint_as_float(rr[1]); }
typedef short s16x4 __attribute__((ext_vector_type(4)));
typedef short bf16x8v __attribute__((ext_vector_type(8)));
typedef float f32x16 __attribute__((ext_vector_type(16)));
__device__ __forceinline__ unsigned offb(unsigned row, unsigned ch) { return 256u * row + 16u * (ch ^ (((row & 3u) << 2) | ((row >> 2) & 3u))); }
constexpr int ATT_TILE_BYTES = 64 * 256, ATT_BUF_BYTES = 2 * ATT_TILE_BYTES;
__device__ __forceinline__ bf16x8v cat8(const s16x4 a, const s16x4 b) { return (bf16x8v){a[0], a[1], a[2], a[3], b[0], b[1], b[2], b[3]}; }

template <int MODE>
__device__ __forceinline__ void phase_attn(KP kp0, int kwave_, LAS unsigned char* lds, int o_idx, int u0 = -1, int us = 0, int u1 = 0) { KPREF(P, kp0); PHASE_IDS();
    constexpr int NKS = MODE == 0 ? 8 : 4;
    constexpr int NDT = MODE == 0 ? 4 : 2;
    constexpr int NH = 1;
    const bf16* Q = (const bf16*)(P.ws + WS_Q); const bf16* K = (const bf16*)(P.ws + WS_K); const bf16* V = (const bf16*)(P.ws + WS_V); bf16* MIX = (bf16*)(P.ws + WS_MIX);
    const int r = lane & 31, hh = lane >> 5, q4 = (lane & 15) >> 2, p4 = lane & 3, blk = (lane >> 4) & 1;
    unsigned kaddr[NKS], vaddr[2][NDT];
    { const unsigned x = ((r & 3u) << 2) | ((r >> 2) & 3u);
#pragma unroll
      for (int s = 0; s < NKS; ++s) kaddr[s] = 256u * r + 16u * (((unsigned)(2 * s + hh)) ^ x);
#pragma unroll
      for (int t = 0; t < 2; ++t)
#pragma unroll
        for (int c = 0; c < NDT; ++c) { const unsigned row = 8u * t + 4u * hh + q4, ch = 4u * c + 2u * blk + (p4 >> 1);
            vaddr[t][c] = 256u * row + 16u * (ch ^ (((row & 3u) << 2) | ((row >> 2) & 3u))) + 8u * (p4 & 1); } }
    const int nunits = MODE == 0 ? 256 : 512;
    LAS float* wt = (LAS float*)(lds + RING_BYTES);
    if (MODE == 0) { for (int j = tid; j < 1280; j += 512) { const int d = 1023 - j; const int cnt = (d <= 128 ? 1 : 0) + (((d & 3) == 0 && d <= 512) ? 1 : 0) + ((d & 15) == 0 ? 1 : 0); wt[j] = (d >= 0) ? (float)cnt : 0.f; }
        __syncthreads(); }
    if (u0 < 0) { u0 = bx; us = G; u1 = nunits; }
    for (int unit = u0; unit < u1; unit += us) {
        int b, head0, q0, kt0, kt1; size_t kvbase; int kvpitch; unsigned kx = 0u;
        if (MODE == 0) { const int qb = 7 - (unit >> 5), bh = unit & 31; b = bh >> 3; head0 = bh & 7; q0 = qb * 256; kt0 = qb >= 2 ? 4 * (qb - 2) : 0; kt1 = qb * 4 + 3; kvbase = (size_t)b * SEQ * 1024 + head0 * 128; kvpitch = 1024; }
        else { b = unit >> 7; const int kvh = (unit >> 6) & 1; kx = 128u * kvh; q0 = (unit & 63) * 32; head0 = 8 * kvh + wave; kt0 = (q0 >= 127 ? q0 - 127 : 0) >> 6; kt1 = (q0 + 31) >> 6; kvbase = (size_t)b * SEQ * 128; kvpitch = 128; }
        const int tq = MODE == 0 ? q0 + 16 * (r & 15) + 2 * wave + (r >> 4) : q0 + r;
        const size_t qrow = (size_t)b * SEQ + tq;
        bf16x8v qf[NH][NKS];
#pragma unroll
        for (int hd = 0; hd < NH; ++hd)
#pragma unroll
            for (int s = 0; s < NKS; ++s) qf[hd][s] = *(const bf16x8v*)(Q + qrow * 1024 + (MODE == 0 ? head0 * 128 : (head0 + hd) * 64) + 16 * s + 8 * hh);
        f32x16 O[NH][NDT]; float m[NH], l[NH];
#pragma unroll
        for (int hd = 0; hd < NH; ++hd) { m[hd] = -1e30f; l[hd] = 0.f;
#pragma unroll
            for (int c = 0; c < NDT; ++c)
#pragma unroll
                for (int i = 0; i < 16; ++i) O[hd][c][i] = 0.f; }
        const int srow = tid >> 4, sch = tid & 15;
        const unsigned soff0 = offb(srow, sch), soff1 = offb(srow + 32, sch);
        u32x4 kreg[2], vreg[2];
        if (MODE == 1) {
            u32x4 kq[3][2], vq[3][2];
#pragma unroll
            for (int j = 0; j < 3; ++j) { const int kt = (kt0 + j <= kt1) ? kt0 + j : kt1; const size_t g0 = kvbase + (size_t)(kt * 64 + srow) * kvpitch + sch * 8, g1 = g0 + (size_t)32 * kvpitch;
                kq[j][0] = *(const u32x4*)(K + g0); kq[j][1] = *(const u32x4*)(K + g1); vq[j][0] = *(const u32x4*)(V + g0); vq[j][1] = *(const u32x4*)(V + g1); }
            __syncthreads();
#pragma unroll
            for (int j = 0; j < 3; ++j) { LAS unsigned char* tb = lds + j * ATT_BUF_BYTES;
                *(LAS u32x4*)(tb + soff0) = kq[j][0]; *(LAS u32x4*)(tb + soff1) = kq[j][1]; *(LAS u32x4*)(tb + ATT_TILE_BYTES + soff0) = vq[j][0]; *(LAS u32x4*)(tb + ATT_TILE_BYTES + soff1) = vq[j][1]; }
            __syncthreads();
        } else {
        { const size_t g0 = kvbase + (size_t)(kt0 * 64 + srow) * kvpitch + sch * 8, g1 = g0 + (size_t)32 * kvpitch;
          kreg[0] = *(const u32x4*)(K + g0); kreg[1] = *(const u32x4*)(K + g1); vreg[0] = *(const u32x4*)(V + g0); vreg[1] = *(const u32x4*)(V + g1); }
        __syncthreads();
        *(LAS u32x4*)(lds + soff0) = kreg[0]; *(LAS u32x4*)(lds + soff1) = kreg[1];
        *(LAS u32x4*)(lds + ATT_TILE_BYTES + soff0) = vreg[0]; *(LAS u32x4*)(lds + ATT_TILE_BYTES + soff1) = vreg[1];
        __syncthreads();
        }
        for (int kt = kt0; kt <= kt1; ++kt) {
            const int cur = MODE == 1 ? (kt - kt0) : ((kt - kt0) & 1);
            LAS unsigned char* kb_ = lds + cur * ATT_BUF_BYTES; LAS unsigned char* vb_ = kb_ + ATT_TILE_BYTES;
            if (MODE == 0 && kt < kt1) { const size_t g0 = kvbase + (size_t)((kt + 1) * 64 + srow) * kvpitch + sch * 8, g1 = g0 + (size_t)32 * kvpitch;
                kreg[0] = *(const u32x4*)(K + g0); kreg[1] = *(const u32x4*)(K + g1); vreg[0] = *(const u32x4*)(V + g0); vreg[1] = *(const u32x4*)(V + g1); }
            {
                const int dq = tq - 64 * kt - 4 * hh;
#pragma unroll
                for (int hd = 0; hd < NH; ++hd) {
                    f32x16 S[2];
#pragma unroll
                    for (int kb = 0; kb < 2; ++kb) {
                        bf16x8v kfr[NKS];
#pragma unroll
                        for (int s = 0; s < NKS; ++s) kfr[s] = *(const LAS bf16x8v*)(kb_ + (kaddr[s] ^ kx) + kb * 8192);
                        ATT_FENCE();
#pragma unroll
                        for (int i = 0; i < 16; ++i) S[kb][i] = 0.f;
#pragma unroll
                        for (int s = 0; s < NKS; ++s) S[kb] = __builtin_amdgcn_mfma_f32_32x32x16_bf16(kfr[s], qf[hd][s], S[kb], 0, 0, 0);
                        ATT_FENCE();
                    }
                    s16x4 vq[2][NDT][2];
#define ATT_RDV(buf, kbv, s2v) do { _Pragma("unroll") for (int c = 0; c < NDT; ++c) { \
                        vq[buf][c][0] = __builtin_amdgcn_ds_read_tr16_b64_v4i16((LAS s16x4*)(vb_ + (vaddr[0][c] ^ kx) + 256 * (32 * (kbv) + 16 * (s2v)))); \
                        vq[buf][c][1] = __builtin_amdgcn_ds_read_tr16_b64_v4i16((LAS s16x4*)(vb_ + (vaddr[1][c] ^ kx) + 256 * (32 * (kbv) + 16 * (s2v)))); } } while (0)
                    float w[2][16]; float tmax = -INFINITY;
#pragma unroll
                    for (int kb = 0; kb < 2; ++kb)
#pragma unroll
                        for (int i = 0; i < 16; ++i) { const int e = kb * 32 + (i & 3) + 8 * (i >> 2), d = dq - e;
                            if (MODE == 0) w[kb][i] = wt[1023 - dq + e];
                            else w[kb][i] = (d >= 0 && d <= 127) ? 1.f : 0.f;
                            S[kb][i] = (w[kb][i] > 0.f) ? S[kb][i] : -INFINITY; tmax = fmaxf(tmax, S[kb][i]); }
                    tmax = xhalf_max(tmax);
                    const float mn = fmaxf(m[hd], tmax), corr = __builtin_amdgcn_exp2f(m[hd] - mn); m[hd] = mn;
                    float ps = 0.f;
#pragma unroll
                    for (int kb = 0; kb < 2; ++kb)
#pragma unroll
                        for (int i = 0; i < 16; ++i) { const float pv = w[kb][i] * __builtin_amdgcn_exp2f(S[kb][i] - mn); S[kb][i] = pv; ps += pv; }
                    l[hd] = l[hd] * corr + ps;
                    ATT_FENCE();
                    ATT_RDV(0, 0, 0); ATT_RDV(1, 0, 1);
                    ATT_FENCE();
#pragma unroll
                    for (int c = 0; c < NDT; ++c)
#pragma unroll
                        for (int i = 0; i < 16; ++i) O[hd][c][i] *= corr;
#pragma unroll
                    for (int kb = 0; kb < 2; ++kb)
#pragma unroll
                        for (int s2 = 0; s2 < 2; ++s2) {
                            bf16x8v pf; { const unsigned a0 = cvt_pk_bf16(S[kb][8 * s2 + 0], S[kb][8 * s2 + 1]), a1 = cvt_pk_bf16(S[kb][8 * s2 + 2], S[kb][8 * s2 + 3]),
                                                         a2 = cvt_pk_bf16(S[kb][8 * s2 + 4], S[kb][8 * s2 + 5]), a3 = cvt_pk_bf16(S[kb][8 * s2 + 6], S[kb][8 * s2 + 7]);
                                pf = __builtin_bit_cast(bf16x8v, (u32x4){a0, a1, a2, a3}); }
#pragma unroll
                            for (int c = 0; c < NDT; ++c) O[hd][c] = __builtin_amdgcn_mfma_f32_32x32x16_bf16(cat8(vq[s2][c][0], vq[s2][c][1]), pf, O[hd][c], 0, 0, 0);
                            ATT_FENCE();
                            if (kb == 0) { if (s2 == 0) ATT_RDV(0, 1, 0); else ATT_RDV(1, 1, 1); }
                            ATT_FENCE();
                        }
#undef ATT_RDV
                }
            }
            if (MODE == 0 && kt < kt1) { LAS unsigned char* nb_ = lds + (cur ^ 1) * ATT_BUF_BYTES;
                *(LAS u32x4*)(nb_ + soff0) = kreg[0]; *(LAS u32x4*)(nb_ + soff1) = kreg[1];
                *(LAS u32x4*)(nb_ + ATT_TILE_BYTES + soff0) = vreg[0]; *(LAS u32x4*)(nb_ + ATT_TILE_BYTES + soff1) = vreg[1]; }
            if (MODE == 0) __syncthreads();
        }
        if (MODE == 0 && kt0 > 0) {
            LAS unsigned char* pk = lds + wave * 16384; LAS unsigned char* pv = pk + 8192;
            const int nfar = 4 * kt0;
            for (int s = 0; s * 16 < nfar; ++s) {
#pragma unroll
                for (int jh = 0; jh < 2; ++jh) { u32x4 kf[4], vf[4];
#pragma unroll
                    for (int j = 0; j < 4; ++j) { const int row = (lane >> 4) + 4 * (4 * jh + j), keypos = 2 * wave + (row >> 4) + 16 * (16 * s + (row & 15)); const size_t g0 = kvbase + (size_t)keypos * kvpitch + (lane & 15) * 8;
                        kf[j] = *(const u32x4*)(K + g0); vf[j] = *(const u32x4*)(V + g0); }
#pragma unroll
                    for (int j = 0; j < 4; ++j) { const unsigned so = offb((lane >> 4) + 4 * (4 * jh + j), lane & 15); *(LAS u32x4*)(pk + so) = kf[j]; *(LAS u32x4*)(pv + so) = vf[j]; } }
                f32x16 S;
#pragma unroll
                for (int i = 0; i < 16; ++i) S[i] = 0.f;
                { bf16x8v kfr[NKS];
#pragma unroll
                  for (int s8 = 0; s8 < NKS; ++s8) kfr[s8] = *(const LAS bf16x8v*)(pk + kaddr[s8]);
                  ATT_FENCE();
#pragma unroll
                  for (int s8 = 0; s8 < NKS; ++s8) S = __builtin_amdgcn_mfma_f32_32x32x16_bf16(kfr[s8], qf[0][s8], S, 0, 0, 0); }
                s16x4 vf2[2][NDT][2];
#pragma unroll
                for (int s2 = 0; s2 < 2; ++s2)
#pragma unroll
                    for (int c = 0; c < NDT; ++c) { vf2[s2][c][0] = __builtin_amdgcn_ds_read_tr16_b64_v4i16((LAS s16x4*)(pv + vaddr[0][c] + 256 * (16 * s2))); vf2[s2][c][1] = __builtin_amdgcn_ds_read_tr16_b64_v4i16((LAS s16x4*)(pv + vaddr[1][c] + 256 * (16 * s2))); }
                ATT_FENCE();
                float tmax = -INFINITY;
#pragma unroll
                for (int i = 0; i < 16; ++i) { const bool ok = (i >> 3) == (r >> 4); S[i] = ok ? S[i] : -INFINITY; tmax = fmaxf(tmax, S[i]); }
                tmax = xhalf_max(tmax);
                const float mn = fmaxf(m[0], tmax), corr = __builtin_amdgcn_exp2f(m[0] - mn); m[0] = mn;
                float ps = 0.f;
#pragma unroll
                for (int i = 0; i < 16; ++i) { const float pvv = __builtin_amdgcn_exp2f(S[i] - mn); S[i] = pvv; ps += pvv; }
                l[0] = l[0] * corr + ps;
#pragma unroll
                for (int c = 0; c < NDT; ++c)
#pragma unroll
                    for (int i = 0; i < 16; ++i) O[0][c][i] *= corr;
#pragma unroll
                for (int s2 = 0; s2 < 2; ++s2) {
                    bf16x8v pf; { const unsigned a0 = cvt_pk_bf16(S[8 * s2 + 0], S[8 * s2 + 1]), a1 = cvt_pk_bf16(S[8 * s2 + 2], S[8 * s2 + 3]), a2 = cvt_pk_bf16(S[8 * s2 + 4], S[8 * s2 + 5]), a3 = cvt_pk_bf16(S[8 * s2 + 6], S[8 * s2 + 7]);
                        pf = __builtin_bit_cast(bf16x8v, (u32x4){a0, a1, a2, a3}); }
#pragma unroll
                    for (int c = 0; c < NDT; ++c) O[0][c] = __builtin_amdgcn_mfma_f32_32x32x16_bf16(cat8(vf2[s2][c][0], vf2[s2][c][1]), pf, O[0][c], 0, 0, 0);
                }
            }
        }
#pragma unroll
        for (int hd = 0; hd < NH; ++hd) {
            float lt = xhalf_sum(l[hd]);
            if (MODE == 1) lt += __builtin_amdgcn_exp2f(P.in[I_OD_SINKS][o_idx * 16 + head0 + hd] * LOG2E - m[hd]);
            const float inv = 1.0f / lt;
            bf16* orow = MIX + qrow * 2048 + (MODE == 0 ? head0 * 128 : (head0 + hd) * 64);
#pragma unroll
            for (int c = 0; c < NDT; ++c)
#pragma unroll
                for (int g4 = 0; g4 < 4; ++g4) { u32x2 o; o.x = cvt_pk_bf16(O[hd][c][4 * g4 + 0] * inv, O[hd][c][4 * g4 + 1] * inv); o.y = cvt_pk_bf16(O[hd][c][4 * g4 + 2] * inv, O[hd][c][4 * g4 + 3] * inv);
                    *(u32x2*)(orow + 32 * c + 8 * g4 + 4 * hh) = o; }
        }
    }
    __syncthreads();
}
#define S5_FENCE() do { asm volatile("" ::: "memory"); __builtin_amdgcn_sched_barrier(0); } while (0)
__device__ __forceinline__ void phase_s5(KP kp0, int kwave_, LAS unsigned char* lds, int o_idx) { KPREF(P, kp0); PHASE_IDS();
    const bf16* Ug = (const bf16*)(P.ws + WS_XB); bf16* Z = (bf16*)(P.ws + WS_YB);
    constexpr int UP = 1296;
    LAS unsigned char* uc = lds; LAS float* eL = (LAS float*)(lds + 64 * UP);
    const int r = lane & 31, hh = lane >> 5;
    for (int bg = bx; bg < 256; bg += G) { const int b = bg >> 6, g = bg & 63, og = o_idx * 64 + g;
        const bf16* TT = (const bf16*)(P.ws + WS_S5TT) + (size_t)og * 512 * 640; const bf16* T2 = (const bf16*)(P.ws + WS_S5T2) + (size_t)og * 128 * 512;
        __syncthreads();
        { const int row = tid >> 3, piece = tid & 7; const bf16* src = Ug + ((size_t)g * MT + (size_t)b * SEQ + 32 * row) * 16 + piece * 64;
#pragma unroll
          for (int q = 0; q < 8; ++q) *(LAS u32x4*)(uc + row * UP + (piece * 8 + q) * 16) = *(const u32x4*)(src + q * 8); }
        __syncthreads();
        {
            const int rt = wave & 1, ct = wave >> 1; f32x16 acc;
#pragma unroll
            for (int i = 0; i < 16; ++i) acc[i] = 0.f;
            const bf16* bp = T2 + (size_t)(32 * ct + r) * 512 + 8 * hh;
            bf16x8v bq[32];
#pragma unroll
            for (int s = 0; s < 32; ++s) bq[s] = *(const bf16x8v*)(bp + 16 * s);
            asm volatile("" ::: "memory");
#pragma unroll
            for (int sb = 0; sb < 4; ++sb) { bf16x8v afr[8];
#pragma unroll
                for (int j = 0; j < 8; ++j) afr[j] = *(const LAS bf16x8v*)(uc + (32 * rt + r) * UP + 32 * (8 * sb + j) + 16 * hh);
                S5_FENCE();
#pragma unroll
                for (int j = 0; j < 8; ++j) acc = __builtin_amdgcn_mfma_f32_32x32x16_bf16(afr[j], bq[8 * sb + j], acc, 0, 0, 0);
                S5_FENCE(); }
#pragma unroll
            for (int i = 0; i < 16; ++i) eL[(32 * rt + (i & 3) + 8 * (i >> 2) + 4 * hh) * 128 + 32 * ct + r] = acc[i];
        }
        __syncthreads();
        const bf16* bp0 = TT + (size_t)(32 * wave + r) * 640 + 8 * hh; const bf16* bp1 = bp0 + (size_t)256 * 640;
        bf16x8v bq[2][5][2];
#pragma unroll
        for (int s = 0; s < 5; ++s) { bq[0][s][0] = *(const bf16x8v*)(bp0 + 16 * s); bq[0][s][1] = *(const bf16x8v*)(bp1 + 16 * s); }
        const float dsk = P.in[I_OD_D][o_idx * 1024 + g * 16 + (r & 15)];
        if (wave == 0) { const f32x2 a32 = ((const f32x2*)(P.ws + WS_S5A32))[og * 64 + lane]; float hr = 0.f, hi = 0.f;
            for (int c8 = 0; c8 < 64; c8 += 8) { float er[8], ei[8];
#pragma unroll
                for (int j = 0; j < 8; ++j) { er[j] = eL[(c8 + j) * 128 + lane]; ei[j] = eL[(c8 + j) * 128 + 64 + lane]; }
#pragma unroll
                for (int j = 0; j < 8; ++j) { const int ch = c8 + j; *(LAS unsigned short*)(uc + ch * UP + 1024 + lane * 2) = f2bf(hr); *(LAS unsigned short*)(uc + ch * UP + 1152 + lane * 2) = f2bf(hi);
                    const float nr = a32[0] * hr - a32[1] * hi + er[j], ni = a32[0] * hi + a32[1] * hr + ei[j]; hr = nr; hi = ni; } } }
        __syncthreads();
        {
            f32x16 acc[2][2];
#pragma unroll
            for (int a = 0; a < 2; ++a)
#pragma unroll
                for (int c = 0; c < 2; ++c)
#pragma unroll
                    for (int i = 0; i < 16; ++i) acc[a][c][i] = 0.f;
#pragma unroll
            for (int bt = 0; bt < 8; ++bt) {
                if (bt < 7) {
#pragma unroll
                    for (int s = 0; s < 5; ++s) { bq[(bt + 1) & 1][s][0] = *(const bf16x8v*)(bp0 + 16 * (5 * (bt + 1) + s)); bq[(bt + 1) & 1][s][1] = *(const bf16x8v*)(bp1 + 16 * (5 * (bt + 1) + s)); } }
                asm volatile("" ::: "memory");
                bf16x8v a0r[5], a1r[5];
#pragma unroll
                for (int s8 = 0; s8 < 5; ++s8) { const int s = 5 * bt + s8; a0r[s8] = *(const LAS bf16x8v*)(uc + r * UP + 32 * s + 16 * hh); a1r[s8] = *(const LAS bf16x8v*)(uc + (32 + r) * UP + 32 * s + 16 * hh); }
                S5_FENCE();
#pragma unroll
                for (int s8 = 0; s8 < 5; ++s8) { const bf16x8v b0 = bq[bt & 1][s8][0], b1 = bq[bt & 1][s8][1], a0 = a0r[s8], a1 = a1r[s8];
                    acc[0][0] = __builtin_amdgcn_mfma_f32_32x32x16_bf16(a0, b0, acc[0][0], 0, 0, 0); acc[1][0] = __builtin_amdgcn_mfma_f32_32x32x16_bf16(a1, b0, acc[1][0], 0, 0, 0);
                    acc[0][1] = __builtin_amdgcn_mfma_f32_32x32x16_bf16(a0, b1, acc[0][1], 0, 0, 0); acc[1][1] = __builtin_amdgcn_mfma_f32_32x32x16_bf16(a1, b1, acc[1][1], 0, 0, 0); }
                S5_FENCE();
            }
            __syncthreads();
#pragma unroll
            for (int cti = 0; cti < 2; ++cti) { const int n = 32 * (wave + 8 * cti) + r;
                unsigned short uu[2][16];
#pragma unroll
                for (int rt = 0; rt < 2; ++rt)
#pragma unroll
                    for (int i = 0; i < 16; ++i) { const int ch = 32 * rt + (i & 3) + 8 * (i >> 2) + 4 * hh; uu[rt][i] = *(const LAS unsigned short*)(uc + ch * UP + n * 2); }
                S5_FENCE();
#pragma unroll
                for (int rt = 0; rt < 2; ++rt)
#pragma unroll
                    for (int i = 0; i < 16; ++i) { const int ch = 32 * rt + (i & 3) + 8 * (i >> 2) + 4 * hh; LAS unsigned short* up = (LAS unsigned short*)(uc + ch * UP + n * 2);
                        *up = f2bf(gelu_tanh(acc[rt][cti][i] + dsk * bf2f(uu[rt][i]))); }
                S5_FENCE(); }
            __syncthreads();
            { u32x4 zz[8];
#pragma unroll
              for (int q = 0; q < 8; ++q) { const int p = tid + 512 * q, t = p >> 1, hf = p & 1; zz[q] = *(const LAS u32x4*)(uc + (t >> 5) * UP + ((t & 31) * 16 + hf * 8) * 2); }
#pragma unroll
              for (int q = 0; q < 8; ++q) { const int p = tid + 512 * q, t = p >> 1, hf = p & 1; *(u32x4*)(Z + ((size_t)b * SEQ + t) * 1024 + g * 16 + hf * 8) = zz[q]; } }
        }
    }
}

constexpr size_t WS_XCV = 572 * MiB;
constexpr int CW_LRU = 8192;
__device__ __forceinline__ void lru_conv_slice(KP kp0, int kwave_, int e) { KPREF(P, kp0); PHASE_IDS();
    const bf16* XB = (const bf16*)(P.ws + WS_XB); bf16* XC = (bf16*)(P.ws + WS_XCV); unsigned* cnt = (unsigned*)(P.ws + WS_CTL) + CW_LRU;
    const int cg = tid & 15, rg = tid >> 4;
    const int sl0 = G == 256 ? (bx >= 192 ? (bx - 192) * 4 : 256) : bx, sl1 = G == 256 ? sl0 + 4 : 256, sls = G == 256 ? 1 : G;
    for (int sl = sl0; sl < sl1 && sl < 256; sl += sls) { const int b = sl >> 6, blk = (sl >> 3) & 7, t0 = (sl & 7) * 256;
        float cw[4][8], cb[8];
#pragma unroll
        for (int q = 0; q < 8; ++q) { cb[q] = P.in[I_EV_CONV_B][e * 1024 + blk * 128 + cg * 8 + q];
#pragma unroll
            for (int i = 0; i < 4; ++i) cw[i][q] = P.in[I_EV_CONV_W][(size_t)(e * 4 + i) * 1024 + blk * 128 + cg * 8 + q]; }
        u32x4 xin[11];
#pragma unroll
        for (int i = 0; i < 11; ++i) { const int tt = t0 + 8 * rg - 3 + i; xin[i] = (tt >= 0) ? *(const u32x4*)(XB + (size_t)(b * SEQ + tt) * 1024 + blk * 128 + cg * 8) : (u32x4){0u, 0u, 0u, 0u}; }
#pragma unroll
        for (int j = 0; j < 8; ++j) { float o[8];
#pragma unroll
            for (int q = 0; q < 8; ++q) o[q] = cb[q];
#pragma unroll
            for (int i = 0; i < 4; ++i) { const u32x4 x = xin[j + i];
                o[0] += cw[i][0] * bf_lo(x.x); o[1] += cw[i][1] * bf_hi(x.x); o[2] += cw[i][2] * bf_lo(x.y); o[3] += cw[i][3] * bf_hi(x.y);
                o[4] += cw[i][4] * bf_lo(x.z); o[5] += cw[i][5] * bf_hi(x.z); o[6] += cw[i][6] * bf_lo(x.w); o[7] += cw[i][7] * bf_hi(x.w); }
            const unsigned long long lo = (unsigned long long)cvt_pk_bf16(o[0], o[1]) | ((unsigned long long)cvt_pk_bf16(o[2], o[3]) << 32), hi = (unsigned long long)cvt_pk_bf16(o[4], o[5]) | ((unsigned long long)cvt_pk_bf16(o[6], o[7]) << 32);
            unsigned long long* dst = (unsigned long long*)(XC + (size_t)(b * SEQ + t0 + 8 * rg + j) * 1024 + blk * 128 + cg * 8);
            __hip_atomic_store(dst, lo, __ATOMIC_RELAXED, __HIP_MEMORY_SCOPE_AGENT); __hip_atomic_store(dst + 1, hi, __ATOMIC_RELAXED, __HIP_MEMORY_SCOPE_AGENT); }
        asm volatile("s_waitcnt vmcnt(0)" ::: "memory");
        __syncthreads();
        if (tid == 0) (void)__hip_atomic_fetch_add(cnt + ((e * 4 + b) * 8 + blk) * 16, 1u, __ATOMIC_RELAXED, __HIP_MEMORY_SCOPE_AGENT);
    }
}
__device__ __forceinline__ void phase_lru(KP kp0, int kwave_, LAS unsigned char* lds, int e) { KPREF(P, kp0); PHASE_IDS();
    const bf16* XC = (const bf16*)(P.ws + WS_XCV); const bf16* YB = (const bf16*)(P.ws + WS_YB); bf16* MIX = (bf16*)(P.ws + WS_MIX);
    LAS unsigned char* xcL = lds;
    LAS float* aL = (LAS float*)(lds + 69632); LAS float* bL = (LAS float*)(lds + 86016);
    LAS float* sA = (LAS float*)(lds + 102400); LAS float* sB = (LAS float*)(lds + 104448);
    LAS float* carry = (LAS float*)(lds + 106496);
    const int c16 = lane & 15, kq = lane >> 4, cg = tid & 15, rg = tid >> 4;
    for (int item = bx; item < 256; item += G) { const int b = item >> 6, blk = (item >> 3) & 7, oct = item & 7, ch0 = blk * 128 + oct * 16;
        bf16x8v bfr[4], bfi[4];
        { const bf16* wg = (const bf16*)(P.ws + WS_WGATE) + ((size_t)(e * 8 + blk) * 256 + oct * 16 + c16) * 128 + 8 * kq;
#pragma unroll
          for (int s = 0; s < 4; ++s) { bfr[s] = *(const bf16x8v*)(wg + 32 * s); bfi[s] = *(const bf16x8v*)(wg + 128 * 128 + 32 * s); } }
        const float gab = P.in[I_EV_GA_B][e * 1024 + ch0 + c16], gxb = P.in[I_EV_GX_B][e * 1024 + ch0 + c16];
        const float sp8 = -8.0f * log1pf(expf(-P.in[I_EV_LAMBDA][e * 1024 + ch0 + c16]));
        if (tid < 16) carry[tid] = 0.f;
        {
            unsigned* cnt = (unsigned*)(P.ws + WS_CTL) + CW_LRU + ((e * 4 + b) * 8 + blk) * 16;
            if (wave == 0) { unsigned sp = 0; while (__hip_atomic_load(cnt, __ATOMIC_RELAXED, __HIP_MEMORY_SCOPE_AGENT) < 8u && ++sp < (1u << 22)) __builtin_amdgcn_s_sleep(1);
                __builtin_amdgcn_fence(__ATOMIC_ACQUIRE, "agent"); asm volatile("s_waitcnt vmcnt(0)" ::: "memory"); }
            __syncthreads(); }
        u32x4 xq[8];
#pragma unroll
        for (int j = 0; j < 8; ++j) xq[j] = *(const u32x4*)(XC + (size_t)(b * SEQ + 8 * rg + j) * 1024 + blk * 128 + cg * 8);
        for (int tc = 0; tc < 8; ++tc) { const int t0 = tc * 256;
#pragma unroll
            for (int j = 0; j < 8; ++j) *(LAS u32x4*)(xcL + (8 * rg + j) * 272 + cg * 16) = xq[j];
            if (tc < 7) {
#pragma unroll
                for (int j = 0; j < 8; ++j) xq[j] = *(const u32x4*)(XC + (size_t)(b * SEQ + t0 + 256 + 8 * rg + j) * 1024 + blk * 128 + cg * 8); }
            float ybv[8];
#pragma unroll
            for (int i = 0; i < 8; ++i) ybv[i] = bf2f(YB[(size_t)(b * SEQ + t0 + 8 * rg + i) * 1024 + ch0 + cg]);
            __syncthreads();
            bf16x8v afg[2][4];
#pragma unroll
            for (int rb = 0; rb < 2; ++rb)
#pragma unroll
                for (int s2 = 0; s2 < 4; ++s2) afg[rb][s2] = *(const LAS bf16x8v*)(xcL + (32 * wave + 16 * rb + c16) * 272 + 64 * s2 + 16 * kq);
            asm volatile("" ::: "memory"); __builtin_amdgcn_sched_barrier(0);
#pragma unroll
            for (int rb = 0; rb < 2; ++rb) { const int row0 = 32 * wave + 16 * rb;
                f32x4 accr = {0.f, 0.f, 0.f, 0.f}, acci = {0.f, 0.f, 0.f, 0.f};
#pragma unroll
                for (int s2 = 0; s2 < 4; ++s2) { const bf16x8v af = afg[rb][s2];
                    accr = __builtin_amdgcn_mfma_f32_16x16x32_bf16(af, bfr[s2], accr, 0, 0, 0); acci = __builtin_amdgcn_mfma_f32_16x16x32_bf16(af, bfi[s2], acci, 0, 0, 0); }
#pragma unroll
                for (int i = 0; i < 4; ++i) { const int row = row0 + 4 * kq + i;
                    const float rr = 1.0f / (1.0f + __expf(-(accr[i] + gab))), ig = 1.0f / (1.0f + __expf(-(acci[i] + gxb)));
                    const float a = __expf(sp8 * rr), mult = sqrtf(fmaxf(1.0f - a * a, 0.f));
                    const float xv = bf2f(*(const LAS unsigned short*)(xcL + row * 272 + (oct * 16 + c16) * 2));
                    aL[row * 16 + c16] = a; bL[row * 16 + c16] = mult * ig * xv; }
            }
            __syncthreads();
            float av[8], bv[8], A = 1.f, B = 0.f;
#pragma unroll
            for (int i = 0; i < 8; ++i) { av[i] = aL[(8 * rg + i) * 16 + cg]; bv[i] = bL[(8 * rg + i) * 16 + cg]; B = av[i] * B + bv[i]; A *= av[i]; }
            { const float a1 = __shfl_up(A, 16), b1 = __shfl_up(B, 16); if (lane >= 16) { B = A * b1 + B; A = A * a1; }
              const float a2 = __shfl_up(A, 32), b2 = __shfl_up(B, 32); if (lane >= 32) { B = A * b2 + B; A = A * a2; } }
            if (lane >= 48) { sA[wave * 16 + cg] = A; sB[wave * 16 + cg] = B; }
            const float ape = __shfl_up(A, 16), bpe = __shfl_up(B, 16);
            __syncthreads();
            float h = carry[(tc & 1) * 16 + cg];
            for (int w = 0; w < wave; ++w) h = sA[w * 16 + cg] * h + sB[w * 16 + cg];
            if (lane >= 16) h = ape * h + bpe;
#pragma unroll
            for (int i = 0; i < 8; ++i) { h = av[i] * h + bv[i];
                MIX[(size_t)(b * SEQ + t0 + 8 * rg + i) * 2048 + 1024 + ch0 + cg] = f2bf(h * ybv[i]); }
            if (rg == 31 && tc < 7) carry[((tc + 1) & 1) * 16 + cg] = h;
        }
    }
}

constexpr int N_PHASES = 2 + 11 * NLAYER + 1;
#ifndef NREP_G
#define NREP_G 1
#endif
#ifndef NREP_M
#define NREP_M 1
#endif
#ifndef NREP_L
#define NREP_L 1
#endif
#ifndef NREP_MB
#define NREP_MB 1
#endif
#ifndef NREP_BAR
#define NREP_BAR 1
#endif
#ifndef PROBE_FFN_STORE
#define PROBE_FFN_STORE 0
#endif
#ifndef NREP_GF
#define NREP_GF 1
#endif
#ifndef NREP_GO
#define NREP_GO 1
#endif
#ifndef NREP_E
#define NREP_E 1
#endif
#ifndef NREP_P
#define NREP_P 1
#endif
#ifndef TAIL_INPROJ
#define TAIL_INPROJ 1
#endif
#ifndef SIDE_BY_SIDE
#define SIDE_BY_SIDE 1
#endif
#ifndef PROBE_R
#define PROBE_R 0
#define PROBE_N 2048
#define PROBE_SPLIT 0
#endif
#ifndef NARROW_ALL
#define NARROW_ALL 0
#endif
#define NARROW_L(l) (NARROW_ALL || (l) == NLAYER - 1)
#ifndef TAIL_HEAVY
#define TAIL_HEAVY 0
#endif
#define TH(a, b) (TAIL_HEAVY ? (a) : (b))
#define NA(a, b) (NARROW_ALL ? (a) : (b))
#ifndef NREP_FIX
#define NREP_FIX 1
#endif
#ifndef MK_ONE_LAUNCH
#define MK_ONE_LAUNCH 1
#endif
__global__ void __launch_bounds__(512, 2) fwd(Params P) {
    extern __shared__ __attribute__((aligned(16))) unsigned char lds_raw[];
    LAS unsigned char* lds = (LAS unsigned char*)lds_raw;
    const int kwave = __builtin_amdgcn_readfirstlane((int)threadIdx.x >> 6);
    for (int u = threadIdx.x; u < (LDS_BYTES - LDSCTL_OFF) / 4; u += 512) ((LAS unsigned*)(lds + LDSCTL_OFF))[u] = 0u;
    __syncthreads();
    const KP kp = (KP)__builtin_amdgcn_kernarg_segment_ptr();
    const int ph_lo = kp->lo, ph_hi = kp->hi;
    unsigned* barw = (unsigned*)(kp->ws + WS_CTL) + CW_BAR + kp->li * XCD_BAR_WORDS;
    XcdBarrier bar; bar.bar = barw; bar.x = 0; bar.w0 = 0u; bar.st = nullptr;
    if (ph_hi - ph_lo > 1) bar = xcd_barrier_post(barw, (volatile LAS unsigned*)(lds + LDSCTL_OFF + 64));
    bar.w0 = (kwave == 0) ? 1u : 0u;
    const bool g256 = gridDim.x == 256;
    const bool tails = g256 && CONV_TAILS;
#define RUN(p) (ph_lo <= (p) && (p) < ph_hi)
#define SEAM(p) do { if (RUN(p) && RUN((p) + 1)) for (int rb_ = 0; rb_ < NREP_BAR; ++rb_) xcd_barrier(bar); } while (0)

    if (RUN(0)) for (int rep = 0; rep < NREP_P; ++rep) phase_ada(kp, kwave, lds);
    SEAM(0);
    if (RUN(1)) for (int rep = 0; rep < NREP_P; ++rep) phase_prep(kp, kwave, lds, tails);
    SEAM(1);
    for (int l = 0; l < NLAYER; ++l) {
        const int pb = 2 + 11 * l, e = l >> 1; const bool odd = (l & 1) != 0;
        if (RUN(pb + 1)) for (int rep = 0; rep < NREP_G; ++rep) { KPREF(P, kp); const int kwave_ = kwave; PHASE_IDS(); const bf16* H = (const bf16*)(P.ws + WS_H); bf16* Qb = (bf16*)(P.ws + WS_Q);
            if (!odd) { pg8::Gemm g{H, (const bf16*)(P.ws + WS_W_EVIN) + (size_t)e * EVEN_IN * DM, MT, EVEN_IN, DM}; pg8::PrefetchOrder S; S.init(MT, EVEN_IN, G, bx); S.ssp = (const float*)(P.ws + WS_SS) + (size_t)(2 * l) * MT * 8; S.buf = lds + RING_BYTES + 8192; S.wave = wave; S.ui = 0;
                if (l == 0 && rep == 0) cvec_reduce_l0(kp, S, bx, G, tid);
                pg8::EpiEvenIn E{Qb, (const float*)(P.ws + WS_COSA), (const float*)(P.ws + WS_SINA), QSCALE_A, lds + RING_BYTES + 8192, (const float*)(P.ws + WS_CVEC) + CV_EVIN + (size_t)e * 4 * EVEN_IN, (LAS float*)(lds + RING_BYTES + 6144)};
                pg8::gemm_phase<pg8::EpiEvenIn, pg8::PrefetchOrder, true, true>(lds, g, S, E, tid);
                { FRESH_IDS();
                if (tails && rep + 1 == NREP_G && fbx >= 128) {
                    if (l == 0) { if (TAIL_INPROJ) conv_range(kp, lds, 1, TH(0, NA(5568, 3776)), TH(4608, NA(8640, 6848)), fbx - 128, 128, fwave, flane); }
                    else if (fbx < 192) s5_pre(kp, lds, 64 + fbx - 128, ftid);
                    else if (TAIL_INPROJ) conv_range(kp, lds, 3, TH(2304, NA(7104, 5312)), TH(4608, NA(8640, 6848)), fbx - 192, 64, fwave, flane); } } }
            else { pg8::Gemm g{H, (const bf16*)(P.ws + WS_W_ODIN) + (size_t)e * ODD_IN * DM, MT, ODD_IN, DM}; pg8::PrefetchOrder S; S.init(MT, ODD_IN, G, bx, (g256 && NARROW_L(l)) ? SPLIT_ODIN : 0); S.ssp = (const float*)(P.ws + WS_SS) + (size_t)(2 * l) * MT * 8; S.buf = lds + RING_BYTES + 8192; S.wave = wave; S.ui = 0;
                pg8::EpiOddIn E{Qb, (bf16*)(P.ws + WS_K), (bf16*)(P.ws + WS_V), (bf16*)(P.ws + WS_XB), (const float*)(P.ws + WS_COSC), (const float*)(P.ws + WS_SINC), QSCALE_C, lds + RING_BYTES + 8192, (const float*)(P.ws + WS_CVEC) + CV_ODIN + (size_t)e * 4 * ODD_IN, (LAS float*)(lds + RING_BYTES + 6144)};
                pg8::gemm_phase<pg8::EpiOddIn, pg8::PrefetchOrder, true, true, true>(lds, g, S, E, tid);
                { FRESH_IDS(); if (TAIL_INPROJ && tails && rep + 1 == NREP_G && l == 1 && fbx >= NA(64, 32)) conv_range(kp, lds, 2, TH(0, NA(3168, 1408)), NA(8544, 6784), fbx - NA(64, 32), NA(192, 224), fwave, flane);
                  if (!tails && g256 && rep + 1 == NREP_G && l == 1 && fbx >= 192) s5_pre(kp, lds, 64 + fbx - 192, ftid); } }
        }
        SEAM(pb + 1);
        if (RUN(pb + 2)) for (int rep = 0; rep < (odd ? 1 : NREP_M); ++rep) { if (!odd) { if (rep == 0) lru_conv_slice(kp, kwave, e); phase_attn<0>(kp, kwave, lds, 0); } else if (!SIDE_BY_SIDE || !g256) phase_attn<1>(kp, kwave, lds, e); }
        if (RUN(pb + 3)) for (int rep = 0; rep < (odd ? NREP_MB : NREP_L); ++rep) { if (!odd) phase_lru(kp, kwave, lds, e); else phase_s5(kp, kwave, lds, e); }
        SEAM(pb + 3);
        if (RUN(pb + 4)) {
            if (odd) for (int rep = 0; rep < NREP_G; ++rep) { KPREF(P, kp); const int kwave_ = kwave; PHASE_IDS(); const bf16* YBb = (const bf16*)(P.ws + WS_YB); bf16* MIX = (bf16*)(P.ws + WS_MIX); pg8::Gemm g{YBb, (const bf16*)(P.ws + WS_W_GLU) + (size_t)e * 1024 * 1024, MT, 1024, 1024}; pg8::StaticOrder S; S.init(MT, 1024, G, bx);
                pg8::EpiGlu E{YBb, MIX, P.in[I_OD_GLU_B] + e * 1024};
                pg8::gemm_phase<pg8::EpiGlu, pg8::StaticOrder, true, true>(lds, g, S, E, tid);
                if (SIDE_BY_SIDE && g256 && rep + 1 == NREP_G) {
                    const int ab = blockIdx.x; if (ab >= 128) phase_attn<1>(kp, kwave, lds, e, ab - 128, 128, 384); else phase_attn<1>(kp, kwave, lds, e, 384 + ab, 128, 512); }
                { FRESH_IDS(); if (TAIL_INPROJ && tails && rep + 1 == NREP_G && l == 1 && fbx >= 128) conv_range(kp, lds, 2, NA(8544, 6784), NA(9824, 8064), fbx - 128, 128, fwave, flane); } }
        }
        if (odd) SEAM(pb + 4);
        if (RUN(pb + 6)) for (int rep = 0; rep < NREP_G * NREP_GO; ++rep) { KPREF(P, kp); const int kwave_ = kwave; PHASE_IDS(); const bf16* MIX = (const bf16*)(P.ws + WS_MIX); const float* mod = (const float*)(P.ws + WS_MOD);
            const bf16* W = odd ? (const bf16*)(P.ws + WS_W_ODOUT) + (size_t)e * DM * DM : (const bf16*)(P.ws + WS_W_EVOUT) + (size_t)e * DM * DM;
            pg8::Gemm g{MIX, W, MT, DM, DM}; pg8::StaticOrder S; S.init(MT, DM, G, bx);
            const bool dry = rep + 1 < NREP_G * NREP_GO;
            pg8::EpiResid E{l == 0 ? P.in[I_X] : nullptr, (const bf16*)(P.ws + WS_XRES), dry ? (bf16*)(P.ws + 710 * MiB) : (bf16*)(P.ws + WS_XRES), nullptr, mod + (size_t)l * 4 * 12288 + 2 * DM, dry ? nullptr : (bf16*)(P.ws + WS_H), P.in[I_NORM_FFN] + l * DM, mod + (size_t)l * 4 * 12288 + 4 * DM, (float*)(P.ws + WS_SS) + (size_t)(2 * l + 1) * MT * 8, (LAS float*)(lds + RING_BYTES)};
            pg8::gemm_phase<pg8::EpiResid, pg8::StaticOrder, true, true>(lds, g, S, E, tid);
        }
        SEAM(pb + 6);
        if (RUN(pb + 8)) for (int rep = 0; rep < NREP_G * NREP_GF; ++rep) { KPREF(P, kp); const int kwave_ = kwave; PHASE_IDS(); const bf16* H = (const bf16*)(P.ws + WS_H);
            pg8::Gemm g{H, (const bf16*)(P.ws + WS_W_FFIN) + (size_t)l * DFF2 * DM, MT, DFF2, DM}; pg8::PrefetchOrder S; S.init(MT, DFF2, G, bx, (g256 && NARROW_L(l)) ? SPLIT_FFIN : 0); S.ssp = (const float*)(P.ws + WS_SS) + (size_t)(2 * l + 1) * MT * 8; S.buf = lds + RING_BYTES + 8192; S.wave = wave; S.ui = 0;
            pg8::EpiFfnIn E{(bf16*)(P.ws + WS_ACT), (float*)(P.ws + WS_HALO_F), (float*)(P.ws + WS_HALO_L), (WS_HALO_MF - WS_HALO_F) / 4, P.in[I_FFN_CONV_W] + (size_t)l * 3 * DFF2, P.in[I_FFN_CONV_B] + (size_t)l * DFF2, (LAS float*)(lds + RING_BYTES), lds + RING_BYTES + 8192, (const float*)(P.ws + WS_CVEC) + CV_FFIN + (size_t)l * 4 * DFF2};
#if PROBE_FFN_STORE
            if (rep + 1 < NREP_G * NREP_GF) { pg8::EpiStore E2{(bf16*)(P.ws + WS_UFF), DFF2}; pg8::gemm_phase<pg8::EpiStore, pg8::PrefetchOrder, true, true>(lds, g, S, E2, tid); } else
#endif
            pg8::gemm_phase<pg8::EpiFfnIn, pg8::PrefetchOrder, true, true, true>(lds, g, S, E, tid);
            { FRESH_IDS(); if (tails && rep + 1 == NREP_G * NREP_GF && l + 1 < NLAYER && fbx >= NA(192, 96)) { conv_range(kp, lds, l + 1, NA(conv_total(l + 1) - 2048, l == 1 ? 8064 : TH(4608, 6848)), conv_total(l + 1), fbx - NA(192, 96), NA(64, 160), fwave, flane); if (TAIL_HEAVY && l == 1) conv_range(kp, lds, 3, 0, 2304, fbx - 96, 160, fwave, flane); } }
        }
        SEAM(pb + 8);
        if (RUN(pb + 10)) for (int rep = 0; rep < NREP_G; ++rep) { KPREF(P, kp); const int kwave_ = kwave; PHASE_IDS(); const bf16* ACT = (const bf16*)(P.ws + WS_ACT); const float* mod = (const float*)(P.ws + WS_MOD);
            pg8::Gemm g{ACT, (const bf16*)(P.ws + WS_W_FFOUT) + (size_t)l * DM * DFF, MT, DM, DFF}; pg8::StaticOrder S; S.init(MT, DM, G, bx);
            if (l + 1 < NLAYER && rep == 0) cvec_reduce(kp, l + 1, bx, G, tid);
            for (int rfix = 0; rfix < NREP_FIX; ++rfix) { pg8::Unit fu; int lastpm = -1; for (int i = 0; S.next(i, fu); ++i) if (fu.pm != lastpm) { lastpm = fu.pm;
                ffn_fix_panel((const float*)(P.ws + WS_HALO_F), (const float*)(P.ws + WS_HALO_L), (bf16*)(P.ws + WS_ACT), P.in[I_FFN_CONV_W] + (size_t)l * 3 * DFF2, P.in[I_FFN_CONV_B] + (size_t)l * DFF2, fu.pm, tid);
                if (g256 && NARROW_L(l)) { pg8::StaticOrder T; T.init(MT, DFF2, G, bx, SPLIT_FFIN); ffn_fix_mid((const float*)(P.ws + WS_HALO_MF), (const float*)(P.ws + WS_HALO_ML), (bf16*)(P.ws + WS_ACT), P.in[I_FFN_CONV_W] + (size_t)l * 3 * DFF2, P.in[I_FFN_CONV_B] + (size_t)l * DFF2, T, fu.pm, tid); } }
              asm volatile("s_waitcnt vmcnt(0)" ::: "memory"); __syncthreads(); }
            const bool dry = rep + 1 < NREP_G, last = l == NLAYER - 1;
            pg8::EpiResid E{nullptr, (const bf16*)(P.ws + WS_XRES), dry ? (bf16*)(P.ws + 710 * MiB) : (bf16*)(P.ws + WS_XRES), nullptr, mod + (size_t)l * 4 * 12288 + 5 * DM, (dry || last) ? nullptr : (bf16*)(P.ws + WS_H), P.in[I_NORM_MIX] + (last ? l : l + 1) * DM, mod + (size_t)(last ? l : l + 1) * 4 * 12288 + DM, (float*)(P.ws + WS_SS) + (size_t)(2 * l + 2) * MT * 8, (LAS float*)(lds + RING_BYTES)};
            pg8::gemm_phase<pg8::EpiResid, pg8::StaticOrder, true, true>(lds, g, S, E, tid);
        }
        SEAM(pb + 10);
    }
#if PROBE_R
    for (int rep = 0; rep < PROBE_R; ++rep) { KPREF(P, kp); const int kwave_ = kwave; PHASE_IDS();
        pg8::Gemm g{(const bf16*)(P.ws + WS_H), (const bf16*)(P.ws + WS_W_FFIN), MT, PROBE_N, DM}; pg8::StaticOrder S; S.init(MT, PROBE_N, G, bx, PROBE_SPLIT);
        pg8::EpiStore E{(bf16*)(P.ws + WS_Q), PROBE_N};
        pg8::gemm_phase<pg8::EpiStore, pg8::StaticOrder, true, true, PROBE_SPLIT != 0>(lds, g, S, E, tid); xcd_barrier(bar); }
#endif
    if (RUN(N_PHASES - 1)) phase_final(kp, kwave);
#undef RUN
#undef SEAM
}

extern "C" void kernel_launch(void* const* d_in, const int* in_sizes, int n_in, void* d_out, int out_size, void* d_ws, size_t ws_size, hipStream_t stream) {
    static int grid = 0;
    if (grid == 0) {
        if (n_in != N_INPUTS || out_size != MT * DM || ws_size < WS_END) { fprintf(stderr, "kernel_launch: unexpected shapes: n_in %d out %d ws %zu (need %zu)\n", n_in, out_size, ws_size, (size_t)WS_END); grid = -1; return; }
        int dev = 0, cus = 0, per_cu = 0;
        if (hipGetDevice(&dev) != hipSuccess || hipDeviceGetAttribute(&cus, hipDeviceAttributeMultiprocessorCount, dev) != hipSuccess) { grid = -1; return; }
        if (hipFuncSetAttribute((const void*)fwd, hipFuncAttributeMaxDynamicSharedMemorySize, LDS_BYTES) != hipSuccess) { fprintf(stderr, "kernel_launch: hipFuncSetAttribute failed\n"); grid = -1; return; }
        if (hipOccupancyMaxActiveBlocksPerMultiprocessor(&per_cu, (const void*)fwd, 512, LDS_BYTES) != hipSuccess || per_cu < 1) fprintf(stderr, "kernel_launch: occupancy query says %d\n", per_cu);
        (void)hipGetLastError();
        grid = cus;
    }
    if (grid < 0) return;
    if (hipMemsetAsync((char*)d_ws + WS_CTL, 0, CTL_ZERO_BYTES, stream) != hipSuccess) return;
    Params p{};
    for (int i = 0; i < N_INPUTS; ++i) p.in[i] = (const float*)d_in[i];
    p.out = (float*)d_out; p.ws = (unsigned char*)d_ws; p.pad = 0;
#if MK_ONE_LAUNCH
    p.lo = 0; p.hi = N_PHASES; p.li = 0;
    hipLaunchKernelGGL(fwd, dim3(grid), dim3(512), LDS_BYTES, stream, p);
#else
    for (int ph = 0; ph < N_PHASES; ++ph) { p.lo = ph; p.hi = ph + 1; p.li = 0; hipLaunchKernelGGL(fwd, dim3(grid), dim3(512), LDS_BYTES, stream, p); }
#endif
    const hipError_t le = hipPeekAtLastError();
    if (le != hipSuccess) fprintf(stderr, "kernel_launch: launch failed: %s\n", hipGetErrorName(le));
}
```

```cpp
#include <hip/hip_runtime.h>
#include <cstdio>
#include <cstdint>
namespace pg8 {
#define PG8_LAS __attribute__((address_space(3)))
typedef unsigned short bf16_t;
typedef short bf16x8 __attribute__((ext_vector_type(8)));
typedef float f32x4 __attribute__((ext_vector_type(4)));
typedef unsigned u32x4 __attribute__((ext_vector_type(4)));
typedef unsigned u32x2 __attribute__((ext_vector_type(2)));
constexpr int BM = 256, BK = 64, HALF = 128, HTB = HALF * BK * 2  , STAGE_BYTES = 8 * HTB, NXCD = 8, WGM = 8;

__host__ __device__ __forceinline__ int lds_byte(int r, int c) { const int st = (r >> 4) * 2 + (c >> 5), rr = r & 15, cc = c & 31, ob = rr * 64 + cc * 2; return st * 1024 + (ob ^ (((ob >> 9) & 1) << 5)); }
__host__ __device__ __forceinline__ void stage_rc(int b, int& R, int& C) { const int st = b / 1024, sb = b % 1024, swz = sb ^ (((sb >> 9) & 1) << 5); R = (st >> 1) * 16 + swz / 64; C = (st & 1) * 32 + (swz % 64) / 2; }
__host__ __device__ __forceinline__ int perm32(int rho) { const int n = rho >> 4, i = rho & 15; return 8 * (i >> 2) + 4 * n + (i & 3); }

struct Unit { int pm, pn, ro, nar; };
struct Gemm { const bf16_t* A; const bf16_t* Bt; int M, N, K; };

struct StaticOrder {
    int nM, nN, nwg, G, c, nsplit;
    __host__ __device__ __forceinline__ void init(int M, int N, int G_, int c_, int nsplit_ = 0) { nM = M / BM; nN = N / BM; nwg = nM * nN; G = G_; c = c_; nsplit = nsplit_; }
    __host__ __device__ __forceinline__ bool next(int i, Unit& u) const {
        const long L = (long)i * G + c; if (L >= nwg + nsplit) return false;
        int wgid = (int)L; u.ro = 0; u.nar = 0;
        if (wgid >= nwg - nsplit) { u.nar = 1; if (wgid >= nwg) { wgid -= nsplit; u.ro = HALF; } }
        { const int q = nwg / NXCD, r = nwg % NXCD, xcd = wgid % NXCD, off = wgid / NXCD; wgid = (xcd < r ? xcd * (q + 1) : r * (q + 1) + (xcd - r) * q) + off; }
        const int nig = WGM * nN, gid = wgid / nig, fm = gid * WGM, gsz = (nM - fm) < WGM ? (nM - fm) : WGM;
        u.pm = fm + ((wgid % nig) % gsz); u.pn = (wgid % nig) / gsz; return true;
    }
    __device__ __forceinline__ void a_ready(const Unit&) const {}
    __device__ __forceinline__ void done(const Unit&) const {}
};

__device__ __forceinline__ unsigned cvt_pk_bf16(float lo, float hi) { unsigned r; asm("v_cvt_pk_bf16_f32 %0, %1, %2" : "=v"(r) : "v"(lo), "v"(hi)); return r; }
__device__ __forceinline__ u32x4 pack8(const f32x4 a, const f32x4 b) { u32x4 w; w.x = cvt_pk_bf16(a[0], a[1]); w.y = cvt_pk_bf16(a[2], a[3]); w.z = cvt_pk_bf16(b[0], b[1]); w.w = cvt_pk_bf16(b[2], b[3]); return w; }
__device__ __forceinline__ float bf_lo(unsigned w) { return __uint_as_float(w << 16); }
__device__ __forceinline__ float bf_hi(unsigned w) { return __uint_as_float(w & 0xffff0000u); }
__device__ __forceinline__ float gelu_tanh(float x) {
    const float u = x * (0.7978845608f + 0.0356774081f * x * x);
    const float e = __builtin_amdgcn_exp2f(-2.885390082f * u);
    return x * __builtin_amdgcn_rcpf(1.0f + e);
}
__device__ __forceinline__ f32x4 gelu4(const f32x4 v) { return (f32x4){gelu_tanh(v[0]), gelu_tanh(v[1]), gelu_tanh(v[2]), gelu_tanh(v[3])}; }
__device__ __forceinline__ float sigmoidf_fast(float x) { return __builtin_amdgcn_rcpf(1.0f + __builtin_amdgcn_exp2f(-1.4426950409f * x)); }

struct PrefetchOrder : StaticOrder {
    const float* ssp; PG8_LAS unsigned char* buf; int wave; mutable int ui;
    __device__ __forceinline__ void fetch(const Unit& u) const {
        int lane; asm volatile("v_mbcnt_lo_u32_b32 %0, -1, 0\n\tv_mbcnt_hi_u32_b32 %0, -1, %0" : "=v"(lane)); const int t = wave * 64 + lane;
        __builtin_amdgcn_global_load_lds((const unsigned*)(ssp + ((size_t)u.pm * BM + (t >> 1)) * 8 + (t & 1) * 4), (PG8_LAS unsigned*)(buf + wave * 1024), 16, 0, 0);
    }
    __device__ __forceinline__ void a_ready(const Unit& u) const { if (ui == 0) { ui = 1; fetch(u); } }
    __device__ __forceinline__ void done(const Unit&) const { Unit n; if (next(ui, n)) fetch(n); ++ui; }
};
__device__ __forceinline__ void build_rtab(PG8_LAS const unsigned char* buf, PG8_LAS float* rtab, int wr, int wc, int fr, int fq) {
    const int t = (wr * 4 + wc) * 64 + fq * 16 + fr;
    const f32x4 p = *(PG8_LAS const f32x4*)(buf + t * 16);
    float s = (p[0] + p[1]) + (p[2] + p[3]);
    s += __shfl_xor(s, 1);
    if ((t & 1) == 0) rtab[t >> 1] = rsqrtf(s * (1.0f / 2048.0f) + 1e-6f);
    asm volatile("s_waitcnt lgkmcnt(0)" ::: "memory"); __builtin_amdgcn_s_barrier(); asm volatile("" ::: "memory");
}

struct EpiStore {
    static constexpr bool PERM = true, AFTER_DRAIN = false;
    bf16_t* O; int ldc;
    __device__ __forceinline__ void operator()(const f32x4 (&acc)[2][2][4][2], const Unit& u, int wr, int wc, int fr, int fq) const {
        const int row0 = u.pm * BM + u.ro + wr * 64 + fr, col0 = u.pn * BM + wc * 32 + 8 * fq;
#pragma unroll
        for (int ai = 0; ai < 2; ++ai)
#pragma unroll
            for (int m = 0; m < 4; ++m) { if (ai == 1 && u.nar) break; bf16_t* rowp = O + (size_t)(row0 + ai * HALF + m * 16) * ldc + col0;
#pragma unroll
                for (int bj = 0; bj < 2; ++bj) *(u32x4*)(rowp + bj * HALF) = pack8(acc[ai][bj][m][0], acc[ai][bj][m][1]); }
    }
};

struct EpiEvenIn {
    static constexpr bool PERM = true, AFTER_DRAIN = false;
    bf16_t *Q; const float *cosT, *sinT; float qscale; PG8_LAS const unsigned char* ssb; const float* cv; PG8_LAS float* rtab;
    __device__ __forceinline__ void operator()(const f32x4 (&acc)[2][2][4][2], const Unit& u, int wr, int wc, int fr, int fq) const {
        const int row0 = u.pm * BM + u.ro + wr * 64 + fr;
        f32x4 cv4[2][2];
#pragma unroll
        for (int bj = 0; bj < 2; ++bj)
#pragma unroll
            for (int n = 0; n < 2; ++n) cv4[bj][n] = *(const f32x4*)(cv + (size_t)(u.pm >> 3) * 5120 + u.pn * BM + bj * HALF + wc * 32 + 8 * fq + 4 * n);
        build_rtab(ssb, rtab, wr, wc, fr, fq);
        if (u.pn < 8) {
            bf16_t* dst = Q + (size_t)(u.pn >> 2) * (8u << 20); const float sc = (u.pn < 4) ? qscale : 1.0f;
            const int head = (u.pn & 3) * 2 + (wc >> 1), i0 = (wc & 1) * 32 + 8 * fq;
#pragma unroll
            for (int ai = 0; ai < 2; ++ai) { if (ai == 1 && u.nar) break;
#pragma unroll
              for (int mh = 0; mh < 2; ++mh) {
                f32x4 cs[2][4];
#pragma unroll
                for (int m2 = 0; m2 < 2; ++m2) { const int m = m2; const size_t tr = (size_t)(row0 + ai * HALF + (2 * mh + m2) * 16) * 64 + i0;
                    cs[m][0] = *(const f32x4*)(cosT + tr); cs[m][1] = *(const f32x4*)(cosT + tr + 4); cs[m][2] = *(const f32x4*)(sinT + tr); cs[m][3] = *(const f32x4*)(sinT + tr + 4); }
#pragma unroll
                for (int m2 = 0; m2 < 2; ++m2) { const int m = 2 * mh + m2; const int row = row0 + ai * HALF + m * 16; const float rrm = rtab[u.ro + wr * 64 + ai * HALF + m * 16 + fr];
                    const f32x4 c0 = cs[m2][0], c1 = cs[m2][1], s0 = cs[m2][2], s1 = cs[m2][3];
                    const f32x4 a0 = acc[ai][0][m][0] * rrm + cv4[0][0], a1 = acc[ai][0][m][1] * rrm + cv4[0][1], b0 = acc[ai][1][m][0] * rrm + cv4[1][0], b1 = acc[ai][1][m][1] * rrm + cv4[1][1];
                    const f32x4 o10 = (a0 * c0 - b0 * s0) * sc, o11 = (a1 * c1 - b1 * s1) * sc, o20 = (b0 * c0 + a0 * s0) * sc, o21 = (b1 * c1 + a1 * s1) * sc;
                    bf16_t* rp = dst + (size_t)row * 1024 + head * 128 + i0;
                    *(u32x4*)(rp) = pack8(o10, o11); *(u32x4*)(rp + 64) = pack8(o20, o21); } } }
        } else {
            const int sel = (u.pn - 8) >> 2; bf16_t* dst = Q + (size_t)(u.pn >> 2) * (8u << 20); const int col0 = (u.pn & 3) * 256 + wc * 32 + 8 * fq;
#pragma unroll
            for (int ai = 0; ai < 2; ++ai)
#pragma unroll
                for (int m = 0; m < 4; ++m) { if (ai == 1 && u.nar) break; bf16_t* rowp = dst + (size_t)(row0 + ai * HALF + m * 16) * 1024 + col0; const float rrm = rtab[u.ro + wr * 64 + ai * HALF + m * 16 + fr];
#pragma unroll
                    for (int bj = 0; bj < 2; ++bj) { f32x4 v0 = acc[ai][bj][m][0] * rrm + cv4[bj][0], v1 = acc[ai][bj][m][1] * rrm + cv4[bj][1];
                        if (sel == 2) { v0 = gelu4(v0); v1 = gelu4(v1); }
                        *(u32x4*)(rowp + bj * HALF) = pack8(v0, v1); } }
        }
    }
};

struct EpiOddIn {
    static constexpr bool PERM = true, AFTER_DRAIN = false;
    bf16_t *Q, *K, *V, *U; const float *cosT, *sinT; float qscale; PG8_LAS const unsigned char* ssb; const float* cv; PG8_LAS float* rtab;
    __device__ __forceinline__ void operator()(const f32x4 (&acc)[2][2][4][2], const Unit& u, int wr, int wc, int fr, int fq) const {
        const int row0 = u.pm * BM + u.ro + wr * 64 + fr;
        f32x4 cv4[2][2];
#pragma unroll
        for (int bj = 0; bj < 2; ++bj)
#pragma unroll
            for (int n = 0; n < 2; ++n) cv4[bj][n] = *(const f32x4*)(cv + (size_t)(u.pm >> 3) * 2304 + u.pn * BM + bj * HALF + wc * 32 + 8 * fq + 4 * n);
        build_rtab(ssb, rtab, wr, wc, fr, fq);
        if (u.pn < 4 || (u.pn == 4 && wc < 2)) {
            const bool isq = u.pn < 4; const float sc = isq ? qscale : 1.0f;
            bf16_t* dst = isq ? Q + (u.pn * 4 + wc) * 64 : K + wc * 64; const int pitch = isq ? 1024 : 128;
#pragma unroll
            for (int ai = 0; ai < 2; ++ai) { if (ai == 1 && u.nar) break;
#pragma unroll
              for (int mh = 0; mh < 2; ++mh) {
                f32x4 cs[2][4];
#pragma unroll
                for (int m2 = 0; m2 < 2; ++m2) { const int m = m2; const size_t tr = (size_t)(row0 + ai * HALF + (2 * mh + m2) * 16) * 32 + 8 * fq;
                    cs[m][0] = *(const f32x4*)(cosT + tr); cs[m][1] = *(const f32x4*)(cosT + tr + 4); cs[m][2] = *(const f32x4*)(sinT + tr); cs[m][3] = *(const f32x4*)(sinT + tr + 4); }
#pragma unroll
                for (int m2 = 0; m2 < 2; ++m2) { const int m = 2 * mh + m2; const int row = row0 + ai * HALF + m * 16; const float rrm = rtab[u.ro + wr * 64 + ai * HALF + m * 16 + fr];
                    const f32x4 c0 = cs[m2][0], c1 = cs[m2][1], s0 = cs[m2][2], s1 = cs[m2][3];
                    const f32x4 a0 = acc[ai][0][m][0] * rrm + cv4[0][0], a1 = acc[ai][0][m][1] * rrm + cv4[0][1], b0 = acc[ai][1][m][0] * rrm + cv4[1][0], b1 = acc[ai][1][m][1] * rrm + cv4[1][1];
                    const f32x4 o10 = (a0 * c0 - b0 * s0) * sc, o11 = (a1 * c1 - b1 * s1) * sc, o20 = (b0 * c0 + a0 * s0) * sc, o21 = (b1 * c1 + a1 * s1) * sc;
                    bf16_t* rp = dst + (size_t)row * pitch + 8 * fq;
                    *(u32x4*)(rp) = pack8(o10, o11); *(u32x4*)(rp + 32) = pack8(o20, o21); } } }
        } else if (u.pn == 4) {
#pragma unroll
            for (int ai = 0; ai < 2; ++ai)
#pragma unroll
                for (int m = 0; m < 4; ++m) { if (ai == 1 && u.nar) break; bf16_t* rowp = V + (size_t)(row0 + ai * HALF + m * 16) * 128 + (wc - 2) * 32 + 8 * fq; const float rrm = rtab[u.ro + wr * 64 + ai * HALF + m * 16 + fr];
#pragma unroll
                    for (int bj = 0; bj < 2; ++bj) *(u32x4*)(rowp + bj * 64) = pack8(acc[ai][bj][m][0] * rrm + cv4[bj][0], acc[ai][bj][m][1] * rrm + cv4[bj][1]); }
        } else {
            const int col0 = (u.pn - 5) * 256 + wc * 32 + 8 * fq;
#pragma unroll
            for (int ai = 0; ai < 2; ++ai)
#pragma unroll
                for (int m = 0; m < 4; ++m) { if (ai == 1 && u.nar) break; bf16_t* rowp = U + ((size_t)(col0 >> 4) * 8192 + (size_t)(row0 + ai * HALF + m * 16)) * 16 + (col0 & 8); const float rrm = rtab[u.ro + wr * 64 + ai * HALF + m * 16 + fr];
#pragma unroll
                    for (int bj = 0; bj < 2; ++bj) *(u32x4*)(rowp + (size_t)bj * 8 * 8192 * 16) = pack8(acc[ai][bj][m][0] * rrm + cv4[bj][0], acc[ai][bj][m][1] * rrm + cv4[bj][1]); }
        }
    }
};

struct EpiResid {
    static constexpr bool PERM = true, AFTER_DRAIN = false;
    const float* base32; const bf16_t* baseb; bf16_t* outb; float* out32; const float* gate; bf16_t* Hn; const float* gn; const float* scn; float* ssn; PG8_LAS float* xs;
    template <bool F32BASE, int MB>
    __device__ __forceinline__ void rows(const f32x4 (&acc)[2][2][4][2], const Unit& u, int ai, int wc, int fq, int row0, int col0, const f32x4 (&gv)[2][2], const f32x4 (&an)[2][2]) const {
#pragma unroll
        for (int mb = 0; mb < 4 / MB; ++mb) {
            f32x4 b32[F32BASE ? MB : 1][2][2]; u32x4 b16[F32BASE ? 1 : MB][2];
#pragma unroll
            for (int m2 = 0; m2 < MB; ++m2) { const size_t off = (size_t)(row0 + ai * HALF + (MB * mb + m2) * 16) * 2048 + col0;
#pragma unroll
                for (int bj = 0; bj < 2; ++bj) {
                    if constexpr (F32BASE) { b32[m2][bj][0] = *(const f32x4*)(base32 + off + bj * HALF); b32[m2][bj][1] = *(const f32x4*)(base32 + off + bj * HALF + 4); }
                    else b16[m2][bj] = *(const u32x4*)(baseb + off + bj * HALF); } }
            float s2v[MB];
#pragma unroll
            for (int m2 = 0; m2 < MB; ++m2) { const int m = MB * mb + m2; const int row = row0 + ai * HALF + m * 16; const size_t off = (size_t)row * 2048 + col0; float s2 = 0.f;
#pragma unroll
                for (int bj = 0; bj < 2; ++bj) {
                    f32x4 x0, x1;
                    if constexpr (F32BASE) { x0 = b32[m2][bj][0]; x1 = b32[m2][bj][1]; }
                    else { const u32x4 w = b16[m2][bj]; x0 = (f32x4){bf_lo(w.x), bf_hi(w.x), bf_lo(w.y), bf_hi(w.y)}; x1 = (f32x4){bf_lo(w.z), bf_hi(w.z), bf_lo(w.w), bf_hi(w.w)}; }
                    const f32x4 o0 = x0 + gv[bj][0] * acc[ai][bj][m][0], o1 = x1 + gv[bj][1] * acc[ai][bj][m][1];
                    if (out32) { *(f32x4*)(out32 + off + bj * HALF) = o0; *(f32x4*)(out32 + off + bj * HALF + 4) = o1; }
                    else *(u32x4*)(outb + off + bj * HALF) = pack8(o0, o1);
                    if (Hn) { s2 += ((o0[0] * o0[0] + o0[1] * o0[1]) + (o0[2] * o0[2] + o0[3] * o0[3])) + ((o1[0] * o1[0] + o1[1] * o1[1]) + (o1[2] * o1[2] + o1[3] * o1[3]));
                        *(u32x4*)(Hn + off + bj * HALF) = pack8(o0 * an[bj][0], o1 * an[bj][1]); } }
                s2v[m2] = s2;
            }
            if (Hn) {
#pragma unroll
                for (int m2 = 0; m2 < MB; ++m2) { const int row = row0 + ai * HALF + (MB * mb + m2) * 16;
                    auto p16 = __builtin_amdgcn_permlane16_swap(__float_as_uint(s2v[m2]), __float_as_uint(s2v[m2]), false, false); const float q = __uint_as_float(p16[0]) + __uint_as_float(p16[1]);
                    auto p32 = __builtin_amdgcn_permlane32_swap(__float_as_uint(q), __float_as_uint(q), false, false);
                    if (fq == 0) xs[wc * 256 + row - u.pm * BM] = __uint_as_float(p32[0]) + __uint_as_float(p32[1]); }
            }
        }
    }
    __device__ __forceinline__ void operator()(const f32x4 (&acc)[2][2][4][2], const Unit& u, int wr, int wc, int fr, int fq) const {
        asm volatile("" : "+v"(fr), "+v"(fq));
        const int row0 = u.pm * BM + wr * 64 + fr, col0 = u.pn * BM + wc * 32 + 8 * fq; const float* gp = gate + (size_t)(u.pm >> 3) * 12288 + col0;
        f32x4 gv[2][2], an[2][2];
#pragma unroll
        for (int bj = 0; bj < 2; ++bj)
#pragma unroll
            for (int n = 0; n < 2; ++n) { gv[bj][n] = *(const f32x4*)(gp + bj * HALF + n * 4);
                an[bj][n] = Hn ? *(const f32x4*)(gn + col0 + bj * HALF + n * 4) * (1.0f + *(const f32x4*)(scn + (size_t)(u.pm >> 3) * 12288 + col0 + bj * HALF + n * 4)) : (f32x4){0.f, 0.f, 0.f, 0.f}; }
#pragma unroll
        for (int ai = 0; ai < 2; ++ai) { if (base32) rows<true, 2>(acc, u, ai, wc, fq, row0, col0, gv, an); else rows<false, 4>(acc, u, ai, wc, fq, row0, col0, gv, an); }
        if (Hn) {
            asm volatile("s_waitcnt lgkmcnt(0)" ::: "memory"); __builtin_amdgcn_s_barrier(); asm volatile("" ::: "memory");
            const int t = (wr * 4 + wc) * 64 + fq * 16 + fr;
            if (t < 256) ssn[((size_t)u.pm * BM + t) * 8 + u.pn] = (xs[t] + xs[256 + t]) + (xs[512 + t] + xs[768 + t]);
        }
    }
};

struct EpiFinal {
    static constexpr bool PERM = true, AFTER_DRAIN = false;
    const bf16_t* baseb; const float* gate; const float* gfin; float* fin; float* fpart; unsigned* fcnt; PG8_LAS float* xs; PG8_LAS float* rt;
    template <int MODE>
    __device__ __forceinline__ void rows(const f32x4 (&acc)[2][2][4][2], const Unit& u, int ai, int wc, int fq, int row0, int col0, const f32x4 (&gv)[2][2], const f32x4 (&gf)[2][2]) const {
        u32x4 b16[4][2];
#pragma unroll
        for (int m = 0; m < 4; ++m)
#pragma unroll
            for (int bj = 0; bj < 2; ++bj) b16[m][bj] = *(const u32x4*)(baseb + (size_t)(row0 + ai * HALF + m * 16) * 2048 + col0 + bj * HALF);
        float s2v[4];
#pragma unroll
        for (int m = 0; m < 4; ++m) { const int row = row0 + ai * HALF + m * 16; const size_t off = (size_t)row * 2048 + col0; float s2 = 0.f; const float r = MODE == 2 ? rt[row - u.pm * BM] : 0.f;
#pragma unroll
            for (int bj = 0; bj < 2; ++bj) { const u32x4 w = b16[m][bj];
                const f32x4 x0 = (f32x4){bf_lo(w.x), bf_hi(w.x), bf_lo(w.y), bf_hi(w.y)}, x1 = (f32x4){bf_lo(w.z), bf_hi(w.z), bf_lo(w.w), bf_hi(w.w)};
                const f32x4 o0 = x0 + gv[bj][0] * acc[ai][bj][m][0], o1 = x1 + gv[bj][1] * acc[ai][bj][m][1];
                if (MODE == 1) s2 += ((o0[0] * o0[0] + o0[1] * o0[1]) + (o0[2] * o0[2] + o0[3] * o0[3])) + ((o1[0] * o1[0] + o1[1] * o1[1]) + (o1[2] * o1[2] + o1[3] * o1[3]));
                else { *(f32x4*)(fin + off + bj * HALF) = o0 * r * gf[bj][0]; *(f32x4*)(fin + off + bj * HALF + 4) = o1 * r * gf[bj][1]; } }
            s2v[m] = s2; }
        if (MODE == 1) {
#pragma unroll
            for (int m = 0; m < 4; ++m) { const int row = row0 + ai * HALF + m * 16;
                auto p16 = __builtin_amdgcn_permlane16_swap(__float_as_uint(s2v[m]), __float_as_uint(s2v[m]), false, false); const float q = __uint_as_float(p16[0]) + __uint_as_float(p16[1]);
                auto p32 = __builtin_amdgcn_permlane32_swap(__float_as_uint(q), __float_as_uint(q), false, false);
                if (fq == 0) xs[wc * 256 + row - u.pm * BM] = __uint_as_float(p32[0]) + __uint_as_float(p32[1]); } }
    }
    __device__ __forceinline__ void operator()(const f32x4 (&acc)[2][2][4][2], const Unit& u, int wr, int wc, int fr, int fq) const {
        asm volatile("" : "+v"(fr), "+v"(fq));
        const int row0 = u.pm * BM + wr * 64 + fr, col0 = u.pn * BM + wc * 32 + 8 * fq; const float* gp = gate + (size_t)(u.pm >> 3) * 12288 + col0;
        f32x4 gv[2][2], gf[2][2];
#pragma unroll
        for (int bj = 0; bj < 2; ++bj)
#pragma unroll
            for (int n = 0; n < 2; ++n) { gv[bj][n] = *(const f32x4*)(gp + bj * HALF + n * 4); gf[bj][n] = *(const f32x4*)(gfin + col0 + bj * HALF + n * 4); }
#pragma unroll
        for (int ai = 0; ai < 2; ++ai) rows<1>(acc, u, ai, wc, fq, row0, col0, gv, gf);
        asm volatile("s_waitcnt lgkmcnt(0)" ::: "memory"); __builtin_amdgcn_s_barrier(); asm volatile("" ::: "memory");
        const int t = (wr * 4 + wc) * 64 + fq * 16 + fr;
        if (t < 256) __hip_atomic_store((unsigned*)(fpart + ((size_t)u.pm * BM + t) * 8 + u.pn), __float_as_uint((xs[t] + xs[256 + t]) + (xs[512 + t] + xs[768 + t])), __ATOMIC_RELAXED, __HIP_MEMORY_SCOPE_AGENT);
        asm volatile("s_waitcnt vmcnt(0)" ::: "memory"); __builtin_amdgcn_s_barrier(); asm volatile("" ::: "memory");
        if (t == 0) (void)__hip_atomic_fetch_add(fcnt + u.pm * 16, 1u, __ATOMIC_RELAXED, __HIP_MEMORY_SCOPE_AGENT);
        if (wr == 0 && wc == 0) { unsigned sp = 0; while (__hip_atomic_load(fcnt + u.pm * 16, __ATOMIC_RELAXED, __HIP_MEMORY_SCOPE_AGENT) < 8u && ++sp < (1u << 22)) __builtin_amdgcn_s_sleep(1);
            __builtin_amdgcn_fence(__ATOMIC_ACQUIRE, "agent"); asm volatile("s_waitcnt vmcnt(0)" ::: "memory"); }
        __builtin_amdgcn_s_barrier(); asm volatile("" ::: "memory");
        if (t < 256) { const float* pp = fpart + ((size_t)u.pm * BM + t) * 8; const f32x4 pa = *(const f32x4*)pp, pb = *(const f32x4*)(pp + 4);
            rt[t] = rsqrtf((((pa[0] + pa[1]) + (pa[2] + pa[3])) + ((pb[0] + pb[1]) + (pb[2] + pb[3]))) * (1.0f / 2048.0f) + 1e-6f); }
        asm volatile("s_waitcnt lgkmcnt(0)" ::: "memory"); __builtin_amdgcn_s_barrier(); asm volatile("" ::: "memory");
#pragma unroll
        for (int ai = 0; ai < 2; ++ai) rows<2>(acc, u, ai, wc, fq, row0, col0, gv, gf);
    }
};

struct EpiGlu {
    static constexpr bool PERM = true, AFTER_DRAIN = false;
    const bf16_t* Z; bf16_t* MIX; const float* gb;
    __device__ __forceinline__ void operator()(const f32x4 (&acc)[2][2][4][2], const Unit& u, int wr, int wc, int fr, int fq) const {
        const int row0 = u.pm * BM + wr * 64 + fr, col0 = u.pn * BM + wc * 32 + 8 * fq;
        f32x4 bv[2][2];
#pragma unroll
        for (int bj = 0; bj < 2; ++bj)
#pragma unroll
            for (int n = 0; n < 2; ++n) bv[bj][n] = *(const f32x4*)(gb + col0 + bj * HALF + 4 * n);
#pragma unroll
        for (int ai = 0; ai < 2; ++ai) {
#pragma unroll
          for (int mh = 0; mh < 1; ++mh) {
            u32x4 zq[4][2];
#pragma unroll
            for (int m2 = 0; m2 < 4; ++m2)
#pragma unroll
                for (int bj = 0; bj < 2; ++bj) zq[m2][bj] = *(const u32x4*)(Z + (size_t)(row0 + ai * HALF + m2 * 16) * 1024 + col0 + bj * HALF);
#pragma unroll
            for (int m2 = 0; m2 < 4; ++m2) { const int m = m2; const size_t row = (size_t)(row0 + ai * HALF + m * 16);
#pragma unroll
                for (int bj = 0; bj < 2; ++bj) { const u32x4 zr = zq[m2][bj];
                    const f32x4 v0 = acc[ai][bj][m][0] + bv[bj][0], v1 = acc[ai][bj][m][1] + bv[bj][1];
                    const f32x4 z0 = (f32x4){bf_lo(zr.x), bf_hi(zr.x), bf_lo(zr.y), bf_hi(zr.y)}, z1 = (f32x4){bf_lo(zr.z), bf_hi(zr.z), bf_lo(zr.w), bf_hi(zr.w)};
                    const f32x4 o0 = (f32x4){z0[0] * sigmoidf_fast(v0[0]), z0[1] * sigmoidf_fast(v0[1]), z0[2] * sigmoidf_fast(v0[2]), z0[3] * sigmoidf_fast(v0[3])};
                    const f32x4 o1 = (f32x4){z1[0] * sigmoidf_fast(v1[0]), z1[1] * sigmoidf_fast(v1[1]), z1[2] * sigmoidf_fast(v1[2]), z1[3] * sigmoidf_fast(v1[3])};
                    *(u32x4*)(MIX + row * 2048 + 1024 + col0 + bj * HALF) = pack8(o0, o1); } } } }
    }
};

__device__ __forceinline__ float dpp_ror1(float v) { return __builtin_bit_cast(float, __builtin_amdgcn_update_dpp(0, __builtin_bit_cast(int, v), 0x121, 0xf, 0xf, false)); }
__device__ __forceinline__ float dpp_ror2(float v) { return __builtin_bit_cast(float, __builtin_amdgcn_update_dpp(0, __builtin_bit_cast(int, v), 0x122, 0xf, 0xf, false)); }
__device__ __forceinline__ float dpp_shr1(float old, float v) { return __builtin_bit_cast(float, __builtin_amdgcn_update_dpp(__builtin_bit_cast(int, old), __builtin_bit_cast(int, v), 0x111, 0xf, 0xf, false)); }
__device__ __forceinline__ float dpp_shr2(float old, float v) { return __builtin_bit_cast(float, __builtin_amdgcn_update_dpp(__builtin_bit_cast(int, old), __builtin_bit_cast(int, v), 0x112, 0xf, 0xf, false)); }
struct EpiFfnIn {
    static constexpr bool PERM = true, AFTER_DRAIN = false;
    bf16_t* ACT; float* halo_first; float* halo_last; size_t hmid; const float* cw; const float* cb; PG8_LAS float* exch; PG8_LAS const unsigned char* ssb; const float* cv;
    __device__ __forceinline__ void operator()(f32x4 (&acc)[2][2][4][2], const Unit& u, int wr, int wc, int fr, int fq) const {
        asm volatile("" : "+v"(fr), "+v"(fq));
        const int jj0 = wc * 32 + 8 * fq, jcol = u.pn * 128 + jj0; const bool nar = u.nar != 0;
        f32x4 cv4[2][2];
#pragma unroll
        for (int bj = 0; bj < 2; ++bj)
#pragma unroll
            for (int n = 0; n < 2; ++n) cv4[bj][n] = *(const f32x4*)(cv + (size_t)(u.pm >> 3) * 11008 + u.pn * BM + bj * HALF + jj0 + 4 * n);
        f32x4 wq[4][2];
#pragma unroll
        for (int bj = 0; bj < 2; ++bj) { const int col = bj * 5504 + jcol;
            wq[0][bj] = *(const f32x4*)(cw + col); wq[1][bj] = *(const f32x4*)(cw + 11008 + col); wq[2][bj] = *(const f32x4*)(cw + 22016 + col); wq[3][bj] = *(const f32x4*)(cb + col); }
        build_rtab(ssb, exch + 1536, wr, wc, fr, fq);
        {
#pragma unroll
            for (int ai = 0; ai < 2; ++ai)
#pragma unroll
                for (int m = 0; m < 4; ++m) { if (ai == 1 && nar) break; const float r = exch[1536 + u.ro + ai * HALF + wr * 64 + m * 16 + fr];
#pragma unroll
                    for (int bj = 0; bj < 2; ++bj)
#pragma unroll
                        for (int n = 0; n < 2; ++n) acc[ai][bj][m][n] = acc[ai][bj][m][n] * r + cv4[bj][n]; }
        }
        float* hlast = halo_last + ((nar && u.ro == 0) ? hmid : (size_t)0); float* hfirst = halo_first + (u.ro ? hmid : (size_t)0);
        if (fr >= 14) { const int r2 = fr - 14;
#pragma unroll
            for (int bj = 0; bj < 2; ++bj)
#pragma unroll
                for (int n = 0; n < 2; ++n) {
                    *(PG8_LAS f32x4*)(exch + ((wr * 2 + r2) * 2 + bj) * 128 + jj0 + 4 * n) = acc[0][bj][3][n];
                    if (!nar) {
                        if (wr == 0) *(PG8_LAS f32x4*)(exch + ((2 * 2 + r2) * 2 + bj) * 128 + jj0 + 4 * n) = acc[1][bj][3][n];
                        else *(f32x4*)(hlast + ((size_t)(u.pm * 2 + r2) * 2 + bj) * 5504 + jcol + 4 * n) = acc[1][bj][3][n];
                    } else if (wr == 1) *(f32x4*)(hlast + ((size_t)(u.pm * 2 + r2) * 2 + bj) * 5504 + jcol + 4 * n) = acc[0][bj][3][n];
                } }
        if (wr == 0 && fr < 2) {
#pragma unroll
            for (int bj = 0; bj < 2; ++bj)
#pragma unroll
                for (int n = 0; n < 2; ++n) *(f32x4*)(hfirst + ((size_t)(u.pm * 2 + fr) * 2 + bj) * 5504 + jcol + 4 * n) = acc[0][bj][0][n]; }
        asm volatile("s_waitcnt lgkmcnt(0)" ::: "memory"); __builtin_amdgcn_s_barrier(); asm volatile("" ::: "memory");
        const bool seq_start = (u.pm & 7) == 0 && u.ro == 0;
        u32x2 held[2][4];
#pragma unroll
        for (int n = 0; n < 2; ++n) {
            f32x4 w0[2], w1[2], w2[2], bb[2];
#pragma unroll
            for (int bj = 0; bj < 2; ++bj) { const int col = bj * 5504 + jcol + 4 * n;
                if (n == 0) { w0[bj] = wq[0][bj]; w1[bj] = wq[1][bj]; w2[bj] = wq[2][bj]; bb[bj] = wq[3][bj]; }
                else { w0[bj] = *(const f32x4*)(cw + col); w1[bj] = *(const f32x4*)(cw + 11008 + col); w2[bj] = *(const f32x4*)(cw + 22016 + col); bb[bj] = *(const f32x4*)(cb + col); } }
#pragma unroll
            for (int ai = 0; ai < 2; ++ai) { if (ai == 1 && nar) break;
                f32x4 prev[2];
                const int slot = 2 * ai + wr - 1;
#pragma unroll
                for (int bj = 0; bj < 2; ++bj) prev[bj] = (slot >= 0) ? *(const PG8_LAS f32x4*)(exch + ((slot * 2 + (fr & 1)) * 2 + bj) * 128 + jj0 + 4 * n) : (f32x4){0.f, 0.f, 0.f, 0.f};
#pragma unroll
                for (int m = 0; m < 4; ++m) {
                    f32x4 cv[2];
#pragma unroll
                    for (int bj = 0; bj < 2; ++bj) { const f32x4 cur = acc[ai][bj][m][n]; f32x4 o;
#pragma unroll
                        for (int q = 0; q < 4; ++q) { const float um1 = dpp_shr1(dpp_ror1(prev[bj][q]), cur[q]), um2 = dpp_shr2(dpp_ror2(prev[bj][q]), cur[q]);
                            o[q] = bb[bj][q] + w0[bj][q] * um2 + w1[bj][q] * um1 + w2[bj][q] * cur[q]; }
                        cv[bj] = o; prev[bj] = cur; }
                    const f32x4 o0 = gelu4(cv[0]) * cv[1];
                    u32x2 w; w.x = cvt_pk_bf16(o0[0], o0[1]); w.y = cvt_pk_bf16(o0[2], o0[3]);
                    if (n == 0) held[ai][m] = w;
                    else { const bool skip = (ai == 0 && m == 0) && wr == 0 && fr < 2 && !seq_start;
                        if (!skip) *(u32x4*)(ACT + (size_t)(u.pm * BM + u.ro + ai * HALF + wr * 64 + m * 16 + fr) * 5504 + jcol) = (u32x4){held[ai][m].x, held[ai][m].y, w.x, w.y}; }
                }
            }
        }
    }
};
template <class Epi, class Sched, bool ALIGN_EPI = false, bool SP2 = false, bool SPLIT = false>
__device__ __forceinline__ void gemm_phase(PG8_LAS unsigned char* lds, const Gemm g, const Sched& S, const Epi& E, int tid_in) {
    int tid = tid_in; asm volatile("" : "+v"(tid));
    const int wid = __builtin_amdgcn_readfirstlane(tid >> 6), lane = tid & 63, wr = wid >> 2, wc = wid & 3, fr = lane & 15, fq = lane >> 4;
    const int K = g.K, nt = K / BK;
    unsigned voffA[2], voffB[2];
#pragma unroll
    for (int i = 0; i < 2; ++i) { int R, C; stage_rc(tid * 16 + i * 8192, R, C); const int Rb = Epi::PERM ? ((R & ~31) + perm32(R & 31)) : R;
        voffA[i] = (unsigned)(R * K + C) * 2u; voffB[i] = (unsigned)(Rb * K + C) * 2u; }
    const size_t kstep = (size_t)(BK * 2);
    const size_t hstep = (size_t)HALF * K * 2;
    const size_t tstep = 2 * hstep;
    const unsigned ldsw = (unsigned)wid * 1024u;
    const int aoff = lds_byte(wr * 64 + fr, fq * 8), boff = lds_byte(wc * 32 + fr, fq * 8);
#define PG8_SA(b, h) (((b) * 2 + (h)) * HTB)
#define PG8_SB(b, h) ((4 + (b) * 2 + (h)) * HTB)
#define PG8_STAGE(bufoff, gbase, voff) do { _Pragma("unroll") for (int _i = 0; _i < 2; ++_i) \
        __builtin_amdgcn_global_load_lds((const unsigned*)((const char*)(gbase) + (voff)[_i]), (PG8_LAS unsigned*)(lds + (bufoff) + ldsw + _i * 8192), 16, 0, 0); } while (0)
#define PG8_LDA(dst, b, h) do { _Pragma("unroll") for (int m = 0; m < 4; ++m) _Pragma("unroll") for (int k = 0; k < 2; ++k) dst[m][k] = *(const PG8_LAS bf16x8*)(lds + PG8_SA(b, h) + aoff + m * 2048 + k * 1024); } while (0)
#define PG8_LDB(dst, b, h) do { _Pragma("unroll") for (int n = 0; n < 2; ++n) _Pragma("unroll") for (int k = 0; k < 2; ++k) dst[n][k] = *(const PG8_LAS bf16x8*)(lds + PG8_SB(b, h) + boff + n * 2048 + k * 1024); } while (0)
#define PG8_MMA(ai, bj, At, Bt) do { __builtin_amdgcn_s_setprio(1); _Pragma("unroll") for (int m = 0; m < 4; ++m) _Pragma("unroll") for (int n = 0; n < 2; ++n) _Pragma("unroll") for (int k = 0; k < 2; ++k) \
        acc[ai][bj][m][n] = __builtin_amdgcn_mfma_f32_16x16x32_bf16(Bt[n][k], At[m][k], acc[ai][bj][m][n], 0, 0, 0); __builtin_amdgcn_s_setprio(0); } while (0)
#define PG8_WAIT_V(n) asm volatile("s_waitcnt vmcnt(" #n ")" ::: "memory")
#define PG8_WAIT_L(n) asm volatile("s_waitcnt lgkmcnt(" #n ")" ::: "memory")
#define PG8_BAR __builtin_amdgcn_s_barrier()
#define PG8_SCHED __builtin_amdgcn_sched_barrier(0)
#define PG8_KLOOP_SP2(NARV)         for (int t = 0; t < nt; t += 2) { \
            const bool last = (t == nt - 2); \
            const char* a1 = cA + (size_t)(t + 1) * kstep; \
            const char* a2 = last ? nA : cA + (size_t)(t + 2) * kstep; const char* b2 = last ? nB : cB + (size_t)(t + 2) * kstep; \
            const char* a3 = a2 + kstep; const char* b3 = b2 + kstep; \
            if (last && has_next) S.a_ready(nxt); \
            PG8_LDB(B0, 0, 0); PG8_LDB(B1, 0, 1); PG8_SCHED; PG8_LDA(At, 0, 0); PG8_STAGE(PG8_SA(1, 1), a1 + hstep, voffA); \
            PG8_WAIT_V(8); PG8_WAIT_L(0); PG8_BAR; PG8_MMA(0, 0, At, B0); PG8_MMA(0, 1, At, B1); PG8_BAR; PG8_SCHED; \
            if (!(NARV)) PG8_LDA(At, 0, 1); PG8_STAGE(PG8_SB(0, 0), b2, voffB); PG8_STAGE(PG8_SB(0, 1), b2 + hstep, voffB); PG8_STAGE(PG8_SA(0, 0), a2, voffA); \
            PG8_WAIT_V(8); PG8_WAIT_L(0); PG8_BAR; if (!(NARV)) { PG8_MMA(1, 0, At, B0); PG8_MMA(1, 1, At, B1); } PG8_BAR; PG8_SCHED; \
            PG8_LDB(B0, 1, 0); PG8_LDB(B1, 1, 1); PG8_SCHED; PG8_LDA(At, 1, 0); PG8_STAGE(PG8_SA(0, 1), a2 + hstep, voffA); \
            PG8_WAIT_V(8); PG8_WAIT_L(0); PG8_BAR; PG8_MMA(0, 0, At, B0); PG8_MMA(0, 1, At, B1); PG8_BAR; PG8_SCHED; \
            if (!(NARV)) PG8_LDA(At, 1, 1); PG8_STAGE(PG8_SB(1, 0), b3, voffB); PG8_STAGE(PG8_SB(1, 1), b3 + hstep, voffB); PG8_STAGE(PG8_SA(1, 0), a3, voffA); \
            PG8_WAIT_V(8); PG8_WAIT_L(0); PG8_BAR; if (!(NARV)) { PG8_MMA(1, 0, At, B0); PG8_MMA(1, 1, At, B1); } PG8_BAR; PG8_SCHED; \
        }
    Unit cur, nxt; int ui = 0;
    if (!S.next(0, cur)) return;
    if constexpr (!SPLIT) { cur.ro = 0; cur.nar = 0; }
    f32x4 acc[2][2][4][2];
#pragma unroll
    for (int a = 0; a < 2; ++a)
#pragma unroll
        for (int b = 0; b < 2; ++b)
#pragma unroll
            for (int m = 0; m < 4; ++m)
#pragma unroll
                for (int n = 0; n < 2; ++n) acc[a][b][m][n] = (f32x4){0.f, 0.f, 0.f, 0.f};
    bf16x8 At[4][2], B0[2][2], B1[2][2];
    const char* cA = (const char*)g.A + (size_t)cur.pm * tstep + (cur.ro ? hstep : (size_t)0); const char* cB = (const char*)g.Bt + (size_t)cur.pn * tstep;
    S.a_ready(cur);
    if constexpr (SP2) {
        PG8_STAGE(PG8_SB(0, 0), cB, voffB); PG8_STAGE(PG8_SB(0, 1), cB + hstep, voffB); PG8_STAGE(PG8_SA(0, 0), cA, voffA); PG8_STAGE(PG8_SA(0, 1), cA + hstep, voffA);
        PG8_STAGE(PG8_SB(1, 0), cB + kstep, voffB); PG8_STAGE(PG8_SA(1, 0), cA + kstep, voffA); PG8_STAGE(PG8_SB(1, 1), cB + hstep + kstep, voffB);
        if (wr == 1) PG8_BAR;
        PG8_WAIT_V(8); PG8_BAR;
        PG8_WAIT_V(6); PG8_BAR;
    } else {
        PG8_STAGE(PG8_SB(0, 0), cB, voffB); PG8_STAGE(PG8_SA(0, 0), cA, voffA); PG8_STAGE(PG8_SB(0, 1), cB + hstep, voffB); PG8_STAGE(PG8_SA(0, 1), cA + hstep, voffA);
        if (wr == 1) PG8_BAR;
        PG8_WAIT_V(4); PG8_BAR;
        PG8_STAGE(PG8_SB(1, 0), cB + kstep, voffB); PG8_STAGE(PG8_SA(1, 0), cA + kstep, voffA); PG8_STAGE(PG8_SB(1, 1), cB + hstep + kstep, voffB);
        PG8_WAIT_V(6); PG8_BAR;
    }
    for (;;) {
        const bool has_next = S.next(ui + 1, nxt);
        if constexpr (!SPLIT) { nxt.ro = 0; nxt.nar = 0; }
        const char* nA = has_next ? (const char*)g.A + (size_t)nxt.pm * tstep + (nxt.ro ? hstep : (size_t)0) : cA; const char* nB = has_next ? (const char*)g.Bt + (size_t)nxt.pn * tstep : cB;
        const bool nar = SPLIT && cur.nar != 0;
        if constexpr (SP2) {
            if (nar) { PG8_KLOOP_SP2(true) } else { PG8_KLOOP_SP2(false) }
        } else {
        for (int t = 0; t < nt; t += 2) {
            const bool last = (t == nt - 2);
            const char* a1 = cA + (size_t)(t + 1) * kstep;
            const char* a2 = last ? nA : cA + (size_t)(t + 2) * kstep; const char* b2 = last ? nB : cB + (size_t)(t + 2) * kstep;
            const char* a3 = a2 + kstep; const char* b3 = b2 + kstep;
            if (last && has_next) S.a_ready(nxt);
            PG8_LDB(B0, 0, 0); PG8_SCHED; PG8_LDA(At, 0, 0); PG8_STAGE(PG8_SA(1, 1), a1 + hstep, voffA);
            PG8_WAIT_L(8); PG8_BAR; PG8_WAIT_L(0); PG8_MMA(0, 0, At, B0); PG8_BAR; PG8_SCHED;
            PG8_LDB(B1, 0, 1); PG8_STAGE(PG8_SB(0, 0), b2, voffB);
            PG8_BAR; PG8_WAIT_L(0); PG8_MMA(0, 1, At, B1); PG8_BAR;
            PG8_LDA(At, 0, 1); PG8_STAGE(PG8_SA(0, 0), a2, voffA);
            PG8_BAR; PG8_WAIT_L(0); PG8_MMA(1, 0, At, B0); PG8_BAR; PG8_SCHED;
            PG8_STAGE(PG8_SB(0, 1), b2 + hstep, voffB);
            PG8_WAIT_V(6); PG8_BAR; PG8_MMA(1, 1, At, B1); PG8_BAR;
            PG8_LDB(B0, 1, 0); PG8_SCHED; PG8_LDA(At, 1, 0); PG8_STAGE(PG8_SA(0, 1), a2 + hstep, voffA);
            PG8_WAIT_L(8); PG8_BAR; PG8_WAIT_L(0); PG8_MMA(0, 0, At, B0); PG8_BAR; PG8_SCHED;
            PG8_LDB(B1, 1, 1); PG8_STAGE(PG8_SB(1, 0), b3, voffB);
            PG8_BAR; PG8_WAIT_L(0); PG8_MMA(0, 1, At, B1); PG8_BAR;
            PG8_LDA(At, 1, 1); PG8_STAGE(PG8_SA(1, 0), a3, voffA);
            PG8_BAR; PG8_WAIT_L(0); PG8_MMA(1, 0, At, B0); PG8_BAR; PG8_SCHED;
            PG8_STAGE(PG8_SB(1, 1), b3 + hstep, voffB);
            PG8_WAIT_V(6); PG8_BAR; PG8_MMA(1, 1, At, B1); PG8_BAR;
        }
        }
        if constexpr (ALIGN_EPI) { if (wr == 0) PG8_BAR; }
        if constexpr (!Epi::AFTER_DRAIN) { E(acc, cur, wr, wc, fr, fq); S.done(cur); }
        if (!has_next) break;
#pragma unroll
        for (int a = 0; a < 2; ++a)
#pragma unroll
            for (int b = 0; b < 2; ++b)
#pragma unroll
                for (int m = 0; m < 4; ++m)
#pragma unroll
                    for (int n = 0; n < 2; ++n) acc[a][b][m][n] = (f32x4){0.f, 0.f, 0.f, 0.f};
        cur = nxt; cA = nA; cB = nB; ++ui;
        if constexpr (ALIGN_EPI) { if (wr == 1) PG8_BAR; }
    }
    PG8_WAIT_V(0);
    if constexpr (!ALIGN_EPI) { if (wr == 0) PG8_BAR; }
    PG8_BAR;
    if constexpr (Epi::AFTER_DRAIN) { E.fused(acc, cur, wr, wc, fr, fq, lds, wid, lane); S.done(cur); }
#undef PG8_KLOOP_SP2
#undef PG8_SA
#undef PG8_SB
#undef PG8_STAGE
#undef PG8_LDA
#undef PG8_LDB
#undef PG8_MMA
#undef PG8_WAIT_V
#undef PG8_WAIT_L
#undef PG8_BAR
#undef PG8_SCHED
}
}

constexpr int DM = 2048, NB = 4, SEQ = 2048, MT = NB * SEQ, NLAYER = 4;
constexpr int EVEN_IN = 5120, ODD_IN = 2304, DFF = 5504, DFF2 = 11008;
constexpr float LOG2E = 1.4426950408889634f;
constexpr float QSCALE_A = 0.08838834764831845f * LOG2E;
constexpr float QSCALE_C = 0.125f * LOG2E;
enum { I_X = 0, I_C, I_POS, I_ADA_W, I_ADA_B, I_NORM_MIX, I_NORM_FFN, I_NORM_FINAL,
       I_EV_W_IN, I_EV_CONV_W, I_EV_CONV_B, I_EV_GA_W, I_EV_GA_B, I_EV_GX_W, I_EV_GX_B, I_EV_LAMBDA, I_EV_W_OUT,
       I_OD_W_IN, I_OD_SINKS, I_OD_A_RE, I_OD_A_IM, I_OD_B_RE, I_OD_B_IM, I_OD_C_RE, I_OD_C_IM, I_OD_D, I_OD_LOG_DT, I_OD_GLU_W, I_OD_GLU_B, I_OD_W_OUT,
       I_FFN_W_IN, I_FFN_CONV_W, I_FFN_CONV_B, I_FFN_W_OUT, N_INPUTS };
constexpr size_t MiB = 1u << 20;
constexpr size_t WS_CTL = 0, CTL_ZERO_BYTES = 65536;
constexpr size_t WS_SS = 516 * MiB;
constexpr size_t WS_CVEC = 524288;
constexpr int CV_EVIN = 0, CV_ODIN = 2 * 4 * 5120, CV_FFIN = CV_ODIN + 2 * 4 * 2304;
constexpr int CV_TOTAL = CV_FFIN + 4 * 4 * 11008;
constexpr size_t WS_CVPART = 526 * MiB;
constexpr size_t WS_MOD = 11 * MiB;
constexpr size_t WS_COSA = 2 * MiB, WS_SINA = 4 * MiB, WS_COSC = 6 * MiB, WS_SINC = 7 * MiB;
constexpr size_t WS_S5T = 8 * MiB;
constexpr size_t WS_WGATE = 10 * MiB;
constexpr size_t WS_W_EVIN = 12 * MiB, WS_W_EVOUT = 52 * MiB, WS_W_ODIN = 68 * MiB, WS_W_ODOUT = 86 * MiB, WS_W_GLU = 102 * MiB, WS_W_FFIN = 106 * MiB, WS_W_FFOUT = 278 * MiB;
constexpr size_t WS_H = 364 * MiB, WS_MIX = 396 * MiB, WS_Q = 428 * MiB, WS_K = 444 * MiB, WS_V = 460 * MiB, WS_XB = 476 * MiB, WS_YB = 492 * MiB;
constexpr size_t WS_XC = 508 * MiB, WS_LA = 540 * MiB, WS_LB = 572 * MiB, WS_UFF = 604 * MiB, WS_ACT = 776 * MiB, WS_END = 862 * MiB;
constexpr size_t WS_HALO_F = 508 * MiB, WS_HALO_L = 512 * MiB;
constexpr size_t WS_FPART = 590 * MiB;
constexpr int CW_FIN = 14336;
constexpr size_t WS_HALO_MF = 560 * MiB, WS_HALO_ML = 564 * MiB;
constexpr int SPLIT_EVIN = 128, SPLIT_ODIN = 32, SPLIT_FFIN = 96;
#ifndef TAIL_HEAVY
#define TAIL_HEAVY 0
#endif
#ifndef NARROW_ALL
#define NARROW_ALL 0
#endif
#ifndef CONV_TAILS
#define CONV_TAILS 1
#endif
constexpr size_t WS_XRES = 712 * MiB;
constexpr int CW_BAR = 4096;
constexpr int RING_BYTES = 131072, LDSCTL_OFF = 163584, LDS_BYTES = 163840;

#define GAS __attribute__((address_space(1)))
#define LAS __attribute__((address_space(3)))
typedef unsigned short bf16;
typedef float f32x4 __attribute__((ext_vector_type(4)));
typedef float f32x2 __attribute__((ext_vector_type(2)));
typedef unsigned u32x4 __attribute__((ext_vector_type(4)));
typedef unsigned u32x2 __attribute__((ext_vector_type(2)));
#define LDS_WAIT() asm volatile("s_waitcnt lgkmcnt(0)" ::: "memory")
using pg8::cvt_pk_bf16; using pg8::bf_lo; using pg8::bf_hi; using pg8::gelu_tanh;
__device__ __forceinline__ float wave_sum(float v) {
#pragma unroll
    for (int o = 1; o < 64; o <<= 1) v += __shfl_xor(v, o);
    return v;
}
__device__ __forceinline__ unsigned short f2bf(float f) { return (unsigned short)(cvt_pk_bf16(f, 0.f) & 0xffffu); }
__device__ __forceinline__ float bf2f(unsigned short b) { return __uint_as_float(((unsigned)b) << 16); }

struct Params { const float* in[N_INPUTS]; float* out; unsigned char* ws; int lo, hi, li, pad; };
typedef const __attribute__((address_space(4))) Params* KP;
#define KPREF(P, kp0) KP kp_ = (kp0); asm volatile("" : "+s"(kp_)); const __attribute__((address_space(4))) Params& P = *kp_
#define PHASE_IDS() int tid; asm volatile("v_mbcnt_lo_u32_b32 %0, -1, 0\n\tv_mbcnt_hi_u32_b32 %0, -1, %0" : "=v"(tid)); tid += kwave_ * 64;     const int lane = tid & 63, wave = __builtin_amdgcn_readfirstlane(tid >> 6); int bx = blockIdx.x; asm volatile("" : "+s"(bx)); const int G = gridDim.x; (void)lane; (void)wave; (void)G
#define FRESH_IDS() int ftid; asm volatile("v_mbcnt_lo_u32_b32 %0, -1, 0\n\tv_mbcnt_hi_u32_b32 %0, -1, %0" : "=v"(ftid)); const int flane = ftid, fwave = kwave; ftid += kwave * 64; int fbx = blockIdx.x; asm volatile("" : "+s"(fbx)); (void)flane; (void)fwave
#ifndef TAIL_INPROJ
#define TAIL_INPROJ 1
#endif
#define XB_TMO      128
#define XB_XCNT(j)  (256  + 64 * (j))
#define XB_XSUB(j)  (1280 + 64 * (j))
#define XB_XGEN(j)  (2304 + 64 * (j))
#define XB_TOP      3328
#define XB_TOPGEN   3392
#define XCD_BAR_WORDS 3456
#define XB_SPIN_CAP (1u << 18)
#define LAS __attribute__((address_space(3)))

__device__ __forceinline__ unsigned xb_ld(unsigned* p)              { return __hip_atomic_load(p, __ATOMIC_RELAXED, __HIP_MEMORY_SCOPE_AGENT); }
__device__ __forceinline__ unsigned xb_add(unsigned* p, unsigned v) { return __hip_atomic_fetch_add(p, v, __ATOMIC_RELAXED, __HIP_MEMORY_SCOPE_AGENT); }
__device__ __forceinline__ unsigned xb_xcc_id() { return (unsigned)__builtin_amdgcn_s_getreg((3 << 11) | 20) & 0xFu; }
#define XB_SPIN(cond, bar) do { unsigned _sp = 0; while (cond) { __builtin_amdgcn_s_sleep(1); \
    if ((++_sp & 255u) == 0u) { if (xb_ld(&(bar)[XB_TMO])) break; if (_sp > XB_SPIN_CAP) { atomicAdd(&(bar)[XB_TMO], 1u); break; } } } } while (0)

struct XcdBarrier {
    unsigned* bar; unsigned x; unsigned w0;
    volatile LAS unsigned* st;
};

__device__ __forceinline__ XcdBarrier xcd_barrier_post(unsigned* bar, volatile LAS unsigned* st) {
    XcdBarrier b; b.bar = bar; b.x = xb_xcc_id(); b.st = st;
    if (threadIdx.x == 0) (void)xb_add(&bar[XB_XCNT(b.x)], 1u);
    b.w0 = 0u;
    return b;
}
__device__ __forceinline__ void xcd_barrier_complete(unsigned* bar, unsigned x, unsigned& nloc, unsigned& nx) {
    const unsigned G = gridDim.x * gridDim.y * gridDim.z;
    unsigned sum, cnt, mine, sp = 0u;
    for (;;) {
        sum = 0u; cnt = 0u; mine = 0u;
#pragma unroll
        for (unsigned j = 0; j < 16; ++j) { const unsigned c = xb_ld(&bar[XB_XCNT(j)]); sum += c; cnt += (c > 0u) ? 1u : 0u; mine = (j == x) ? c : mine; }
        if (sum == G) break;
        __builtin_amdgcn_s_sleep(1);
        if ((++sp & 255u) == 0u) { if (xb_ld(&bar[XB_TMO])) break; if (sp > XB_SPIN_CAP) { atomicAdd(&bar[XB_TMO], 1u); break; } }
    }
    nloc = mine > 0u ? mine : 1u; nx = cnt > 0u ? cnt : 1u;
}

__device__ __forceinline__ void xcd_barrier(const XcdBarrier& b) {
    asm volatile("s_waitcnt vmcnt(0)" ::: "memory");
    __syncthreads();
    if (b.w0 != 0u && __builtin_amdgcn_mbcnt_hi(~0u, __builtin_amdgcn_mbcnt_lo(~0u, 0u)) == 0u) {
        unsigned* bar = b.bar;
        __builtin_amdgcn_s_waitcnt(0);
        unsigned nloc = b.st[0], nx = b.st[1];
        if (nloc == 0u) { xcd_barrier_complete(bar, b.x, nloc, nx); b.st[0] = nloc; b.st[1] = nx; }
        const unsigned old = xb_add(&bar[XB_XSUB(b.x)], 1u);
        const unsigned gen = old / nloc;
        if (old + 1u == (gen + 1u) * nloc) {
            __builtin_amdgcn_fence(__ATOMIC_RELEASE, "agent");
            asm volatile("s_waitcnt vmcnt(0)" ::: "memory");
            const unsigned og = xb_add(&bar[XB_TOP], 1u);
            const unsigned tg = og / nx;
            if (og + 1u == (tg + 1u) * nx) xb_add(&bar[XB_TOPGEN], 1u);
            else XB_SPIN(xb_ld(&bar[XB_TOPGEN]) == tg, bar);
            __builtin_amdgcn_fence(__ATOMIC_ACQUIRE, "agent");
            xb_add(&bar[XB_XGEN(b.x)], 1u);
            asm volatile("s_waitcnt vmcnt(0)" ::: "memory");
        } else {
            XB_SPIN(xb_ld(&bar[XB_XGEN(b.x)]) == gen, bar);
            __builtin_amdgcn_fence(__ATOMIC_ACQUIRE, "agent");
            asm volatile("s_waitcnt vmcnt(0)" ::: "memory");
        }
    }
    __syncthreads();
}
__device__ __forceinline__ void sincos_rev(double ang, float& s, float& c) {
    double rev = ang * 0.15915494309189535; rev -= floor(rev); const float fr = (float)rev;
    s = __builtin_amdgcn_sinf(fr); c = __builtin_amdgcn_cosf(fr);
}

constexpr size_t WS_S5TT = 604 * MiB, WS_S5T2 = 690 * MiB, WS_S5A32 = 707 * MiB;
__device__ __forceinline__ void s5_pre(KP kp0, LAS unsigned char* lds, int og, int tid) { KPREF(P, kp0);
    LAS float* apr = (LAS float*)lds; LAS float* api = apr + 33 * 64;
    LAS float* bbr = api + 33 * 64; LAS float* bbi = bbr + 1024;
    LAS float* cre = bbi + 1024; LAS float* cim = cre + 1024;
    LAS float* kern = cim + 1024;
    const int o = og >> 6, g = og & 63;
    const float dt = expf(P.in[I_OD_LOG_DT][og]);
    __syncthreads();
    for (int idx = tid; idx < 33 * 64; idx += 512) { const int k = idx >> 6, p = idx & 63; const float are = P.in[I_OD_A_RE][og * 64 + p], aim = P.in[I_OD_A_IM][og * 64 + p];
        const float er = expf((float)k * are * dt); float s, c; sincos_rev((double)k * (double)aim * (double)dt, s, c); apr[idx] = er * c; api[idx] = er * s; }
    for (int idx = tid; idx < 1024; idx += 512) { cre[idx] = P.in[I_OD_C_RE][(size_t)og * 1024 + idx]; cim[idx] = P.in[I_OD_C_IM][(size_t)og * 1024 + idx]; }
    __syncthreads();
    for (int idx = tid; idx < 1024; idx += 512) { const int p = idx >> 4; const float are = P.in[I_OD_A_RE][og * 64 + p], aim = P.in[I_OD_A_IM][og * 64 + p];
        const float xr = apr[64 + p] - 1.0f, xi = api[64 + p], den = 1.0f / (are * are + aim * aim), cr = (xr * are + xi * aim) * den, ci = (xi * are - xr * aim) * den;
        const float br = P.in[I_OD_B_RE][(size_t)og * 1024 + idx], bi = P.in[I_OD_B_IM][(size_t)og * 1024 + idx];
        bbr[idx] = cr * br - ci * bi; bbi[idx] = cr * bi + ci * br; }
    if (tid < 64) ((f32x2*)(P.ws + WS_S5A32))[og * 64 + tid] = (f32x2){apr[32 * 64 + tid], api[32 * 64 + tid]};
    __syncthreads();
    {
        const int pair = tid & 255, cp = pair >> 4, c = pair & 15, kh = tid >> 8; float acc[16];
#pragma unroll
        for (int kk = 0; kk < 16; ++kk) acc[kk] = 0.f;
        for (int p = 0; p < 64; ++p) { const float gr = cre[cp * 64 + p] * bbr[p * 16 + c] - cim[cp * 64 + p] * bbi[p * 16 + c], gi = cre[cp * 64 + p] * bbi[p * 16 + c] + cim[cp * 64 + p] * bbr[p * 16 + c];
#pragma unroll
            for (int kk = 0; kk < 16; ++kk) acc[kk] += gr * apr[(16 * kh + kk) * 64 + p] - gi * api[(16 * kh + kk) * 64 + p]; }
#pragma unroll
        for (int kk = 0; kk < 16; ++kk) kern[(16 * kh + kk) * 256 + pair] = acc[kk];
    }
    __syncthreads();
    bf16* TT = (bf16*)(P.ws + WS_S5TT) + (size_t)og * 512 * 640; bf16* T2 = (bf16*)(P.ws + WS_S5T2) + (size_t)og * 128 * 512;
    for (int idx = tid; idx < 512 * 64; idx += 512) { const int n = idx >> 6, ic = idx & 63, i = ic >> 1, ch = ic & 1, j = n >> 4, cp = n & 15; float v[8];
#pragma unroll
        for (int cc = 0; cc < 8; ++cc) v[cc] = (j >= i) ? kern[(j - i) * 256 + cp * 16 + 8 * ch + cc] : 0.f;
        u32x4 w; w.x = cvt_pk_bf16(v[0], v[1]); w.y = cvt_pk_bf16(v[2], v[3]); w.z = cvt_pk_bf16(v[4], v[5]); w.w = cvt_pk_bf16(v[6], v[7]);
        *(u32x4*)(TT + (size_t)n * 640 + i * 16 + 8 * ch) = w; }
    for (int idx = tid; idx < 512 * 16; idx += 512) { const int n = idx >> 4, q = idx & 15, j = n >> 4, cp = n & 15, im = q >> 3, p0 = (q & 7) * 8; float v[8];
#pragma unroll
        for (int cc = 0; cc < 8; ++cc) { const int p = p0 + cc; const float ar = apr[(j + 1) * 64 + p], ai = api[(j + 1) * 64 + p], cr = cre[cp * 64 + p], ci = cim[cp * 64 + p];
            v[cc] = im ? -(cr * ai + ci * ar) : (cr * ar - ci * ai); }
        u32x4 w; w.x = cvt_pk_bf16(v[0], v[1]); w.y = cvt_pk_bf16(v[2], v[3]); w.z = cvt_pk_bf16(v[4], v[5]); w.w = cvt_pk_bf16(v[6], v[7]);
        *(u32x4*)(TT + (size_t)n * 640 + 512 + 64 * im + p0) = w; }
    for (int idx = tid; idx < 128 * 64; idx += 512) { const int comp = idx >> 6, ic = idx & 63, i = ic >> 1, ch = ic & 1, p = comp & 63, im = comp >> 6; float v[8];
        const float ar = apr[(31 - i) * 64 + p], ai = api[(31 - i) * 64 + p];
#pragma unroll
        for (int cc = 0; cc < 8; ++cc) { const float br = bbr[p * 16 + 8 * ch + cc], bi = bbi[p * 16 + 8 * ch + cc]; v[cc] = im ? (ar * bi + ai * br) : (ar * br - ai * bi); }
        u32x4 w; w.x = cvt_pk_bf16(v[0], v[1]); w.y = cvt_pk_bf16(v[2], v[3]); w.z = cvt_pk_bf16(v[4], v[5]); w.w = cvt_pk_bf16(v[6], v[7]);
        *(u32x4*)(T2 + (size_t)comp * 512 + i * 16 + 8 * ch) = w; }
}


__device__ __forceinline__ void phase_ada(KP kp0, int kwave_, LAS unsigned char* lds) { KPREF(P, kp0); PHASE_IDS();
    LAS float* cond = (LAS float*)lds;
    LAS float* part = (LAS float*)(lds + 32768);
    const float* c = P.in[I_C];
    for (int i = tid; i < NB * DM; i += 512) { const float v = c[i]; cond[i] = v / (1.0f + __expf(-v)); }
    __syncthreads();
    float* mod = (float*)(P.ws + WS_MOD);
    for (int item = bx; item < 192; item += G) {
        const int l = item / 48, ng = item % 48;
        const float* W = P.in[I_ADA_W] + (size_t)l * DM * 12288 + (size_t)(wave * 256) * 12288 + ng * 256 + lane * 4;
        f32x4 a0 = {0.f, 0.f, 0.f, 0.f}, a1 = a0, a2 = a0, a3 = a0;
#pragma unroll 8
        for (int k = 0; k < 256; ++k) {
            const f32x4 w = *(const f32x4*)(W + (size_t)k * 12288); const int kk = wave * 256 + k;
            a0 += cond[kk] * w; a1 += cond[2048 + kk] * w; a2 += cond[4096 + kk] * w; a3 += cond[6144 + kk] * w;
        }
        LAS float* pp = part + wave * 1024 + lane * 4;
        *(LAS f32x4*)(pp) = a0; *(LAS f32x4*)(pp + 256) = a1; *(LAS f32x4*)(pp + 512) = a2; *(LAS f32x4*)(pp + 768) = a3;
        __syncthreads();
        for (int o = tid; o < 1024; o += 512) {
            float s = 0.f;
#pragma unroll
            for (int w = 0; w < 8; ++w) s += part[w * 1024 + o];
            const int b = o >> 8, cc = o & 255;
            mod[(size_t)(l * 4 + b) * 12288 + ng * 256 + cc] = s + P.in[I_ADA_B][l * 12288 + ng * 256 + cc];
        }
        __syncthreads();
    }
    if (bx >= 192 || G < 256) for (int og = (G < 256 ? bx : bx - 192); og < (G == 256 ? 64 : 128); og += (G < 256 ? G : 64)) s5_pre(kp0, lds, og, tid);
}

__device__ __forceinline__ int cmap(int type, int n) {
    if (type == 1) { if (n >= 2048) return n; const int tile = n >> 8, j = n & 255, bj = j >> 7, jj = j & 127; return tile * 256 + (jj >> 6) * 128 + bj * 64 + (jj & 63); }
    if (type == 2) {
        if (n >= 1280) return n;
        if (n < 1024) { const int tile = n >> 8, j = n & 255, bj = j >> 7, jj = j & 127; return tile * 256 + (jj >> 5) * 64 + bj * 32 + (jj & 31); }
        const int j = n - 1024, bj = j >> 7, jj = j & 127; if (jj < 64) return 1024 + (jj >> 5) * 64 + bj * 32 + (jj & 31); return 1152 + bj * 64 + (jj - 64);
    }
    if (type == 3) { const int tile = n >> 8, j = n & 255; return (j >> 7) * 5504 + tile * 128 + (j & 127); }
    return n;
}
__device__ __forceinline__ void tr_item(const float* W, int K, int N, bf16* WT, int k0, int c0a, int c0b, int dstr0, LAS float* scr, int lane, float* cv, const float* sh) {
    const int csrc = ((lane & 8) ? c0b : c0a) + (lane & 7) * 4, cl = (lane & 15) * 4;
#pragma unroll
    for (int i = 0; i < 16; ++i) { const int kk = 4 * i + (lane >> 4); const f32x4 v = __builtin_nontemporal_load((const f32x4*)(W + (size_t)(k0 + kk) * N + csrc));
        LAS float* d = scr + kk * 65 + cl; d[0] = v[0]; d[1] = v[1]; d[2] = v[2]; d[3] = v[3]; }
    LDS_WAIT(); asm volatile("" ::: "memory");
    const int c = lane & 7;
#pragma unroll
    for (int j = 0; j < 8; ++j) { const int n = (lane >> 3) + 8 * j; const LAS float* s = scr + (8 * c) * 65 + n;
        u32x4 o; o.x = cvt_pk_bf16(s[0 * 65], s[1 * 65]); o.y = cvt_pk_bf16(s[2 * 65], s[3 * 65]); o.z = cvt_pk_bf16(s[4 * 65], s[5 * 65]); o.w = cvt_pk_bf16(s[6 * 65], s[7 * 65]);
        __builtin_nontemporal_store(o, (u32x4*)(WT + (size_t)(dstr0 + n) * K + k0 + 8 * c)); }
    if (cv) { float a0 = 0.f, a1 = 0.f, a2 = 0.f, a3 = 0.f;
        const int s0 = __float_as_int(sh[k0 + lane]), s1 = __float_as_int(sh[12288 + k0 + lane]), s2 = __float_as_int(sh[2 * 12288 + k0 + lane]), s3 = __float_as_int(sh[3 * 12288 + k0 + lane]);
#pragma unroll
        for (int k = 0; k < 64; ++k) { const float w = scr[k * 65 + lane];
            a0 += __int_as_float(__builtin_amdgcn_readlane(s0, k)) * w; a1 += __int_as_float(__builtin_amdgcn_readlane(s1, k)) * w;
            a2 += __int_as_float(__builtin_amdgcn_readlane(s2, k)) * w; a3 += __int_as_float(__builtin_amdgcn_readlane(s3, k)) * w; }
        cv[dstr0 + lane] = a0; cv[N + dstr0 + lane] = a1; cv[2 * N + dstr0 + lane] = a2; cv[3 * N + dstr0 + lane] = a3; }
    LDS_WAIT(); asm volatile("" ::: "memory");
}
constexpr int CONV_EVEN = 11872, CONV_ODD = 10688;
__device__ __forceinline__ int conv_total(int L) { return (L & 1) ? CONV_ODD : CONV_EVEN; }
__device__ __forceinline__ void conv_item(KP kp0, int L, int idx, LAS float* scr, int lane) { KPREF(P, kp0);
    const float* mod = (const float*)(P.ws + WS_MOD) + (size_t)L * 4 * 12288; float* cvpart = (float*)(P.ws + WS_CVPART);
    const int e = L >> 1; const bool odd = (L & 1) != 0;
    int r = idx, in_idx, K, N, ctype = 0, cvo = -1; size_t wsoff; const float* sh = mod; size_t li_off;
    const int n_in = odd ? 1152 : 2560, n_aux = odd ? 256 : 32;
    if (r < n_in) { in_idx = odd ? I_OD_W_IN : I_EV_W_IN; K = 2048; N = odd ? ODD_IN : EVEN_IN; ctype = odd ? 2 : 1; wsoff = odd ? WS_W_ODIN : WS_W_EVIN; cvo = odd ? CV_ODIN + e * 4 * ODD_IN : CV_EVIN + e * 4 * EVEN_IN; li_off = (size_t)e * K * N; }
    else if ((r -= n_in) < n_aux) {
        if (!odd) { const int mat = r >> 1, kb = r & 1, gate = mat & 1, eb = e * 8 + (mat >> 1);
#pragma unroll
            for (int nb = 0; nb < 2; ++nb)
                tr_item(P.in[gate ? I_EV_GX_W : I_EV_GA_W] + (size_t)eb * 16384, 128, 128, (bf16*)(P.ws + WS_WGATE) + ((size_t)eb * 256 + gate * 128) * 128, 64 * kb, 64 * nb, 64 * nb + 32, 64 * nb, scr, lane, nullptr, nullptr);
            return; }
        in_idx = I_OD_GLU_W; K = 1024; N = 1024; wsoff = WS_W_GLU; li_off = (size_t)e * K * N; }
    else if ((r -= n_aux) < 1024) { in_idx = odd ? I_OD_W_OUT : I_EV_W_OUT; K = 2048; N = 2048; wsoff = odd ? WS_W_ODOUT : WS_W_EVOUT; li_off = (size_t)e * K * N; }
    else if ((r -= 1024) < 5504) { in_idx = I_FFN_W_IN; K = 2048; N = DFF2; ctype = 3; wsoff = WS_W_FFIN; cvo = CV_FFIN + L * 4 * DFF2; sh = mod + 3 * DM; li_off = (size_t)L * K * N; }
    else { r -= 5504; in_idx = I_FFN_W_OUT; K = DFF; N = 2048; wsoff = WS_W_FFOUT; li_off = (size_t)L * K * N; }
    const int nblk = N / 64, kb = r / nblk, nb = r % nblk;
    tr_item(P.in[in_idx] + li_off, K, N, (bf16*)(P.ws + wsoff) + li_off, 64 * kb, cmap(ctype, 64 * nb), cmap(ctype, 64 * nb + 32), 64 * nb, scr, lane,
            cvo >= 0 ? cvpart + ((size_t)kb * CV_TOTAL + cvo) : nullptr, sh);
}
__device__ __forceinline__ void conv_range(KP kp0, LAS unsigned char* lds, int L, int first, int last, int rank, int nranks, int wave, int lane) {
    LAS float* scr = (LAS float*)(lds + wave * 16640);
    for (int it = first + rank * 8 + wave; it < last; it += nranks * 8) conv_item(kp0, L, it, scr, lane);
}
__device__ __forceinline__ void cvec_reduce(KP kp0, int L, int bx, int G, int tid) { KPREF(P, kp0);
    const float* cvpart = (const float*)(P.ws + WS_CVPART); float* cvec = (float*)(P.ws + WS_CVEC);
    const int e = L >> 1, n_in = (L & 1) ? 4 * ODD_IN : 4 * EVEN_IN, o_in = (L & 1) ? CV_ODIN + e * 4 * ODD_IN : CV_EVIN + e * 4 * EVEN_IN, o_ff = CV_FFIN + L * 4 * DFF2;
    for (int i = bx * 512 + tid; i < n_in + 4 * DFF2; i += G * 512) { const int off = i < n_in ? o_in + i : o_ff + (i - n_in); float v[32];
#pragma unroll
        for (int kb = 0; kb < 32; ++kb) v[kb] = cvpart[(size_t)kb * CV_TOTAL + off];
        float s = 0.f;
#pragma unroll
        for (int kb = 0; kb < 32; ++kb) s += v[kb];
        cvec[off] = s; }
}
__device__ __forceinline__ void cvec_reduce_l0(KP kp0, const pg8::StaticOrder& S, int bx, int G, int tid) { KPREF(P, kp0);
    const float* cvpart = (const float*)(P.ws + WS_CVPART); float* cvec = (float*)(P.ws + WS_CVEC);
    pg8::Unit u;
    for (int i = 0; S.next(i, u); ++i) if (tid < 256) { const int off = CV_EVIN + (u.pm >> 3) * EVEN_IN + u.pn * 256 + tid; float v[32];
#pragma unroll
        for (int kb = 0; kb < 32; ++kb) v[kb] = cvpart[(size_t)kb * CV_TOTAL + off];
        float s = 0.f;
#pragma unroll
        for (int kb = 0; kb < 32; ++kb) s += v[kb];
        cvec[off] = s; }
    for (int i = bx * 512 + tid; i < 4 * DFF2; i += G * 512) { const int off = CV_FFIN + i; float v[32];
#pragma unroll
        for (int kb = 0; kb < 32; ++kb) v[kb] = cvpart[(size_t)kb * CV_TOTAL + off];
        float s = 0.f;
#pragma unroll
        for (int kb = 0; kb < 32; ++kb) s += v[kb];
        cvec[off] = s; }
    asm volatile("s_waitcnt vmcnt(0)" ::: "memory"); __syncthreads();
}
__device__ __forceinline__ void norm0_rows(KP kp0, int bx, int G, int wave, int lane);
__device__ __forceinline__ int conv_up(int L, bool tails) { return (!tails || !CONV_TAILS) ? conv_total(L) : (L == 0 ? CONV_EVEN : (TAIL_INPROJ ? (TAIL_HEAVY ? 0 : NARROW_ALL ? (L == 1 ? 5568 : (L == 2 ? 3168 : 7104)) : L == 1 ? 3776 : (L == 2 ? 1408 : 5312)) : (L == 2 ? 8064 : 6848))); }
__device__ __forceinline__ void phase_prep(KP kp0, int kwave_, LAS unsigned char* lds, bool tails) { KPREF(P, kp0); PHASE_IDS();
    {
        LAS float* scr = (LAS float*)(lds + wave * 16640);
        const int t0 = conv_up(0, tails), t1 = t0 + conv_up(1, tails), t2 = t1 + conv_up(2, tails), t3 = t2 + conv_up(3, tails);
        for (int it = bx * 8 + wave; it < t3; it += G * 8) { const int L = it < t0 ? 0 : (it < t1 ? 1 : (it < t2 ? 2 : 3)); conv_item(kp0, L, it - (L == 0 ? 0 : (L == 1 ? t0 : (L == 2 ? t1 : t2))), scr, lane); }
    }
    norm0_rows(kp0, bx, G, wave, lane);
    const int gw = bx * 8 + wave, NGW = G * 8; (void)gw; (void)NGW;
    const int gt = bx * 512 + tid, NT = G * 512;
    const int* pos = (const int*)P.in[I_POS];
    float* cosA = (float*)(P.ws + WS_COSA); float* sinA = (float*)(P.ws + WS_SINA); float* cosC = (float*)(P.ws + WS_COSC); float* sinC = (float*)(P.ws + WS_SINC);
    for (int idx = gt; idx < MT * 64; idx += NT) { const int row = idx >> 6, i = idx & 63;
        const double inv = exp2(-(double)i * (13.287712379549449 / 64.0)); float s, c; sincos_rev((double)pos[row] * inv, s, c); cosA[idx] = c; sinA[idx] = s; }
    for (int idx = gt; idx < MT * 32; idx += NT) { const int row = idx >> 5, i = idx & 31;
        const double inv = exp2(-(double)i * (13.287712379549449 / 32.0)); float s, c; sincos_rev((double)pos[row] * inv, s, c); cosC[idx] = c; sinC[idx] = s; }
}

__device__ __forceinline__ void norm0_rows(KP kp0, int bx, int G, int wave, int lane) { KPREF(P, kp0);
    const float* x = P.in[I_X]; const float* gwt = P.in[I_NORM_MIX];
    const float* modl = (const float*)(P.ws + WS_MOD);
    bf16* H = (bf16*)(P.ws + WS_H); float* ss = (float*)(P.ws + WS_SS);
    const int gw = bx * 8 + wave, NGW = G * 8;
    for (int row0 = gw; row0 < MT; row0 += 2 * NGW) {
        f32x4 vv[2][8];
#pragma unroll
        for (int rb = 0; rb < 2; ++rb) { const int row = row0 + rb * NGW < MT ? row0 + rb * NGW : row0; const f32x4* xr = (const f32x4*)(x + (size_t)row * DM) + lane;
#pragma unroll
            for (int j = 0; j < 8; ++j) vv[rb][j] = xr[64 * j]; }
#pragma unroll
        for (int rb = 0; rb < 2; ++rb) { const int row = row0 + rb * NGW; if (row < MT) { float s2 = 0.f;
#pragma unroll
            for (int j = 0; j < 8; ++j) { const f32x4 v = vv[rb][j]; s2 += (v[0] * v[0] + v[1] * v[1]) + (v[2] * v[2] + v[3] * v[3]); }
            s2 = wave_sum(s2); if (lane < 8) ss[(size_t)row * 8 + lane] = lane == 0 ? s2 : 0.f;
            const float* sc = modl + (size_t)(row >> 11) * 12288 + DM;
            u32x2* o8 = (u32x2*)(H + (size_t)row * DM) + lane;
#pragma unroll
            for (int j = 0; j < 8; ++j) { const int col = (lane + 64 * j) * 4;
                const f32x4 y = vv[rb][j] * *(const f32x4*)(gwt + col) * (1.0f + *(const f32x4*)(sc + col));
                u32x2 w; w.x = cvt_pk_bf16(y[0], y[1]); w.y = cvt_pk_bf16(y[2], y[3]); o8[64 * j] = w; } } }
    }
}
__device__ __forceinline__ void phase_final(KP kp0, int kwave_) { KPREF(P, kp0); PHASE_IDS();
    const float* gwt = P.in[I_NORM_FINAL]; const bf16* X = (const bf16*)(P.ws + WS_XRES);
    const int gw = bx * 8 + wave, NGW = G * 8;
    constexpr int RB = 4;
    for (int row0 = gw; row0 < MT; row0 += RB * NGW) {
        u32x4 raw[RB][4];
#pragma unroll
        for (int rb = 0; rb < RB; ++rb) { const int row = row0 + rb * NGW < MT ? row0 + rb * NGW : row0; const u32x4* xr = (const u32x4*)(X + (size_t)row * DM) + lane;
#pragma unroll
            for (int j = 0; j < 4; ++j) raw[rb][j] = xr[64 * j]; }
#pragma unroll
        for (int rb = 0; rb < RB; ++rb) { const int row = row0 + rb * NGW; if (row < MT) {
            f32x4 v[4][2]; float ss = 0.f;
#pragma unroll
            for (int j = 0; j < 4; ++j) { const u32x4 w = raw[rb][j]; v[j][0] = (f32x4){bf_lo(w.x), bf_hi(w.x), bf_lo(w.y), bf_hi(w.y)}; v[j][1] = (f32x4){bf_lo(w.z), bf_hi(w.z), bf_lo(w.w), bf_hi(w.w)};
                ss += ((v[j][0][0] * v[j][0][0] + v[j][0][1] * v[j][0][1]) + (v[j][0][2] * v[j][0][2] + v[j][0][3] * v[j][0][3])) + ((v[j][1][0] * v[j][1][0] + v[j][1][1] * v[j][1][1]) + (v[j][1][2] * v[j][1][2] + v[j][1][3] * v[j][1][3])); }
            const float rstd = rsqrtf(wave_sum(ss) * (1.0f / DM) + 1e-6f);
#pragma unroll
            for (int j = 0; j < 4; ++j) { const int col = (lane + 64 * j) * 8; float* o = P.out + (size_t)row * DM + col;
                *(f32x4*)(o) = v[j][0] * rstd * *(const f32x4*)(gwt + col); *(f32x4*)(o + 4) = v[j][1] * rstd * *(const f32x4*)(gwt + col + 4); } } }
    }
}

__device__ __forceinline__ void ffn_fix_panel(const float* hf, const float* hl, bf16* ACT, const float* cw, const float* cb, int pm, int tid) {
    if ((pm & 7) == 0) return;
#pragma unroll
    for (int it = 0; it < 3; ++it) { const int gq0 = tid + 512 * it, gq = gq0 < DFF / 4 ? gq0 : DFF / 4 - 1; { const int j = 4 * gq;
        f32x4 o[2][2];
#pragma unroll
        for (int bj = 0; bj < 2; ++bj) { const int col = bj * DFF + j;
            const f32x4 l0 = *(const f32x4*)(hl + ((size_t)((pm - 1) * 2 + 0) * 2 + bj) * DFF + j), l1 = *(const f32x4*)(hl + ((size_t)((pm - 1) * 2 + 1) * 2 + bj) * DFF + j);
            const f32x4 f0 = *(const f32x4*)(hf + ((size_t)(pm * 2 + 0) * 2 + bj) * DFF + j), f1 = *(const f32x4*)(hf + ((size_t)(pm * 2 + 1) * 2 + bj) * DFF + j);
            const f32x4 w0 = *(const f32x4*)(cw + col), w1 = *(const f32x4*)(cw + DFF2 + col), w2 = *(const f32x4*)(cw + 2 * DFF2 + col), bb = *(const f32x4*)(cb + col);
            o[0][bj] = bb + w0 * l0 + w1 * l1 + w2 * f0;
            o[1][bj] = bb + w0 * l1 + w1 * f0 + w2 * f1; }
#pragma unroll
        for (int rr = 0; rr < 2; ++rr) { const f32x4 r = pg8::gelu4(o[rr][0]) * o[rr][1]; u32x2 w; w.x = cvt_pk_bf16(r[0], r[1]); w.y = cvt_pk_bf16(r[2], r[3]);
            if (gq0 < DFF / 4) *(u32x2*)(ACT + (size_t)(pm * 256 + rr) * DFF + j) = w; } } }
}
__device__ __forceinline__ bool tile_is_split(const pg8::StaticOrder& T, int pm, int pn) {
    const int nig = pg8::WGM * T.nN, gid = pm / pg8::WGM, fm = gid * pg8::WGM, gsz = (T.nM - fm) < pg8::WGM ? (T.nM - fm) : pg8::WGM;
    const int w2 = gid * nig + pn * gsz + (pm - fm), q = T.nwg / pg8::NXCD, r = T.nwg % pg8::NXCD;
    int xcd, off; if (w2 < r * (q + 1)) { xcd = w2 / (q + 1); off = w2 % (q + 1); } else { const int w = w2 - r * (q + 1); xcd = r + w / q; off = w % q; }
    return off * pg8::NXCD + xcd >= T.nwg - T.nsplit;
}
__device__ __forceinline__ void ffn_fix_mid(const float* hmf, const float* hml, bf16* ACT, const float* cw, const float* cb, const pg8::StaticOrder& T, int pm, int tid) {
    int my_pn = -1, cnt = 0;
    for (int pn = 0; pn < DFF / 128; ++pn) if (tile_is_split(T, pm, pn)) { if ((tid >> 5) == cnt) my_pn = pn; ++cnt; }
    if (my_pn < 0) return;
    const int j = my_pn * 128 + (tid & 31) * 4;
    f32x4 o[2][2];
#pragma unroll
    for (int bj = 0; bj < 2; ++bj) { const int col = bj * DFF + j;
        const f32x4 l0 = *(const f32x4*)(hml + ((size_t)(pm * 2 + 0) * 2 + bj) * DFF + j), l1 = *(const f32x4*)(hml + ((size_t)(pm * 2 + 1) * 2 + bj) * DFF + j);
        const f32x4 f0 = *(const f32x4*)(hmf + ((size_t)(pm * 2 + 0) * 2 + bj) * DFF + j), f1 = *(const f32x4*)(hmf + ((size_t)(pm * 2 + 1) * 2 + bj) * DFF + j);
        const f32x4 w0 = *(const f32x4*)(cw + col), w1 = *(const f32x4*)(cw + DFF2 + col), w2 = *(const f32x4*)(cw + 2 * DFF2 + col), bb = *(const f32x4*)(cb + col);
        o[0][bj] = bb + w0 * l0 + w1 * l1 + w2 * f0;
        o[1][bj] = bb + w0 * l1 + w1 * f0 + w2 * f1; }
#pragma unroll
    for (int rr = 0; rr < 2; ++rr) { const f32x4 r = pg8::gelu4(o[rr][0]) * o[rr][1]; u32x2 w; w.x = cvt_pk_bf16(r[0], r[1]); w.y = cvt_pk_bf16(r[2], r[3]);
        *(u32x2*)(ACT + (size_t)(pm * 256 + 128 + rr) * DFF + j) = w; }
}

#define ATT_FENCE() do { asm volatile("" ::: "memory"); __builtin_amdgcn_sched_barrier(0); } while (0)
__device__ __forceinline__ float xhalf_max(float x) { auto rr = __builtin_amdgcn_permlane32_swap(__float_as_uint(x), __float_as_uint(x), false, false); return fmaxf(__uint_as_float(rr[0]), __uint_as_float(rr[1])); }
__device__ __forceinline__ float xhalf_sum(float x) { auto rr = __builtin_amdgcn_permlane32_swap(__float_as_uint(x), __float_as_uint(x), false, false); return __uint_as_float(rr[0]) + __uint_as_float(rr[1]); }
typedef short s16x4 __attribute__((ext_vector_type(4)));
typedef short bf16x8v __attribute__((ext_vector_type(8)));
typedef float f32x16 __attribute__((ext_vector_type(16)));
__device__ __forceinline__ unsigned offb(unsigned row, unsigned ch) { return 256u * row + 16u * (ch ^ (((row & 3u) << 2) | ((row >> 2) & 3u))); }
constexpr int ATT_TILE_BYTES = 64 * 256, ATT_BUF_BYTES = 2 * ATT_TILE_BYTES;
__device__ __forceinline__ bf16x8v cat8(const s16x4 a, const s16x4 b) { return (bf16x8v){a[0], a[1], a[2], a[3], b[0], b[1], b[2], b[3]}; }

template <int MODE>
__device__ __forceinline__ void phase_attn(KP kp0, int kwave_, LAS unsigned char* lds, int o_idx, int u0 = -1, int us = 0, int u1 = 0) { KPREF(P, kp0); PHASE_IDS();
    constexpr int NKS = MODE == 0 ? 8 : 4;
    constexpr int NDT = MODE == 0 ? 4 : 2;
    constexpr int NH = 1;
    const bf16* Q = (const bf16*)(P.ws + WS_Q); const bf16* K = (const bf16*)(P.ws + WS_K); const bf16* V = (const bf16*)(P.ws + WS_V); bf16* MIX = (bf16*)(P.ws + WS_MIX);
    const int r = lane & 31, hh = lane >> 5, q4 = (lane & 15) >> 2, p4 = lane & 3, blk = (lane >> 4) & 1;
    unsigned kaddr[NKS], vaddr[2][NDT];
    { const unsigned x = ((r & 3u) << 2) | ((r >> 2) & 3u);
#pragma unroll
      for (int s = 0; s < NKS; ++s) kaddr[s] = 256u * r + 16u * (((unsigned)(2 * s + hh)) ^ x);
#pragma unroll
      for (int t = 0; t < 2; ++t)
#pragma unroll
        for (int c = 0; c < NDT; ++c) { const unsigned row = 8u * t + 4u * hh + q4, ch = 4u * c + 2u * blk + (p4 >> 1);
            vaddr[t][c] = 256u * row + 16u * (ch ^ (((row & 3u) << 2) | ((row >> 2) & 3u))) + 8u * (p4 & 1); } }
    const int nunits = MODE == 0 ? 256 : 512;
    LAS float* wt = (LAS float*)(lds + RING_BYTES);
    if (MODE == 0) { for (int j = tid; j < 1280; j += 512) { const int d = 1023 - j; const int cnt = (d <= 128 ? 1 : 0) + (((d & 3) == 0 && d <= 512) ? 1 : 0) + ((d & 15) == 0 ? 1 : 0); wt[j] = (d >= 0) ? (float)cnt : 0.f; }
        __syncthreads(); }
    if (u0 < 0) { u0 = bx; us = G; u1 = nunits; }
    for (int unit = u0; unit < u1; unit += us) {
        int b, head0, q0, kt0, kt1; size_t kvbase; int kvpitch; unsigned kx = 0u;
        if (MODE == 0) { const int qb = 7 - (unit >> 5), bh = unit & 31; b = bh >> 3; head0 = bh & 7; q0 = qb * 256; kt0 = qb >= 2 ? 4 * (qb - 2) : 0; kt1 = qb * 4 + 3; kvbase = (size_t)b * SEQ * 1024 + head0 * 128; kvpitch = 1024; }
        else { b = unit >> 7; const int kvh = (unit >> 6) & 1; kx = 128u * kvh; q0 = (unit & 63) * 32; head0 = 8 * kvh + wave; kt0 = (q0 >= 127 ? q0 - 127 : 0) >> 6; kt1 = (q0 + 31) >> 6; kvbase = (size_t)b * SEQ * 128; kvpitch = 128; }
        const int tq = MODE == 0 ? q0 + 16 * (r & 15) + 2 * wave + (r >> 4) : q0 + r;
        const size_t qrow = (size_t)b * SEQ + tq;
        bf16x8v qf[NH][NKS];
#pragma unroll
        for (int hd = 0; hd < NH; ++hd)
#pragma unroll
            for (int s = 0; s < NKS; ++s) qf[hd][s] = *(const bf16x8v*)(Q + qrow * 1024 + (MODE == 0 ? head0 * 128 : (head0 + hd) * 64) + 16 * s + 8 * hh);
        f32x16 O[NH][NDT]; float m[NH], l[NH];
#pragma unroll
        for (int hd = 0; hd < NH; ++hd) { m[hd] = -1e30f; l[hd] = 0.f;
#pragma unroll
            for (int c = 0; c < NDT; ++c)
#pragma unroll
                for (int i = 0; i < 16; ++i) O[hd][c][i] = 0.f; }
        const int srow = tid >> 4, sch = tid & 15;
        const unsigned soff0 = offb(srow, sch), soff1 = offb(srow + 32, sch);
        u32x4 kreg[2], vreg[2];
        if (MODE == 1) {
            u32x4 kq[3][2], vq[3][2];
#pragma unroll
            for (int j = 0; j < 3; ++j) { const int kt = (kt0 + j <= kt1) ? kt0 + j : kt1; const size_t g0 = kvbase + (size_t)(kt * 64 + srow) * kvpitch + sch * 8, g1 = g0 + (size_t)32 * kvpitch;
                kq[j][0] = *(const u32x4*)(K + g0); kq[j][1] = *(const u32x4*)(K + g1); vq[j][0] = *(const u32x4*)(V + g0); vq[j][1] = *(const u32x4*)(V + g1); }
            __syncthreads();
#pragma unroll
            for (int j = 0; j < 3; ++j) { LAS unsigned char* tb = lds + j * ATT_BUF_BYTES;
                *(LAS u32x4*)(tb + soff0) = kq[j][0]; *(LAS u32x4*)(tb + soff1) = kq[j][1]; *(LAS u32x4*)(tb + ATT_TILE_BYTES + soff0) = vq[j][0]; *(LAS u32x4*)(tb + ATT_TILE_BYTES + soff1) = vq[j][1]; }
            __syncthreads();
        } else {
        { const size_t g0 = kvbase + (size_t)(kt0 * 64 + srow) * kvpitch + sch * 8, g1 = g0 + (size_t)32 * kvpitch;
          kreg[0] = *(const u32x4*)(K + g0); kreg[1] = *(const u32x4*)(K + g1); vreg[0] = *(const u32x4*)(V + g0); vreg[1] = *(const u32x4*)(V + g1); }
        __syncthreads();
        *(LAS u32x4*)(lds + soff0) = kreg[0]; *(LAS u32x4*)(lds + soff1) = kreg[1];
        *(LAS u32x4*)(lds + ATT_TILE_BYTES + soff0) = vreg[0]; *(LAS u32x4*)(lds + ATT_TILE_BYTES + soff1) = vreg[1];
        __syncthreads();
        }
        for (int kt = kt0; kt <= kt1; ++kt) {
            const int cur = MODE == 1 ? (kt - kt0) : ((kt - kt0) & 1);
            LAS unsigned char* kb_ = lds + cur * ATT_BUF_BYTES; LAS unsigned char* vb_ = kb_ + ATT_TILE_BYTES;
            if (MODE == 0 && kt < kt1) { const size_t g0 = kvbase + (size_t)((kt + 1) * 64 + srow) * kvpitch + sch * 8, g1 = g0 + (size_t)32 * kvpitch;
                kreg[0] = *(const u32x4*)(K + g0); kreg[1] = *(const u32x4*)(K + g1); vreg[0] = *(const u32x4*)(V + g0); vreg[1] = *(const u32x4*)(V + g1); }
            {
                const int dq = tq - 64 * kt - 4 * hh;
#pragma unroll
                for (int hd = 0; hd < NH; ++hd) {
                    f32x16 S[2];
#pragma unroll
                    for (int kb = 0; kb < 2; ++kb) {
                        bf16x8v kfr[NKS];
#pragma unroll
                        for (int s = 0; s < NKS; ++s) kfr[s] = *(const LAS bf16x8v*)(kb_ + (kaddr[s] ^ kx) + kb * 8192);
                        ATT_FENCE();
#pragma unroll
                        for (int i = 0; i < 16; ++i) S[kb][i] = 0.f;
#pragma unroll
                        for (int s = 0; s < NKS; ++s) S[kb] = __builtin_amdgcn_mfma_f32_32x32x16_bf16(kfr[s], qf[hd][s], S[kb], 0, 0, 0);
                        ATT_FENCE();
                    }
                    s16x4 vq[2][NDT][2];
#define ATT_RDV(buf, kbv, s2v) do { _Pragma("unroll") for (int c = 0; c < NDT; ++c) { \
                        vq[buf][c][0] = __builtin_amdgcn_ds_read_tr16_b64_v4i16((LAS s16x4*)(vb_ + (vaddr[0][c] ^ kx) + 256 * (32 * (kbv) + 16 * (s2v)))); \
                        vq[buf][c][1] = __builtin_amdgcn_ds_read_tr16_b64_v4i16((LAS s16x4*)(vb_ + (vaddr[1][c] ^ kx) + 256 * (32 * (kbv) + 16 * (s2v)))); } } while (0)
                    float w[2][16]; float tmax = -INFINITY;
#pragma unroll
                    for (int kb = 0; kb < 2; ++kb)
#pragma unroll
                        for (int i = 0; i < 16; ++i) { const int e = kb * 32 + (i & 3) + 8 * (i >> 2), d = dq - e;
                            if (MODE == 0) w[kb][i] = wt[1023 - dq + e];
                            else w[kb][i] = (d >= 0 && d <= 127) ? 1.f : 0.f;
                            S[kb][i] = (w[kb][i] > 0.f) ? S[kb][i] : -INFINITY; tmax = fmaxf(tmax, S[kb][i]); }
                    tmax = xhalf_max(tmax);
                    const float mn = fmaxf(m[hd], tmax), corr = __builtin_amdgcn_exp2f(m[hd] - mn); m[hd] = mn;
                    float ps = 0.f;
#pragma unroll
                    for (int kb = 0; kb < 2; ++kb)
#pragma unroll
                        for (int i = 0; i < 16; ++i) { const float pv = w[kb][i] * __builtin_amdgcn_exp2f(S[kb][i] - mn); S[kb][i] = pv; ps += pv; }
                    l[hd] = l[hd] * corr + ps;
                    ATT_FENCE();
                    ATT_RDV(0, 0, 0); ATT_RDV(1, 0, 1);
                    ATT_FENCE();
#pragma unroll
                    for (int c = 0; c < NDT; ++c)
#pragma unroll
                        for (int i = 0; i < 16; ++i) O[hd][c][i] *= corr;
#pragma unroll
                    for (int kb = 0; kb < 2; ++kb)
#pragma unroll
                        for (int s2 = 0; s2 < 2; ++s2) {
                            bf16x8v pf; { const unsigned a0 = cvt_pk_bf16(S[kb][8 * s2 + 0], S[kb][8 * s2 + 1]), a1 = cvt_pk_bf16(S[kb][8 * s2 + 2], S[kb][8 * s2 + 3]),
                                                         a2 = cvt_pk_bf16(S[kb][8 * s2 + 4], S[kb][8 * s2 + 5]), a3 = cvt_pk_bf16(S[kb][8 * s2 + 6], S[kb][8 * s2 + 7]);
                                pf = __builtin_bit_cast(bf16x8v, (u32x4){a0, a1, a2, a3}); }
#pragma unroll
                            for (int c = 0; c < NDT; ++c) O[hd][c] = __builtin_amdgcn_mfma_f32_32x32x16_bf16(cat8(vq[s2][c][0], vq[s2][c][1]), pf, O[hd][c], 0, 0, 0);
                            ATT_FENCE();
                            if (kb == 0) { if (s2 == 0) ATT_RDV(0, 1, 0); else ATT_RDV(1, 1, 1); }
                            ATT_FENCE();
                        }
#undef ATT_RDV
                }
            }
            if (MODE == 0 && kt < kt1) { LAS unsigned char* nb_ = lds + (cur ^ 1) * ATT_BUF_BYTES;
                *(LAS u32x4*)(nb_ + soff0) = kreg[0]; *(LAS u32x4*)(nb_ + soff1) = kreg[1];
                *(LAS u32x4*)(nb_ + ATT_TILE_BYTES + soff0) = vreg[0]; *(LAS u32x4*)(nb_ + ATT_TILE_BYTES + soff1) = vreg[1]; }
            if (MODE == 0) __syncthreads();
        }
        if (MODE == 0 && kt0 > 0) {
            LAS unsigned char* pk = lds + wave * 16384; LAS unsigned char* pv = pk + 8192;
            const int nfar = 4 * kt0;
            for (int s = 0; s * 16 < nfar; ++s) {
#pragma unroll
                for (int jh = 0; jh < 2; ++jh) { u32x4 kf[4], vf[4];
#pragma unroll
                    for (int j = 0; j < 4; ++j) { const int row = (lane >> 4) + 4 * (4 * jh + j), keypos = 2 * wave + (row >> 4) + 16 * (16 * s + (row & 15)); const size_t g0 = kvbase + (size_t)keypos * kvpitch + (lane & 15) * 8;
                        kf[j] = *(const u32x4*)(K + g0); vf[j] = *(const u32x4*)(V + g0); }
#pragma unroll
                    for (int j = 0; j < 4; ++j) { const unsigned so = offb((lane >> 4) + 4 * (4 * jh + j), lane & 15); *(LAS u32x4*)(pk + so) = kf[j]; *(LAS u32x4*)(pv + so) = vf[j]; } }
                f32x16 S;
#pragma unroll
                for (int i = 0; i < 16; ++i) S[i] = 0.f;
                { bf16x8v kfr[NKS];
#pragma unroll
                  for (int s8 = 0; s8 < NKS; ++s8) kfr[s8] = *(const LAS bf16x8v*)(pk + kaddr[s8]);
                  ATT_FENCE();
#pragma unroll
                  for (int s8 = 0; s8 < NKS; ++s8) S = __builtin_amdgcn_mfma_f32_32x32x16_bf16(kfr[s8], qf[0][s8], S, 0, 0, 0); }
                s16x4 vf2[2][NDT][2];
#pragma unroll
                for (int s2 = 0; s2 < 2; ++s2)
#pragma unroll
                    for (int c = 0; c < NDT; ++c) { vf2[s2][c][0] = __builtin_amdgcn_ds_read_tr16_b64_v4i16((LAS s16x4*)(pv + vaddr[0][c] + 256 * (16 * s2))); vf2[s2][c][1] = __builtin_amdgcn_ds_read_tr16_b64_v4i16((LAS s16x4*)(pv + vaddr[1][c] + 256 * (16 * s2))); }
                ATT_FENCE();
                float tmax = -INFINITY;
#pragma unroll
                for (int i = 0; i < 16; ++i) { const bool ok = (i >> 3) == (r >> 4); S[i] = ok ? S[i] : -INFINITY; tmax = fmaxf(tmax, S[i]); }
                tmax = xhalf_max(tmax);
                const float mn = fmaxf(m[0], tmax), corr = __builtin_amdgcn_exp2f(m[0] - mn); m[0] = mn;
                float ps = 0.f;
#pragma unroll
                for (int i = 0; i < 16; ++i) { const float pvv = __builtin_amdgcn_exp2f(S[i] - mn); S[i] = pvv; ps += pvv; }
                l[0] = l[0] * corr + ps;
#pragma unroll
                for (int c = 0; c < NDT; ++c)
#pragma unroll
                    for (int i = 0; i < 16; ++i) O[0][c][i] *= corr;
#pragma unroll
                for (int s2 = 0; s2 < 2; ++s2) {
                    bf16x8v pf; { const unsigned a0 = cvt_pk_bf16(S[8 * s2 + 0], S[8 * s2 + 1]), a1 = cvt_pk_bf16(S[8 * s2 + 2], S[8 * s2 + 3]), a2 = cvt_pk_bf16(S[8 * s2 + 4], S[8 * s2 + 5]), a3 = cvt_pk_bf16(S[8 * s2 + 6], S[8 * s2 + 7]);
                        pf = __builtin_bit_cast(bf16x8v, (u32x4){a0, a1, a2, a3}); }
#pragma unroll
                    for (int c = 0; c < NDT; ++c) O[0][c] = __builtin_amdgcn_mfma_f32_32x32x16_bf16(cat8(vf2[s2][c][0], vf2[s2][c][1]), pf, O[0][c], 0, 0, 0);
                }
            }
        }
#pragma unroll
        for (int hd = 0; hd < NH; ++hd) {
            float lt = xhalf_sum(l[hd]);
            if (MODE == 1) lt += __builtin_amdgcn_exp2f(P.in[I_OD_SINKS][o_idx * 16 + head0 + hd] * LOG2E - m[hd]);
            const float inv = 1.0f / lt;
            bf16* orow = MIX + qrow * 2048 + (MODE == 0 ? head0 * 128 : (head0 + hd) * 64);
#pragma unroll
            for (int c = 0; c < NDT; ++c)
#pragma unroll
                for (int g4 = 0; g4 < 4; ++g4) { u32x2 o; o.x = cvt_pk_bf16(O[hd][c][4 * g4 + 0] * inv, O[hd][c][4 * g4 + 1] * inv); o.y = cvt_pk_bf16(O[hd][c][4 * g4 + 2] * inv, O[hd][c][4 * g4 + 3] * inv);
                    *(u32x2*)(orow + 32 * c + 8 * g4 + 4 * hh) = o; }
        }
    }
    __syncthreads();
}
#define S5_FENCE() do { asm volatile("" ::: "memory"); __builtin_amdgcn_sched_barrier(0); } while (0)
__device__ __forceinline__ void phase_s5(KP kp0, int kwave_, LAS unsigned char* lds, int o_idx) { KPREF(P, kp0); PHASE_IDS();
    const bf16* Ug = (const bf16*)(P.ws + WS_XB); bf16* Z = (bf16*)(P.ws + WS_YB);
    constexpr int UP = 1296;
    LAS unsigned char* uc = lds; LAS float* eL = (LAS float*)(lds + 64 * UP);
    const int r = lane & 31, hh = lane >> 5;
    for (int bg = bx; bg < 256; bg += G) { const int b = bg >> 6, g = bg & 63, og = o_idx * 64 + g;
        const bf16* TT = (const bf16*)(P.ws + WS_S5TT) + (size_t)og * 512 * 640; const bf16* T2 = (const bf16*)(P.ws + WS_S5T2) + (size_t)og * 128 * 512;
        __syncthreads();
        { const int row = tid >> 3, piece = tid & 7; const bf16* src = Ug + ((size_t)g * MT + (size_t)b * SEQ + 32 * row) * 16 + piece * 64;
#pragma unroll
          for (int q = 0; q < 8; ++q) *(LAS u32x4*)(uc + row * UP + (piece * 8 + q) * 16) = *(const u32x4*)(src + q * 8); }
        __syncthreads();
        {
            const int rt = wave & 1, ct = wave >> 1; f32x16 acc;
#pragma unroll
            for (int i = 0; i < 16; ++i) acc[i] = 0.f;
            const bf16* bp = T2 + (size_t)(32 * ct + r) * 512 + 8 * hh;
            bf16x8v bq[32];
#pragma unroll
            for (int s = 0; s < 32; ++s) bq[s] = *(const bf16x8v*)(bp + 16 * s);
            asm volatile("" ::: "memory");
#pragma unroll
            for (int sb = 0; sb < 4; ++sb) { bf16x8v afr[8];
#pragma unroll
                for (int j = 0; j < 8; ++j) afr[j] = *(const LAS bf16x8v*)(uc + (32 * rt + r) * UP + 32 * (8 * sb + j) + 16 * hh);
                S5_FENCE();
#pragma unroll
                for (int j = 0; j < 8; ++j) acc = __builtin_amdgcn_mfma_f32_32x32x16_bf16(afr[j], bq[8 * sb + j], acc, 0, 0, 0);
                S5_FENCE(); }
#pragma unroll
            for (int i = 0; i < 16; ++i) eL[(32 * rt + (i & 3) + 8 * (i >> 2) + 4 * hh) * 128 + 32 * ct + r] = acc[i];
        }
        __syncthreads();
        const bf16* bp0 = TT + (size_t)(32 * wave + r) * 640 + 8 * hh; const bf16* bp1 = bp0 + (size_t)256 * 640;
        bf16x8v bq[2][5][2];
#pragma unroll
        for (int s = 0; s < 5; ++s) { bq[0][s][0] = *(const bf16x8v*)(bp0 + 16 * s); bq[0][s][1] = *(const bf16x8v*)(bp1 + 16 * s); }
        const float dsk = P.in[I_OD_D][o_idx * 1024 + g * 16 + (r & 15)];
        if (wave == 0) { const f32x2 a32 = ((const f32x2*)(P.ws + WS_S5A32))[og * 64 + lane]; float hr = 0.f, hi = 0.f;
            for (int c8 = 0; c8 < 64; c8 += 8) { float er[8], ei[8];
#pragma unroll
                for (int j = 0; j < 8; ++j) { er[j] = eL[(c8 + j) * 128 + lane]; ei[j] = eL[(c8 + j) * 128 + 64 + lane]; }
#pragma unroll
                for (int j = 0; j < 8; ++j) { const int ch = c8 + j; *(LAS unsigned short*)(uc + ch * UP + 1024 + lane * 2) = f2bf(hr); *(LAS unsigned short*)(uc + ch * UP + 1152 + lane * 2) = f2bf(hi);
                    const float nr = a32[0] * hr - a32[1] * hi + er[j], ni = a32[0] * hi + a32[1] * hr + ei[j]; hr = nr; hi = ni; } } }
        __syncthreads();
        {
            f32x16 acc[2][2];
#pragma unroll
            for (int a = 0; a < 2; ++a)
#pragma unroll
                for (int c = 0; c < 2; ++c)
#pragma unroll
                    for (int i = 0; i < 16; ++i) acc[a][c][i] = 0.f;
#pragma unroll
            for (int bt = 0; bt < 8; ++bt) {
                if (bt < 7) {
#pragma unroll
                    for (int s = 0; s < 5; ++s) { bq[(bt + 1) & 1][s][0] = *(const bf16x8v*)(bp0 + 16 * (5 * (bt + 1) + s)); bq[(bt + 1) & 1][s][1] = *(const bf16x8v*)(bp1 + 16 * (5 * (bt + 1) + s)); } }
                asm volatile("" ::: "memory");
                bf16x8v a0r[5], a1r[5];
#pragma unroll
                for (int s8 = 0; s8 < 5; ++s8) { const int s = 5 * bt + s8; a0r[s8] = *(const LAS bf16x8v*)(uc + r * UP + 32 * s + 16 * hh); a1r[s8] = *(const LAS bf16x8v*)(uc + (32 + r) * UP + 32 * s + 16 * hh); }
                S5_FENCE();
#pragma unroll
                for (int s8 = 0; s8 < 5; ++s8) { const bf16x8v b0 = bq[bt & 1][s8][0], b1 = bq[bt & 1][s8][1], a0 = a0r[s8], a1 = a1r[s8];
                    acc[0][0] = __builtin_amdgcn_mfma_f32_32x32x16_bf16(a0, b0, acc[0][0], 0, 0, 0); acc[1][0] = __builtin_amdgcn_mfma_f32_32x32x16_bf16(a1, b0, acc[1][0], 0, 0, 0);
                    acc[0][1] = __builtin_amdgcn_mfma_f32_32x32x16_bf16(a0, b1, acc[0][1], 0, 0, 0); acc[1][1] = __builtin_amdgcn_mfma_f32_32x32x16_bf16(a1, b1, acc[1][1], 0, 0, 0); }
                S5_FENCE();
            }
            __syncthreads();
#pragma unroll
            for (int cti = 0; cti < 2; ++cti) { const int n = 32 * (wave + 8 * cti) + r;
                unsigned short uu[2][16];
#pragma unroll
                for (int rt = 0; rt < 2; ++rt)
#pragma unroll
                    for (int i = 0; i < 16; ++i) { const int ch = 32 * rt + (i & 3) + 8 * (i >> 2) + 4 * hh; uu[rt][i] = *(const LAS unsigned short*)(uc + ch * UP + n * 2); }
                S5_FENCE();
#pragma unroll
                for (int rt = 0; rt < 2; ++rt)
#pragma unroll
                    for (int i = 0; i < 16; ++i) { const int ch = 32 * rt + (i & 3) + 8 * (i >> 2) + 4 * hh; LAS unsigned short* up = (LAS unsigned short*)(uc + ch * UP + n * 2);
                        *up = f2bf(gelu_tanh(acc[rt][cti][i] + dsk * bf2f(uu[rt][i]))); }
                S5_FENCE(); }
            __syncthreads();
            { u32x4 zz[8];
#pragma unroll
              for (int q = 0; q < 8; ++q) { const int p = tid + 512 * q, t = p >> 1, hf = p & 1; zz[q] = *(const LAS u32x4*)(uc + (t >> 5) * UP + ((t & 31) * 16 + hf * 8) * 2); }
#pragma unroll
              for (int q = 0; q < 8; ++q) { const int p = tid + 512 * q, t = p >> 1, hf = p & 1; *(u32x4*)(Z + ((size_t)b * SEQ + t) * 1024 + g * 16 + hf * 8) = zz[q]; } }
        }
    }
}

constexpr size_t WS_XCV = 572 * MiB;
constexpr int CW_LRU = 8192;
__device__ __forceinline__ void lru_conv_slice(KP kp0, int kwave_, int e) { KPREF(P, kp0); PHASE_IDS();
    const bf16* XB = (const bf16*)(P.ws + WS_XB); bf16* XC = (bf16*)(P.ws + WS_XCV); unsigned* cnt = (unsigned*)(P.ws + WS_CTL) + CW_LRU;
    const int cg = tid & 15, rg = tid >> 4;
    const int sl0 = G == 256 ? (bx >= 192 ? (bx - 192) * 4 : 256) : bx, sl1 = G == 256 ? sl0 + 4 : 256, sls = G == 256 ? 1 : G;
    for (int sl = sl0; sl < sl1 && sl < 256; sl += sls) { const int b = sl >> 6, blk = (sl >> 3) & 7, t0 = (sl & 7) * 256;
        float cw[4][8], cb[8];
#pragma unroll
        for (int q = 0; q < 8; ++q) { cb[q] = P.in[I_EV_CONV_B][e * 1024 + blk * 128 + cg * 8 + q];
#pragma unroll
            for (int i = 0; i < 4; ++i) cw[i][q] = P.in[I_EV_CONV_W][(size_t)(e * 4 + i) * 1024 + blk * 128 + cg * 8 + q]; }
        u32x4 xin[11];
#pragma unroll
        for (int i = 0; i < 11; ++i) { const int tt = t0 + 8 * rg - 3 + i; xin[i] = (tt >= 0) ? *(const u32x4*)(XB + (size_t)(b * SEQ + tt) * 1024 + blk * 128 + cg * 8) : (u32x4){0u, 0u, 0u, 0u}; }
#pragma unroll
        for (int j = 0; j < 8; ++j) { float o[8];
#pragma unroll
            for (int q = 0; q < 8; ++q) o[q] = cb[q];
#pragma unroll
            for (int i = 0; i < 4; ++i) { const u32x4 x = xin[j + i];
                o[0] += cw[i][0] * bf_lo(x.x); o[1] += cw[i][1] * bf_hi(x.x); o[2] += cw[i][2] * bf_lo(x.y); o[3] += cw[i][3] * bf_hi(x.y);
                o[4] += cw[i][4] * bf_lo(x.z); o[5] += cw[i][5] * bf_hi(x.z); o[6] += cw[i][6] * bf_lo(x.w); o[7] += cw[i][7] * bf_hi(x.w); }
            const unsigned long long lo = (unsigned long long)cvt_pk_bf16(o[0], o[1]) | ((unsigned long long)cvt_pk_bf16(o[2], o[3]) << 32), hi = (unsigned long long)cvt_pk_bf16(o[4], o[5]) | ((unsigned long long)cvt_pk_bf16(o[6], o[7]) << 32);
            unsigned long long* dst = (unsigned long long*)(XC + (size_t)(b * SEQ + t0 + 8 * rg + j) * 1024 + blk * 128 + cg * 8);
            __hip_atomic_store(dst, lo, __ATOMIC_RELAXED, __HIP_MEMORY_SCOPE_AGENT); __hip_atomic_store(dst + 1, hi, __ATOMIC_RELAXED, __HIP_MEMORY_SCOPE_AGENT); }
        asm volatile("s_waitcnt vmcnt(0)" ::: "memory");
        __syncthreads();
        if (tid == 0) (void)__hip_atomic_fetch_add(cnt + ((e * 4 + b) * 8 + blk) * 16, 1u, __ATOMIC_RELAXED, __HIP_MEMORY_SCOPE_AGENT);
    }
}
__device__ __forceinline__ void phase_lru(KP kp0, int kwave_, LAS unsigned char* lds, int e) { KPREF(P, kp0); PHASE_IDS();
    const bf16* XC = (const bf16*)(P.ws + WS_XCV); const bf16* YB = (const bf16*)(P.ws + WS_YB); bf16* MIX = (bf16*)(P.ws + WS_MIX);
    LAS unsigned char* xcL = lds;
    LAS float* aL = (LAS float*)(lds + 69632); LAS float* bL = (LAS float*)(lds + 86016);
    LAS float* sA = (LAS float*)(lds + 102400); LAS float* sB = (LAS float*)(lds + 104448);
    LAS float* carry = (LAS float*)(lds + 106496);
    const int c16 = lane & 15, kq = lane >> 4, cg = tid & 15, rg = tid >> 4;
    for (int item = bx; item < 256; item += G) { const int b = item >> 6, blk = (item >> 3) & 7, oct = item & 7, ch0 = blk * 128 + oct * 16;
        bf16x8v bfr[4], bfi[4];
        { const bf16* wg = (const bf16*)(P.ws + WS_WGATE) + ((size_t)(e * 8 + blk) * 256 + oct * 16 + c16) * 128 + 8 * kq;
#pragma unroll
          for (int s = 0; s < 4; ++s) { bfr[s] = *(const bf16x8v*)(wg + 32 * s); bfi[s] = *(const bf16x8v*)(wg + 128 * 128 + 32 * s); } }
        const float gab = P.in[I_EV_GA_B][e * 1024 + ch0 + c16], gxb = P.in[I_EV_GX_B][e * 1024 + ch0 + c16];
        const float sp8 = -8.0f * log1pf(expf(-P.in[I_EV_LAMBDA][e * 1024 + ch0 + c16]));
        if (tid < 16) carry[tid] = 0.f;
        {
            unsigned* cnt = (unsigned*)(P.ws + WS_CTL) + CW_LRU + ((e * 4 + b) * 8 + blk) * 16;
            if (wave == 0) { unsigned sp = 0; while (__hip_atomic_load(cnt, __ATOMIC_RELAXED, __HIP_MEMORY_SCOPE_AGENT) < 8u && ++sp < (1u << 22)) __builtin_amdgcn_s_sleep(1);
                __builtin_amdgcn_fence(__ATOMIC_ACQUIRE, "agent"); asm volatile("s_waitcnt vmcnt(0)" ::: "memory"); }
            __syncthreads(); }
        u32x4 xq[8];
#pragma unroll
        for (int j = 0; j < 8; ++j) xq[j] = *(const u32x4*)(XC + (size_t)(b * SEQ + 8 * rg + j) * 1024 + blk * 128 + cg * 8);
        for (int tc = 0; tc < 8; ++tc) { const int t0 = tc * 256;
#pragma unroll
            for (int j = 0; j < 8; ++j) *(LAS u32x4*)(xcL + (8 * rg + j) * 272 + cg * 16) = xq[j];
            if (tc < 7) {
#pragma unroll
                for (int j = 0; j < 8; ++j) xq[j] = *(const u32x4*)(XC + (size_t)(b * SEQ + t0 + 256 + 8 * rg + j) * 1024 + blk * 128 + cg * 8); }
            float ybv[8];
#pragma unroll
            for (int i = 0; i < 8; ++i) ybv[i] = bf2f(YB[(size_t)(b * SEQ + t0 + 8 * rg + i) * 1024 + ch0 + cg]);
            __syncthreads();
            bf16x8v afg[2][4];
#pragma unroll
            for (int rb = 0; rb < 2; ++rb)
#pragma unroll
                for (int s2 = 0; s2 < 4; ++s2) afg[rb][s2] = *(const LAS bf16x8v*)(xcL + (32 * wave + 16 * rb + c16) * 272 + 64 * s2 + 16 * kq);
            asm volatile("" ::: "memory"); __builtin_amdgcn_sched_barrier(0);
#pragma unroll
            for (int rb = 0; rb < 2; ++rb) { const int row0 = 32 * wave + 16 * rb;
                f32x4 accr = {0.f, 0.f, 0.f, 0.f}, acci = {0.f, 0.f, 0.f, 0.f};
#pragma unroll
                for (int s2 = 0; s2 < 4; ++s2) { const bf16x8v af = afg[rb][s2];
                    accr = __builtin_amdgcn_mfma_f32_16x16x32_bf16(af, bfr[s2], accr, 0, 0, 0); acci = __builtin_amdgcn_mfma_f32_16x16x32_bf16(af, bfi[s2], acci, 0, 0, 0); }
#pragma unroll
                for (int i = 0; i < 4; ++i) { const int row = row0 + 4 * kq + i;
                    const float rr = 1.0f / (1.0f + __expf(-(accr[i] + gab))), ig = 1.0f / (1.0f + __expf(-(acci[i] + gxb)));
                    const float a = __expf(sp8 * rr), mult = sqrtf(fmaxf(1.0f - a * a, 0.f));
                    const float xv = bf2f(*(const LAS unsigned short*)(xcL + row * 272 + (oct * 16 + c16) * 2));
                    aL[row * 16 + c16] = a; bL[row * 16 + c16] = mult * ig * xv; }
            }
            __syncthreads();
            float av[8], bv[8], A = 1.f, B = 0.f;
#pragma unroll
            for (int i = 0; i < 8; ++i) { av[i] = aL[(8 * rg + i) * 16 + cg]; bv[i] = bL[(8 * rg + i) * 16 + cg]; B = av[i] * B + bv[i]; A *= av[i]; }
            { const float a1 = __shfl_up(A, 16), b1 = __shfl_up(B, 16); if (lane >= 16) { B = A * b1 + B; A = A * a1; }
              const float a2 = __shfl_up(A, 32), b2 = __shfl_up(B, 32); if (lane >= 32) { B = A * b2 + B; A = A * a2; } }
            if (lane >= 48) { sA[wave * 16 + cg] = A; sB[wave * 16 + cg] = B; }
            const float ape = __shfl_up(A, 16), bpe = __shfl_up(B, 16);
            __syncthreads();
            float h = carry[(tc & 1) * 16 + cg];
            for (int w = 0; w < wave; ++w) h = sA[w * 16 + cg] * h + sB[w * 16 + cg];
            if (lane >= 16) h = ape * h + bpe;
#pragma unroll
            for (int i = 0; i < 8; ++i) { h = av[i] * h + bv[i];
                MIX[(size_t)(b * SEQ + t0 + 8 * rg + i) * 2048 + 1024 + ch0 + cg] = f2bf(h * ybv[i]); }
            if (rg == 31 && tc < 7) carry[((tc + 1) & 1) * 16 + cg] = h;
        }
    }
}

constexpr int N_PHASES = 2 + 11 * NLAYER + 1;
#ifndef NREP_G
#define NREP_G 1
#endif
#ifndef NREP_M
#define NREP_M 1
#endif
#ifndef NREP_L
#define NREP_L 1
#endif
#ifndef NREP_MB
#define NREP_MB 1
#endif
#ifndef NREP_BAR
#define NREP_BAR 1
#endif
#ifndef PROBE_FFN_STORE
#define PROBE_FFN_STORE 0
#endif
#ifndef NREP_GF
#define NREP_GF 1
#endif
#ifndef NREP_GO
#define NREP_GO 1
#endif
#ifndef NREP_E
#define NREP_E 1
#endif
#ifndef NREP_P
#define NREP_P 1
#endif
#ifndef TAIL_INPROJ
#define TAIL_INPROJ 1
#endif
#ifndef SIDE_BY_SIDE
#define SIDE_BY_SIDE 1
#endif
#ifndef PROBE_R
#define PROBE_R 0
#define PROBE_N 2048
#define PROBE_SPLIT 0
#endif
#ifndef NARROW_ALL
#define NARROW_ALL 0
#endif
#define NARROW_L(l) (NARROW_ALL || (l) == NLAYER - 1)
#ifndef TAIL_HEAVY
#define TAIL_HEAVY 0
#endif
#define TH(a, b) (TAIL_HEAVY ? (a) : (b))
#define NA(a, b) (NARROW_ALL ? (a) : (b))
#ifndef NREP_FIX
#define NREP_FIX 1
#endif
#ifndef FUSE_FINAL
#define FUSE_FINAL 1
#endif
#ifndef MK_ONE_LAUNCH
#define MK_ONE_LAUNCH 1
#endif
__global__ void __launch_bounds__(512, 2) fwd(Params P) {
    extern __shared__ __attribute__((aligned(16))) unsigned char lds_raw[];
    LAS unsigned char* lds = (LAS unsigned char*)lds_raw;
    const int kwave = __builtin_amdgcn_readfirstlane((int)threadIdx.x >> 6);
    for (int u = threadIdx.x; u < (LDS_BYTES - LDSCTL_OFF) / 4; u += 512) ((LAS unsigned*)(lds + LDSCTL_OFF))[u] = 0u;
    __syncthreads();
    const KP kp = (KP)__builtin_amdgcn_kernarg_segment_ptr();
    const int ph_lo = kp->lo, ph_hi = kp->hi;
    unsigned* barw = (unsigned*)(kp->ws + WS_CTL) + CW_BAR + kp->li * XCD_BAR_WORDS;
    XcdBarrier bar; bar.bar = barw; bar.x = 0; bar.w0 = 0u; bar.st = nullptr;
    if (ph_hi - ph_lo > 1) bar = xcd_barrier_post(barw, (volatile LAS unsigned*)(lds + LDSCTL_OFF + 64));
    bar.w0 = (kwave == 0) ? 1u : 0u;
    const bool g256 = gridDim.x == 256;
    const bool tails = g256 && CONV_TAILS;
#define RUN(p) (ph_lo <= (p) && (p) < ph_hi)
#define SEAM(p) do { if (RUN(p) && RUN((p) + 1)) for (int rb_ = 0; rb_ < NREP_BAR; ++rb_) xcd_barrier(bar); } while (0)

    if (RUN(0)) for (int rep = 0; rep < NREP_P; ++rep) phase_ada(kp, kwave, lds);
    SEAM(0);
    if (RUN(1)) for (int rep = 0; rep < NREP_P; ++rep) phase_prep(kp, kwave, lds, tails);
    SEAM(1);
    for (int l = 0; l < NLAYER; ++l) {
        const int pb = 2 + 11 * l, e = l >> 1; const bool odd = (l & 1) != 0;
        if (RUN(pb + 1)) for (int rep = 0; rep < NREP_G; ++rep) { KPREF(P, kp); const int kwave_ = kwave; PHASE_IDS(); const bf16* H = (const bf16*)(P.ws + WS_H); bf16* Qb = (bf16*)(P.ws + WS_Q);
            if (!odd) { pg8::Gemm g{H, (const bf16*)(P.ws + WS_W_EVIN) + (size_t)e * EVEN_IN * DM, MT, EVEN_IN, DM}; pg8::PrefetchOrder S; S.init(MT, EVEN_IN, G, bx); S.ssp = (const float*)(P.ws + WS_SS) + (size_t)(2 * l) * MT * 8; S.buf = lds + RING_BYTES + 8192; S.wave = wave; S.ui = 0;
                if (l == 0 && rep == 0) cvec_reduce_l0(kp, S, bx, G, tid);
                pg8::EpiEvenIn E{Qb, (const float*)(P.ws + WS_COSA), (const float*)(P.ws + WS_SINA), QSCALE_A, lds + RING_BYTES + 8192, (const float*)(P.ws + WS_CVEC) + CV_EVIN + (size_t)e * 4 * EVEN_IN, (LAS float*)(lds + RING_BYTES + 6144)};
                pg8::gemm_phase<pg8::EpiEvenIn, pg8::PrefetchOrder, true, true>(lds, g, S, E, tid);
                { FRESH_IDS();
                if (tails && rep + 1 == NREP_G && fbx >= 128) {
                    if (l == 0) { if (TAIL_INPROJ) conv_range(kp, lds, 1, TH(0, NA(5568, 3776)), TH(4608, NA(8640, 6848)), fbx - 128, 128, fwave, flane); }
                    else if (fbx < 192) s5_pre(kp, lds, 64 + fbx - 128, ftid);
                    else if (TAIL_INPROJ) conv_range(kp, lds, 3, TH(2304, NA(7104, 5312)), TH(4608, NA(8640, 6848)), fbx - 192, 64, fwave, flane); } } }
            else { pg8::Gemm g{H, (const bf16*)(P.ws + WS_W_ODIN) + (size_t)e * ODD_IN * DM, MT, ODD_IN, DM}; pg8::PrefetchOrder S; S.init(MT, ODD_IN, G, bx, (g256 && NARROW_L(l)) ? SPLIT_ODIN : 0); S.ssp = (const float*)(P.ws + WS_SS) + (size_t)(2 * l) * MT * 8; S.buf = lds + RING_BYTES + 8192; S.wave = wave; S.ui = 0;
                pg8::EpiOddIn E{Qb, (bf16*)(P.ws + WS_K), (bf16*)(P.ws + WS_V), (bf16*)(P.ws + WS_XB), (const float*)(P.ws + WS_COSC), (const float*)(P.ws + WS_SINC), QSCALE_C, lds + RING_BYTES + 8192, (const float*)(P.ws + WS_CVEC) + CV_ODIN + (size_t)e * 4 * ODD_IN, (LAS float*)(lds + RING_BYTES + 6144)};
                pg8::gemm_phase<pg8::EpiOddIn, pg8::PrefetchOrder, true, true, true>(lds, g, S, E, tid);
                { FRESH_IDS(); if (TAIL_INPROJ && tails && rep + 1 == NREP_G && l == 1 && fbx >= NA(64, 32)) conv_range(kp, lds, 2, TH(0, NA(3168, 1408)), NA(8544, 6784), fbx - NA(64, 32), NA(192, 224), fwave, flane);
                  if (!tails && g256 && rep + 1 == NREP_G && l == 1 && fbx >= 192) s5_pre(kp, lds, 64 + fbx - 192, ftid); } }
        }
        SEAM(pb + 1);
        if (RUN(pb + 2)) for (int rep = 0; rep < (odd ? 1 : NREP_M); ++rep) { if (!odd) { if (rep == 0) lru_conv_slice(kp, kwave, e); phase_attn<0>(kp, kwave, lds, 0); } else if (!SIDE_BY_SIDE || !g256) phase_attn<1>(kp, kwave, lds, e); }
        if (RUN(pb + 3)) for (int rep = 0; rep < (odd ? NREP_MB : NREP_L); ++rep) { if (!odd) phase_lru(kp, kwave, lds, e); else phase_s5(kp, kwave, lds, e); }
        SEAM(pb + 3);
        if (RUN(pb + 4)) {
            if (odd) for (int rep = 0; rep < NREP_G; ++rep) { KPREF(P, kp); const int kwave_ = kwave; PHASE_IDS(); const bf16* YBb = (const bf16*)(P.ws + WS_YB); bf16* MIX = (bf16*)(P.ws + WS_MIX); pg8::Gemm g{YBb, (const bf16*)(P.ws + WS_W_GLU) + (size_t)e * 1024 * 1024, MT, 1024, 1024}; pg8::StaticOrder S; S.init(MT, 1024, G, bx);
                pg8::EpiGlu E{YBb, MIX, P.in[I_OD_GLU_B] + e * 1024};
                pg8::gemm_phase<pg8::EpiGlu, pg8::StaticOrder, true, true>(lds, g, S, E, tid);
                if (SIDE_BY_SIDE && g256 && rep + 1 == NREP_G) {
                    const int ab = blockIdx.x; if (ab >= 128) phase_attn<1>(kp, kwave, lds, e, ab - 128, 128, 384); else phase_attn<1>(kp, kwave, lds, e, 384 + ab, 128, 512); }
                { FRESH_IDS(); if (TAIL_INPROJ && tails && rep + 1 == NREP_G && l == 1 && fbx >= 128) conv_range(kp, lds, 2, NA(8544, 6784), NA(9824, 8064), fbx - 128, 128, fwave, flane); } }
        }
        if (odd) SEAM(pb + 4);
        if (RUN(pb + 6)) for (int rep = 0; rep < NREP_G * NREP_GO; ++rep) { KPREF(P, kp); const int kwave_ = kwave; PHASE_IDS(); const bf16* MIX = (const bf16*)(P.ws + WS_MIX); const float* mod = (const float*)(P.ws + WS_MOD);
            const bf16* W = odd ? (const bf16*)(P.ws + WS_W_ODOUT) + (size_t)e * DM * DM : (const bf16*)(P.ws + WS_W_EVOUT) + (size_t)e * DM * DM;
            pg8::Gemm g{MIX, W, MT, DM, DM}; pg8::StaticOrder S; S.init(MT, DM, G, bx);
            const bool dry = rep + 1 < NREP_G * NREP_GO;
            pg8::EpiResid E{l == 0 ? P.in[I_X] : nullptr, (const bf16*)(P.ws + WS_XRES), dry ? (bf16*)(P.ws + 710 * MiB) : (bf16*)(P.ws + WS_XRES), nullptr, mod + (size_t)l * 4 * 12288 + 2 * DM, dry ? nullptr : (bf16*)(P.ws + WS_H), P.in[I_NORM_FFN] + l * DM, mod + (size_t)l * 4 * 12288 + 4 * DM, (float*)(P.ws + WS_SS) + (size_t)(2 * l + 1) * MT * 8, (LAS float*)(lds + RING_BYTES)};
            pg8::gemm_phase<pg8::EpiResid, pg8::StaticOrder, true, true>(lds, g, S, E, tid);
        }
        SEAM(pb + 6);
        if (RUN(pb + 8)) for (int rep = 0; rep < NREP_G * NREP_GF; ++rep) { KPREF(P, kp); const int kwave_ = kwave; PHASE_IDS(); const bf16* H = (const bf16*)(P.ws + WS_H);
            pg8::Gemm g{H, (const bf16*)(P.ws + WS_W_FFIN) + (size_t)l * DFF2 * DM, MT, DFF2, DM}; pg8::PrefetchOrder S; S.init(MT, DFF2, G, bx, (g256 && NARROW_L(l)) ? SPLIT_FFIN : 0); S.ssp = (const float*)(P.ws + WS_SS) + (size_t)(2 * l + 1) * MT * 8; S.buf = lds + RING_BYTES + 8192; S.wave = wave; S.ui = 0;
            pg8::EpiFfnIn E{(bf16*)(P.ws + WS_ACT), (float*)(P.ws + WS_HALO_F), (float*)(P.ws + WS_HALO_L), (WS_HALO_MF - WS_HALO_F) / 4, P.in[I_FFN_CONV_W] + (size_t)l * 3 * DFF2, P.in[I_FFN_CONV_B] + (size_t)l * DFF2, (LAS float*)(lds + RING_BYTES), lds + RING_BYTES + 8192, (const float*)(P.ws + WS_CVEC) + CV_FFIN + (size_t)l * 4 * DFF2};
#if PROBE_FFN_STORE
            if (rep + 1 < NREP_G * NREP_GF) { pg8::EpiStore E2{(bf16*)(P.ws + WS_UFF), DFF2}; pg8::gemm_phase<pg8::EpiStore, pg8::PrefetchOrder, true, true>(lds, g, S, E2, tid); } else
#endif
            pg8::gemm_phase<pg8::EpiFfnIn, pg8::PrefetchOrder, true, true, true>(lds, g, S, E, tid);
            { FRESH_IDS(); if (tails && rep + 1 == NREP_G * NREP_GF && l + 1 < NLAYER && fbx >= NA(192, 96)) { conv_range(kp, lds, l + 1, NA(conv_total(l + 1) - 2048, l == 1 ? 8064 : TH(4608, 6848)), conv_total(l + 1), fbx - NA(192, 96), NA(64, 160), fwave, flane); if (TAIL_HEAVY && l == 1) conv_range(kp, lds, 3, 0, 2304, fbx - 96, 160, fwave, flane); } }
        }
        SEAM(pb + 8);
        if (RUN(pb + 10) && l == NLAYER - 1 && g256 && FUSE_FINAL) { KPREF(P, kp); const int kwave_ = kwave; PHASE_IDS(); const bf16* ACT = (const bf16*)(P.ws + WS_ACT); const float* mod = (const float*)(P.ws + WS_MOD);
            pg8::Gemm g{ACT, (const bf16*)(P.ws + WS_W_FFOUT) + (size_t)l * DM * DFF, MT, DM, DFF}; pg8::StaticOrder S; S.init(MT, DM, G, bx);
            { pg8::Unit fu; int lastpm = -1; for (int i = 0; S.next(i, fu); ++i) if (fu.pm != lastpm) { lastpm = fu.pm;
                ffn_fix_panel((const float*)(P.ws + WS_HALO_F), (const float*)(P.ws + WS_HALO_L), (bf16*)(P.ws + WS_ACT), P.in[I_FFN_CONV_W] + (size_t)l * 3 * DFF2, P.in[I_FFN_CONV_B] + (size_t)l * DFF2, fu.pm, tid);
                if (NARROW_L(l)) { pg8::StaticOrder T; T.init(MT, DFF2, G, bx, SPLIT_FFIN); ffn_fix_mid((const float*)(P.ws + WS_HALO_MF), (const float*)(P.ws + WS_HALO_ML), (bf16*)(P.ws + WS_ACT), P.in[I_FFN_CONV_W] + (size_t)l * 3 * DFF2, P.in[I_FFN_CONV_B] + (size_t)l * DFF2, T, fu.pm, tid); } }
              asm volatile("s_waitcnt vmcnt(0)" ::: "memory"); __syncthreads(); }
            pg8::EpiFinal EF{(const bf16*)(P.ws + WS_XRES), mod + (size_t)l * 4 * 12288 + 5 * DM, P.in[I_NORM_FINAL], P.out, (float*)(P.ws + WS_FPART), (unsigned*)(P.ws + WS_CTL) + CW_FIN, (LAS float*)(lds + RING_BYTES), (LAS float*)(lds + RING_BYTES + 6144)};
            pg8::gemm_phase<pg8::EpiFinal, pg8::StaticOrder, true, true>(lds, g, S, EF, tid);
        } else
        if (RUN(pb + 10)) for (int rep = 0; rep < NREP_G; ++rep) { KPREF(P, kp); const int kwave_ = kwave; PHASE_IDS(); const bf16* ACT = (const bf16*)(P.ws + WS_ACT); const float* mod = (const float*)(P.ws + WS_MOD);
            pg8::Gemm g{ACT, (const bf16*)(P.ws + WS_W_FFOUT) + (size_t)l * DM * DFF, MT, DM, DFF}; pg8::StaticOrder S; S.init(MT, DM, G, bx);
            if (l + 1 < NLAYER && rep == 0) cvec_reduce(kp, l + 1, bx, G, tid);
            for (int rfix = 0; rfix < NREP_FIX; ++rfix) { pg8::Unit fu; int lastpm = -1; for (int i = 0; S.next(i, fu); ++i) if (fu.pm != lastpm) { lastpm = fu.pm;
                ffn_fix_panel((const float*)(P.ws + WS_HALO_F), (const float*)(P.ws + WS_HALO_L), (bf16*)(P.ws + WS_ACT), P.in[I_FFN_CONV_W] + (size_t)l * 3 * DFF2, P.in[I_FFN_CONV_B] + (size_t)l * DFF2, fu.pm, tid);
                if (g256 && NARROW_L(l)) { pg8::StaticOrder T; T.init(MT, DFF2, G, bx, SPLIT_FFIN); ffn_fix_mid((const float*)(P.ws + WS_HALO_MF), (const float*)(P.ws + WS_HALO_ML), (bf16*)(P.ws + WS_ACT), P.in[I_FFN_CONV_W] + (size_t)l * 3 * DFF2, P.in[I_FFN_CONV_B] + (size_t)l * DFF2, T, fu.pm, tid); } }
              asm volatile("s_waitcnt vmcnt(0)" ::: "memory"); __syncthreads(); }
            const bool dry = rep + 1 < NREP_G, last = l == NLAYER - 1;
            pg8::EpiResid E{nullptr, (const bf16*)(P.ws + WS_XRES), dry ? (bf16*)(P.ws + 710 * MiB) : (bf16*)(P.ws + WS_XRES), nullptr, mod + (size_t)l * 4 * 12288 + 5 * DM, (dry || last) ? nullptr : (bf16*)(P.ws + WS_H), P.in[I_NORM_MIX] + (last ? l : l + 1) * DM, mod + (size_t)(last ? l : l + 1) * 4 * 12288 + DM, (float*)(P.ws + WS_SS) + (size_t)(2 * l + 2) * MT * 8, (LAS float*)(lds + RING_BYTES)};
            pg8::gemm_phase<pg8::EpiResid, pg8::StaticOrder, true, true>(lds, g, S, E, tid);
        }
        SEAM(pb + 10);
    }
#if PROBE_R
    for (int rep = 0; rep < PROBE_R; ++rep) { KPREF(P, kp); const int kwave_ = kwave; PHASE_IDS();
        pg8::Gemm g{(const bf16*)(P.ws + WS_H), (const bf16*)(P.ws + WS_W_FFIN), MT, PROBE_N, DM}; pg8::StaticOrder S; S.init(MT, PROBE_N, G, bx, PROBE_SPLIT);
        pg8::EpiStore E{(bf16*)(P.ws + WS_Q), PROBE_N};
        pg8::gemm_phase<pg8::EpiStore, pg8::StaticOrder, true, true, PROBE_SPLIT != 0>(lds, g, S, E, tid); xcd_barrier(bar); }
#endif
    if (RUN(N_PHASES - 1) && !(g256 && FUSE_FINAL)) phase_final(kp, kwave);
#undef RUN
#undef SEAM
}

extern "C" void kernel_launch(void* const* d_in, const int* in_sizes, int n_in, void* d_out, int out_size, void* d_ws, size_t ws_size, hipStream_t stream) {
    static int grid = 0;
    if (grid == 0) {
        if (n_in != N_INPUTS || out_size != MT * DM || ws_size < WS_END) { fprintf(stderr, "kernel_launch: unexpected shapes: n_in %d out %d ws %zu (need %zu)\n", n_in, out_size, ws_size, (size_t)WS_END); grid = -1; return; }
        int dev = 0, cus = 0, per_cu = 0;
        if (hipGetDevice(&dev) != hipSuccess || hipDeviceGetAttribute(&cus, hipDeviceAttributeMultiprocessorCount, dev) != hipSuccess) { grid = -1; return; }
        if (hipFuncSetAttribute((const void*)fwd, hipFuncAttributeMaxDynamicSharedMemorySize, LDS_BYTES) != hipSuccess) { fprintf(stderr, "kernel_launch: hipFuncSetAttribute failed\n"); grid = -1; return; }
        if (hipOccupancyMaxActiveBlocksPerMultiprocessor(&per_cu, (const void*)fwd, 512, LDS_BYTES) != hipSuccess || per_cu < 1) fprintf(stderr, "kernel_launch: occupancy query says %d\n", per_cu);
        (void)hipGetLastError();
        grid = cus;
    }
    if (grid < 0) return;
    if (hipMemsetAsync((char*)d_ws + WS_CTL, 0, CTL_ZERO_BYTES, stream) != hipSuccess) return;
    Params p{};
    for (int i = 0; i < N_INPUTS; ++i) p.in[i] = (const float*)d_in[i];
    p.out = (float*)d_out; p.ws = (unsigned char*)d_ws; p.pad = 0;
#if MK_ONE_LAUNCH
    p.lo = 0; p.hi = N_PHASES; p.li = 0;
    hipLaunchKernelGGL(fwd, dim3(grid), dim3(512), LDS_BYTES, stream, p);
#else
    for (int ph = 0; ph < N_PHASES; ++ph) { p.lo = ph; p.hi = ph + 1; p.li = 0; hipLaunchKernelGGL(fwd, dim3(grid), dim3(512), LDS_BYTES, stream, p); }
#endif
    const hipError_t le = hipPeekAtLastError();
    if (le != hipSuccess) fprintf(stderr, "kernel_launch: launch failed: %s\n", hipGetErrorName(le));
}
```
